# Optimizing an MI355X kernel written in HIP

```python
import math
import jax, jax.numpy as jnp
from jax import lax
import numpy as np

D_MODEL = 2048
BATCH = 4
SEQ = 2048
DEPTH = 2
DEC_BATCH = 8
DEC_SEQ = 64
PAST_LEN = 1024

CHUNK = 64
BLOCK = 16
N_EVEN = (DEPTH + 1) // 2
N_ODD = DEPTH // 2

H_A = 4
DK_A = 128
DV_A = 256
ROPE_BASE = 10000.0
H_B = 8
DK_B = 128
DV_B = 128
H_C = 4
DK_C = 256
DV_C = 512
GK_RANK = 16
GATE_NORMALIZER = 16.0
D_FF = 5504
CONV_W = 3
EPS = 1e-6

QA = H_A * DK_A
VA = H_A * DV_A
QB = H_B * DK_B
VB = H_B * DV_B
D_IN_EVEN = 2 * QA + 2 * VA + 2 * QB + 2 * VB
D_MIX_EVEN = VA + VB
SPLITS_EVEN = (QA, 2 * QA, 2 * QA + VA, 2 * QA + 2 * VA,
               2 * QA + 2 * VA + QB, 2 * QA + 2 * VA + 2 * QB, 2 * QA + 2 * VA + 2 * QB + VB)
QC = H_C * DK_C
VC = H_C * DV_C
D_IN_ODD = 2 * QC + 2 * VC + GK_RANK
SPLITS_ODD = (QC, 2 * QC, 2 * QC + VC, 2 * QC + 2 * VC)

kernel_name = "hybrid_retention_hgrn2_gla_convglu_stream_step"


def rmsnorm(x, w):
    xf = x.astype(jnp.float32)
    y = xf * lax.rsqrt(jnp.mean(xf * xf, axis=-1, keepdims=True) + EPS)
    return (y * w.astype(jnp.float32)).astype(x.dtype)


def head_groupnorm(x):
    xf = x.astype(jnp.float32)
    mu = jnp.mean(xf, axis=-1, keepdims=True)
    var = jnp.mean(jnp.square(xf - mu), axis=-1, keepdims=True)
    return ((xf - mu) * lax.rsqrt(var + EPS)).astype(x.dtype)


def rotary(x, pos):
    half = x.shape[-1] // 2
    inv = ROPE_BASE ** (-jnp.arange(half, dtype=jnp.float32) / half)
    ang = pos.astype(jnp.float32)[:, None] * inv[None, :]
    cos = jnp.cos(ang)[None, :, None, :]
    sin = jnp.sin(ang)[None, :, None, :]
    xf = x.astype(jnp.float32)
    x1, x2 = xf[..., :half], xf[..., half:]
    return jnp.concatenate([x1 * cos - x2 * sin, x1 * sin + x2 * cos], axis=-1).astype(x.dtype)


def gated_linear_recurrence(q, k, v, log_g, s0):
    B, T, H, K = q.shape
    V = v.shape[-1]
    n = -(-T // BLOCK)
    pad = n * BLOCK - T

    def prep(a):
        a = jnp.pad(a.astype(jnp.float32), ((0, 0), (0, pad), (0, 0), (0, 0)))
        return a.reshape(B, n, BLOCK, H, a.shape[-1]).transpose(1, 0, 3, 2, 4)

    qb, kb, vb, gb = prep(q), prep(k), prep(v), prep(log_g)
    b = jnp.cumsum(gb, axis=3)
    b_last = b[:, :, :, -1:, :]
    q_in = qb * jnp.exp(b)
    k_in = kb * jnp.exp(-b)
    k_out = kb * jnp.exp(b_last - b)
    causal = jnp.tril(jnp.ones((BLOCK, BLOCK), dtype=bool))
    scores = jnp.where(causal, jnp.einsum('nbhlk,nbhsk->nbhls', q_in, k_in), 0.0)
    o_intra = jnp.einsum('nbhls,nbhsv->nbhlv', scores, vb)

    def step(S, xs):
        q_i, k_o, v_i, dec = xs
        o_inter = jnp.einsum('bhlk,bhkv->bhlv', q_i, S)
        S = jnp.exp(dec)[..., 0, :, None] * S + jnp.einsum('bhlk,bhlv->bhkv', k_o, v_i)
        return S, o_inter

    s_final, o_inter = lax.scan(step, s0.astype(jnp.float32), (q_in, k_out, vb, b_last))
    o = (o_intra + o_inter).transpose(1, 0, 3, 2, 4).reshape(B, n * BLOCK, H, V)[:, :T]
    return o.astype(v.dtype), s_final.astype(s0.dtype)


def even_mixer(h, pos, s_ret, s_hgrn, w_in, w_out, hgrn_gnorm, lb):
    B, T, _ = h.shape
    q_a, k_a, v_a, g_a, q_b, f_b, i_b, g_b = jnp.split(h @ w_in, SPLITS_EVEN, axis=-1)
    q_a = rotary(q_a.reshape(B, T, H_A, DK_A), pos)
    k_a = rotary(k_a.reshape(B, T, H_A, DK_A), pos) * (DK_A ** -0.5)
    log_gamma = jnp.log1p(-jnp.exp2(-5.0 - jnp.arange(H_A, dtype=jnp.float32)))
    log_g_a = jnp.broadcast_to(log_gamma[None, None, :, None], (B, T, H_A, DK_A))
    o_a, s_ret_new = gated_linear_recurrence(q_a, k_a, v_a.reshape(B, T, H_A, DV_A), log_g_a, s_ret)
    o_a = head_groupnorm(o_a).reshape(B, T, VA) * jax.nn.silu(g_a)
    q_b = jax.nn.silu(q_b).reshape(B, T, H_B, DK_B) * (DK_B ** -0.5)
    f = lb + (1.0 - lb) * jax.nn.sigmoid(f_b.astype(jnp.float32))
    k_b = (1.0 - f).reshape(B, T, H_B, DK_B)
    log_f = jnp.log(f).reshape(B, T, H_B, DK_B)
    o_b, s_hgrn_new = gated_linear_recurrence(q_b, k_b, i_b.reshape(B, T, H_B, DV_B), log_f, s_hgrn)
    o_b = rmsnorm(o_b, hgrn_gnorm).reshape(B, T, VB) * jax.nn.silu(g_b)
    y = jnp.concatenate([o_a, o_b], axis=-1) @ w_out
    return y, s_ret_new, s_hgrn_new


def odd_mixer(h, s_gla, w_in, w_gk2, b_gk2, gla_gnorm, w_out):
    B, T, _ = h.shape
    q, k, v, g, gk_low = jnp.split(h @ w_in, SPLITS_ODD, axis=-1)
    q = q.reshape(B, T, H_C, DK_C) * (DK_C ** -0.5)
    k = k.reshape(B, T, H_C, DK_C)
    log_g = jax.nn.log_sigmoid((gk_low @ w_gk2 + b_gk2).astype(jnp.float32)) / GATE_NORMALIZER
    o, s_new = gated_linear_recurrence(q, k, v.reshape(B, T, H_C, DV_C), log_g.reshape(B, T, H_C, DK_C), s_gla)
    o = rmsnorm(o, gla_gnorm).reshape(B, T, VC) * jax.nn.silu(g)
    return o @ w_out, s_new


def conv_ffn(h, conv_buf, w_up, conv_w, conv_b, w_down):
    a, u = jnp.split(h @ w_up, 2, axis=-1)
    T = a.shape[1]
    a_ext = jnp.concatenate([conv_buf.astype(a.dtype), a], axis=1)
    a_conv = conv_b + sum(a_ext[:, j:j + T] * conv_w[j] for j in range(CONV_W))
    y = (jax.nn.silu(a_conv) * u) @ w_down
    return y, a_ext[:, -(CONV_W - 1):]


def run_group(x, pos, s_ret, s_hgrn, s_gla, s_conv, norm_mix, norm_ffn, norm_final,
              w_in_even, w_out_even, hgrn_lb, hgrn_gnorm, w_in_odd, w_gk2, b_gk2, gla_gnorm,
              w_out_odd, ffn_w_up, ffn_conv_w, ffn_conv_b, ffn_w_down):
    lb_all = jnp.cumsum(jax.nn.softmax(hgrn_lb.astype(jnp.float32), axis=0), axis=0)
    new_ret, new_hgrn, new_gla, new_conv = [], [], [], []
    h = x
    for l in range(DEPTH):
        i = l // 2
        hn = rmsnorm(h, norm_mix[l])
        if l % 2 == 0:
            y, sr, sh = even_mixer(hn, pos, s_ret[i], s_hgrn[i], w_in_even[i], w_out_even[i],
                                   hgrn_gnorm[i], lb_all[l])
            new_ret.append(sr)
            new_hgrn.append(sh)
        else:
            y, sg = odd_mixer(hn, s_gla[i], w_in_odd[i], w_gk2[i], b_gk2[i], gla_gnorm[i], w_out_odd[i])
            new_gla.append(sg)
        h = h + y
        y, sc = conv_ffn(rmsnorm(h, norm_ffn[l]), s_conv[l], ffn_w_up[l], ffn_conv_w[l],
                         ffn_conv_b[l], ffn_w_down[l])
        new_conv.append(sc)
        h = h + y
    return (rmsnorm(h, norm_final), jnp.stack(new_ret), jnp.stack(new_hgrn),
            jnp.stack(new_gla), jnp.stack(new_conv))


def setup_inputs(seed: int = 0) -> dict:
    key = jax.random.key(seed)
    ks = jax.random.split(key, 24)

    def nrm(k, shape, scale):
        return jax.random.normal(k, shape, dtype=jnp.float32) * scale

    return {
        "x_prompt": nrm(ks[0], (BATCH, SEQ, D_MODEL), 1.0),
        "x_sample": nrm(ks[1], (DEC_BATCH, DEC_SEQ, D_MODEL), 1.0),
        "state_ret": nrm(ks[2], (N_EVEN, DEC_BATCH, H_A, DK_A, DV_A), 0.5),
        "state_hgrn": nrm(ks[3], (N_EVEN, DEC_BATCH, H_B, DK_B, DV_B), 0.5),
        "state_gla": nrm(ks[4], (N_ODD, DEC_BATCH, H_C, DK_C, DV_C), 0.5),
        "cache_ffn_conv": nrm(ks[5], (DEPTH, DEC_BATCH, CONV_W - 1, D_FF), 1.0),
        "norm_mix": 1.0 + nrm(ks[6], (DEPTH, D_MODEL), 0.02),
        "norm_ffn": 1.0 + nrm(ks[7], (DEPTH, D_MODEL), 0.02),
        "norm_final": 1.0 + nrm(ks[8], (D_MODEL,), 0.02),
        "w_in_even": nrm(ks[9], (N_EVEN, D_MODEL, D_IN_EVEN), D_MODEL ** -0.5),
        "w_out_even": nrm(ks[10], (N_EVEN, D_MIX_EVEN, D_MODEL), D_MIX_EVEN ** -0.5),
        "hgrn_lb": nrm(ks[11], (DEPTH + 1, QB), 0.1),
        "hgrn_gnorm": 1.0 + nrm(ks[12], (N_EVEN, DV_B), 0.02),
        "w_in_odd": nrm(ks[13], (N_ODD, D_MODEL, D_IN_ODD), D_MODEL ** -0.5),
        "w_gk2": nrm(ks[14], (N_ODD, GK_RANK, QC), GK_RANK ** -0.5),
        "b_gk2": nrm(ks[15], (N_ODD, QC), 0.02),
        "gla_gnorm": 1.0 + nrm(ks[16], (N_ODD, DV_C), 0.02),
        "w_out_odd": nrm(ks[17], (N_ODD, VC, D_MODEL), VC ** -0.5),
        "ffn_w_up": nrm(ks[18], (DEPTH, D_MODEL, 2 * D_FF), D_MODEL ** -0.5),
        "ffn_conv_w": nrm(ks[19], (DEPTH, CONV_W, D_FF), CONV_W ** -0.5),
        "ffn_conv_b": nrm(ks[20], (DEPTH, D_FF), 0.02),
        "ffn_w_down": nrm(ks[21], (DEPTH, D_FF, D_MODEL), D_FF ** -0.5),
    }


def reference(x_prompt, x_sample, state_ret, state_hgrn, state_gla, cache_ffn_conv,
              norm_mix, norm_ffn, norm_final, w_in_even, w_out_even, hgrn_lb, hgrn_gnorm,
              w_in_odd, w_gk2, b_gk2, gla_gnorm, w_out_odd, ffn_w_up, ffn_conv_w, ffn_conv_b,
              ffn_w_down):
    dt = x_prompt.dtype
    Bp = x_prompt.shape[0]
    y_prompt, ret_p, hgrn_p, gla_p, conv_p = run_group(
        x_prompt, jnp.arange(SEQ, dtype=jnp.int32),
        jnp.zeros((N_EVEN, Bp, H_A, DK_A, DV_A), dt),
        jnp.zeros((N_EVEN, Bp, H_B, DK_B, DV_B), dt),
        jnp.zeros((N_ODD, Bp, H_C, DK_C, DV_C), dt),
        jnp.zeros((DEPTH, Bp, CONV_W - 1, D_FF), dt),
        norm_mix, norm_ffn, norm_final, w_in_even, w_out_even, hgrn_lb, hgrn_gnorm,
        w_in_odd, w_gk2, b_gk2, gla_gnorm, w_out_odd, ffn_w_up, ffn_conv_w, ffn_conv_b, ffn_w_down)
    y_sample, ret_s, hgrn_s, gla_s, conv_s = run_group(
        x_sample, PAST_LEN + jnp.arange(x_sample.shape[1], dtype=jnp.int32),
        state_ret, state_hgrn, state_gla, cache_ffn_conv,
        norm_mix, norm_ffn, norm_final, w_in_even, w_out_even, hgrn_lb, hgrn_gnorm,
        w_in_odd, w_gk2, b_gk2, gla_gnorm, w_out_odd, ffn_w_up, ffn_conv_w, ffn_conv_b, ffn_w_down)
    return (y_prompt, y_sample, ret_p, ret_s, hgrn_p, hgrn_s, gla_p, gla_s, conv_p, conv_s)
```

```cpp
#include <hip/hip_runtime.h>
#include <hip/hip_bf16.h>
#include <hip/hip_cooperative_groups.h>
#include <cstdio>
namespace cg = cooperative_groups;

typedef unsigned short u16;
using bf16x8 = __attribute__((ext_vector_type(8))) short;
using f32x4 = __attribute__((ext_vector_type(4))) float;
typedef __attribute__((ext_vector_type(4))) unsigned u32x4_t;

constexpr int MP = 8192, MS = 512, MT = 8704, D = 2048;
constexpr int DFF = 5504, NUP = 11008;
constexpr int NINE = 7168, NINO = 6160, NINO_PAD = 6400;
constexpr int NCH = 136;
constexpr float EPS = 1e-6f;

constexpr size_t SZ_WINE = (size_t)NINE * D * 2, SZ_WOUT = (size_t)D * D * 2, SZ_WINO = (size_t)NINO_PAD * D * 2;
constexpr size_t SZ_WUP = (size_t)NUP * D * 2, SZ_WDN = (size_t)D * DFF * 2;
constexpr size_t OFF_WINE = 0;
constexpr size_t OFF_WOUTE = OFF_WINE + SZ_WINE;
constexpr size_t OFF_WINO = OFF_WOUTE + SZ_WOUT;
constexpr size_t OFF_WOUTO = OFF_WINO + SZ_WINO;
constexpr size_t OFF_WUP0 = OFF_WOUTO + SZ_WOUT;
constexpr size_t OFF_WUP1 = OFF_WUP0 + SZ_WUP;
constexpr size_t OFF_WDN0 = OFF_WUP1 + SZ_WUP;
constexpr size_t OFF_WDN1 = OFF_WDN0 + SZ_WDN;
constexpr size_t OFF_H = OFF_WDN1 + SZ_WDN;
constexpr size_t OFF_HN = OFF_H + (size_t)MT * D * 4;
constexpr size_t OFF_BIG = OFF_HN + (size_t)MT * D * 2;
constexpr size_t OFF_R = OFF_BIG + (size_t)MT * NUP * 2;
constexpr size_t SZ_R = 104ull * 1048576;
constexpr size_t OFF_RSS = OFF_R + SZ_R;
constexpr size_t OFF_SIDE = OFF_RSS + 3ull * MT * 4 + 256;
constexpr size_t SZ_SIDE1 = 34ull * 2 * DFF * 2;
constexpr size_t OFF_BAR = OFF_SIDE + 3 * SZ_SIDE1 + 256;
constexpr size_t WS_NEED = OFF_BAR + 16384;
constexpr size_t R_QA = 0;
constexpr size_t R_KA = R_QA + (size_t)NCH * 4 * 64 * 128 * 2;
constexpr size_t R_VA = R_KA + (size_t)NCH * 4 * 64 * 128 * 2;
constexpr size_t R_PA = R_VA + (size_t)NCH * 4 * 256 * 64 * 2;
constexpr size_t R_DA = R_PA + (size_t)NCH * 4 * 4096 * 2;
constexpr size_t R_QB = R_DA + (size_t)NCH * 4 * 128 * 4;
constexpr size_t R_KB = R_QB + (size_t)NCH * 8 * 64 * 128 * 2;
constexpr size_t R_VB = R_KB + (size_t)NCH * 8 * 64 * 128 * 2;
constexpr size_t R_PB = R_VB + (size_t)NCH * 8 * 128 * 64 * 2;
constexpr size_t R_DB = R_PB + (size_t)NCH * 8 * 4096 * 2;
constexpr size_t R_END_EVEN = R_DB + (size_t)NCH * 8 * 128 * 4;
constexpr size_t R_QC = 0;
constexpr size_t R_KC = R_QC + (size_t)NCH * 4 * 64 * 256 * 2;
constexpr size_t R_VC = R_KC + (size_t)NCH * 4 * 64 * 256 * 2;
constexpr size_t R_PC = R_VC + (size_t)NCH * 4 * 512 * 64 * 2;
constexpr size_t R_DC = R_PC + (size_t)NCH * 4 * 4096 * 2;
constexpr size_t R_END_ODD = R_DC + (size_t)NCH * 4 * 256 * 4;
static_assert(R_END_EVEN <= SZ_R && R_END_ODD <= SZ_R && (size_t)MT * DFF * 2 <= SZ_R, "R region too small");

constexpr size_t O_YP = 0;
constexpr size_t O_YS = O_YP + (size_t)MP * D;
constexpr size_t O_RETP = O_YS + (size_t)MS * D;
constexpr size_t O_RETS = O_RETP + 4ull * 4 * 128 * 256;
constexpr size_t O_HGP = O_RETS + 8ull * 4 * 128 * 256;
constexpr size_t O_HGS = O_HGP + 4ull * 8 * 128 * 128;
constexpr size_t O_GLP = O_HGS + 8ull * 8 * 128 * 128;
constexpr size_t O_GLS = O_GLP + 4ull * 4 * 256 * 512;
constexpr size_t O_CVP = O_GLS + 8ull * 4 * 256 * 512;
constexpr size_t O_CVS = O_CVP + 2ull * 4 * 2 * DFF;
constexpr size_t O_END = O_CVS + 2ull * 8 * 2 * DFF;

struct Params {
  const float* in[22];
  float* out;
  unsigned char* ws;
  int ph_lo, ph_hi, coop, pad;
};

__device__ __forceinline__ u16 f2bf(float f) {
  unsigned u = __float_as_uint(f);
  u += 0x7fffu + ((u >> 16) & 1u);
  return (u16)(u >> 16);
}
__device__ __forceinline__ float bf2f(u16 h) { return __uint_as_float(((unsigned)h) << 16); }
__device__ __forceinline__ unsigned pack2(float a, float b) { return (unsigned)f2bf(a) | ((unsigned)f2bf(b) << 16); }
__device__ __forceinline__ float sigmoidf_(float x) { return 1.f / (1.f + __expf(-x)); }
__device__ __forceinline__ float siluf_(float x) { return x / (1.f + __expf(-x)); }

__device__ __forceinline__ int tidx(int wv) { int l; asm volatile("v_mbcnt_lo_u32_b32 %0, -1, 0\n\tv_mbcnt_hi_u32_b32 %0, -1, %0" : "=v"(l)); return wv * 64 + l; }

__device__ __forceinline__ void convert_w(int wv, const float* __restrict__ src, u16* __restrict__ dst, int K, int N, int Npad, u16* tile, const float* __restrict__ kscale = nullptr, int upperm = 0) {
  const int tix = tidx(wv);
  constexpr int TS = 262;
  const int tn = (Npad + 255) / 256, tk = K / 64, nt = tn * tk, tid = tix;
  for (int t = blockIdx.x; t < nt; t += gridDim.x) {
    const int n0 = (t % tn) * 256, k0 = (t / tn) * 64;
    float4 v[8];
#pragma unroll
    for (int i = 0; i < 8; ++i) {
      const int idx = tid + i * 512, kk = idx >> 6, n = n0 + (idx & 63) * 4;
      v[i] = make_float4(0.f, 0.f, 0.f, 0.f);
      if (n < N) v[i] = *(const float4*)(src + (size_t)(k0 + kk) * N + n);
      if (kscale) { const float sc = kscale[k0 + kk]; v[i].x *= sc; v[i].y *= sc; v[i].z *= sc; v[i].w *= sc; }
    }
    __syncthreads();
#pragma unroll
    for (int i = 0; i < 8; ++i) {
      const int idx = tid + i * 512, kk = idx >> 6, nl = (idx & 63) * 4;
      *(unsigned*)(tile + kk * TS + nl) = pack2(v[i].x, v[i].y);
      *(unsigned*)(tile + kk * TS + nl + 2) = pack2(v[i].z, v[i].w);
    }
    __syncthreads();
#pragma unroll
    for (int i = 0; i < 4; ++i) {
      const int item = tid + i * 512, ks = item & 7, n = item >> 3;
      if (n0 + n < Npad) {
        const u16* tp = tile + (ks * 8) * TS + n;
        uint4 o;
        o.x = (unsigned)tp[0] | ((unsigned)tp[TS] << 16);
        o.y = (unsigned)tp[2 * TS] | ((unsigned)tp[3 * TS] << 16);
        o.z = (unsigned)tp[4 * TS] | ((unsigned)tp[5 * TS] << 16);
        o.w = (unsigned)tp[6 * TS] | ((unsigned)tp[7 * TS] << 16);
        int nr = n0 + n;
        if (upperm) nr = (nr < DFF) ? ((nr >> 7) * 256 + (nr & 127)) : ((((nr - DFF) >> 7) * 256) + 128 + ((nr - DFF) & 127));
        *(uint4*)(dst + (size_t)nr * K + k0 + ks * 8) = o;
      }
    }
  }
}

template <int MODE>
__device__ __forceinline__ void rmsnorm_phase(int wv, const Params& p, const float* __restrict__ w) {
  const int tix = tidx(wv);
  const int lane = tix & 63, gw = blockIdx.x * 8 + (tix >> 6), nw = gridDim.x * 8;
  const float* h = (const float*)(p.ws + OFF_H);
  u16* hn = (u16*)(p.ws + OFF_HN);
#define RMS_LOAD(dst, row_) do { const int r_ = (row_); const float* src_; \
    if (MODE == 0) src_ = (r_ < MP) ? p.in[0] + (size_t)r_ * D : p.in[1] + (size_t)(r_ - MP) * D; \
    else src_ = h + (size_t)r_ * D; \
    _Pragma("unroll") for (int i = 0; i < 8; ++i) dst[i] = *(const f32x4*)(src_ + (i * 64 + lane) * 4); } while (0)
  f32x4 v[8];
  if (gw < MT) RMS_LOAD(v, gw);
#pragma unroll 1
  for (int row = gw; row < MT; row += nw) {
    f32x4 nx[8];
    if (row + nw < MT) RMS_LOAD(nx, row + nw);
    else {
#pragma unroll
      for (int i = 0; i < 8; ++i) nx[i] = v[i];
    }
    __builtin_amdgcn_sched_barrier(0);
    float ss = 0.f;
#pragma unroll
    for (int i = 0; i < 8; ++i) ss += v[i][0] * v[i][0] + v[i][1] * v[i][1] + v[i][2] * v[i][2] + v[i][3] * v[i][3];
#pragma unroll
    for (int o = 32; o > 0; o >>= 1) ss += __shfl_xor(ss, o, 64);
    const float rs = rsqrtf(ss * (1.f / D) + EPS);
#pragma unroll
    for (int i = 0; i < 8; ++i) {
      const int col = (i * 64 + lane) * 4;
      const float4 wv4 = *(const float4*)(w + col);
      const float4 y = make_float4(v[i][0] * rs * wv4.x, v[i][1] * rs * wv4.y, v[i][2] * rs * wv4.z, v[i][3] * rs * wv4.w);
      if (MODE == 2) {
        float* dst = (row < MP) ? p.out + O_YP + (size_t)row * D : p.out + O_YS + (size_t)(row - MP) * D;
        *(float4*)(dst + col) = y;
      } else {
        *(uint2*)(hn + (size_t)row * D + col) = make_uint2(pack2(y.x, y.y), pack2(y.z, y.w));
      }
    }
#pragma unroll
    for (int i = 0; i < 8; ++i) v[i] = nx[i];
  }
#undef RMS_LOAD
}

__device__ __forceinline__ void ld8(const u16* p, float* f) {
  uint4 v = *(const uint4*)p;
  f[0] = __uint_as_float(v.x << 16); f[1] = __uint_as_float(v.x & 0xffff0000u);
  f[2] = __uint_as_float(v.y << 16); f[3] = __uint_as_float(v.y & 0xffff0000u);
  f[4] = __uint_as_float(v.z << 16); f[5] = __uint_as_float(v.z & 0xffff0000u);
  f[6] = __uint_as_float(v.w << 16); f[7] = __uint_as_float(v.w & 0xffff0000u);
}
__device__ __forceinline__ void st8(u16* p, const float* f) {
  *(uint4*)p = make_uint4(pack2(f[0], f[1]), pack2(f[2], f[3]), pack2(f[4], f[5]), pack2(f[6], f[7]));
}

constexpr int BM = 256, BK = 64, HALF = 128, NXCD = 8, WGM = 8, HT = HALF * BK;

__device__ __forceinline__ int lds_byte(int r, int c) {
  int st = (r >> 4) * 2 + (c >> 5), rr = r & 15, cc = c & 31, ob = rr * 64 + cc * 2;
  return st * 1024 + (ob ^ (((ob >> 9) & 1) << 5));
}
__device__ __forceinline__ void stage_rc(int b, int& R, int& C) {
  int st = b / 1024, sb = b % 1024, swz = sb ^ (((sb >> 9) & 1) << 5);
  R = (st >> 1) * 16 + swz / 64; C = (st & 1) * 32 + (swz % 64) / 2;
}

__device__ __forceinline__ void tile_coords(int wgid, int nM, int nN, int& pm, int& pn) {
  const int nwg = nM * nN;
  { int q = nwg / NXCD, r = nwg % NXCD, xcd = wgid % NXCD, off = wgid / NXCD;
    wgid = (xcd < r ? xcd * (q + 1) : r * (q + 1) + (xcd - r) * q) + off; }
  const int nig = WGM * nN, gid = wgid / nig, fm = gid * WGM, gsz = min(nM - fm, WGM);
  pm = fm + ((wgid % nig) % gsz); pn = (wgid % nig) / gsz;
}

struct EpiStoreBf16 {
  static constexpr bool GATE = false;
  u16* out; int ldo; const float* rss;
  __device__ __forceinline__ float row_scale(int row) const { return rss ? rsqrtf(rss[row] * (1.f / D) + EPS) : 1.f; }
  __device__ __forceinline__ float operator()(int row, int col, f32x4 v, float sc) const {
    uint2 pk = make_uint2(pack2(v[0] * sc, v[1] * sc), pack2(v[2] * sc, v[3] * sc));
    *(uint2*)(out + (size_t)row * ldo + col) = pk;
    return 0.f;
  }
  __device__ __forceinline__ void row_end(int, float, int) const {}
};
struct EpiAccum {
  static constexpr bool GATE = false;
  float* h; u16* hb; float* rss; const float* rin;
  __device__ __forceinline__ float row_scale(int) const { return 1.f; }
  __device__ __forceinline__ float operator()(int row, int col, f32x4 v, float) const {
    float* q = h + (size_t)row * D + col;
    float4 o = *(const float4*)(rin + (size_t)row * D + col);
    o.x += v[0]; o.y += v[1]; o.z += v[2]; o.w += v[3];
    *(float4*)q = o;
    if (rss) {
      *(uint2*)(hb + (size_t)row * D + col) = make_uint2(pack2(o.x, o.y), pack2(o.z, o.w));
      return o.x * o.x + o.y * o.y + o.z * o.z + o.w * o.w;
    }
    return 0.f;
  }
  __device__ __forceinline__ void row_end(int row, float ss, int fq) const {
    if (rss) {
      ss += __shfl_xor(ss, 16, 64);
      ss += __shfl_xor(ss, 32, 64);
      if (fq == 0) unsafeAtomicAdd(rss + row, ss);
    }
  }
};

struct EpiGate {
  static constexpr bool GATE = true;
  const __attribute__((address_space(4))) void* kp; int layer; int rssoff;
  __device__ __forceinline__ float row_scale(int) const { return 1.f; }
  __device__ __forceinline__ float operator()(int, int, f32x4, float) const { return 0.f; }
  __device__ __forceinline__ void row_end(int, float, int) const {}
};

template <int M, int N, int K, int TAIL, class Epi>
__device__ __forceinline__ void gemm_phase(int wv, const u16* __restrict__ A, const u16* __restrict__ Bt, Epi epi, u16* shm) {
  const int tix = tidx(wv);
#define SA(b, h) (shm + ((b) * 2 + (h)) * HT)
#define SB(b, h) (shm + (4 + (b) * 2 + (h)) * HT)
#define STAGE(P, BASE, br, kt) do { const u16* _gb = BASE + ((long)(br) * K + (long)(kt0 + (kt)) * BK); \
    for (int _i = 0; _i < 2; ++_i) { int _b = tix * 16 + _i * 8192; \
      __builtin_amdgcn_global_load_lds((const unsigned*)(_gb + toff[_i]), \
        (__attribute__((address_space(3))) unsigned*)((char*)(P) + _b), 16, 0, 0); } } while (0)
#define LDA(dst, b, h) for (int m = 0; m < 4; ++m) for (int k = 0; k < 2; ++k) \
    dst[m][k] = *reinterpret_cast<const bf16x8*>((char*)SA(b, h) + lds_byte(wr * 64 + m * 16 + fr, k * 32 + fq * 8))
#define LDB(dst, b, h) for (int n = 0; n < 2; ++n) for (int k = 0; k < 2; ++k) \
    dst[n][k] = *reinterpret_cast<const bf16x8*>((char*)SB(b, h) + lds_byte(wc * 32 + n * 16 + fr, k * 32 + fq * 8))
#define MMA(ai, bj, At_, Bt_) do { __builtin_amdgcn_s_setprio(1); \
    for (int m = 0; m < 4; ++m) for (int n = 0; n < 2; ++n) for (int k = 0; k < 2; ++k) \
      acc[ai][bj][m][n] = __builtin_amdgcn_mfma_f32_16x16x32_bf16(Bt_[n][k], At_[m][k], acc[ai][bj][m][n], 0, 0, 0); \
    __builtin_amdgcn_s_setprio(0); } while (0)
#define WAIT_V(n) asm volatile("s_waitcnt vmcnt(" #n ")" ::: "memory")
#define WAIT_L(n) asm volatile("s_waitcnt lgkmcnt(" #n ")" ::: "memory")
#define BAR __builtin_amdgcn_s_barrier()
#define SCHED __builtin_amdgcn_sched_barrier(0)
  const int nM = M / BM, nN = N / BM, nwg = nM * nN, G = gridDim.x;
  const int nunits = nwg;
  const int wid = tix >> 6, lane = tix & 63, wr = wid >> 2, wc = wid & 3, fr = lane & 15, fq = lane >> 4;
  const int nt_total = K / BK;
  unsigned toff[2];
  for (int _i = 0; _i < 2; ++_i) { int _b = tix * 16 + _i * 8192; int _r, _c; stage_rc(_b, _r, _c); toff[_i] = (unsigned)(_r * K + _c); }
  for (int vw = blockIdx.x; vw < nunits; vw += G) {
    int pm, pn;
    tile_coords(vw, nM, nN, pm, pn);
    const int brow = pm * BM, bcol = pn * BM;
    constexpr int kt0 = 0, nt = nt_total;
    f32x4 acc[2][2][4][2];
    for (int a = 0; a < 2; ++a) for (int b = 0; b < 2; ++b) for (int m = 0; m < 4; ++m) for (int n = 0; n < 2; ++n) acc[a][b][m][n] = f32x4{0.f, 0.f, 0.f, 0.f};
    bf16x8 At[4][2], B0[2][2], B1[2][2];
    STAGE(SB(0, 0), Bt, bcol, 0); STAGE(SA(0, 0), A, brow, 0);
    STAGE(SB(0, 1), Bt, bcol + HALF, 0); STAGE(SA(0, 1), A, brow + HALF, 0);
    if (wr == 1) BAR;
    WAIT_V(4); BAR;
    STAGE(SB(1, 0), Bt, bcol, 1); STAGE(SA(1, 0), A, brow, 1); STAGE(SB(1, 1), Bt, bcol + HALF, 1);
    WAIT_V(6); BAR;
    for (int t = 0; t < nt - 2; t += 2) {
      LDB(B0, 0, 0); SCHED; LDA(At, 0, 0); STAGE(SA(1, 1), A, brow + HALF, t + 1);
      WAIT_L(8); BAR; WAIT_L(0); MMA(0, 0, At, B0); BAR; SCHED;
      LDB(B1, 0, 1); STAGE(SB(0, 0), Bt, bcol, t + 2);
      BAR; WAIT_L(0); MMA(0, 1, At, B1); BAR;
      LDA(At, 0, 1); STAGE(SA(0, 0), A, brow, t + 2);
      BAR; WAIT_L(0); MMA(1, 0, At, B0); BAR; SCHED;
      STAGE(SB(0, 1), Bt, bcol + HALF, t + 2);
      WAIT_V(6); BAR; MMA(1, 1, At, B1); BAR;
      LDB(B0, 1, 0); SCHED; LDA(At, 1, 0); STAGE(SA(0, 1), A, brow + HALF, t + 2);
      WAIT_L(8); BAR; WAIT_L(0); MMA(0, 0, At, B0); BAR; SCHED;
      LDB(B1, 1, 1); STAGE(SB(1, 0), Bt, bcol, t + 3);
      BAR; WAIT_L(0); MMA(0, 1, At, B1); BAR;
      LDA(At, 1, 1); STAGE(SA(1, 0), A, brow, t + 3);
      BAR; WAIT_L(0); MMA(1, 0, At, B0); BAR; SCHED;
      STAGE(SB(1, 1), Bt, bcol + HALF, t + 3);
      WAIT_V(6); BAR; MMA(1, 1, At, B1); BAR;
    }
    { LDB(B0, 0, 0); LDA(At, 0, 0); STAGE(SA(1, 1), A, brow + HALF, nt - 1);
      BAR; WAIT_L(0); MMA(0, 0, At, B0); BAR;
      LDB(B1, 0, 1); BAR; WAIT_L(0); MMA(0, 1, At, B1); BAR;
      LDA(At, 0, 1); WAIT_V(4); BAR; WAIT_L(0); MMA(1, 0, At, B0); MMA(1, 1, At, B1); BAR; }
    { LDB(B0, 1, 0); LDA(At, 1, 0); WAIT_V(2); BAR; WAIT_L(0); MMA(0, 0, At, B0); BAR;
      LDB(B1, 1, 1); WAIT_V(0); BAR; WAIT_L(0); MMA(0, 1, At, B1); BAR;
      LDA(At, 1, 1); BAR; WAIT_L(0); MMA(1, 0, At, B0); MMA(1, 1, At, B1); BAR; }
    if (wr == 0) BAR;
    if constexpr (Epi::GATE) {
      constexpr int LS = 136;
      u16* La = shm;
      u16* Lu = shm + 256 * LS;
      const __attribute__((address_space(4))) Params* gkp = (const __attribute__((address_space(4))) Params*)epi.kp;
      asm volatile("" : "+s"(gkp));
      int e_pm = pm, e_pn = pn, e_tix = tix;
      asm volatile("" : "+s"(e_pm), "+s"(e_pn));
      asm volatile("" : "+v"(e_tix));
      const int e_brow = e_pm * BM;
      {
        const int e_lane = e_tix & 63, e_wid = e_tix >> 6, e_wr = e_wid >> 2, e_wc = e_wid & 3, e_fr = e_lane & 15, e_fq = e_lane >> 4;
        const float* rss = (const float*)(gkp->ws + OFF_RSS) + epi.rssoff;
        _Pragma("unroll") for (int ai = 0; ai < 2; ++ai) _Pragma("unroll") for (int m = 0; m < 4; ++m) {
          const int rl = ai * HALF + e_wr * 64 + m * 16 + e_fr;
          const float sc = rsqrtf(rss[e_brow + rl] * (1.f / D) + EPS);
          _Pragma("unroll") for (int n = 0; n < 2; ++n) {
            const f32x4 a = acc[ai][0][m][n], uu = acc[ai][1][m][n];
            const int lo = rl * LS + e_wc * 32 + n * 16 + e_fq * 4;
            *(uint2*)(La + lo) = make_uint2(pack2(a[0] * sc, a[1] * sc), pack2(a[2] * sc, a[3] * sc));
            *(uint2*)(Lu + lo) = make_uint2(pack2(uu[0] * sc, uu[1] * sc), pack2(uu[2] * sc, uu[3] * sc));
          }
        }
      }
      WAIT_L(0); BAR; asm volatile("" ::: "memory");
      {
        const bool samp = e_brow >= MP;
        const int layer = epi.layer;
        u16* gg = (u16*)(gkp->ws + OFF_R);
        u16* side = (u16*)(gkp->ws + OFF_SIDE);
        const float* cw = gkp->in[19] + (size_t)layer * 3 * DFF;
        const float* cb = gkp->in[20] + (size_t)layer * DFF;
        const float* cache = gkp->in[5] + (size_t)layer * 8 * 2 * DFF;
        float* cvo = gkp->out + (samp ? O_CVS + (size_t)layer * 8 * 2 * DFF : O_CVP + (size_t)layer * 4 * 2 * DFF);
        const int cg = e_tix & 15, r0 = e_tix >> 4, c = e_pn * 128 + cg * 8;
        float w0[8], w1[8], w2[8], bb[8];
        _Pragma("unroll") for (int e = 0; e < 8; ++e) { w0[e] = cw[c + e]; w1[e] = cw[DFF + c + e]; w2[e] = cw[2 * DFF + c + e]; bb[e] = cb[c + e]; }
        _Pragma("unroll 1") for (int it = 0; it < 8; ++it) {
          const int rl = it * 32 + r0;
          const int t = samp ? (rl & 63) : ((e_pm & 7) * 256 + rl);
          const int sb = (e_pm - 32) * 4 + (rl >> 6);
          float a[8], uu[8], am1[8], am2[8], y[8];
          ld8(La + rl * LS + cg * 8, a);
          ld8(Lu + rl * LS + cg * 8, uu);
          _Pragma("unroll") for (int e = 0; e < 8; ++e) { am1[e] = 0.f; am2[e] = 0.f; }
          if (t >= 1 && rl >= 1) ld8(La + (rl - 1) * LS + cg * 8, am1);
          if (t >= 2 && rl >= 2) ld8(La + (rl - 2) * LS + cg * 8, am2);
          if (samp && t < 2) {
            const float* c1 = cache + (size_t)(sb * 2 + 1) * DFF + c;
            if (t == 0) {
              const float* c0 = cache + (size_t)(sb * 2 + 0) * DFF + c;
              _Pragma("unroll") for (int e = 0; e < 8; ++e) { am2[e] = c0[e]; am1[e] = c1[e]; }
            } else {
              _Pragma("unroll") for (int e = 0; e < 8; ++e) am2[e] = c1[e];
            }
          }
          if (!(t >= 2 && rl < 2)) {
            _Pragma("unroll") for (int e = 0; e < 8; ++e) { float cv = bb[e] + w0[e] * am2[e] + w1[e] * am1[e] + w2[e] * a[e]; y[e] = siluf_(cv) * uu[e]; }
            st8(gg + (size_t)(e_brow + rl) * DFF + c, y);
          } else {
            st8(side + (size_t)(e_pm * 2 + rl) * DFF + c, a);
            st8(side + SZ_SIDE1 / 2 + (size_t)(e_pm * 2 + rl) * DFF + c, uu);
          }
          if (rl >= 254) st8(side + SZ_SIDE1 + (size_t)(e_pm * 2 + rl - 254) * DFF + c, a);
          int crow = -1;
          if (!samp) { if ((e_pm & 7) == 7 && rl >= 254) crow = (e_pm >> 3) * 2 + rl - 254; }
          else { if ((rl & 63) >= 62) crow = sb * 2 + (rl & 63) - 62; }
          if (crow >= 0) {
            float* dst = cvo + (size_t)crow * DFF + c;
            *(float4*)dst = make_float4(a[0], a[1], a[2], a[3]);
            *(float4*)(dst + 4) = make_float4(a[4], a[5], a[6], a[7]);
          }
        }
      }
      WAIT_L(0); BAR; asm volatile("" ::: "memory");
    } else {
    for (int ai = 0; ai < 2; ++ai) for (int m = 0; m < 4; ++m) {
      const int row = brow + ai * HALF + wr * 64 + m * 16 + fr;
      const float sc = epi.row_scale(row);
      float ss = 0.f;
      for (int bj = 0; bj < 2; ++bj) for (int n = 0; n < 2; ++n)
        ss += epi(row, bcol + bj * HALF + wc * 32 + n * 16 + fq * 4, acc[ai][bj][m][n], sc);
      epi.row_end(row, ss, fq);
      if (m & 1) asm volatile("" ::: "memory");
    }
    }
  }
#undef SA
#undef SB
#undef STAGE
#undef LDA
#undef LDB
#undef MMA
}


template <int K>
__device__ __forceinline__ void gemm_tail_phase(int wv, const u16* __restrict__ A, const u16* __restrict__ Bt, float* __restrict__ h, float* lds, u16* __restrict__ hb, float* __restrict__ rss, const float* __restrict__ rin_tail) {
  const int tix = tidx(wv);
  const int tid = tix, w = tid >> 6, lane = tid & 63, fr = lane & 15, fq = lane >> 4;
  for (int u = blockIdx.x; u < 256; u += gridDim.x) {
    const int tm = u >> 5, tn = u & 31;
    const u16* Ab = A + (size_t)(MP + tm * 64 + fr) * K + fq * 8;
    const u16* Bb = Bt + (size_t)(tn * 64 + fr) * K + fq * 8;
    f32x4 acc[4][4];
#pragma unroll
    for (int i = 0; i < 4; ++i)
#pragma unroll
      for (int j = 0; j < 4; ++j) acc[i][j] = f32x4{0.f, 0.f, 0.f, 0.f};
    const u16* Ab2 = A + (size_t)(MP + tm * 64 + fr) * K + fq * 16;
    const u16* Bb2 = Bt + (size_t)(tn * 64 + fr) * K + fq * 16;
#pragma unroll 1
    for (int ks = w; ks < K / 64; ks += 8) {
      bf16x8 a[4][2], b[4][2];
#pragma unroll
      for (int i = 0; i < 4; ++i) {
        a[i][0] = *(const bf16x8*)(Ab2 + (size_t)i * 16 * K + ks * 64);
        a[i][1] = *(const bf16x8*)(Ab2 + (size_t)i * 16 * K + ks * 64 + 8);
        b[i][0] = *(const bf16x8*)(Bb2 + (size_t)i * 16 * K + ks * 64);
        b[i][1] = *(const bf16x8*)(Bb2 + (size_t)i * 16 * K + ks * 64 + 8);
      }
#pragma unroll
      for (int mb = 0; mb < 4; ++mb)
#pragma unroll
        for (int nb = 0; nb < 4; ++nb) {
          acc[mb][nb] = __builtin_amdgcn_mfma_f32_16x16x32_bf16(b[nb][0], a[mb][0], acc[mb][nb], 0, 0, 0);
          acc[mb][nb] = __builtin_amdgcn_mfma_f32_16x16x32_bf16(b[nb][1], a[mb][1], acc[mb][nb], 0, 0, 0);
        }
    }
    __syncthreads();
#pragma unroll
    for (int mb = 0; mb < 4; ++mb)
#pragma unroll
      for (int nb = 0; nb < 4; ++nb) *(f32x4*)(lds + w * 4096 + (mb * 16 + fr) * 64 + nb * 16 + fq * 4) = acc[mb][nb];
    __syncthreads();
    const int e = tid * 8, row = e >> 6, col = e & 63;
    float4 s0 = make_float4(0.f, 0.f, 0.f, 0.f), s1 = s0;
#pragma unroll
    for (int ww = 0; ww < 8; ++ww) {
      float4 x0 = *(const float4*)(lds + ww * 4096 + e), x1 = *(const float4*)(lds + ww * 4096 + e + 4);
      s0.x += x0.x; s0.y += x0.y; s0.z += x0.z; s0.w += x0.w;
      s1.x += x1.x; s1.y += x1.y; s1.z += x1.z; s1.w += x1.w;
    }
    float* q = h + (size_t)(MP + tm * 64 + row) * D + tn * 64 + col;
    const float* rq_ = rin_tail + (size_t)(tm * 64 + row) * D + tn * 64 + col;
    float4 o0 = *(const float4*)rq_, o1 = *(const float4*)(rq_ + 4);
    o0.x += s0.x; o0.y += s0.y; o0.z += s0.z; o0.w += s0.w;
    o1.x += s1.x; o1.y += s1.y; o1.z += s1.z; o1.w += s1.w;
    *(float4*)q = o0; *(float4*)(q + 4) = o1;
    if (rss) {
      const int grow = MP + tm * 64 + row;
      *(uint4*)(hb + (size_t)grow * D + tn * 64 + col) = make_uint4(pack2(o0.x, o0.y), pack2(o0.z, o0.w), pack2(o1.x, o1.y), pack2(o1.z, o1.w));
      float ss = o0.x * o0.x + o0.y * o0.y + o0.z * o0.z + o0.w * o0.w + o1.x * o1.x + o1.y * o1.y + o1.z * o1.z + o1.w * o1.w;
      ss += __shfl_xor(ss, 1, 64); ss += __shfl_xor(ss, 2, 64); ss += __shfl_xor(ss, 4, 64);
      if ((tid & 7) == 0) unsafeAtomicAdd(rss + grow, ss);
    }
  }
}

template <int MODE>
__device__ __forceinline__ void prep_range(int wv, const Params& p, int u0, int u1, int ustride, unsigned char* shm) {
  const int tix = tidx(wv);
  constexpr int K = (MODE == 2) ? 256 : 128;
  constexpr int V = (MODE == 0) ? 256 : (MODE == 1 ? 128 : 512);
  constexpr int H = (MODE == 1) ? 8 : 4;
  constexpr int LD = (MODE == 2) ? NINO_PAD : NINE;
  constexpr int NSEG = 4, TL = 16, KS = K + 8, VS = V + 8, NPASS = K / 128;
  constexpr int NQ = K / 64, NV = V / 64;
  constexpr bool PFV = (MODE != 2);
  const int tid = tix, seg = tid >> 7;
  const u16* proj = (const u16*)(p.ws + OFF_BIG);
  unsigned char* R = p.ws + OFF_R;
  u16* qin = (u16*)(R + (MODE == 0 ? R_QA : MODE == 1 ? R_QB : R_QC));
  u16* koT = (u16*)(R + (MODE == 0 ? R_KA : MODE == 1 ? R_KB : R_KC));
  u16* vT = (u16*)(R + (MODE == 0 ? R_VA : MODE == 1 ? R_VB : R_VC));
  u16* Pm = (u16*)(R + (MODE == 0 ? R_PA : MODE == 1 ? R_PB : R_PC));
  float* dL = (float*)(R + (MODE == 0 ? R_DA : MODE == 1 ? R_DB : R_DC));
  u16* qs = (u16*)shm;
  u16* ksm = qs + 64 * KS;
  float* segtot = (float*)(ksm + 64 * KS);
  float* gl = segtot + NSEG * K;
  u16* rq = (u16*)(gl + 64 * 16);
  u16* rk = rq + 64 * KS;
  u16* rv = PFV ? rk + 64 * KS : rq;
  typedef __attribute__((ext_vector_type(4))) unsigned u32x4_t;
  u32x4_t rqr[NQ], rkr[NQ], rvr[PFV ? NV : 1];
#define PREP_ISSUE(uu_) do { \
    const int c_i = (uu_) / H, h_i = (uu_) % H; \
    const int row0_i = (c_i < 128) ? (c_i >> 5) * 2048 + (c_i & 31) * 64 : MP + (c_i - 128) * 64; \
    const u16* prow_i = proj + (size_t)row0_i * LD; \
    const int cq_i = (MODE == 0) ? h_i * 128 : (MODE == 1 ? 3072 + h_i * 128 : h_i * 256); \
    const int ck_i = (MODE == 0) ? 512 + h_i * 128 : (MODE == 1 ? 4096 + h_i * 128 : 1024 + h_i * 256); \
    const int vc_i = (MODE == 0) ? 1024 + h_i * 256 : (MODE == 1 ? 5120 + h_i * 128 : 2048 + h_i * 512); \
    _Pragma("unroll") for (int i = 0; i < NQ; ++i) { \
      const int idx = tid + i * 512, r = idx / (K / 8), cc = idx % (K / 8); \
      rqr[i] = *(const u32x4_t*)(prow_i + (size_t)r * LD + cq_i + cc * 8); \
      rkr[i] = *(const u32x4_t*)(prow_i + (size_t)r * LD + ck_i + cc * 8); \
    } \
    if constexpr (PFV) { \
      _Pragma("unroll") for (int i = 0; i < NV; ++i) { \
        const int idx = tid + i * 512, r = idx / (V / 8), cc = idx % (V / 8); \
        rvr[i] = *(const u32x4_t*)(prow_i + (size_t)r * LD + vc_i + cc * 8); \
      } \
    } } while (0)
  if (u0 < u1) PREP_ISSUE(u0);
#pragma unroll 1
  for (int uu = u0; uu < u1; uu += ustride) {
  const int c = uu / H, h = uu % H;
  int row0, pos0;
  if (c < 128) { row0 = (c >> 5) * 2048 + (c & 31) * 64; pos0 = (c & 31) * 64; }
  else { row0 = MP + (c - 128) * 64; pos0 = 1024; }
  const size_t u = (size_t)c * H + h;
  const u16* prow = proj + (size_t)row0 * LD;
  const int vc0 = (MODE == 0) ? 1024 + h * 256 : (MODE == 1 ? 5120 + h * 128 : 2048 + h * 512);
  __syncthreads();
#pragma unroll
  for (int i = 0; i < NQ; ++i) {
    const int idx = tid + i * 512, r = idx / (K / 8), cc = idx % (K / 8);
    *(u32x4_t*)(rq + r * KS + cc * 8) = rqr[i];
    *(u32x4_t*)(rk + r * KS + cc * 8) = rkr[i];
  }
  if constexpr (PFV) {
#pragma unroll
    for (int i = 0; i < NV; ++i) {
      const int idx = tid + i * 512, r = idx / (V / 8), cc = idx % (V / 8);
      *(u32x4_t*)(rv + r * VS + cc * 8) = rvr[i];
    }
  }
  if (MODE == 2) {
    for (int i = tid; i < 64 * 2; i += 512) {
      const int r = i >> 1, hh = i & 1;
      uint4 g4 = *(const uint4*)(prow + (size_t)r * LD + 6144 + hh * 8);
      float* d = gl + r * 16 + hh * 8;
      d[0] = __uint_as_float(g4.x << 16); d[1] = __uint_as_float(g4.x & 0xffff0000u);
      d[2] = __uint_as_float(g4.y << 16); d[3] = __uint_as_float(g4.y & 0xffff0000u);
      d[4] = __uint_as_float(g4.z << 16); d[5] = __uint_as_float(g4.z & 0xffff0000u);
      d[6] = __uint_as_float(g4.w << 16); d[7] = __uint_as_float(g4.w & 0xffff0000u);
    }
  }
  if (uu + ustride < u1) PREP_ISSUE(uu + ustride);
  __builtin_amdgcn_sched_barrier(0);
  __syncthreads();
#pragma unroll 1
  for (int pass = 0; pass < NPASS; ++pass) {
  const int kk = pass * 128 + (tid & 127);
  float qv[TL], kv[TL], bc[TL];
  if (MODE == 0) {
    const int j = kk & 63;
    const float invr = exp2f(-(float)j * (13.287712379549449f / 64.f)) * 0.15915494309189535f;
    const float lgam = log1pf(-exp2f(-5.f - (float)h));
#pragma unroll
    for (int i = 0; i < TL; ++i) {
      const int l = seg * TL + i;
      float rev = (float)(pos0 + l) * invr;
      rev -= floorf(rev);
      const float sn = __builtin_amdgcn_sinf(rev), cs = __builtin_amdgcn_cosf(rev);
      const float q1 = bf2f(rq[l * KS + j]), q2 = bf2f(rq[l * KS + j + 64]), k1 = bf2f(rk[l * KS + j]), k2 = bf2f(rk[l * KS + j + 64]);
      const float qr = (kk < 64) ? q1 * cs - q2 * sn : q1 * sn + q2 * cs;
      const float kr = (kk < 64) ? k1 * cs - k2 * sn : k1 * sn + k2 * cs;
      qv[i] = qr; kv[i] = kr * 0.08838834764831845f;
      bc[i] = lgam;
    }
  } else if (MODE == 1) {
    const int ch = h * 128 + kk;
    const float* lbp = p.in[11];
    float e0 = __expf(lbp[ch]), e1 = __expf(lbp[1024 + ch]), e2 = __expf(lbp[2048 + ch]);
    const float lb = e0 / (e0 + e1 + e2);
#pragma unroll
    for (int i = 0; i < TL; ++i) {
      const int l = seg * TL + i;
      const float qx = bf2f(rq[l * KS + kk]), fx = bf2f(rk[l * KS + kk]);
      qv[i] = siluf_(qx) * 0.08838834764831845f;
      const float sg = sigmoidf_(fx);
      const float f = lb + (1.f - lb) * sg;
      kv[i] = (1.f - lb) * (1.f - sg);
      bc[i] = __logf(f);
    }
  } else {
    const int ch = h * 256 + kk;
    const float* w2 = p.in[14];
    float wvv[16];
#pragma unroll
    for (int r = 0; r < 16; ++r) wvv[r] = w2[r * 1024 + ch];
    const float bias = p.in[15][ch];
#pragma unroll
    for (int i = 0; i < TL; ++i) {
      const int l = seg * TL + i;
      qv[i] = bf2f(rq[l * KS + kk]) * 0.0625f;
      kv[i] = bf2f(rk[l * KS + kk]);
      float x = bias;
#pragma unroll
      for (int r = 0; r < 16; ++r) x += gl[l * 16 + r] * wvv[r];
      const float ls = fminf(x, 0.f) - log1pf(__expf(-fabsf(x)));
      bc[i] = ls * (1.f / 16.f);
    }
  }
#pragma unroll
  for (int i = 1; i < TL; ++i) bc[i] += bc[i - 1];
  segtot[seg * K + kk] = bc[TL - 1];
  __syncthreads();
  float pre = 0.f, bL = 0.f;
#pragma unroll
  for (int sg = 0; sg < NSEG; ++sg) { float t = segtot[sg * K + kk]; bL += t; if (sg < seg) pre += t; }
  if (seg == 0) dL[u * K + kk] = __expf(bL);
  unsigned kop[TL / 2];
#pragma unroll
  for (int i = 0; i < TL; i += 2) {
    float ko2[2];
#pragma unroll
    for (int e = 0; e < 2; ++e) {
      const int l = seg * TL + i + e;
      const float b = bc[i + e] + pre;
      const float qi = qv[i + e] * __expf(b);
      const float ki = kv[i + e] * __expf(-b);
      ko2[e] = kv[i + e] * __expf(bL - b);
      const u16 qb = f2bf(qi);
      qs[l * KS + kk] = qb;
      ksm[l * KS + kk] = f2bf(ki);
    }
    kop[i / 2] = pack2(ko2[0], ko2[1]);
  }
  {
#pragma unroll
    for (int i = 0; i < TL / 8; ++i) {
      const int cc = seg * 2 + i;
      uint4* dst = (uint4*)(koT + u * K * 64 + ((((kk >> 4) * 2 + (cc >> 2)) * 64 + (cc & 3) * 16 + (kk & 15)) << 3));
      *dst = make_uint4(kop[i * 4 + 0], kop[i * 4 + 1], kop[i * 4 + 2], kop[i * 4 + 3]);
    }
  }
  }
  __syncthreads();
  for (int i = tid; i < 64 * (K / 8); i += 512) {
    const int r = i / (K / 8), cc = i % (K / 8);
    *(uint4*)(qin + u * 64 * K + ((((r >> 4) * (K / 32) + (cc >> 2)) * 64 + (cc & 3) * 16 + (r & 15)) << 3)) = *(const uint4*)(qs + r * KS + cc * 8);
  }
  if constexpr (!PFV) {
    for (int i = tid; i < 64 * (V / 8); i += 512) {
      const int r = i / (V / 8), cc = i % (V / 8);
      *(uint4*)(rv + r * VS + cc * 8) = *(const uint4*)(prow + (size_t)r * LD + vc0 + cc * 8);
    }
    __syncthreads();
  }
  for (int it = tid; it < V * 4; it += 512) {
    const int ch = it % V, sg = it / V;
    unsigned pk[8];
#pragma unroll
    for (int i = 0; i < 8; ++i) {
      u16 a = rv[(sg * 16 + 2 * i) * VS + ch];
      u16 b = rv[(sg * 16 + 2 * i + 1) * VS + ch];
      pk[i] = (unsigned)a | ((unsigned)b << 16);
    }
    {
      const int c0 = sg * 2, c1 = sg * 2 + 1;
      *(uint4*)(vT + u * V * 64 + ((((ch >> 4) * 2 + (c0 >> 2)) * 64 + (c0 & 3) * 16 + (ch & 15)) << 3)) = make_uint4(pk[0], pk[1], pk[2], pk[3]);
      *(uint4*)(vT + u * V * 64 + ((((ch >> 4) * 2 + (c1 >> 2)) * 64 + (c1 & 3) * 16 + (ch & 15)) << 3)) = make_uint4(pk[4], pk[5], pk[6], pk[7]);
    }
  }
  {
    const int w = tid >> 6, lane = tid & 63, fr = lane & 15, fq = lane >> 4;
#pragma unroll 1
    for (int bi = 0; bi < 2; ++bi) {
      const int blk = w + bi * 8, lb = blk >> 2, sb = blk & 3;
      f32x4 acc = {0.f, 0.f, 0.f, 0.f};
      if (sb <= lb) {
#pragma unroll
        for (int kst = 0; kst < K / 32; ++kst) {
          bf16x8 a = *(const bf16x8*)(ksm + (sb * 16 + fr) * KS + kst * 32 + fq * 8);
          bf16x8 b = *(const bf16x8*)(qs + (lb * 16 + fr) * KS + kst * 32 + fq * 8);
          acc = __builtin_amdgcn_mfma_f32_16x16x32_bf16(a, b, acc, 0, 0, 0);
        }
      }
      const int l = lb * 16 + fr, s0 = sb * 16 + fq * 4;
      float v0 = (s0 + 0 <= l) ? acc[0] : 0.f, v1 = (s0 + 1 <= l) ? acc[1] : 0.f;
      float v2 = (s0 + 2 <= l) ? acc[2] : 0.f, v3 = (s0 + 3 <= l) ? acc[3] : 0.f;
      *(uint2*)(Pm + u * 4096 + ((((lb * 2 + (s0 >> 5)) * 64 + ((s0 & 31) >> 3) * 16 + fr) << 3) + (s0 & 7))) = make_uint2(pack2(v0, v1), pack2(v2, v3));
    }
  }
  }
}

template <int K, int V>
__device__ __forceinline__ void seq_unit(int wv, const u16* __restrict__ qin, const u16* __restrict__ koT, const u16* __restrict__ Pm, const u16* __restrict__ vT,
                         const float* __restrict__ dL, int H, int c0, int nch, int h, int vs,
                         const float* __restrict__ s0, float* __restrict__ sout, u16* __restrict__ o, int row0, int ocol, unsigned char* shm) {
  const int tix = tidx(wv);
  constexpr int NKB = K / 128, SST = K + 8;
  u16* ST = (u16*)shm;
  const int tid = tix, w = tid >> 6, lane = tid & 63, fr = lane & 15, fq = lane >> 4;
  f32x4 accS[NKB][2];
  __syncthreads();
#pragma unroll
  for (int kb = 0; kb < NKB; ++kb)
#pragma unroll
    for (int vb = 0; vb < 2; ++vb) {
      const int k = (w * NKB + kb) * 16 + fq * 4, vcol = vb * 16 + fr;
#pragma unroll
      for (int j = 0; j < 4; ++j) accS[kb][vb][j] = s0 ? s0[(size_t)(k + j) * V + vs * 32 + vcol] : 0.f;
      *(uint2*)(ST + vcol * SST + k) = make_uint2(pack2(accS[kb][vb][0], accS[kb][vb][1]), pack2(accS[kb][vb][2], accS[kb][vb][3]));
    }
  __syncthreads();
  int cur = 0;
  const int lb = w >> 1, ovb = w & 1;
  struct FragsO { bf16x8 op[2], oq[K / 32]; };
  struct FragsS { bf16x8 ka[NKB][2], vf[2][2]; float4 d[NKB]; };
  auto load_o = [&](int ci, FragsO& f) {
    const size_t u = (size_t)(c0 + ci) * H + h;
    const u16* Pu = Pm + u * 4096;
    const u16* qu = qin + u * 64 * K;
#pragma unroll
    for (int ss = 0; ss < 2; ++ss) f.op[ss] = *(const bf16x8*)(Pu + (((lb * 2 + ss) * 64 + lane) << 3));
#pragma unroll
    for (int kst = 0; kst < K / 32; ++kst) f.oq[kst] = *(const bf16x8*)(qu + (((lb * (K / 32) + kst) * 64 + lane) << 3));
  };
  auto load_s = [&](int ci, FragsS& f) {
    const size_t u = (size_t)(c0 + ci) * H + h;
    const u16* ku = koT + u * K * 64;
    const u16* vu = vT + u * V * 64;
    const float* du = dL + u * K;
#pragma unroll
    for (int vb = 0; vb < 2; ++vb)
#pragma unroll
      for (int ss = 0; ss < 2; ++ss) f.vf[vb][ss] = *(const bf16x8*)(vu + ((((vs * 2 + vb) * 2 + ss) * 64 + lane) << 3));
#pragma unroll
    for (int kb = 0; kb < NKB; ++kb) {
      const int kbase = (w * NKB + kb) * 16;
      f.d[kb] = *(const float4*)(du + kbase + fq * 4);
      f.ka[kb][0] = *(const bf16x8*)(ku + ((((w * NKB + kb) * 2 + 0) * 64 + lane) << 3));
      f.ka[kb][1] = *(const bf16x8*)(ku + ((((w * NKB + kb) * 2 + 1) * 64 + lane) << 3));
    }
  };
  FragsO fo;
  FragsS f0;
  load_o(0, fo);
  load_s(0, f0);
  for (int ci = 0; ci < nch; ++ci) {
    const int cn = ci + 1 < nch ? ci + 1 : ci;
    FragsO fo1;
    FragsS f1;
    load_o(cn, fo1);
    load_s(cn, f1);
    __builtin_amdgcn_sched_barrier(0);
    const u16* STc = ST + cur * 32 * SST;
    u16* STn = ST + (cur ^ 1) * 32 * SST;
    f32x4 ao = {0.f, 0.f, 0.f, 0.f};
#pragma unroll
    for (int ss = 0; ss < 2; ++ss) {
      bf16x8 a = ovb ? f0.vf[1][ss] : f0.vf[0][ss];
      ao = __builtin_amdgcn_mfma_f32_16x16x32_bf16(a, fo.op[ss], ao, 0, 0, 0);
    }
#pragma unroll
    for (int kst = 0; kst < K / 32; ++kst) {
      bf16x8 a = *(const bf16x8*)(STc + (ovb * 16 + fr) * SST + kst * 32 + fq * 8);
      ao = __builtin_amdgcn_mfma_f32_16x16x32_bf16(a, fo.oq[kst], ao, 0, 0, 0);
    }
    *(uint2*)(o + (size_t)(row0 + ci * 64 + lb * 16 + fr) * D + ocol + vs * 32 + ovb * 16 + fq * 4) =
        make_uint2(pack2(ao[0], ao[1]), pack2(ao[2], ao[3]));
#pragma unroll
    for (int kb = 0; kb < NKB; ++kb) {
      const int kbase = (w * NKB + kb) * 16;
      const float4 d4 = f0.d[kb];
#pragma unroll
      for (int vb = 0; vb < 2; ++vb) {
        f32x4 sv = accS[kb][vb];
        sv[0] *= d4.x; sv[1] *= d4.y; sv[2] *= d4.z; sv[3] *= d4.w;
        sv = __builtin_amdgcn_mfma_f32_16x16x32_bf16(f0.ka[kb][0], f0.vf[vb][0], sv, 0, 0, 0);
        sv = __builtin_amdgcn_mfma_f32_16x16x32_bf16(f0.ka[kb][1], f0.vf[vb][1], sv, 0, 0, 0);
        accS[kb][vb] = sv;
        *(uint2*)(STn + (vb * 16 + fr) * SST + kbase + fq * 4) = make_uint2(pack2(sv[0], sv[1]), pack2(sv[2], sv[3]));
      }
    }
    asm volatile("s_waitcnt lgkmcnt(0)" ::: "memory");
    __builtin_amdgcn_s_barrier();
    asm volatile("" ::: "memory");
    cur ^= 1;
    f0 = f1;
    fo = fo1;
  }
#pragma unroll
  for (int kb = 0; kb < NKB; ++kb)
#pragma unroll
    for (int vb = 0; vb < 2; ++vb) {
      const int k = (w * NKB + kb) * 16 + fq * 4, vcol = vb * 16 + fr;
#pragma unroll
      for (int j = 0; j < 4; ++j) sout[(size_t)(k + j) * V + vs * 32 + vcol] = accS[kb][vb][j];
    }
}

__device__ __forceinline__ void seq_even_phase(int wv, const Params& p, unsigned char* shm) {
  unsigned char* R = p.ws + OFF_R;
  u16* o = (u16*)(p.ws + OFF_HN);
  for (int u = blockIdx.x; u < 768; u += gridDim.x) {
    if (u < 256) {
      const int x = u & 7, y = u >> 3;
      if (y < 16) {
        const int g = x * 2 + (y >> 3), b = g >> 2, h = g & 3, vs = y & 7;
        seq_unit<128, 256>(wv, (u16*)(R + R_QA), (u16*)(R + R_KA), (u16*)(R + R_PA), (u16*)(R + R_VA), (float*)(R + R_DA), 4, b * 32, 32, h, vs,
                           nullptr, p.out + O_RETP + (size_t)(b * 4 + h) * 128 * 256, o, b * 2048, h * 256, shm);
      } else {
        const int yy = y - 16, g = x * 4 + (yy >> 2), b = g >> 3, h = g & 7, vs = yy & 3;
        seq_unit<128, 128>(wv, (u16*)(R + R_QB), (u16*)(R + R_KB), (u16*)(R + R_PB), (u16*)(R + R_VB), (float*)(R + R_DB), 8, b * 32, 32, h, vs,
                           nullptr, p.out + O_HGP + (size_t)(b * 8 + h) * 128 * 128, o, b * 2048, 1024 + h * 128, shm);
      }
    } else if (u < 512) {
      int x = u - 256, b = x >> 5, h = (x >> 3) & 3, vs = x & 7;
      seq_unit<128, 256>(wv, (u16*)(R + R_QA), (u16*)(R + R_KA), (u16*)(R + R_PA), (u16*)(R + R_VA), (float*)(R + R_DA), 4, 128 + b, 1, h, vs,
                         p.in[2] + (size_t)(b * 4 + h) * 128 * 256, p.out + O_RETS + (size_t)(b * 4 + h) * 128 * 256, o, MP + b * 64, h * 256, shm);
    } else {
      int x = u - 512, b = x >> 5, h = (x >> 2) & 7, vs = x & 3;
      seq_unit<128, 128>(wv, (u16*)(R + R_QB), (u16*)(R + R_KB), (u16*)(R + R_PB), (u16*)(R + R_VB), (float*)(R + R_DB), 8, 128 + b, 1, h, vs,
                         p.in[3] + (size_t)(b * 8 + h) * 128 * 128, p.out + O_HGS + (size_t)(b * 8 + h) * 128 * 128, o, MP + b * 64, 1024 + h * 128, shm);
    }
  }
}
__device__ __forceinline__ void seq_odd_phase(int wv, const Params& p, unsigned char* shm) {
  unsigned char* R = p.ws + OFF_R;
  u16* o = (u16*)(p.ws + OFF_HN);
  for (int u = blockIdx.x; u < 768; u += gridDim.x) {
    if (u < 256) {
      const int x = u & 7, y = u >> 3, g = x * 2 + (y >> 4), b = g >> 2, h = g & 3, vs = y & 15;
      seq_unit<256, 512>(wv, (u16*)(R + R_QC), (u16*)(R + R_KC), (u16*)(R + R_PC), (u16*)(R + R_VC), (float*)(R + R_DC), 4, b * 32, 32, h, vs,
                         nullptr, p.out + O_GLP + (size_t)(b * 4 + h) * 256 * 512, o, b * 2048, h * 512, shm);
    } else {
      int x = u - 256, b = x >> 6, h = (x >> 4) & 3, vs = x & 15;
      seq_unit<256, 512>(wv, (u16*)(R + R_QC), (u16*)(R + R_KC), (u16*)(R + R_PC), (u16*)(R + R_VC), (float*)(R + R_DC), 4, 128 + b, 1, h, vs,
                         p.in[4] + (size_t)(b * 4 + h) * 256 * 512, p.out + O_GLS + (size_t)(b * 4 + h) * 256 * 512, o, MP + b * 64, h * 512, shm);
    }
  }
}

__device__ __forceinline__ void up8(u32x4_t v, float* f) {
  f[0] = __uint_as_float(v[0] << 16); f[1] = __uint_as_float(v[0] & 0xffff0000u);
  f[2] = __uint_as_float(v[1] << 16); f[3] = __uint_as_float(v[1] & 0xffff0000u);
  f[4] = __uint_as_float(v[2] << 16); f[5] = __uint_as_float(v[2] & 0xffff0000u);
  f[6] = __uint_as_float(v[3] << 16); f[7] = __uint_as_float(v[3] & 0xffff0000u);
}
template <int ODD>
__device__ __forceinline__ void post_phase(int wv, const Params& p) {
  const int tix = tidx(wv);
  const int lane = tix & 63, gw = blockIdx.x * 8 + (tix >> 6), nw = gridDim.x * 8;
  const u16* o = (const u16*)(p.ws + OFF_HN);
  const u16* proj = (const u16*)(p.ws + OFF_BIG);
  u16* ao = (u16*)(p.ws + OFF_R);
#define POST_LOAD(xr_, gr_, row_) do { const int r_ = (row_); \
    _Pragma("unroll") for (int i = 0; i < 4; ++i) { const int col_ = i * 512 + lane * 8; \
      xr_[i] = *(const u32x4_t*)(o + (size_t)r_ * D + col_); \
      gr_[i] = *(const u32x4_t*)(proj + (size_t)r_ * (ODD ? NINO_PAD : NINE) + (ODD ? 4096 + col_ : (i < 2 ? 2048 + col_ : 6144 + (col_ - 1024)))); } } while (0)
  u32x4_t xr[4], gr[4];
  if (gw < MT) POST_LOAD(xr, gr, gw);
#pragma unroll 1
  for (int row = gw; row < MT; row += nw) {
    u32x4_t xn[4], gn4[4];
    if (row + nw < MT) POST_LOAD(xn, gn4, row + nw);
    else {
#pragma unroll
      for (int i = 0; i < 4; ++i) { xn[i] = xr[i]; gn4[i] = gr[i]; }
    }
    __builtin_amdgcn_sched_barrier(0);
#pragma unroll
    for (int i = 0; i < 4; ++i) {
      const int col = i * 512 + lane * 8;
      float x[8], g[8], y[8];
      up8(xr[i], x);
      up8(gr[i], g);
      if (ODD) {
        float ss = 0.f;
#pragma unroll
        for (int e = 0; e < 8; ++e) ss += x[e] * x[e];
#pragma unroll
        for (int off = 32; off > 0; off >>= 1) ss += __shfl_xor(ss, off, 64);
        const float rs = rsqrtf(ss * (1.f / 512.f) + EPS);
        const float* gn = p.in[16] + lane * 8;
#pragma unroll
        for (int e = 0; e < 8; ++e) y[e] = x[e] * rs * gn[e] * siluf_(g[e]);
      } else if (i < 2) {
        float s1 = 0.f;
#pragma unroll
        for (int e = 0; e < 8; ++e) s1 += x[e];
#pragma unroll
        for (int off = 16; off > 0; off >>= 1) s1 += __shfl_xor(s1, off, 64);
        const float mu = s1 * (1.f / 256.f);
        float s2 = 0.f;
#pragma unroll
        for (int e = 0; e < 8; ++e) { float dlt = x[e] - mu; s2 += dlt * dlt; }
#pragma unroll
        for (int off = 16; off > 0; off >>= 1) s2 += __shfl_xor(s2, off, 64);
        const float rs = rsqrtf(s2 * (1.f / 256.f) + EPS);
#pragma unroll
        for (int e = 0; e < 8; ++e) y[e] = (x[e] - mu) * rs * siluf_(g[e]);
      } else {
        float ss = 0.f;
#pragma unroll
        for (int e = 0; e < 8; ++e) ss += x[e] * x[e];
#pragma unroll
        for (int off = 8; off > 0; off >>= 1) ss += __shfl_xor(ss, off, 64);
        const float rs = rsqrtf(ss * (1.f / 128.f) + EPS);
        const float* gn = p.in[12] + (lane & 15) * 8;
#pragma unroll
        for (int e = 0; e < 8; ++e) y[e] = x[e] * rs * gn[e] * siluf_(g[e]);
      }
      st8(ao + (size_t)row * D + col, y);
    }
#pragma unroll
    for (int i = 0; i < 4; ++i) { xr[i] = xn[i]; gr[i] = gn4[i]; }
  }
#undef POST_LOAD
}

__device__ __forceinline__ void gate_phase(int wv, const Params& p, int layer) {
  const int tix = tidx(wv);
  const u16* au = (const u16*)(p.ws + OFF_BIG);
  u16* gg = (u16*)(p.ws + OFF_R);
  const float* cw = p.in[19] + (size_t)layer * 3 * DFF;
  const float* cb = p.in[20] + (size_t)layer * DFF;
  const float* cache = p.in[5] + (size_t)layer * 8 * 2 * DFF;
  const int nitems = (MT / 16) * (DFF / 8);
  for (int it = blockIdx.x * 512 + tix; it < nitems; it += gridDim.x * 512) {
    const int cg8 = it % (DFF / 8), rb = it / (DFF / 8), c0 = cg8 * 8, r0 = rb * 16;
    float w0[8], w1[8], w2[8], bb[8], am2[8], am1[8];
#pragma unroll
    for (int e = 0; e < 8; ++e) { w0[e] = cw[c0 + e]; w1[e] = cw[DFF + c0 + e]; w2[e] = cw[2 * DFF + c0 + e]; bb[e] = cb[c0 + e]; }
    int t0, T, b; bool samp = r0 >= MP;
    if (!samp) { b = r0 >> 11; t0 = r0 & 2047; T = 2048; } else { b = (r0 - MP) >> 6; t0 = (r0 - MP) & 63; T = 64; }
    if (t0 == 0) {
      if (samp) {
#pragma unroll
        for (int e = 0; e < 8; ++e) { am2[e] = cache[(size_t)(b * 2 + 0) * DFF + c0 + e]; am1[e] = cache[(size_t)(b * 2 + 1) * DFF + c0 + e]; }
      } else {
#pragma unroll
        for (int e = 0; e < 8; ++e) { am2[e] = 0.f; am1[e] = 0.f; }
      }
    } else {
      ld8(au + (size_t)(r0 - 2) * NUP + c0, am2);
      ld8(au + (size_t)(r0 - 1) * NUP + c0, am1);
    }
#pragma unroll 4
    for (int i = 0; i < 16; ++i) {
      float a[8], uu[8], y[8];
      ld8(au + (size_t)(r0 + i) * NUP + c0, a);
      ld8(au + (size_t)(r0 + i) * NUP + DFF + c0, uu);
#pragma unroll
      for (int e = 0; e < 8; ++e) {
        float cv = bb[e] + w0[e] * am2[e] + w1[e] * am1[e] + w2[e] * a[e];
        y[e] = siluf_(cv) * uu[e];
        am2[e] = am1[e]; am1[e] = a[e];
      }
      st8(gg + (size_t)(r0 + i) * DFF + c0, y);
    }
    if (t0 + 16 == T) {
      float* dst = samp ? p.out + O_CVS + (size_t)(layer * 8 + b) * 2 * DFF : p.out + O_CVP + (size_t)(layer * 4 + b) * 2 * DFF;
#pragma unroll
      for (int e = 0; e < 8; ++e) { dst[c0 + e] = am2[e]; dst[DFF + c0 + e] = am1[e]; }
    }
  }
}


__device__ __forceinline__ void gate_fixup(int wv, const Params& p, int layer) {
  const int tix = tidx(wv);
  const u16* side = (const u16*)(p.ws + OFF_SIDE);
  u16* gg = (u16*)(p.ws + OFF_R);
  const float* cw = p.in[19] + (size_t)layer * 3 * DFF;
  const float* cb = p.in[20] + (size_t)layer * DFF;
  for (int vw = blockIdx.x; vw < (MP / BM) * (D / BM); vw += gridDim.x) {
    int pm, pn;
    tile_coords(vw, MP / BM, D / BM, pm, pn);
    if ((pm & 7) == 0) continue;
    for (int c8 = tix; c8 < DFF / 8; c8 += 512) {
      const int c = c8 * 8;
      float a0[8], a1[8], u0[8], u1[8], q2[8], q1[8], y0[8], y1[8];
      ld8(side + (size_t)(pm * 2 + 0) * DFF + c, a0);
      ld8(side + (size_t)(pm * 2 + 1) * DFF + c, a1);
      ld8(side + SZ_SIDE1 / 2 + (size_t)(pm * 2 + 0) * DFF + c, u0);
      ld8(side + SZ_SIDE1 / 2 + (size_t)(pm * 2 + 1) * DFF + c, u1);
      ld8(side + SZ_SIDE1 + (size_t)((pm - 1) * 2 + 0) * DFF + c, q2);
      ld8(side + SZ_SIDE1 + (size_t)((pm - 1) * 2 + 1) * DFF + c, q1);
#pragma unroll
      for (int e = 0; e < 8; ++e) {
        const float w0 = cw[c + e], w1 = cw[DFF + c + e], w2 = cw[2 * DFF + c + e], bb = cb[c + e];
        y0[e] = siluf_(bb + w0 * q2[e] + w1 * q1[e] + w2 * a0[e]) * u0[e];
        y1[e] = siluf_(bb + w0 * q1[e] + w1 * a0[e] + w2 * a1[e]) * u1[e];
      }
      st8(gg + (size_t)(pm * 256 + 0) * DFF + c, y0);
      st8(gg + (size_t)(pm * 256 + 1) * DFF + c, y1);
    }
  }
  asm volatile("s_waitcnt vmcnt(0)" ::: "memory");
  __syncthreads();
}

#define XB_TMO      128
#define XB_XCNT(j)  (256  + 64 * (j))
#define XB_XSUB(j)  (1280 + 64 * (j))
#define XB_XGEN(j)  (2304 + 64 * (j))
#define XB_TOP      3328
#define XB_TOPGEN   3392
#define XCD_BAR_WORDS 3456
#define XB_SPIN_CAP (1u << 22)
#define LAS __attribute__((address_space(3)))
__device__ __forceinline__ unsigned xb_ld(unsigned* p)              { return __hip_atomic_load(p, __ATOMIC_RELAXED, __HIP_MEMORY_SCOPE_AGENT); }
__device__ __forceinline__ unsigned xb_add(unsigned* p, unsigned v) { return __hip_atomic_fetch_add(p, v, __ATOMIC_RELAXED, __HIP_MEMORY_SCOPE_AGENT); }
__device__ __forceinline__ unsigned xb_xcc_id() { return (unsigned)__builtin_amdgcn_s_getreg((3 << 11) | 20) & 0xFu; }
#define XB_SPIN(cond, bar) do { unsigned _sp = 0; while (cond) { __builtin_amdgcn_s_sleep(1); \
    if ((++_sp & 255u) == 0u) { if (xb_ld(&(bar)[XB_TMO])) break; if (_sp > XB_SPIN_CAP) { atomicAdd(&(bar)[XB_TMO], 1u); break; } } } } while (0)
struct XcdBarrier { unsigned* bar; unsigned x; volatile LAS unsigned* st; };
__device__ __forceinline__ XcdBarrier xcd_barrier_post(int wv, unsigned* bar, volatile LAS unsigned* st) {
  XcdBarrier b; b.bar = bar; b.x = xb_xcc_id(); b.st = st;
  if (tidx(wv) == 0) (void)xb_add(&bar[XB_XCNT(b.x)], 1u);
  return b;
}
__device__ __forceinline__ void xcd_barrier_complete(unsigned* bar, unsigned x, unsigned& nloc, unsigned& nx) {
  const unsigned G = gridDim.x * gridDim.y * gridDim.z;
  unsigned sum, cnt, mine, sp = 0u;
  for (;;) {
    sum = 0u; cnt = 0u; mine = 0u;
#pragma unroll
    for (unsigned j = 0; j < 16; ++j) { const unsigned c = xb_ld(&bar[XB_XCNT(j)]); sum += c; cnt += (c > 0u) ? 1u : 0u; mine = (j == x) ? c : mine; }
    if (sum == G) break;
    __builtin_amdgcn_s_sleep(1);
    if ((++sp & 255u) == 0u) { if (xb_ld(&bar[XB_TMO])) break; if (sp > XB_SPIN_CAP) { atomicAdd(&bar[XB_TMO], 1u); break; } }
  }
  nloc = mine > 0u ? mine : 1u; nx = cnt > 0u ? cnt : 1u;
}
__device__ __forceinline__ void xcd_barrier(int wv, const XcdBarrier& b) {
  asm volatile("s_waitcnt vmcnt(0)" ::: "memory");
  __syncthreads();
  if (tidx(wv) == 0) {
    unsigned* bar = b.bar;
    __builtin_amdgcn_s_waitcnt(0);
    unsigned nloc = b.st[0], nx = b.st[1];
    if (nloc == 0u) { xcd_barrier_complete(bar, b.x, nloc, nx); b.st[0] = nloc; b.st[1] = nx; }
    const unsigned old = xb_add(&bar[XB_XSUB(b.x)], 1u);
    const unsigned gen = old / nloc;
    if (old + 1u == (gen + 1u) * nloc) {
      __builtin_amdgcn_fence(__ATOMIC_RELEASE, "agent");
      asm volatile("s_waitcnt vmcnt(0)" ::: "memory");
      const unsigned og = xb_add(&bar[XB_TOP], 1u);
      const unsigned tg = og / nx;
      if (og + 1u == (tg + 1u) * nx) xb_add(&bar[XB_TOPGEN], 1u);
      else XB_SPIN(xb_ld(&bar[XB_TOPGEN]) == tg, bar);
      __builtin_amdgcn_fence(__ATOMIC_ACQUIRE, "agent");
      xb_add(&bar[XB_XGEN(b.x)], 1u);
      asm volatile("s_waitcnt vmcnt(0)" ::: "memory");
    } else {
      XB_SPIN(xb_ld(&bar[XB_XGEN(b.x)]) == gen, bar);
      __builtin_amdgcn_fence(__ATOMIC_ACQUIRE, "agent");
      asm volatile("s_waitcnt vmcnt(0)" ::: "memory");
    }
  }
  __syncthreads();
}

constexpr int NPHASE = 21;
#ifndef PHMASK
#define PHMASK 0xFFFFFFFFu
#endif
#define PH_ON(k) (((PHMASK) >> (k)) & 1u)
constexpr int LDS_BYTES = 147456;

typedef const __attribute__((address_space(4))) Params* KParamsPtr;
#ifndef XSYNC
#define XSYNC 0
#endif
#ifndef DUPMASK
#define DUPMASK 0u
#endif
#define DUP_ON(k) (((DUPMASK) >> (k)) & 1u)
__device__ __forceinline__ bool ph_in(KParamsPtr& kp, int k) { asm volatile("" : "+s"(kp)); return kp->ph_lo <= k && k < kp->ph_hi; }
#define PH_IN(k) ph_in(kp, (k))
#define PHASE(k, ...) if (PH_IN(k)) { if (PH_ON(k)) { for (int rep = 0; rep < 1 + (int)DUP_ON(k); ++rep) { asm volatile("" : "+s"(kp)); Params p; __builtin_memcpy(&p, kp, sizeof(Params)); unsigned char* ws = p.ws; __VA_ARGS__ } } \
    asm volatile("" : "+s"(kp)); \
    if (kp->coop && (k) + 1 < kp->ph_hi) { XcdBarrier xb; xb.bar = (unsigned*)(kp->ws + OFF_BAR); xb.x = xb_xcc_id(); xb.st = (volatile LAS unsigned*)&xb_words; xcd_barrier(wv, xb); if (XSYNC) xcd_barrier(wv, xb); } }
#define PHASE_X(k, ...) if (PH_IN(k)) { asm volatile("" : "+s"(kp)); Params p; __builtin_memcpy(&p, kp, sizeof(Params)); unsigned char* ws = p.ws; __VA_ARGS__ }
#define GEMM_ACC(k, Aoff, Woff, KK, RSSP, FIXL, RINP, RINS) PHASE(k, { float* rssp = (RSSP); if ((FIXL) >= 0) gate_fixup(wv, p, FIXL); \
    gemm_phase<MP, D, KK, 0>(wv, (const u16*)(ws + Aoff), (const u16*)(ws + Woff), EpiAccum{(float*)(ws + OFF_H), (u16*)(ws + OFF_HN), rssp, (RINP)}, (u16*)shm); \
    gemm_tail_phase<KK>(wv, (const u16*)(ws + Aoff), (const u16*)(ws + Woff), (float*)(ws + OFF_H), (float*)shm, (u16*)(ws + OFF_HN), rssp, (RINS)); })

__global__ void __launch_bounds__(512) fwd_kernel(Params p_) {
  extern __shared__ __attribute__((aligned(16))) unsigned char shm[];
  cg::grid_group grid = cg::this_grid();
  KParamsPtr kp = (KParamsPtr)__builtin_amdgcn_kernarg_segment_ptr();
  const int wv = __builtin_amdgcn_readfirstlane((int)(threadIdx.x >> 6));
  __shared__ uint4 xb_words;
  if (tidx(wv) == 0) xb_words = make_uint4(0u, 0u, 0u, 0u);
  __syncthreads();
  if (kp->coop == 2) grid.sync();
  (void)xcd_barrier_post(wv, (unsigned*)(kp->ws + OFF_BAR), (volatile LAS unsigned*)&xb_words);
  PHASE(0,
        convert_w(wv, p.in[9], (u16*)(ws + OFF_WINE), D, NINE, NINE, (u16*)shm);
        convert_w(wv, p.in[10], (u16*)(ws + OFF_WOUTE), D, D, D, (u16*)shm);
        convert_w(wv, p.in[13], (u16*)(ws + OFF_WINO), D, NINO, NINO_PAD, (u16*)shm, p.in[6] + D);
        convert_w(wv, p.in[17], (u16*)(ws + OFF_WOUTO), D, D, D, (u16*)shm);
        convert_w(wv, p.in[18], (u16*)(ws + OFF_WUP0), D, NUP, NUP, (u16*)shm, p.in[7], 1);
        convert_w(wv, p.in[18] + (size_t)D * NUP, (u16*)(ws + OFF_WUP1), D, NUP, NUP, (u16*)shm, p.in[7] + D, 1);
        convert_w(wv, p.in[21], (u16*)(ws + OFF_WDN0), DFF, D, D, (u16*)shm);
        convert_w(wv, p.in[21] + (size_t)DFF * D, (u16*)(ws + OFF_WDN1), DFF, D, D, (u16*)shm);
        for (int i = blockIdx.x * 512 + tidx(wv); i < 3 * MT; i += gridDim.x * 512) ((float*)(ws + OFF_RSS))[i] = 0.f;
        rmsnorm_phase<0>(wv, p, p.in[6]);)
  PHASE(1, gemm_phase<MT, NINE, D, 0>(wv, (const u16*)(ws + OFF_HN), (const u16*)(ws + OFF_WINE), EpiStoreBf16{(u16*)(ws + OFF_BIG), NINE, nullptr}, (u16*)shm);)
  PHASE(2, { const int b_ = blockIdx.x, G_ = gridDim.x;
        prep_range<0>(wv, p, b_, NCH * 4, G_, shm);
        const int first1 = ((NCH * 4 - b_ + G_ - 1) / G_) * G_ + b_ - NCH * 4;
        prep_range<1>(wv, p, first1, NCH * 8, G_, shm); })
  PHASE(3, seq_even_phase(wv, p, shm);)
  PHASE(4, post_phase<0>(wv, p);)
  GEMM_ACC(5, OFF_R, OFF_WOUTE, D, (float*)(ws + OFF_RSS), -1, p.in[0], p.in[1])
  PHASE(7, gemm_phase<MT, NUP, D, 0>(wv, (const u16*)(ws + OFF_HN), (const u16*)(ws + OFF_WUP0), EpiGate{(const __attribute__((address_space(4))) void*)kp, 0, 0}, (u16*)shm);)
  GEMM_ACC(9, OFF_R, OFF_WDN0, DFF, (float*)(ws + OFF_RSS) + MT, 0, (const float*)(ws + OFF_H), (const float*)(ws + OFF_H) + (size_t)MP * D)
  PHASE(11, gemm_phase<MT, NINO_PAD, D, 0>(wv, (const u16*)(ws + OFF_HN), (const u16*)(ws + OFF_WINO), EpiStoreBf16{(u16*)(ws + OFF_BIG), NINO_PAD, (const float*)(ws + OFF_RSS) + MT}, (u16*)shm);)
  PHASE(12, prep_range<2>(wv, p, blockIdx.x, NCH * 4, gridDim.x, shm);)
  PHASE(13, seq_odd_phase(wv, p, shm);)
  PHASE(14, post_phase<1>(wv, p);)
  GEMM_ACC(15, OFF_R, OFF_WOUTO, D, (float*)(ws + OFF_RSS) + 2 * MT, -1, (const float*)(ws + OFF_H), (const float*)(ws + OFF_H) + (size_t)MP * D)
  PHASE(17, gemm_phase<MT, NUP, D, 0>(wv, (const u16*)(ws + OFF_HN), (const u16*)(ws + OFF_WUP1), EpiGate{(const __attribute__((address_space(4))) void*)kp, 1, 2 * MT}, (u16*)shm);)
  GEMM_ACC(19, OFF_R, OFF_WDN1, DFF, (float*)nullptr, 1, (const float*)(ws + OFF_H), (const float*)(ws + OFF_H) + (size_t)MP * D)
  PHASE(20, rmsnorm_phase<2>(wv, p, p.in[8]);)
}

extern "C" void kernel_launch(void* const* d_in, const int* in_sizes, int n_in, void* d_out, int out_size, void* d_ws, size_t ws_size,
                              hipStream_t stream) {
  static int grid_blocks = 0;
  if (grid_blocks == 0) {
    int dev = 0, cus = 0, per_cu = 0;
    hipGetDevice(&dev);
    hipDeviceGetAttribute(&cus, hipDeviceAttributeMultiprocessorCount, dev);
    hipFuncSetAttribute((const void*)fwd_kernel, hipFuncAttributeMaxDynamicSharedMemorySize, LDS_BYTES);
    hipOccupancyMaxActiveBlocksPerMultiprocessor(&per_cu, (const void*)fwd_kernel, 512, LDS_BYTES);
    if (per_cu < 1) per_cu = 1;
    grid_blocks = cus * per_cu;
    (void)hipGetLastError();
  }
  if (n_in != 22 || ws_size < WS_NEED || (size_t)out_size != O_END) {
    fprintf(stderr, "kernel_launch: unexpected sizes n_in=%d ws=%zu need=%zu out=%d\n", n_in, ws_size, (size_t)WS_NEED, out_size);
    hipMemsetAsync(d_out, 0, (size_t)out_size * 4, stream);
    return;
  }
  Params p{};
  for (int i = 0; i < 22; ++i) p.in[i] = (const float*)d_in[i];
  p.out = (float*)d_out;
  p.ws = (unsigned char*)d_ws;
#if 0
  for (int ph = 0; ph < NPHASE; ++ph) {
    p.ph_lo = ph; p.ph_hi = ph + 1; p.coop = 0;
    hipLaunchKernelGGL(fwd_kernel, dim3(grid_blocks), dim3(512), LDS_BYTES, stream, p);
  }
#else
  p.ph_lo = 0; p.ph_hi = NPHASE; p.coop = 1;
  hipMemsetAsync((unsigned char*)d_ws + OFF_BAR, 0, XCD_BAR_WORDS * 4, stream);
  void* args[] = {&p};
  hipError_t e = hipLaunchCooperativeKernel((const void*)fwd_kernel, dim3(grid_blocks), dim3(512), args, LDS_BYTES, stream);
  if (e != hipSuccess) fprintf(stderr, "cooperative launch failed: %s (grid %d)\n", hipGetErrorString(e), grid_blocks);
#endif
}
```

```cpp
#include <hip/hip_runtime.h>
#include <hip/hip_bf16.h>
#include <hip/hip_cooperative_groups.h>
#include <cstdio>
namespace cg = cooperative_groups;

typedef unsigned short u16;
using bf16x8 = __attribute__((ext_vector_type(8))) short;
using f32x4 = __attribute__((ext_vector_type(4))) float;
typedef __attribute__((ext_vector_type(4))) unsigned u32x4_t;

constexpr int MP = 8192, MS = 512, MT = 8704, D = 2048;
constexpr int DFF = 5504, NUP = 11008;
constexpr int NINE = 7168, NINO = 6160, NINO_PAD = 6400;
constexpr int NCH = 136;
constexpr float EPS = 1e-6f;

constexpr size_t SZ_WINE = (size_t)NINE * D * 2, SZ_WOUT = (size_t)D * D * 2, SZ_WINO = (size_t)NINO_PAD * D * 2;
constexpr size_t SZ_WUP = (size_t)NUP * D * 2, SZ_WDN = (size_t)D * DFF * 2;
constexpr size_t OFF_WINE = 0;
constexpr size_t OFF_WOUTE = OFF_WINE + SZ_WINE;
constexpr size_t OFF_WINO = OFF_WOUTE + SZ_WOUT;
constexpr size_t OFF_WOUTO = OFF_WINO + SZ_WINO;
constexpr size_t OFF_WUP0 = OFF_WOUTO + SZ_WOUT;
constexpr size_t OFF_WUP1 = OFF_WUP0 + SZ_WUP;
constexpr size_t OFF_WDN0 = OFF_WUP1 + SZ_WUP;
constexpr size_t OFF_WDN1 = OFF_WDN0 + SZ_WDN;
constexpr size_t OFF_H = OFF_WDN1 + SZ_WDN;
constexpr size_t OFF_HN = OFF_H + (size_t)MT * D * 4;
constexpr size_t OFF_BIG = OFF_HN + (size_t)MT * D * 2;
constexpr size_t OFF_R = OFF_BIG + (size_t)MT * NUP * 2;
constexpr size_t SZ_R = 104ull * 1048576;
constexpr size_t OFF_RSS = OFF_R + SZ_R;
constexpr size_t OFF_SIDE = OFF_RSS + 3ull * MT * 4 + 256;
constexpr size_t SZ_SIDE1 = 34ull * 2 * DFF * 2;
constexpr size_t OFF_BAR = OFF_SIDE + 3 * SZ_SIDE1 + 256;
constexpr size_t WS_NEED = OFF_BAR + 16384;
constexpr size_t R_QA = 0;
constexpr size_t R_KA = R_QA + (size_t)NCH * 4 * 64 * 128 * 2;
constexpr size_t R_VA = R_KA + (size_t)NCH * 4 * 64 * 128 * 2;
constexpr size_t R_PA = R_VA + (size_t)NCH * 4 * 256 * 64 * 2;
constexpr size_t R_DA = R_PA + (size_t)NCH * 4 * 4096 * 2;
constexpr size_t R_QB = R_DA + (size_t)NCH * 4 * 128 * 4;
constexpr size_t R_KB = R_QB + (size_t)NCH * 8 * 64 * 128 * 2;
constexpr size_t R_VB = R_KB + (size_t)NCH * 8 * 64 * 128 * 2;
constexpr size_t R_PB = R_VB + (size_t)NCH * 8 * 128 * 64 * 2;
constexpr size_t R_DB = R_PB + (size_t)NCH * 8 * 4096 * 2;
constexpr size_t R_END_EVEN = R_DB + (size_t)NCH * 8 * 128 * 4;
constexpr size_t R_QC = 0;
constexpr size_t R_KC = R_QC + (size_t)NCH * 4 * 64 * 256 * 2;
constexpr size_t R_VC = R_KC + (size_t)NCH * 4 * 64 * 256 * 2;
constexpr size_t R_PC = R_VC + (size_t)NCH * 4 * 512 * 64 * 2;
constexpr size_t R_DC = R_PC + (size_t)NCH * 4 * 4096 * 2;
constexpr size_t R_END_ODD = R_DC + (size_t)NCH * 4 * 256 * 4;
static_assert(R_END_EVEN <= SZ_R && R_END_ODD <= SZ_R && (size_t)MT * DFF * 2 <= SZ_R, "R region too small");

constexpr size_t O_YP = 0;
constexpr size_t O_YS = O_YP + (size_t)MP * D;
constexpr size_t O_RETP = O_YS + (size_t)MS * D;
constexpr size_t O_RETS = O_RETP + 4ull * 4 * 128 * 256;
constexpr size_t O_HGP = O_RETS + 8ull * 4 * 128 * 256;
constexpr size_t O_HGS = O_HGP + 4ull * 8 * 128 * 128;
constexpr size_t O_GLP = O_HGS + 8ull * 8 * 128 * 128;
constexpr size_t O_GLS = O_GLP + 4ull * 4 * 256 * 512;
constexpr size_t O_CVP = O_GLS + 8ull * 4 * 256 * 512;
constexpr size_t O_CVS = O_CVP + 2ull * 4 * 2 * DFF;
constexpr size_t O_END = O_CVS + 2ull * 8 * 2 * DFF;

struct Params {
  const float* in[22];
  float* out;
  unsigned char* ws;
  int ph_lo, ph_hi, coop, pad;
};

__device__ __forceinline__ u16 f2bf(float f) {
  unsigned u = __float_as_uint(f);
  u += 0x7fffu + ((u >> 16) & 1u);
  return (u16)(u >> 16);
}
__device__ __forceinline__ float bf2f(u16 h) { return __uint_as_float(((unsigned)h) << 16); }
__device__ __forceinline__ unsigned pack2(float a, float b) { return (unsigned)f2bf(a) | ((unsigned)f2bf(b) << 16); }
__device__ __forceinline__ float sigmoidf_(float x) { return 1.f / (1.f + __expf(-x)); }
__device__ __forceinline__ float siluf_(float x) { return x / (1.f + __expf(-x)); }

__device__ __forceinline__ int tidx(int wv) { int l; asm volatile("v_mbcnt_lo_u32_b32 %0, -1, 0\n\tv_mbcnt_hi_u32_b32 %0, -1, %0" : "=v"(l)); return wv * 64 + l; }

__device__ __forceinline__ void convert_w(int wv, const float* __restrict__ src, u16* __restrict__ dst, int K, int N, int Npad, u16* tile, const float* __restrict__ kscale = nullptr, int upperm = 0) {
  const int tix = tidx(wv);
  constexpr int TS = 262;
  const int tn = (Npad + 255) / 256, tk = K / 64, nt = tn * tk, tid = tix;
  for (int t = blockIdx.x; t < nt; t += gridDim.x) {
    const int n0 = (t % tn) * 256, k0 = (t / tn) * 64;
    float4 v[8];
#pragma unroll
    for (int i = 0; i < 8; ++i) {
      const int idx = tid + i * 512, kk = idx >> 6, n = n0 + (idx & 63) * 4;
      v[i] = make_float4(0.f, 0.f, 0.f, 0.f);
      if (n < N) v[i] = *(const float4*)(src + (size_t)(k0 + kk) * N + n);
      if (kscale) { const float sc = kscale[k0 + kk]; v[i].x *= sc; v[i].y *= sc; v[i].z *= sc; v[i].w *= sc; }
    }
    __syncthreads();
#pragma unroll
    for (int i = 0; i < 8; ++i) {
      const int idx = tid + i * 512, kk = idx >> 6, nl = (idx & 63) * 4;
      *(unsigned*)(tile + kk * TS + nl) = pack2(v[i].x, v[i].y);
      *(unsigned*)(tile + kk * TS + nl + 2) = pack2(v[i].z, v[i].w);
    }
    __syncthreads();
#pragma unroll
    for (int i = 0; i < 4; ++i) {
      const int item = tid + i * 512, ks = item & 7, n = item >> 3;
      if (n0 + n < Npad) {
        const u16* tp = tile + (ks * 8) * TS + n;
        uint4 o;
        o.x = (unsigned)tp[0] | ((unsigned)tp[TS] << 16);
        o.y = (unsigned)tp[2 * TS] | ((unsigned)tp[3 * TS] << 16);
        o.z = (unsigned)tp[4 * TS] | ((unsigned)tp[5 * TS] << 16);
        o.w = (unsigned)tp[6 * TS] | ((unsigned)tp[7 * TS] << 16);
        int nr = n0 + n;
        if (upperm) nr = (nr < DFF) ? ((nr >> 7) * 256 + (nr & 127)) : ((((nr - DFF) >> 7) * 256) + 128 + ((nr - DFF) & 127));
        *(uint4*)(dst + (size_t)nr * K + k0 + ks * 8) = o;
      }
    }
  }
}

template <int MODE>
__device__ __forceinline__ void rmsnorm_phase(int wv, const Params& p, const float* __restrict__ w) {
  const int tix = tidx(wv);
  const int lane = tix & 63, gw = blockIdx.x * 8 + (tix >> 6), nw = gridDim.x * 8;
  const float* h = (const float*)(p.ws + OFF_H);
  u16* hn = (u16*)(p.ws + OFF_HN);
#define RMS_LOAD(dst, row_) do { const int r_ = (row_); const float* src_; \
    if (MODE == 0) src_ = (r_ < MP) ? p.in[0] + (size_t)r_ * D : p.in[1] + (size_t)(r_ - MP) * D; \
    else src_ = h + (size_t)r_ * D; \
    _Pragma("unroll") for (int i = 0; i < 8; ++i) dst[i] = *(const f32x4*)(src_ + (i * 64 + lane) * 4); } while (0)
  f32x4 v[8];
  if (gw < MT) RMS_LOAD(v, gw);
#pragma unroll 1
  for (int row = gw; row < MT; row += nw) {
    f32x4 nx[8];
    if (row + nw < MT) RMS_LOAD(nx, row + nw);
    else {
#pragma unroll
      for (int i = 0; i < 8; ++i) nx[i] = v[i];
    }
    __builtin_amdgcn_sched_barrier(0);
    float ss = 0.f;
#pragma unroll
    for (int i = 0; i < 8; ++i) ss += v[i][0] * v[i][0] + v[i][1] * v[i][1] + v[i][2] * v[i][2] + v[i][3] * v[i][3];
#pragma unroll
    for (int o = 32; o > 0; o >>= 1) ss += __shfl_xor(ss, o, 64);
    const float rs = rsqrtf(ss * (1.f / D) + EPS);
#pragma unroll
    for (int i = 0; i < 8; ++i) {
      const int col = (i * 64 + lane) * 4;
      const float4 wv4 = *(const float4*)(w + col);
      const float4 y = make_float4(v[i][0] * rs * wv4.x, v[i][1] * rs * wv4.y, v[i][2] * rs * wv4.z, v[i][3] * rs * wv4.w);
      if (MODE == 2) {
        float* dst = (row < MP) ? p.out + O_YP + (size_t)row * D : p.out + O_YS + (size_t)(row - MP) * D;
        *(float4*)(dst + col) = y;
      } else {
        *(uint2*)(hn + (size_t)row * D + col) = make_uint2(pack2(y.x, y.y), pack2(y.z, y.w));
      }
    }
#pragma unroll
    for (int i = 0; i < 8; ++i) v[i] = nx[i];
  }
#undef RMS_LOAD
}

__device__ __forceinline__ void ld8(const u16* p, float* f) {
  uint4 v = *(const uint4*)p;
  f[0] = __uint_as_float(v.x << 16); f[1] = __uint_as_float(v.x & 0xffff0000u);
  f[2] = __uint_as_float(v.y << 16); f[3] = __uint_as_float(v.y & 0xffff0000u);
  f[4] = __uint_as_float(v.z << 16); f[5] = __uint_as_float(v.z & 0xffff0000u);
  f[6] = __uint_as_float(v.w << 16); f[7] = __uint_as_float(v.w & 0xffff0000u);
}
__device__ __forceinline__ void st8(u16* p, const float* f) {
  *(uint4*)p = make_uint4(pack2(f[0], f[1]), pack2(f[2], f[3]), pack2(f[4], f[5]), pack2(f[6], f[7]));
}

constexpr int BM = 256, BK = 64, HALF = 128, NXCD = 8, WGM = 8, HT = HALF * BK;

__device__ __forceinline__ int lds_byte(int r, int c) {
  int st = (r >> 4) * 2 + (c >> 5), rr = r & 15, cc = c & 31, ob = rr * 64 + cc * 2;
  return st * 1024 + (ob ^ (((ob >> 9) & 1) << 5));
}
__device__ __forceinline__ void stage_rc(int b, int& R, int& C) {
  int st = b / 1024, sb = b % 1024, swz = sb ^ (((sb >> 9) & 1) << 5);
  R = (st >> 1) * 16 + swz / 64; C = (st & 1) * 32 + (swz % 64) / 2;
}

__device__ __forceinline__ void tile_coords(int wgid, int nM, int nN, int& pm, int& pn) {
  const int nwg = nM * nN;
  { int q = nwg / NXCD, r = nwg % NXCD, xcd = wgid % NXCD, off = wgid / NXCD;
    wgid = (xcd < r ? xcd * (q + 1) : r * (q + 1) + (xcd - r) * q) + off; }
  const int nig = WGM * nN, gid = wgid / nig, fm = gid * WGM, gsz = min(nM - fm, WGM);
  pm = fm + ((wgid % nig) % gsz); pn = (wgid % nig) / gsz;
}

struct EpiStoreBf16 {
  static constexpr bool GATE = false;
  u16* out; int ldo; const float* rss;
  __device__ __forceinline__ float row_scale(int row) const { return rss ? rsqrtf(rss[row] * (1.f / D) + EPS) : 1.f; }
  __device__ __forceinline__ float operator()(int row, int col, f32x4 v, float sc) const {
    uint2 pk = make_uint2(pack2(v[0] * sc, v[1] * sc), pack2(v[2] * sc, v[3] * sc));
    *(uint2*)(out + (size_t)row * ldo + col) = pk;
    return 0.f;
  }
  __device__ __forceinline__ void row_end(int, float, int) const {}
};
struct EpiAccum {
  static constexpr bool GATE = false;
  u16* hb; float* rss; const float* rin32;
  __device__ __forceinline__ float row_scale(int) const { return 1.f; }
  __device__ __forceinline__ float operator()(int row, int col, f32x4 v, float) const {
    u16* q = hb + (size_t)row * D + col;
    float4 o;
    if (rin32) o = *(const float4*)(rin32 + (size_t)row * D + col);
    else { const uint2 r = *(const uint2*)q; o = make_float4(__uint_as_float(r.x << 16), __uint_as_float(r.x & 0xffff0000u), __uint_as_float(r.y << 16), __uint_as_float(r.y & 0xffff0000u)); }
    o.x += v[0]; o.y += v[1]; o.z += v[2]; o.w += v[3];
    *(uint2*)q = make_uint2(pack2(o.x, o.y), pack2(o.z, o.w));
    return rss ? o.x * o.x + o.y * o.y + o.z * o.z + o.w * o.w : 0.f;
  }
  __device__ __forceinline__ void row_end(int row, float ss, int fq) const {
    if (rss) {
      ss += __shfl_xor(ss, 16, 64);
      ss += __shfl_xor(ss, 32, 64);
      if (fq == 0) unsafeAtomicAdd(rss + row, ss);
    }
  }
};

struct EpiGate {
  static constexpr bool GATE = true;
  const __attribute__((address_space(4))) void* kp; int layer; int rssoff;
  __device__ __forceinline__ float row_scale(int) const { return 1.f; }
  __device__ __forceinline__ float operator()(int, int, f32x4, float) const { return 0.f; }
  __device__ __forceinline__ void row_end(int, float, int) const {}
};

template <int M, int N, int K, int TAIL, class Epi>
__device__ __forceinline__ void gemm_phase(int wv, const u16* __restrict__ A, const u16* __restrict__ Bt, Epi epi, u16* shm) {
  const int tix = tidx(wv);
#define SA(b, h) (shm + ((b) * 2 + (h)) * HT)
#define SB(b, h) (shm + (4 + (b) * 2 + (h)) * HT)
#define STAGE(P, BASE, br, kt) do { const u16* _gb = BASE + ((long)(br) * K + (long)(kt0 + (kt)) * BK); \
    for (int _i = 0; _i < 2; ++_i) { int _b = tix * 16 + _i * 8192; \
      __builtin_amdgcn_global_load_lds((const unsigned*)(_gb + toff[_i]), \
        (__attribute__((address_space(3))) unsigned*)((char*)(P) + _b), 16, 0, 0); } } while (0)
#define LDA(dst, b, h) for (int m = 0; m < 4; ++m) for (int k = 0; k < 2; ++k) \
    dst[m][k] = *reinterpret_cast<const bf16x8*>((char*)SA(b, h) + lds_byte(wr * 64 + m * 16 + fr, k * 32 + fq * 8))
#define LDB(dst, b, h) for (int n = 0; n < 2; ++n) for (int k = 0; k < 2; ++k) \
    dst[n][k] = *reinterpret_cast<const bf16x8*>((char*)SB(b, h) + lds_byte(wc * 32 + n * 16 + fr, k * 32 + fq * 8))
#define MMA(ai, bj, At_, Bt_) do { __builtin_amdgcn_s_setprio(1); \
    for (int m = 0; m < 4; ++m) for (int n = 0; n < 2; ++n) for (int k = 0; k < 2; ++k) \
      acc[ai][bj][m][n] = __builtin_amdgcn_mfma_f32_16x16x32_bf16(Bt_[n][k], At_[m][k], acc[ai][bj][m][n], 0, 0, 0); \
    __builtin_amdgcn_s_setprio(0); } while (0)
#define WAIT_V(n) asm volatile("s_waitcnt vmcnt(" #n ")" ::: "memory")
#define WAIT_L(n) asm volatile("s_waitcnt lgkmcnt(" #n ")" ::: "memory")
#define BAR __builtin_amdgcn_s_barrier()
#define SCHED __builtin_amdgcn_sched_barrier(0)
  const int nM = M / BM, nN = N / BM, nwg = nM * nN, G = gridDim.x;
  const int nunits = nwg;
  const int wid = tix >> 6, lane = tix & 63, wr = wid >> 2, wc = wid & 3, fr = lane & 15, fq = lane >> 4;
  const int nt_total = K / BK;
  unsigned toff[2];
  for (int _i = 0; _i < 2; ++_i) { int _b = tix * 16 + _i * 8192; int _r, _c; stage_rc(_b, _r, _c); toff[_i] = (unsigned)(_r * K + _c); }
  for (int vw = blockIdx.x; vw < nunits; vw += G) {
    int pm, pn;
    tile_coords(vw, nM, nN, pm, pn);
    const int brow = pm * BM, bcol = pn * BM;
    constexpr int kt0 = 0, nt = nt_total;
    f32x4 acc[2][2][4][2];
    for (int a = 0; a < 2; ++a) for (int b = 0; b < 2; ++b) for (int m = 0; m < 4; ++m) for (int n = 0; n < 2; ++n) acc[a][b][m][n] = f32x4{0.f, 0.f, 0.f, 0.f};
    bf16x8 At[4][2], B0[2][2], B1[2][2];
    STAGE(SB(0, 0), Bt, bcol, 0); STAGE(SA(0, 0), A, brow, 0);
    STAGE(SB(0, 1), Bt, bcol + HALF, 0); STAGE(SA(0, 1), A, brow + HALF, 0);
    if (wr == 1) BAR;
    WAIT_V(4); BAR;
    STAGE(SB(1, 0), Bt, bcol, 1); STAGE(SA(1, 0), A, brow, 1); STAGE(SB(1, 1), Bt, bcol + HALF, 1);
    WAIT_V(6); BAR;
    for (int t = 0; t < nt - 2; t += 2) {
      LDB(B0, 0, 0); SCHED; LDA(At, 0, 0); STAGE(SA(1, 1), A, brow + HALF, t + 1);
      WAIT_L(8); BAR; WAIT_L(0); MMA(0, 0, At, B0); BAR; SCHED;
      LDB(B1, 0, 1); STAGE(SB(0, 0), Bt, bcol, t + 2);
      BAR; WAIT_L(0); MMA(0, 1, At, B1); BAR;
      LDA(At, 0, 1); STAGE(SA(0, 0), A, brow, t + 2);
      BAR; WAIT_L(0); MMA(1, 0, At, B0); BAR; SCHED;
      STAGE(SB(0, 1), Bt, bcol + HALF, t + 2);
      WAIT_V(6); BAR; MMA(1, 1, At, B1); BAR;
      LDB(B0, 1, 0); SCHED; LDA(At, 1, 0); STAGE(SA(0, 1), A, brow + HALF, t + 2);
      WAIT_L(8); BAR; WAIT_L(0); MMA(0, 0, At, B0); BAR; SCHED;
      LDB(B1, 1, 1); STAGE(SB(1, 0), Bt, bcol, t + 3);
      BAR; WAIT_L(0); MMA(0, 1, At, B1); BAR;
      LDA(At, 1, 1); STAGE(SA(1, 0), A, brow, t + 3);
      BAR; WAIT_L(0); MMA(1, 0, At, B0); BAR; SCHED;
      STAGE(SB(1, 1), Bt, bcol + HALF, t + 3);
      WAIT_V(6); BAR; MMA(1, 1, At, B1); BAR;
    }
    { LDB(B0, 0, 0); LDA(At, 0, 0); STAGE(SA(1, 1), A, brow + HALF, nt - 1);
      BAR; WAIT_L(0); MMA(0, 0, At, B0); BAR;
      LDB(B1, 0, 1); BAR; WAIT_L(0); MMA(0, 1, At, B1); BAR;
      LDA(At, 0, 1); WAIT_V(4); BAR; WAIT_L(0); MMA(1, 0, At, B0); MMA(1, 1, At, B1); BAR; }
    { LDB(B0, 1, 0); LDA(At, 1, 0); WAIT_V(2); BAR; WAIT_L(0); MMA(0, 0, At, B0); BAR;
      LDB(B1, 1, 1); WAIT_V(0); BAR; WAIT_L(0); MMA(0, 1, At, B1); BAR;
      LDA(At, 1, 1); BAR; WAIT_L(0); MMA(1, 0, At, B0); MMA(1, 1, At, B1); BAR; }
    if (wr == 0) BAR;
    if constexpr (Epi::GATE) {
      constexpr int LS = 136;
      u16* La = shm;
      u16* Lu = shm + 256 * LS;
      const __attribute__((address_space(4))) Params* gkp = (const __attribute__((address_space(4))) Params*)epi.kp;
      asm volatile("" : "+s"(gkp));
      int e_pm = pm, e_pn = pn, e_tix = tix;
      asm volatile("" : "+s"(e_pm), "+s"(e_pn));
      asm volatile("" : "+v"(e_tix));
      const int e_brow = e_pm * BM;
      {
        const int e_lane = e_tix & 63, e_wid = e_tix >> 6, e_wr = e_wid >> 2, e_wc = e_wid & 3, e_fr = e_lane & 15, e_fq = e_lane >> 4;
        const float* rss = (const float*)(gkp->ws + OFF_RSS) + epi.rssoff;
        _Pragma("unroll") for (int ai = 0; ai < 2; ++ai) _Pragma("unroll") for (int m = 0; m < 4; ++m) {
          const int rl = ai * HALF + e_wr * 64 + m * 16 + e_fr;
          const float sc = rsqrtf(rss[e_brow + rl] * (1.f / D) + EPS);
          _Pragma("unroll") for (int n = 0; n < 2; ++n) {
            const f32x4 a = acc[ai][0][m][n], uu = acc[ai][1][m][n];
            const int lo = rl * LS + e_wc * 32 + n * 16 + e_fq * 4;
            *(uint2*)(La + lo) = make_uint2(pack2(a[0] * sc, a[1] * sc), pack2(a[2] * sc, a[3] * sc));
            *(uint2*)(Lu + lo) = make_uint2(pack2(uu[0] * sc, uu[1] * sc), pack2(uu[2] * sc, uu[3] * sc));
          }
        }
      }
      WAIT_L(0); BAR; asm volatile("" ::: "memory");
      {
        const bool samp = e_brow >= MP;
        const int layer = epi.layer;
        u16* gg = (u16*)(gkp->ws + OFF_R);
        u16* side = (u16*)(gkp->ws + OFF_SIDE);
        const float* cw = gkp->in[19] + (size_t)layer * 3 * DFF;
        const float* cb = gkp->in[20] + (size_t)layer * DFF;
        const float* cache = gkp->in[5] + (size_t)layer * 8 * 2 * DFF;
        float* cvo = gkp->out + (samp ? O_CVS + (size_t)layer * 8 * 2 * DFF : O_CVP + (size_t)layer * 4 * 2 * DFF);
        const int cg = e_tix & 15, r0 = e_tix >> 4, c = e_pn * 128 + cg * 8;
        float w0[8], w1[8], w2[8], bb[8];
        _Pragma("unroll") for (int e = 0; e < 8; ++e) { w0[e] = cw[c + e]; w1[e] = cw[DFF + c + e]; w2[e] = cw[2 * DFF + c + e]; bb[e] = cb[c + e]; }
        _Pragma("unroll 1") for (int it = 0; it < 8; ++it) {
          const int rl = it * 32 + r0;
          const int t = samp ? (rl & 63) : ((e_pm & 7) * 256 + rl);
          const int sb = (e_pm - 32) * 4 + (rl >> 6);
          float a[8], uu[8], am1[8], am2[8], y[8];
          ld8(La + rl * LS + cg * 8, a);
          ld8(Lu + rl * LS + cg * 8, uu);
          _Pragma("unroll") for (int e = 0; e < 8; ++e) { am1[e] = 0.f; am2[e] = 0.f; }
          if (t >= 1 && rl >= 1) ld8(La + (rl - 1) * LS + cg * 8, am1);
          if (t >= 2 && rl >= 2) ld8(La + (rl - 2) * LS + cg * 8, am2);
          if (samp && t < 2) {
            const float* c1 = cache + (size_t)(sb * 2 + 1) * DFF + c;
            if (t == 0) {
              const float* c0 = cache + (size_t)(sb * 2 + 0) * DFF + c;
              _Pragma("unroll") for (int e = 0; e < 8; ++e) { am2[e] = c0[e]; am1[e] = c1[e]; }
            } else {
              _Pragma("unroll") for (int e = 0; e < 8; ++e) am2[e] = c1[e];
            }
          }
          if (!(t >= 2 && rl < 2)) {
            _Pragma("unroll") for (int e = 0; e < 8; ++e) { float cv = bb[e] + w0[e] * am2[e] + w1[e] * am1[e] + w2[e] * a[e]; y[e] = siluf_(cv) * uu[e]; }
            st8(gg + (size_t)(e_brow + rl) * DFF + c, y);
          } else {
            st8(side + (size_t)(e_pm * 2 + rl) * DFF + c, a);
            st8(side + SZ_SIDE1 / 2 + (size_t)(e_pm * 2 + rl) * DFF + c, uu);
          }
          if (rl >= 254) st8(side + SZ_SIDE1 + (size_t)(e_pm * 2 + rl - 254) * DFF + c, a);
          int crow = -1;
          if (!samp) { if ((e_pm & 7) == 7 && rl >= 254) crow = (e_pm >> 3) * 2 + rl - 254; }
          else { if ((rl & 63) >= 62) crow = sb * 2 + (rl & 63) - 62; }
          if (crow >= 0) {
            float* dst = cvo + (size_t)crow * DFF + c;
            *(float4*)dst = make_float4(a[0], a[1], a[2], a[3]);
            *(float4*)(dst + 4) = make_float4(a[4], a[5], a[6], a[7]);
          }
        }
      }
      WAIT_L(0); BAR; asm volatile("" ::: "memory");
    } else {
    for (int ai = 0; ai < 2; ++ai) for (int m = 0; m < 4; ++m) {
      const int row = brow + ai * HALF + wr * 64 + m * 16 + fr;
      const float sc = epi.row_scale(row);
      float ss = 0.f;
      for (int bj = 0; bj < 2; ++bj) for (int n = 0; n < 2; ++n)
        ss += epi(row, bcol + bj * HALF + wc * 32 + n * 16 + fq * 4, acc[ai][bj][m][n], sc);
      epi.row_end(row, ss, fq);
      if (m & 1) asm volatile("" ::: "memory");
    }
    }
  }
#undef SA
#undef SB
#undef STAGE
#undef LDA
#undef LDB
#undef MMA
}


template <int K>
__device__ __forceinline__ void gemm_tail_phase(int wv, const u16* __restrict__ A, const u16* __restrict__ Bt, float* lds, u16* __restrict__ hb, float* __restrict__ rss, const float* __restrict__ rin32_tail) {
  const int tix = tidx(wv);
  const int tid = tix, w = tid >> 6, lane = tid & 63, fr = lane & 15, fq = lane >> 4;
  for (int u = blockIdx.x; u < 256; u += gridDim.x) {
    const int tm = u >> 5, tn = u & 31;
    const u16* Ab = A + (size_t)(MP + tm * 64 + fr) * K + fq * 8;
    const u16* Bb = Bt + (size_t)(tn * 64 + fr) * K + fq * 8;
    f32x4 acc[4][4];
#pragma unroll
    for (int i = 0; i < 4; ++i)
#pragma unroll
      for (int j = 0; j < 4; ++j) acc[i][j] = f32x4{0.f, 0.f, 0.f, 0.f};
    const u16* Ab2 = A + (size_t)(MP + tm * 64 + fr) * K + fq * 16;
    const u16* Bb2 = Bt + (size_t)(tn * 64 + fr) * K + fq * 16;
#pragma unroll 1
    for (int ks = w; ks < K / 64; ks += 8) {
      bf16x8 a[4][2], b[4][2];
#pragma unroll
      for (int i = 0; i < 4; ++i) {
        a[i][0] = *(const bf16x8*)(Ab2 + (size_t)i * 16 * K + ks * 64);
        a[i][1] = *(const bf16x8*)(Ab2 + (size_t)i * 16 * K + ks * 64 + 8);
        b[i][0] = *(const bf16x8*)(Bb2 + (size_t)i * 16 * K + ks * 64);
        b[i][1] = *(const bf16x8*)(Bb2 + (size_t)i * 16 * K + ks * 64 + 8);
      }
#pragma unroll
      for (int mb = 0; mb < 4; ++mb)
#pragma unroll
        for (int nb = 0; nb < 4; ++nb) {
          acc[mb][nb] = __builtin_amdgcn_mfma_f32_16x16x32_bf16(b[nb][0], a[mb][0], acc[mb][nb], 0, 0, 0);
          acc[mb][nb] = __builtin_amdgcn_mfma_f32_16x16x32_bf16(b[nb][1], a[mb][1], acc[mb][nb], 0, 0, 0);
        }
    }
    __syncthreads();
#pragma unroll
    for (int mb = 0; mb < 4; ++mb)
#pragma unroll
      for (int nb = 0; nb < 4; ++nb) *(f32x4*)(lds + w * 4096 + (mb * 16 + fr) * 64 + nb * 16 + fq * 4) = acc[mb][nb];
    __syncthreads();
    const int e = tid * 8, row = e >> 6, col = e & 63;
    float4 s0 = make_float4(0.f, 0.f, 0.f, 0.f), s1 = s0;
#pragma unroll
    for (int ww = 0; ww < 8; ++ww) {
      float4 x0 = *(const float4*)(lds + ww * 4096 + e), x1 = *(const float4*)(lds + ww * 4096 + e + 4);
      s0.x += x0.x; s0.y += x0.y; s0.z += x0.z; s0.w += x0.w;
      s1.x += x1.x; s1.y += x1.y; s1.z += x1.z; s1.w += x1.w;
    }
    const int grow = MP + tm * 64 + row;
    u16* q = hb + (size_t)grow * D + tn * 64 + col;
    float r8[8];
    if (rin32_tail) {
      const float* rq_ = rin32_tail + (size_t)(tm * 64 + row) * D + tn * 64 + col;
      const float4 a0 = *(const float4*)rq_, a1 = *(const float4*)(rq_ + 4);
      r8[0] = a0.x; r8[1] = a0.y; r8[2] = a0.z; r8[3] = a0.w; r8[4] = a1.x; r8[5] = a1.y; r8[6] = a1.z; r8[7] = a1.w;
    } else ld8(q, r8);
    r8[0] += s0.x; r8[1] += s0.y; r8[2] += s0.z; r8[3] += s0.w; r8[4] += s1.x; r8[5] += s1.y; r8[6] += s1.z; r8[7] += s1.w;
    st8(q, r8);
    if (rss) {
      float ss = 0.f;
#pragma unroll
      for (int e2 = 0; e2 < 8; ++e2) ss += r8[e2] * r8[e2];
      ss += __shfl_xor(ss, 1, 64); ss += __shfl_xor(ss, 2, 64); ss += __shfl_xor(ss, 4, 64);
      if ((tid & 7) == 0) unsafeAtomicAdd(rss + grow, ss);
    }
  }
}

template <int MODE>
__device__ __forceinline__ void prep_range(int wv, const Params& p, int u0, int u1, int ustride, unsigned char* shm) {
  const int tix = tidx(wv);
  constexpr int K = (MODE == 2) ? 256 : 128;
  constexpr int V = (MODE == 0) ? 256 : (MODE == 1 ? 128 : 512);
  constexpr int H = (MODE == 1) ? 8 : 4;
  constexpr int LD = (MODE == 2) ? NINO_PAD : NINE;
  constexpr int NSEG = 4, TL = 16, KS = K + 8, VS = V + 8, NPASS = K / 128;
  constexpr int NQ = K / 64, NV = V / 64;
  constexpr bool PFV = (MODE != 2);
  const int tid = tix, seg = tid >> 7;
  const u16* proj = (const u16*)(p.ws + OFF_BIG);
  unsigned char* R = p.ws + OFF_R;
  u16* qin = (u16*)(R + (MODE == 0 ? R_QA : MODE == 1 ? R_QB : R_QC));
  u16* koT = (u16*)(R + (MODE == 0 ? R_KA : MODE == 1 ? R_KB : R_KC));
  u16* vT = (u16*)(R + (MODE == 0 ? R_VA : MODE == 1 ? R_VB : R_VC));
  u16* Pm = (u16*)(R + (MODE == 0 ? R_PA : MODE == 1 ? R_PB : R_PC));
  float* dL = (float*)(R + (MODE == 0 ? R_DA : MODE == 1 ? R_DB : R_DC));
  u16* qs = (u16*)shm;
  u16* ksm = qs + 64 * KS;
  float* segtot = (float*)(ksm + 64 * KS);
  float* gl = segtot + NSEG * K;
  u16* rq = (u16*)(gl + 64 * 16);
  u16* rk = rq + 64 * KS;
  u16* rv = PFV ? rk + 64 * KS : rq;
  typedef __attribute__((ext_vector_type(4))) unsigned u32x4_t;
  u32x4_t rqr[NQ], rkr[NQ], rvr[PFV ? NV : 1];
#define PREP_ISSUE(uu_) do { \
    const int c_i = (uu_) / H, h_i = (uu_) % H; \
    const int row0_i = (c_i < 128) ? (c_i >> 5) * 2048 + (c_i & 31) * 64 : MP + (c_i - 128) * 64; \
    const u16* prow_i = proj + (size_t)row0_i * LD; \
    const int cq_i = (MODE == 0) ? h_i * 128 : (MODE == 1 ? 3072 + h_i * 128 : h_i * 256); \
    const int ck_i = (MODE == 0) ? 512 + h_i * 128 : (MODE == 1 ? 4096 + h_i * 128 : 1024 + h_i * 256); \
    const int vc_i = (MODE == 0) ? 1024 + h_i * 256 : (MODE == 1 ? 5120 + h_i * 128 : 2048 + h_i * 512); \
    _Pragma("unroll") for (int i = 0; i < NQ; ++i) { \
      const int idx = tid + i * 512, r = idx / (K / 8), cc = idx % (K / 8); \
      rqr[i] = *(const u32x4_t*)(prow_i + (size_t)r * LD + cq_i + cc * 8); \
      rkr[i] = *(const u32x4_t*)(prow_i + (size_t)r * LD + ck_i + cc * 8); \
    } \
    if constexpr (PFV) { \
      _Pragma("unroll") for (int i = 0; i < NV; ++i) { \
        const int idx = tid + i * 512, r = idx / (V / 8), cc = idx % (V / 8); \
        rvr[i] = *(const u32x4_t*)(prow_i + (size_t)r * LD + vc_i + cc * 8); \
      } \
    } } while (0)
  if (u0 < u1) PREP_ISSUE(u0);
#pragma unroll 1
  for (int uu = u0; uu < u1; uu += ustride) {
  const int c = uu / H, h = uu % H;
  int row0, pos0;
  if (c < 128) { row0 = (c >> 5) * 2048 + (c & 31) * 64; pos0 = (c & 31) * 64; }
  else { row0 = MP + (c - 128) * 64; pos0 = 1024; }
  const size_t u = (size_t)c * H + h;
  const u16* prow = proj + (size_t)row0 * LD;
  const int vc0 = (MODE == 0) ? 1024 + h * 256 : (MODE == 1 ? 5120 + h * 128 : 2048 + h * 512);
  __syncthreads();
#pragma unroll
  for (int i = 0; i < NQ; ++i) {
    const int idx = tid + i * 512, r = idx / (K / 8), cc = idx % (K / 8);
    *(u32x4_t*)(rq + r * KS + cc * 8) = rqr[i];
    *(u32x4_t*)(rk + r * KS + cc * 8) = rkr[i];
  }
  if constexpr (PFV) {
#pragma unroll
    for (int i = 0; i < NV; ++i) {
      const int idx = tid + i * 512, r = idx / (V / 8), cc = idx % (V / 8);
      *(u32x4_t*)(rv + r * VS + cc * 8) = rvr[i];
    }
  }
  if (MODE == 2) {
    for (int i = tid; i < 64 * 2; i += 512) {
      const int r = i >> 1, hh = i & 1;
      uint4 g4 = *(const uint4*)(prow + (size_t)r * LD + 6144 + hh * 8);
      float* d = gl + r * 16 + hh * 8;
      d[0] = __uint_as_float(g4.x << 16); d[1] = __uint_as_float(g4.x & 0xffff0000u);
      d[2] = __uint_as_float(g4.y << 16); d[3] = __uint_as_float(g4.y & 0xffff0000u);
      d[4] = __uint_as_float(g4.z << 16); d[5] = __uint_as_float(g4.z & 0xffff0000u);
      d[6] = __uint_as_float(g4.w << 16); d[7] = __uint_as_float(g4.w & 0xffff0000u);
    }
  }
  if (uu + ustride < u1) PREP_ISSUE(uu + ustride);
  __builtin_amdgcn_sched_barrier(0);
  __syncthreads();
#pragma unroll 1
  for (int pass = 0; pass < NPASS; ++pass) {
  const int kk = pass * 128 + (tid & 127);
  float qv[TL], kv[TL], bc[TL];
  if (MODE == 0) {
    const int j = kk & 63;
    const float invr = exp2f(-(float)j * (13.287712379549449f / 64.f)) * 0.15915494309189535f;
    const float lgam = log1pf(-exp2f(-5.f - (float)h));
#pragma unroll
    for (int i = 0; i < TL; ++i) {
      const int l = seg * TL + i;
      float rev = (float)(pos0 + l) * invr;
      rev -= floorf(rev);
      const float sn = __builtin_amdgcn_sinf(rev), cs = __builtin_amdgcn_cosf(rev);
      const float q1 = bf2f(rq[l * KS + j]), q2 = bf2f(rq[l * KS + j + 64]), k1 = bf2f(rk[l * KS + j]), k2 = bf2f(rk[l * KS + j + 64]);
      const float qr = (kk < 64) ? q1 * cs - q2 * sn : q1 * sn + q2 * cs;
      const float kr = (kk < 64) ? k1 * cs - k2 * sn : k1 * sn + k2 * cs;
      qv[i] = qr; kv[i] = kr * 0.08838834764831845f;
      bc[i] = lgam;
    }
  } else if (MODE == 1) {
    const int ch = h * 128 + kk;
    const float* lbp = p.in[11];
    float e0 = __expf(lbp[ch]), e1 = __expf(lbp[1024 + ch]), e2 = __expf(lbp[2048 + ch]);
    const float lb = e0 / (e0 + e1 + e2);
#pragma unroll
    for (int i = 0; i < TL; ++i) {
      const int l = seg * TL + i;
      const float qx = bf2f(rq[l * KS + kk]), fx = bf2f(rk[l * KS + kk]);
      qv[i] = siluf_(qx) * 0.08838834764831845f;
      const float sg = sigmoidf_(fx);
      const float f = lb + (1.f - lb) * sg;
      kv[i] = (1.f - lb) * (1.f - sg);
      bc[i] = __logf(f);
    }
  } else {
    const int ch = h * 256 + kk;
    const float* w2 = p.in[14];
    float wvv[16];
#pragma unroll
    for (int r = 0; r < 16; ++r) wvv[r] = w2[r * 1024 + ch];
    const float bias = p.in[15][ch];
#pragma unroll
    for (int i = 0; i < TL; ++i) {
      const int l = seg * TL + i;
      qv[i] = bf2f(rq[l * KS + kk]) * 0.0625f;
      kv[i] = bf2f(rk[l * KS + kk]);
      float x = bias;
#pragma unroll
      for (int r = 0; r < 16; ++r) x += gl[l * 16 + r] * wvv[r];
      const float ls = fminf(x, 0.f) - log1pf(__expf(-fabsf(x)));
      bc[i] = ls * (1.f / 16.f);
    }
  }
#pragma unroll
  for (int i = 1; i < TL; ++i) bc[i] += bc[i - 1];
  segtot[seg * K + kk] = bc[TL - 1];
  __syncthreads();
  float pre = 0.f, bL = 0.f;
#pragma unroll
  for (int sg = 0; sg < NSEG; ++sg) { float t = segtot[sg * K + kk]; bL += t; if (sg < seg) pre += t; }
  if (seg == 0) dL[u * K + kk] = __expf(bL);
  unsigned kop[TL / 2];
#pragma unroll
  for (int i = 0; i < TL; i += 2) {
    float ko2[2];
#pragma unroll
    for (int e = 0; e < 2; ++e) {
      const int l = seg * TL + i + e;
      const float b = bc[i + e] + pre;
      const float qi = qv[i + e] * __expf(b);
      const float ki = kv[i + e] * __expf(-b);
      ko2[e] = kv[i + e] * __expf(bL - b);
      const u16 qb = f2bf(qi);
      qs[l * KS + kk] = qb;
      ksm[l * KS + kk] = f2bf(ki);
    }
    kop[i / 2] = pack2(ko2[0], ko2[1]);
  }
  {
#pragma unroll
    for (int i = 0; i < TL / 8; ++i) {
      const int cc = seg * 2 + i;
      uint4* dst = (uint4*)(koT + u * K * 64 + ((((kk >> 4) * 2 + (cc >> 2)) * 64 + (cc & 3) * 16 + (kk & 15)) << 3));
      *dst = make_uint4(kop[i * 4 + 0], kop[i * 4 + 1], kop[i * 4 + 2], kop[i * 4 + 3]);
    }
  }
  }
  __syncthreads();
  for (int i = tid; i < 64 * (K / 8); i += 512) {
    const int r = i / (K / 8), cc = i % (K / 8);
    *(uint4*)(qin + u * 64 * K + ((((r >> 4) * (K / 32) + (cc >> 2)) * 64 + (cc & 3) * 16 + (r & 15)) << 3)) = *(const uint4*)(qs + r * KS + cc * 8);
  }
  if constexpr (!PFV) {
    for (int i = tid; i < 64 * (V / 8); i += 512) {
      const int r = i / (V / 8), cc = i % (V / 8);
      *(uint4*)(rv + r * VS + cc * 8) = *(const uint4*)(prow + (size_t)r * LD + vc0 + cc * 8);
    }
    __syncthreads();
  }
  for (int it = tid; it < V * 4; it += 512) {
    const int ch = it % V, sg = it / V;
    unsigned pk[8];
#pragma unroll
    for (int i = 0; i < 8; ++i) {
      u16 a = rv[(sg * 16 + 2 * i) * VS + ch];
      u16 b = rv[(sg * 16 + 2 * i + 1) * VS + ch];
      pk[i] = (unsigned)a | ((unsigned)b << 16);
    }
    {
      const int c0 = sg * 2, c1 = sg * 2 + 1;
      *(uint4*)(vT + u * V * 64 + ((((ch >> 4) * 2 + (c0 >> 2)) * 64 + (c0 & 3) * 16 + (ch & 15)) << 3)) = make_uint4(pk[0], pk[1], pk[2], pk[3]);
      *(uint4*)(vT + u * V * 64 + ((((ch >> 4) * 2 + (c1 >> 2)) * 64 + (c1 & 3) * 16 + (ch & 15)) << 3)) = make_uint4(pk[4], pk[5], pk[6], pk[7]);
    }
  }
  {
    const int w = tid >> 6, lane = tid & 63, fr = lane & 15, fq = lane >> 4;
#pragma unroll 1
    for (int bi = 0; bi < 2; ++bi) {
      const int blk = w + bi * 8, lb = blk >> 2, sb = blk & 3;
      f32x4 acc = {0.f, 0.f, 0.f, 0.f};
      if (sb <= lb) {
#pragma unroll
        for (int kst = 0; kst < K / 32; ++kst) {
          bf16x8 a = *(const bf16x8*)(ksm + (sb * 16 + fr) * KS + kst * 32 + fq * 8);
          bf16x8 b = *(const bf16x8*)(qs + (lb * 16 + fr) * KS + kst * 32 + fq * 8);
          acc = __builtin_amdgcn_mfma_f32_16x16x32_bf16(a, b, acc, 0, 0, 0);
        }
      }
      const int l = lb * 16 + fr, s0 = sb * 16 + fq * 4;
      float v0 = (s0 + 0 <= l) ? acc[0] : 0.f, v1 = (s0 + 1 <= l) ? acc[1] : 0.f;
      float v2 = (s0 + 2 <= l) ? acc[2] : 0.f, v3 = (s0 + 3 <= l) ? acc[3] : 0.f;
      *(uint2*)(Pm + u * 4096 + ((((lb * 2 + (s0 >> 5)) * 64 + ((s0 & 31) >> 3) * 16 + fr) << 3) + (s0 & 7))) = make_uint2(pack2(v0, v1), pack2(v2, v3));
    }
  }
  }
}

template <int K, int V>
__device__ __forceinline__ void seq_unit(int wv, const u16* __restrict__ qin, const u16* __restrict__ koT, const u16* __restrict__ Pm, const u16* __restrict__ vT,
                         const float* __restrict__ dL, int H, int c0, int nch, int h, int vs,
                         const float* __restrict__ s0, float* __restrict__ sout, u16* __restrict__ o, int row0, int ocol, unsigned char* shm) {
  const int tix = tidx(wv);
  constexpr int NKB = K / 128, SST = K + 8;
  u16* ST = (u16*)shm;
  const int tid = tix, w = tid >> 6, lane = tid & 63, fr = lane & 15, fq = lane >> 4;
  f32x4 accS[NKB][2];
  __syncthreads();
#pragma unroll
  for (int kb = 0; kb < NKB; ++kb)
#pragma unroll
    for (int vb = 0; vb < 2; ++vb) {
      const int k = (w * NKB + kb) * 16 + fq * 4, vcol = vb * 16 + fr;
#pragma unroll
      for (int j = 0; j < 4; ++j) accS[kb][vb][j] = s0 ? s0[(size_t)(k + j) * V + vs * 32 + vcol] : 0.f;
      *(uint2*)(ST + vcol * SST + k) = make_uint2(pack2(accS[kb][vb][0], accS[kb][vb][1]), pack2(accS[kb][vb][2], accS[kb][vb][3]));
    }
  __syncthreads();
  int cur = 0;
  const int lb = w >> 1, ovb = w & 1;
  struct FragsO { bf16x8 op[2], oq[K / 32]; };
  struct FragsS { bf16x8 ka[NKB][2], vf[2][2]; float4 d[NKB]; };
  auto load_o = [&](int ci, FragsO& f) {
    const size_t u = (size_t)(c0 + ci) * H + h;
    const u16* Pu = Pm + u * 4096;
    const u16* qu = qin + u * 64 * K;
#pragma unroll
    for (int ss = 0; ss < 2; ++ss) f.op[ss] = *(const bf16x8*)(Pu + (((lb * 2 + ss) * 64 + lane) << 3));
#pragma unroll
    for (int kst = 0; kst < K / 32; ++kst) f.oq[kst] = *(const bf16x8*)(qu + (((lb * (K / 32) + kst) * 64 + lane) << 3));
  };
  auto load_s = [&](int ci, FragsS& f) {
    const size_t u = (size_t)(c0 + ci) * H + h;
    const u16* ku = koT + u * K * 64;
    const u16* vu = vT + u * V * 64;
    const float* du = dL + u * K;
#pragma unroll
    for (int vb = 0; vb < 2; ++vb)
#pragma unroll
      for (int ss = 0; ss < 2; ++ss) f.vf[vb][ss] = *(const bf16x8*)(vu + ((((vs * 2 + vb) * 2 + ss) * 64 + lane) << 3));
#pragma unroll
    for (int kb = 0; kb < NKB; ++kb) {
      const int kbase = (w * NKB + kb) * 16;
      f.d[kb] = *(const float4*)(du + kbase + fq * 4);
      f.ka[kb][0] = *(const bf16x8*)(ku + ((((w * NKB + kb) * 2 + 0) * 64 + lane) << 3));
      f.ka[kb][1] = *(const bf16x8*)(ku + ((((w * NKB + kb) * 2 + 1) * 64 + lane) << 3));
    }
  };
  FragsO fo;
  FragsS f0;
  load_o(0, fo);
  load_s(0, f0);
  for (int ci = 0; ci < nch; ++ci) {
    const int cn = ci + 1 < nch ? ci + 1 : ci;
    FragsO fo1;
    FragsS f1;
    load_o(cn, fo1);
    load_s(cn, f1);
    __builtin_amdgcn_sched_barrier(0);
    const u16* STc = ST + cur * 32 * SST;
    u16* STn = ST + (cur ^ 1) * 32 * SST;
    f32x4 ao = {0.f, 0.f, 0.f, 0.f};
#pragma unroll
    for (int ss = 0; ss < 2; ++ss) {
      bf16x8 a = ovb ? f0.vf[1][ss] : f0.vf[0][ss];
      ao = __builtin_amdgcn_mfma_f32_16x16x32_bf16(a, fo.op[ss], ao, 0, 0, 0);
    }
#pragma unroll
    for (int kst = 0; kst < K / 32; ++kst) {
      bf16x8 a = *(const bf16x8*)(STc + (ovb * 16 + fr) * SST + kst * 32 + fq * 8);
      ao = __builtin_amdgcn_mfma_f32_16x16x32_bf16(a, fo.oq[kst], ao, 0, 0, 0);
    }
    *(uint2*)(o + (size_t)(row0 + ci * 64 + lb * 16 + fr) * D + ocol + vs * 32 + ovb * 16 + fq * 4) =
        make_uint2(pack2(ao[0], ao[1]), pack2(ao[2], ao[3]));
#pragma unroll
    for (int kb = 0; kb < NKB; ++kb) {
      const int kbase = (w * NKB + kb) * 16;
      const float4 d4 = f0.d[kb];
#pragma unroll
      for (int vb = 0; vb < 2; ++vb) {
        f32x4 sv = accS[kb][vb];
        sv[0] *= d4.x; sv[1] *= d4.y; sv[2] *= d4.z; sv[3] *= d4.w;
        sv = __builtin_amdgcn_mfma_f32_16x16x32_bf16(f0.ka[kb][0], f0.vf[vb][0], sv, 0, 0, 0);
        sv = __builtin_amdgcn_mfma_f32_16x16x32_bf16(f0.ka[kb][1], f0.vf[vb][1], sv, 0, 0, 0);
        accS[kb][vb] = sv;
        *(uint2*)(STn + (vb * 16 + fr) * SST + kbase + fq * 4) = make_uint2(pack2(sv[0], sv[1]), pack2(sv[2], sv[3]));
      }
    }
    asm volatile("s_waitcnt lgkmcnt(0)" ::: "memory");
    __builtin_amdgcn_s_barrier();
    asm volatile("" ::: "memory");
    cur ^= 1;
    f0 = f1;
    fo = fo1;
  }
#pragma unroll
  for (int kb = 0; kb < NKB; ++kb)
#pragma unroll
    for (int vb = 0; vb < 2; ++vb) {
      const int k = (w * NKB + kb) * 16 + fq * 4, vcol = vb * 16 + fr;
#pragma unroll
      for (int j = 0; j < 4; ++j) sout[(size_t)(k + j) * V + vs * 32 + vcol] = accS[kb][vb][j];
    }
}

__device__ __forceinline__ void seq_even_phase(int wv, const Params& p, unsigned char* shm) {
  unsigned char* R = p.ws + OFF_R;
  u16* o = (u16*)(p.ws + OFF_H);
  for (int u = blockIdx.x; u < 768; u += gridDim.x) {
    if (u < 256) {
      const int x = u & 7, y = u >> 3;
      if (y < 16) {
        const int g = x * 2 + (y >> 3), b = g >> 2, h = g & 3, vs = y & 7;
        seq_unit<128, 256>(wv, (u16*)(R + R_QA), (u16*)(R + R_KA), (u16*)(R + R_PA), (u16*)(R + R_VA), (float*)(R + R_DA), 4, b * 32, 32, h, vs,
                           nullptr, p.out + O_RETP + (size_t)(b * 4 + h) * 128 * 256, o, b * 2048, h * 256, shm);
      } else {
        const int yy = y - 16, g = x * 4 + (yy >> 2), b = g >> 3, h = g & 7, vs = yy & 3;
        seq_unit<128, 128>(wv, (u16*)(R + R_QB), (u16*)(R + R_KB), (u16*)(R + R_PB), (u16*)(R + R_VB), (float*)(R + R_DB), 8, b * 32, 32, h, vs,
                           nullptr, p.out + O_HGP + (size_t)(b * 8 + h) * 128 * 128, o, b * 2048, 1024 + h * 128, shm);
      }
    } else if (u < 512) {
      int x = u - 256, b = x >> 5, h = (x >> 3) & 3, vs = x & 7;
      seq_unit<128, 256>(wv, (u16*)(R + R_QA), (u16*)(R + R_KA), (u16*)(R + R_PA), (u16*)(R + R_VA), (float*)(R + R_DA), 4, 128 + b, 1, h, vs,
                         p.in[2] + (size_t)(b * 4 + h) * 128 * 256, p.out + O_RETS + (size_t)(b * 4 + h) * 128 * 256, o, MP + b * 64, h * 256, shm);
    } else {
      int x = u - 512, b = x >> 5, h = (x >> 2) & 7, vs = x & 3;
      seq_unit<128, 128>(wv, (u16*)(R + R_QB), (u16*)(R + R_KB), (u16*)(R + R_PB), (u16*)(R + R_VB), (float*)(R + R_DB), 8, 128 + b, 1, h, vs,
                         p.in[3] + (size_t)(b * 8 + h) * 128 * 128, p.out + O_HGS + (size_t)(b * 8 + h) * 128 * 128, o, MP + b * 64, 1024 + h * 128, shm);
    }
  }
}
__device__ __forceinline__ void seq_odd_phase(int wv, const Params& p, unsigned char* shm) {
  unsigned char* R = p.ws + OFF_R;
  u16* o = (u16*)(p.ws + OFF_H);
  for (int u = blockIdx.x; u < 768; u += gridDim.x) {
    if (u < 256) {
      const int x = u & 7, y = u >> 3, g = x * 2 + (y >> 4), b = g >> 2, h = g & 3, vs = y & 15;
      seq_unit<256, 512>(wv, (u16*)(R + R_QC), (u16*)(R + R_KC), (u16*)(R + R_PC), (u16*)(R + R_VC), (float*)(R + R_DC), 4, b * 32, 32, h, vs,
                         nullptr, p.out + O_GLP + (size_t)(b * 4 + h) * 256 * 512, o, b * 2048, h * 512, shm);
    } else {
      int x = u - 256, b = x >> 6, h = (x >> 4) & 3, vs = x & 15;
      seq_unit<256, 512>(wv, (u16*)(R + R_QC), (u16*)(R + R_KC), (u16*)(R + R_PC), (u16*)(R + R_VC), (float*)(R + R_DC), 4, 128 + b, 1, h, vs,
                         p.in[4] + (size_t)(b * 4 + h) * 256 * 512, p.out + O_GLS + (size_t)(b * 4 + h) * 256 * 512, o, MP + b * 64, h * 512, shm);
    }
  }
}

__device__ __forceinline__ void up8(u32x4_t v, float* f) {
  f[0] = __uint_as_float(v[0] << 16); f[1] = __uint_as_float(v[0] & 0xffff0000u);
  f[2] = __uint_as_float(v[1] << 16); f[3] = __uint_as_float(v[1] & 0xffff0000u);
  f[4] = __uint_as_float(v[2] << 16); f[5] = __uint_as_float(v[2] & 0xffff0000u);
  f[6] = __uint_as_float(v[3] << 16); f[7] = __uint_as_float(v[3] & 0xffff0000u);
}
template <int ODD>
__device__ __forceinline__ void post_phase(int wv, const Params& p) {
  const int tix = tidx(wv);
  const int lane = tix & 63, gw = blockIdx.x * 8 + (tix >> 6), nw = gridDim.x * 8;
  const u16* o = (const u16*)(p.ws + OFF_H);
  const u16* proj = (const u16*)(p.ws + OFF_BIG);
  u16* ao = (u16*)(p.ws + OFF_R);
#define POST_LOAD(xr_, gr_, row_) do { const int r_ = (row_); \
    _Pragma("unroll") for (int i = 0; i < 4; ++i) { const int col_ = i * 512 + lane * 8; \
      xr_[i] = *(const u32x4_t*)(o + (size_t)r_ * D + col_); \
      gr_[i] = *(const u32x4_t*)(proj + (size_t)r_ * (ODD ? NINO_PAD : NINE) + (ODD ? 4096 + col_ : (i < 2 ? 2048 + col_ : 6144 + (col_ - 1024)))); } } while (0)
  u32x4_t xr[4], gr[4];
  if (gw < MT) POST_LOAD(xr, gr, gw);
#pragma unroll 1
  for (int row = gw; row < MT; row += nw) {
    u32x4_t xn[4], gn4[4];
    if (row + nw < MT) POST_LOAD(xn, gn4, row + nw);
    else {
#pragma unroll
      for (int i = 0; i < 4; ++i) { xn[i] = xr[i]; gn4[i] = gr[i]; }
    }
    __builtin_amdgcn_sched_barrier(0);
#pragma unroll
    for (int i = 0; i < 4; ++i) {
      const int col = i * 512 + lane * 8;
      float x[8], g[8], y[8];
      up8(xr[i], x);
      up8(gr[i], g);
      if (ODD) {
        float ss = 0.f;
#pragma unroll
        for (int e = 0; e < 8; ++e) ss += x[e] * x[e];
#pragma unroll
        for (int off = 32; off > 0; off >>= 1) ss += __shfl_xor(ss, off, 64);
        const float rs = rsqrtf(ss * (1.f / 512.f) + EPS);
        const float* gn = p.in[16] + lane * 8;
#pragma unroll
        for (int e = 0; e < 8; ++e) y[e] = x[e] * rs * gn[e] * siluf_(g[e]);
      } else if (i < 2) {
        float s1 = 0.f;
#pragma unroll
        for (int e = 0; e < 8; ++e) s1 += x[e];
#pragma unroll
        for (int off = 16; off > 0; off >>= 1) s1 += __shfl_xor(s1, off, 64);
        const float mu = s1 * (1.f / 256.f);
        float s2 = 0.f;
#pragma unroll
        for (int e = 0; e < 8; ++e) { float dlt = x[e] - mu; s2 += dlt * dlt; }
#pragma unroll
        for (int off = 16; off > 0; off >>= 1) s2 += __shfl_xor(s2, off, 64);
        const float rs = rsqrtf(s2 * (1.f / 256.f) + EPS);
#pragma unroll
        for (int e = 0; e < 8; ++e) y[e] = (x[e] - mu) * rs * siluf_(g[e]);
      } else {
        float ss = 0.f;
#pragma unroll
        for (int e = 0; e < 8; ++e) ss += x[e] * x[e];
#pragma unroll
        for (int off = 8; off > 0; off >>= 1) ss += __shfl_xor(ss, off, 64);
        const float rs = rsqrtf(ss * (1.f / 128.f) + EPS);
        const float* gn = p.in[12] + (lane & 15) * 8;
#pragma unroll
        for (int e = 0; e < 8; ++e) y[e] = x[e] * rs * gn[e] * siluf_(g[e]);
      }
      st8(ao + (size_t)row * D + col, y);
    }
#pragma unroll
    for (int i = 0; i < 4; ++i) { xr[i] = xn[i]; gr[i] = gn4[i]; }
  }
#undef POST_LOAD
}


__device__ __forceinline__ void final_norm_phase(int wv, const Params& p) {
  const int tix = tidx(wv);
  const int lane = tix & 63, gw = blockIdx.x * 8 + (tix >> 6), nw = gridDim.x * 8;
  const u16* hb = (const u16*)(p.ws + OFF_HN);
  const float* w = p.in[8];
  u32x4_t v[4];
  if (gw < MT) {
#pragma unroll
    for (int i = 0; i < 4; ++i) v[i] = *(const u32x4_t*)(hb + (size_t)gw * D + i * 512 + lane * 8);
  }
#pragma unroll 1
  for (int row = gw; row < MT; row += nw) {
    u32x4_t nx[4];
    const int nrow = row + nw < MT ? row + nw : row;
#pragma unroll
    for (int i = 0; i < 4; ++i) nx[i] = *(const u32x4_t*)(hb + (size_t)nrow * D + i * 512 + lane * 8);
    __builtin_amdgcn_sched_barrier(0);
    float x[4][8];
    float ss = 0.f;
#pragma unroll
    for (int i = 0; i < 4; ++i) {
      up8(v[i], x[i]);
#pragma unroll
      for (int e = 0; e < 8; ++e) ss += x[i][e] * x[i][e];
    }
#pragma unroll
    for (int o = 32; o > 0; o >>= 1) ss += __shfl_xor(ss, o, 64);
    const float rs = rsqrtf(ss * (1.f / D) + EPS);
    float* dst = (row < MP) ? p.out + O_YP + (size_t)row * D : p.out + O_YS + (size_t)(row - MP) * D;
#pragma unroll
    for (int i = 0; i < 4; ++i) {
      const int col = i * 512 + lane * 8;
      const float4 w0 = *(const float4*)(w + col), w1 = *(const float4*)(w + col + 4);
      *(float4*)(dst + col) = make_float4(x[i][0] * rs * w0.x, x[i][1] * rs * w0.y, x[i][2] * rs * w0.z, x[i][3] * rs * w0.w);
      *(float4*)(dst + col + 4) = make_float4(x[i][4] * rs * w1.x, x[i][5] * rs * w1.y, x[i][6] * rs * w1.z, x[i][7] * rs * w1.w);
    }
#pragma unroll
    for (int i = 0; i < 4; ++i) v[i] = nx[i];
  }
}

__device__ __forceinline__ void gate_phase(int wv, const Params& p, int layer) {
  const int tix = tidx(wv);
  const u16* au = (const u16*)(p.ws + OFF_BIG);
  u16* gg = (u16*)(p.ws + OFF_R);
  const float* cw = p.in[19] + (size_t)layer * 3 * DFF;
  const float* cb = p.in[20] + (size_t)layer * DFF;
  const float* cache = p.in[5] + (size_t)layer * 8 * 2 * DFF;
  const int nitems = (MT / 16) * (DFF / 8);
  for (int it = blockIdx.x * 512 + tix; it < nitems; it += gridDim.x * 512) {
    const int cg8 = it % (DFF / 8), rb = it / (DFF / 8), c0 = cg8 * 8, r0 = rb * 16;
    float w0[8], w1[8], w2[8], bb[8], am2[8], am1[8];
#pragma unroll
    for (int e = 0; e < 8; ++e) { w0[e] = cw[c0 + e]; w1[e] = cw[DFF + c0 + e]; w2[e] = cw[2 * DFF + c0 + e]; bb[e] = cb[c0 + e]; }
    int t0, T, b; bool samp = r0 >= MP;
    if (!samp) { b = r0 >> 11; t0 = r0 & 2047; T = 2048; } else { b = (r0 - MP) >> 6; t0 = (r0 - MP) & 63; T = 64; }
    if (t0 == 0) {
      if (samp) {
#pragma unroll
        for (int e = 0; e < 8; ++e) { am2[e] = cache[(size_t)(b * 2 + 0) * DFF + c0 + e]; am1[e] = cache[(size_t)(b * 2 + 1) * DFF + c0 + e]; }
      } else {
#pragma unroll
        for (int e = 0; e < 8; ++e) { am2[e] = 0.f; am1[e] = 0.f; }
      }
    } else {
      ld8(au + (size_t)(r0 - 2) * NUP + c0, am2);
      ld8(au + (size_t)(r0 - 1) * NUP + c0, am1);
    }
#pragma unroll 4
    for (int i = 0; i < 16; ++i) {
      float a[8], uu[8], y[8];
      ld8(au + (size_t)(r0 + i) * NUP + c0, a);
      ld8(au + (size_t)(r0 + i) * NUP + DFF + c0, uu);
#pragma unroll
      for (int e = 0; e < 8; ++e) {
        float cv = bb[e] + w0[e] * am2[e] + w1[e] * am1[e] + w2[e] * a[e];
        y[e] = siluf_(cv) * uu[e];
        am2[e] = am1[e]; am1[e] = a[e];
      }
      st8(gg + (size_t)(r0 + i) * DFF + c0, y);
    }
    if (t0 + 16 == T) {
      float* dst = samp ? p.out + O_CVS + (size_t)(layer * 8 + b) * 2 * DFF : p.out + O_CVP + (size_t)(layer * 4 + b) * 2 * DFF;
#pragma unroll
      for (int e = 0; e < 8; ++e) { dst[c0 + e] = am2[e]; dst[DFF + c0 + e] = am1[e]; }
    }
  }
}


__device__ __forceinline__ void gate_fixup(int wv, const Params& p, int layer) {
  const int tix = tidx(wv);
  const u16* side = (const u16*)(p.ws + OFF_SIDE);
  u16* gg = (u16*)(p.ws + OFF_R);
  const float* cw = p.in[19] + (size_t)layer * 3 * DFF;
  const float* cb = p.in[20] + (size_t)layer * DFF;
  for (int vw = blockIdx.x; vw < (MP / BM) * (D / BM); vw += gridDim.x) {
    int pm, pn;
    tile_coords(vw, MP / BM, D / BM, pm, pn);
    if ((pm & 7) == 0) continue;
    for (int c8 = tix; c8 < DFF / 8; c8 += 512) {
      const int c = c8 * 8;
      float a0[8], a1[8], u0[8], u1[8], q2[8], q1[8], y0[8], y1[8];
      ld8(side + (size_t)(pm * 2 + 0) * DFF + c, a0);
      ld8(side + (size_t)(pm * 2 + 1) * DFF + c, a1);
      ld8(side + SZ_SIDE1 / 2 + (size_t)(pm * 2 + 0) * DFF + c, u0);
      ld8(side + SZ_SIDE1 / 2 + (size_t)(pm * 2 + 1) * DFF + c, u1);
      ld8(side + SZ_SIDE1 + (size_t)((pm - 1) * 2 + 0) * DFF + c, q2);
      ld8(side + SZ_SIDE1 + (size_t)((pm - 1) * 2 + 1) * DFF + c, q1);
#pragma unroll
      for (int e = 0; e < 8; ++e) {
        const float w0 = cw[c + e], w1 = cw[DFF + c + e], w2 = cw[2 * DFF + c + e], bb = cb[c + e];
        y0[e] = siluf_(bb + w0 * q2[e] + w1 * q1[e] + w2 * a0[e]) * u0[e];
        y1[e] = siluf_(bb + w0 * q1[e] + w1 * a0[e] + w2 * a1[e]) * u1[e];
      }
      st8(gg + (size_t)(pm * 256 + 0) * DFF + c, y0);
      st8(gg + (size_t)(pm * 256 + 1) * DFF + c, y1);
    }
  }
  asm volatile("s_waitcnt vmcnt(0)" ::: "memory");
  __syncthreads();
}

#define XB_TMO      128
#define XB_XCNT(j)  (256  + 64 * (j))
#define XB_XSUB(j)  (1280 + 64 * (j))
#define XB_XGEN(j)  (2304 + 64 * (j))
#define XB_TOP      3328
#define XB_TOPGEN   3392
#define XCD_BAR_WORDS 3456
#define XB_SPIN_CAP (1u << 22)
#define LAS __attribute__((address_space(3)))
__device__ __forceinline__ unsigned xb_ld(unsigned* p)              { return __hip_atomic_load(p, __ATOMIC_RELAXED, __HIP_MEMORY_SCOPE_AGENT); }
__device__ __forceinline__ unsigned xb_add(unsigned* p, unsigned v) { return __hip_atomic_fetch_add(p, v, __ATOMIC_RELAXED, __HIP_MEMORY_SCOPE_AGENT); }
__device__ __forceinline__ unsigned xb_xcc_id() { return (unsigned)__builtin_amdgcn_s_getreg((3 << 11) | 20) & 0xFu; }
#define XB_SPIN(cond, bar) do { unsigned _sp = 0; while (cond) { __builtin_amdgcn_s_sleep(1); \
    if ((++_sp & 255u) == 0u) { if (xb_ld(&(bar)[XB_TMO])) break; if (_sp > XB_SPIN_CAP) { atomicAdd(&(bar)[XB_TMO], 1u); break; } } } } while (0)
struct XcdBarrier { unsigned* bar; unsigned x; volatile LAS unsigned* st; };
__device__ __forceinline__ XcdBarrier xcd_barrier_post(int wv, unsigned* bar, volatile LAS unsigned* st) {
  XcdBarrier b; b.bar = bar; b.x = xb_xcc_id(); b.st = st;
  if (tidx(wv) == 0) (void)xb_add(&bar[XB_XCNT(b.x)], 1u);
  return b;
}
__device__ __forceinline__ void xcd_barrier_complete(unsigned* bar, unsigned x, unsigned& nloc, unsigned& nx) {
  const unsigned G = gridDim.x * gridDim.y * gridDim.z;
  unsigned sum, cnt, mine, sp = 0u;
  for (;;) {
    sum = 0u; cnt = 0u; mine = 0u;
#pragma unroll
    for (unsigned j = 0; j < 16; ++j) { const unsigned c = xb_ld(&bar[XB_XCNT(j)]); sum += c; cnt += (c > 0u) ? 1u : 0u; mine = (j == x) ? c : mine; }
    if (sum == G) break;
    __builtin_amdgcn_s_sleep(1);
    if ((++sp & 255u) == 0u) { if (xb_ld(&bar[XB_TMO])) break; if (sp > XB_SPIN_CAP) { atomicAdd(&bar[XB_TMO], 1u); break; } }
  }
  nloc = mine > 0u ? mine : 1u; nx = cnt > 0u ? cnt : 1u;
}
__device__ __forceinline__ void xcd_barrier(int wv, const XcdBarrier& b) {
  asm volatile("s_waitcnt vmcnt(0)" ::: "memory");
  __syncthreads();
  if (tidx(wv) == 0) {
    unsigned* bar = b.bar;
    __builtin_amdgcn_s_waitcnt(0);
    unsigned nloc = b.st[0], nx = b.st[1];
    if (nloc == 0u) { xcd_barrier_complete(bar, b.x, nloc, nx); b.st[0] = nloc; b.st[1] = nx; }
    const unsigned old = xb_add(&bar[XB_XSUB(b.x)], 1u);
    const unsigned gen = old / nloc;
    if (old + 1u == (gen + 1u) * nloc) {
      __builtin_amdgcn_fence(__ATOMIC_RELEASE, "agent");
      asm volatile("s_waitcnt vmcnt(0)" ::: "memory");
      const unsigned og = xb_add(&bar[XB_TOP], 1u);
      const unsigned tg = og / nx;
      if (og + 1u == (tg + 1u) * nx) xb_add(&bar[XB_TOPGEN], 1u);
      else XB_SPIN(xb_ld(&bar[XB_TOPGEN]) == tg, bar);
      __builtin_amdgcn_fence(__ATOMIC_ACQUIRE, "agent");
      xb_add(&bar[XB_XGEN(b.x)], 1u);
      asm volatile("s_waitcnt vmcnt(0)" ::: "memory");
    } else {
      XB_SPIN(xb_ld(&bar[XB_XGEN(b.x)]) == gen, bar);
      __builtin_amdgcn_fence(__ATOMIC_ACQUIRE, "agent");
      asm volatile("s_waitcnt vmcnt(0)" ::: "memory");
    }
  }
  __syncthreads();
}

constexpr int NPHASE = 21;
#ifndef PHMASK
#define PHMASK 0xFFFFFFFFu
#endif
#define PH_ON(k) (((PHMASK) >> (k)) & 1u)
constexpr int LDS_BYTES = 147456;

typedef const __attribute__((address_space(4))) Params* KParamsPtr;
#ifndef XSYNC
#define XSYNC 0
#endif
#ifndef DUPMASK
#define DUPMASK 0u
#endif
#define DUP_ON(k) (((DUPMASK) >> (k)) & 1u)
__device__ __forceinline__ bool ph_in(KParamsPtr& kp, int k) { asm volatile("" : "+s"(kp)); return kp->ph_lo <= k && k < kp->ph_hi; }
#define PH_IN(k) ph_in(kp, (k))
#define PHASE(k, ...) if (PH_IN(k)) { if (PH_ON(k)) { for (int rep = 0; rep < 1 + (int)DUP_ON(k); ++rep) { asm volatile("" : "+s"(kp)); Params p; __builtin_memcpy(&p, kp, sizeof(Params)); unsigned char* ws = p.ws; __VA_ARGS__ } } \
    asm volatile("" : "+s"(kp)); \
    if (kp->coop && (k) + 1 < kp->ph_hi) { XcdBarrier xb; xb.bar = (unsigned*)(kp->ws + OFF_BAR); xb.x = xb_xcc_id(); xb.st = (volatile LAS unsigned*)&xb_words; xcd_barrier(wv, xb); if (XSYNC) xcd_barrier(wv, xb); } }
#define PHASE_X(k, ...) if (PH_IN(k)) { asm volatile("" : "+s"(kp)); Params p; __builtin_memcpy(&p, kp, sizeof(Params)); unsigned char* ws = p.ws; __VA_ARGS__ }
#define GEMM_ACC(k, Aoff, Woff, KK, RSSP, FIXL, RINP, RINS) PHASE(k, { float* rssp = (RSSP); if ((FIXL) >= 0) gate_fixup(wv, p, FIXL); \
    gemm_phase<MP, D, KK, 0>(wv, (const u16*)(ws + Aoff), (const u16*)(ws + Woff), EpiAccum{(u16*)(ws + OFF_HN), rssp, (RINP)}, (u16*)shm); \
    gemm_tail_phase<KK>(wv, (const u16*)(ws + Aoff), (const u16*)(ws + Woff), (float*)shm, (u16*)(ws + OFF_HN), rssp, (RINS)); })

__global__ void __launch_bounds__(512) fwd_kernel(Params p_) {
  extern __shared__ __attribute__((aligned(16))) unsigned char shm[];
  cg::grid_group grid = cg::this_grid();
  KParamsPtr kp = (KParamsPtr)__builtin_amdgcn_kernarg_segment_ptr();
  const int wv = __builtin_amdgcn_readfirstlane((int)(threadIdx.x >> 6));
  __shared__ uint4 xb_words;
  if (tidx(wv) == 0) xb_words = make_uint4(0u, 0u, 0u, 0u);
  __syncthreads();
  if (kp->coop == 2) grid.sync();
  (void)xcd_barrier_post(wv, (unsigned*)(kp->ws + OFF_BAR), (volatile LAS unsigned*)&xb_words);
  PHASE(0,
        convert_w(wv, p.in[9], (u16*)(ws + OFF_WINE), D, NINE, NINE, (u16*)shm);
        convert_w(wv, p.in[10], (u16*)(ws + OFF_WOUTE), D, D, D, (u16*)shm);
        convert_w(wv, p.in[13], (u16*)(ws + OFF_WINO), D, NINO, NINO_PAD, (u16*)shm, p.in[6] + D);
        convert_w(wv, p.in[17], (u16*)(ws + OFF_WOUTO), D, D, D, (u16*)shm);
        convert_w(wv, p.in[18], (u16*)(ws + OFF_WUP0), D, NUP, NUP, (u16*)shm, p.in[7], 1);
        convert_w(wv, p.in[18] + (size_t)D * NUP, (u16*)(ws + OFF_WUP1), D, NUP, NUP, (u16*)shm, p.in[7] + D, 1);
        convert_w(wv, p.in[21], (u16*)(ws + OFF_WDN0), DFF, D, D, (u16*)shm);
        convert_w(wv, p.in[21] + (size_t)DFF * D, (u16*)(ws + OFF_WDN1), DFF, D, D, (u16*)shm);
        for (int i = blockIdx.x * 512 + tidx(wv); i < 3 * MT; i += gridDim.x * 512) ((float*)(ws + OFF_RSS))[i] = 0.f;
        rmsnorm_phase<0>(wv, p, p.in[6]);)
  PHASE(1, gemm_phase<MT, NINE, D, 0>(wv, (const u16*)(ws + OFF_HN), (const u16*)(ws + OFF_WINE), EpiStoreBf16{(u16*)(ws + OFF_BIG), NINE, nullptr}, (u16*)shm);)
  PHASE(2, { const int b_ = blockIdx.x, G_ = gridDim.x;
        prep_range<0>(wv, p, b_, NCH * 4, G_, shm);
        const int first1 = ((NCH * 4 - b_ + G_ - 1) / G_) * G_ + b_ - NCH * 4;
        prep_range<1>(wv, p, first1, NCH * 8, G_, shm); })
  PHASE(3, seq_even_phase(wv, p, shm);)
  PHASE(4, post_phase<0>(wv, p);)
  GEMM_ACC(5, OFF_R, OFF_WOUTE, D, (float*)(ws + OFF_RSS), -1, p.in[0], p.in[1])
  PHASE(7, gemm_phase<MT, NUP, D, 0>(wv, (const u16*)(ws + OFF_HN), (const u16*)(ws + OFF_WUP0), EpiGate{(const __attribute__((address_space(4))) void*)kp, 0, 0}, (u16*)shm);)
  GEMM_ACC(9, OFF_R, OFF_WDN0, DFF, (float*)(ws + OFF_RSS) + MT, 0, (const float*)nullptr, (const float*)nullptr)
  PHASE(11, gemm_phase<MT, NINO_PAD, D, 0>(wv, (const u16*)(ws + OFF_HN), (const u16*)(ws + OFF_WINO), EpiStoreBf16{(u16*)(ws + OFF_BIG), NINO_PAD, (const float*)(ws + OFF_RSS) + MT}, (u16*)shm);)
  PHASE(12, prep_range<2>(wv, p, blockIdx.x, NCH * 4, gridDim.x, shm);)
  PHASE(13, seq_odd_phase(wv, p, shm);)
  PHASE(14, post_phase<1>(wv, p);)
  GEMM_ACC(15, OFF_R, OFF_WOUTO, D, (float*)(ws + OFF_RSS) + 2 * MT, -1, (const float*)nullptr, (const float*)nullptr)
  PHASE(17, gemm_phase<MT, NUP, D, 0>(wv, (const u16*)(ws + OFF_HN), (const u16*)(ws + OFF_WUP1), EpiGate{(const __attribute__((address_space(4))) void*)kp, 1, 2 * MT}, (u16*)shm);)
  GEMM_ACC(19, OFF_R, OFF_WDN1, DFF, (float*)nullptr, 1, (const float*)nullptr, (const float*)nullptr)
  PHASE(20, final_norm_phase(wv, p);)
}

extern "C" void kernel_launch(void* const* d_in, const int* in_sizes, int n_in, void* d_out, int out_size, void* d_ws, size_t ws_size,
                              hipStream_t stream) {
  static int grid_blocks = 0;
  if (grid_blocks == 0) {
    int dev = 0, cus = 0, per_cu = 0;
    hipGetDevice(&dev);
    hipDeviceGetAttribute(&cus, hipDeviceAttributeMultiprocessorCount, dev);
    hipFuncSetAttribute((const void*)fwd_kernel, hipFuncAttributeMaxDynamicSharedMemorySize, LDS_BYTES);
    hipOccupancyMaxActiveBlocksPerMultiprocessor(&per_cu, (const void*)fwd_kernel, 512, LDS_BYTES);
    if (per_cu < 1) per_cu = 1;
    grid_blocks = cus * per_cu;
    (void)hipGetLastError();
  }
  if (n_in != 22 || ws_size < WS_NEED || (size_t)out_size != O_END) {
    fprintf(stderr, "kernel_launch: unexpected sizes n_in=%d ws=%zu need=%zu out=%d\n", n_in, ws_size, (size_t)WS_NEED, out_size);
    hipMemsetAsync(d_out, 0, (size_t)out_size * 4, stream);
    return;
  }
  Params p{};
  for (int i = 0; i < 22; ++i) p.in[i] = (const float*)d_in[i];
  p.out = (float*)d_out;
  p.ws = (unsigned char*)d_ws;
#if 0
  for (int ph = 0; ph < NPHASE; ++ph) {
    p.ph_lo = ph; p.ph_hi = ph + 1; p.coop = 0;
    hipLaunchKernelGGL(fwd_kernel, dim3(grid_blocks), dim3(512), LDS_BYTES, stream, p);
  }
#else
  p.ph_lo = 0; p.ph_hi = NPHASE; p.coop = 1;
  hipMemsetAsync((unsigned char*)d_ws + OFF_BAR, 0, XCD_BAR_WORDS * 4, stream);
  void* args[] = {&p};
  hipError_t e = hipLaunchCooperativeKernel((const void*)fwd_kernel, dim3(grid_blocks), dim3(512), args, LDS_BYTES, stream);
  if (e != hipSuccess) fprintf(stderr, "cooperative launch failed: %s (grid %d)\n", hipGetErrorString(e), grid_blocks);
#endif
}
```

```cpp
#include <hip/hip_runtime.h>
#include <hip/hip_bf16.h>
#include <hip/hip_cooperative_groups.h>
#include <cstdio>
namespace cg = cooperative_groups;

typedef unsigned short u16;
using bf16x8 = __attribute__((ext_vector_type(8))) short;
using f32x4 = __attribute__((ext_vector_type(4))) float;
typedef __attribute__((ext_vector_type(4))) unsigned u32x4_t;

constexpr int MP = 8192, MS = 512, MT = 8704, D = 2048;
constexpr int DFF = 5504, NUP = 11008;
constexpr int NINE = 7168, NINO = 6160, NINO_PAD = 6400;
constexpr int NCH = 136;
constexpr float EPS = 1e-6f;

constexpr size_t SZ_WINE = (size_t)NINE * D * 2, SZ_WOUT = (size_t)D * D * 2, SZ_WINO = (size_t)NINO_PAD * D * 2;
constexpr size_t SZ_WUP = (size_t)NUP * D * 2, SZ_WDN = (size_t)D * DFF * 2;
constexpr size_t OFF_WINE = 0;
constexpr size_t OFF_WOUTE = OFF_WINE + SZ_WINE;
constexpr size_t OFF_WINO = OFF_WOUTE + SZ_WOUT;
constexpr size_t OFF_WOUTO = OFF_WINO + SZ_WINO;
constexpr size_t OFF_WUP0 = OFF_WOUTO + SZ_WOUT;
constexpr size_t OFF_WUP1 = OFF_WUP0 + SZ_WUP;
constexpr size_t OFF_WDN0 = OFF_WUP1 + SZ_WUP;
constexpr size_t OFF_WDN1 = OFF_WDN0 + SZ_WDN;
constexpr size_t OFF_H = OFF_WDN1 + SZ_WDN;
constexpr size_t OFF_HN = OFF_H + (size_t)MT * D * 4;
constexpr size_t OFF_BIG = OFF_HN + (size_t)MT * D * 2;
constexpr size_t OFF_R = OFF_BIG + (size_t)MT * NUP * 2;
constexpr size_t SZ_R = 104ull * 1048576;
constexpr size_t OFF_RSS = OFF_R + SZ_R;
constexpr size_t OFF_SIDE = OFF_RSS + 3ull * MT * 4 + 256;
constexpr size_t SZ_SIDE1 = 34ull * 2 * DFF * 2;
constexpr size_t OFF_BAR = OFF_SIDE + 3 * SZ_SIDE1 + 256;
constexpr size_t WS_NEED = OFF_BAR + 16384;
constexpr size_t R_QA = 0;
constexpr size_t R_KA = R_QA + (size_t)NCH * 4 * 64 * 128 * 2;
constexpr size_t R_VA = R_KA + (size_t)NCH * 4 * 64 * 128 * 2;
constexpr size_t R_PA = R_VA + (size_t)NCH * 4 * 256 * 64 * 2;
constexpr size_t R_DA = R_PA + (size_t)NCH * 4 * 4096 * 2;
constexpr size_t R_QB = R_DA + (size_t)NCH * 4 * 128 * 4;
constexpr size_t R_KB = R_QB + (size_t)NCH * 8 * 64 * 128 * 2;
constexpr size_t R_VB = R_KB + (size_t)NCH * 8 * 64 * 128 * 2;
constexpr size_t R_PB = R_VB + (size_t)NCH * 8 * 128 * 64 * 2;
constexpr size_t R_DB = R_PB + (size_t)NCH * 8 * 4096 * 2;
constexpr size_t R_END_EVEN = R_DB + (size_t)NCH * 8 * 128 * 4;
constexpr size_t R_QC = 0;
constexpr size_t R_KC = R_QC + (size_t)NCH * 4 * 64 * 256 * 2;
constexpr size_t R_VC = R_KC + (size_t)NCH * 4 * 64 * 256 * 2;
constexpr size_t R_PC = R_VC + (size_t)NCH * 4 * 512 * 64 * 2;
constexpr size_t R_DC = R_PC + (size_t)NCH * 4 * 4096 * 2;
constexpr size_t R_END_ODD = R_DC + (size_t)NCH * 4 * 256 * 4;
static_assert(R_END_EVEN <= SZ_R && R_END_ODD <= SZ_R && (size_t)MT * DFF * 2 <= SZ_R, "R region too small");

constexpr size_t O_YP = 0;
constexpr size_t O_YS = O_YP + (size_t)MP * D;
constexpr size_t O_RETP = O_YS + (size_t)MS * D;
constexpr size_t O_RETS = O_RETP + 4ull * 4 * 128 * 256;
constexpr size_t O_HGP = O_RETS + 8ull * 4 * 128 * 256;
constexpr size_t O_HGS = O_HGP + 4ull * 8 * 128 * 128;
constexpr size_t O_GLP = O_HGS + 8ull * 8 * 128 * 128;
constexpr size_t O_GLS = O_GLP + 4ull * 4 * 256 * 512;
constexpr size_t O_CVP = O_GLS + 8ull * 4 * 256 * 512;
constexpr size_t O_CVS = O_CVP + 2ull * 4 * 2 * DFF;
constexpr size_t O_END = O_CVS + 2ull * 8 * 2 * DFF;

struct Params {
  const float* in[22];
  float* out;
  unsigned char* ws;
  int ph_lo, ph_hi, coop, pad;
};

__device__ __forceinline__ u16 f2bf(float f) {
  unsigned u = __float_as_uint(f);
  u += 0x7fffu + ((u >> 16) & 1u);
  return (u16)(u >> 16);
}
__device__ __forceinline__ float bf2f(u16 h) { return __uint_as_float(((unsigned)h) << 16); }
__device__ __forceinline__ unsigned pack2(float a, float b) { return (unsigned)f2bf(a) | ((unsigned)f2bf(b) << 16); }
__device__ __forceinline__ float sigmoidf_(float x) { return 1.f / (1.f + __expf(-x)); }
__device__ __forceinline__ float siluf_(float x) { return x / (1.f + __expf(-x)); }

__device__ __forceinline__ int tidx(int wv) { int l; asm volatile("v_mbcnt_lo_u32_b32 %0, -1, 0\n\tv_mbcnt_hi_u32_b32 %0, -1, %0" : "=v"(l)); return wv * 64 + l; }

__device__ __forceinline__ void convert_w(int wv, const float* __restrict__ src, u16* __restrict__ dst, int K, int N, int Npad, u16* tile, const float* __restrict__ kscale = nullptr, int upperm = 0) {
  const int tix = tidx(wv);
  constexpr int TS = 262;
  const int tn = (Npad + 255) / 256, tk = K / 64, nt = tn * tk, tid = tix;
  for (int t = blockIdx.x; t < nt; t += gridDim.x) {
    const int n0 = (t % tn) * 256, k0 = (t / tn) * 64;
    float4 v[8];
#pragma unroll
    for (int i = 0; i < 8; ++i) {
      const int idx = tid + i * 512, kk = idx >> 6, n = n0 + (idx & 63) * 4;
      v[i] = make_float4(0.f, 0.f, 0.f, 0.f);
      if (n < N) v[i] = *(const float4*)(src + (size_t)(k0 + kk) * N + n);
      if (kscale) { const float sc = kscale[k0 + kk]; v[i].x *= sc; v[i].y *= sc; v[i].z *= sc; v[i].w *= sc; }
    }
    __syncthreads();
#pragma unroll
    for (int i = 0; i < 8; ++i) {
      const int idx = tid + i * 512, kk = idx >> 6, nl = (idx & 63) * 4;
      *(unsigned*)(tile + kk * TS + nl) = pack2(v[i].x, v[i].y);
      *(unsigned*)(tile + kk * TS + nl + 2) = pack2(v[i].z, v[i].w);
    }
    __syncthreads();
#pragma unroll
    for (int i = 0; i < 4; ++i) {
      const int item = tid + i * 512, ks = item & 7, n = item >> 3;
      if (n0 + n < Npad) {
        const u16* tp = tile + (ks * 8) * TS + n;
        uint4 o;
        o.x = (unsigned)tp[0] | ((unsigned)tp[TS] << 16);
        o.y = (unsigned)tp[2 * TS] | ((unsigned)tp[3 * TS] << 16);
        o.z = (unsigned)tp[4 * TS] | ((unsigned)tp[5 * TS] << 16);
        o.w = (unsigned)tp[6 * TS] | ((unsigned)tp[7 * TS] << 16);
        int nr = n0 + n;
        if (upperm) nr = (nr < DFF) ? ((nr >> 7) * 256 + (nr & 127)) : ((((nr - DFF) >> 7) * 256) + 128 + ((nr - DFF) & 127));
        *(uint4*)(dst + (size_t)nr * K + k0 + ks * 8) = o;
      }
    }
  }
}

template <int MODE>
__device__ __forceinline__ void rmsnorm_phase(int wv, const Params& p, const float* __restrict__ w) {
  const int tix = tidx(wv);
  const int lane = tix & 63, gw = blockIdx.x * 8 + (tix >> 6), nw = gridDim.x * 8;
  const float* h = (const float*)(p.ws + OFF_H);
  u16* hn = (u16*)(p.ws + OFF_HN);
#define RMS_LOAD(dst, row_) do { const int r_ = (row_); const float* src_; \
    if (MODE == 0) src_ = (r_ < MP) ? p.in[0] + (size_t)r_ * D : p.in[1] + (size_t)(r_ - MP) * D; \
    else src_ = h + (size_t)r_ * D; \
    _Pragma("unroll") for (int i = 0; i < 8; ++i) dst[i] = *(const f32x4*)(src_ + (i * 64 + lane) * 4); } while (0)
  f32x4 v[8];
  if (gw < MT) RMS_LOAD(v, gw);
#pragma unroll 1
  for (int row = gw; row < MT; row += nw) {
    f32x4 nx[8];
    if (row + nw < MT) RMS_LOAD(nx, row + nw);
    else {
#pragma unroll
      for (int i = 0; i < 8; ++i) nx[i] = v[i];
    }
    __builtin_amdgcn_sched_barrier(0);
    float ss = 0.f;
#pragma unroll
    for (int i = 0; i < 8; ++i) ss += v[i][0] * v[i][0] + v[i][1] * v[i][1] + v[i][2] * v[i][2] + v[i][3] * v[i][3];
#pragma unroll
    for (int o = 32; o > 0; o >>= 1) ss += __shfl_xor(ss, o, 64);
    const float rs = rsqrtf(ss * (1.f / D) + EPS);
#pragma unroll
    for (int i = 0; i < 8; ++i) {
      const int col = (i * 64 + lane) * 4;
      const float4 wv4 = *(const float4*)(w + col);
      const float4 y = make_float4(v[i][0] * rs * wv4.x, v[i][1] * rs * wv4.y, v[i][2] * rs * wv4.z, v[i][3] * rs * wv4.w);
      if (MODE == 2) {
        float* dst = (row < MP) ? p.out + O_YP + (size_t)row * D : p.out + O_YS + (size_t)(row - MP) * D;
        *(float4*)(dst + col) = y;
      } else {
        *(uint2*)(hn + (size_t)row * D + col) = make_uint2(pack2(y.x, y.y), pack2(y.z, y.w));
      }
    }
#pragma unroll
    for (int i = 0; i < 8; ++i) v[i] = nx[i];
  }
#undef RMS_LOAD
}

__device__ __forceinline__ void ld8(const u16* p, float* f) {
  uint4 v = *(const uint4*)p;
  f[0] = __uint_as_float(v.x << 16); f[1] = __uint_as_float(v.x & 0xffff0000u);
  f[2] = __uint_as_float(v.y << 16); f[3] = __uint_as_float(v.y & 0xffff0000u);
  f[4] = __uint_as_float(v.z << 16); f[5] = __uint_as_float(v.z & 0xffff0000u);
  f[6] = __uint_as_float(v.w << 16); f[7] = __uint_as_float(v.w & 0xffff0000u);
}
__device__ __forceinline__ void st8(u16* p, const float* f) {
  *(uint4*)p = make_uint4(pack2(f[0], f[1]), pack2(f[2], f[3]), pack2(f[4], f[5]), pack2(f[6], f[7]));
}

constexpr int BM = 256, BK = 64, HALF = 128, NXCD = 8, WGM = 8, HT = HALF * BK;

__device__ __forceinline__ int lds_byte(int r, int c) {
  int st = (r >> 4) * 2 + (c >> 5), rr = r & 15, cc = c & 31, ob = rr * 64 + cc * 2;
  return st * 1024 + (ob ^ (((ob >> 9) & 1) << 5));
}
__device__ __forceinline__ void stage_rc(int b, int& R, int& C) {
  int st = b / 1024, sb = b % 1024, swz = sb ^ (((sb >> 9) & 1) << 5);
  R = (st >> 1) * 16 + swz / 64; C = (st & 1) * 32 + (swz % 64) / 2;
}

__device__ __forceinline__ void tile_coords(int wgid, int nM, int nN, int& pm, int& pn) {
  const int nwg = nM * nN;
  { int q = nwg / NXCD, r = nwg % NXCD, xcd = wgid % NXCD, off = wgid / NXCD;
    wgid = (xcd < r ? xcd * (q + 1) : r * (q + 1) + (xcd - r) * q) + off; }
  const int nig = WGM * nN, gid = wgid / nig, fm = gid * WGM, gsz = min(nM - fm, WGM);
  pm = fm + ((wgid % nig) % gsz); pn = (wgid % nig) / gsz;
}

struct EpiStoreBf16 {
  static constexpr bool GATE = false;
  u16* out; int ldo; const float* rss;
  __device__ __forceinline__ float row_scale(int row) const { return rss ? rsqrtf(rss[row] * (1.f / D) + EPS) : 1.f; }
  __device__ __forceinline__ float operator()(int row, int col, f32x4 v, float sc) const {
    uint2 pk = make_uint2(pack2(v[0] * sc, v[1] * sc), pack2(v[2] * sc, v[3] * sc));
    *(uint2*)(out + (size_t)row * ldo + col) = pk;
    return 0.f;
  }
  __device__ __forceinline__ void row_end(int, float, int) const {}
};
struct EpiAccum {
  static constexpr bool GATE = false;
  u16* hb; float* rss; const float* rin32;
  __device__ __forceinline__ float row_scale(int) const { return 1.f; }
  __device__ __forceinline__ float operator()(int row, int col, f32x4 v, float) const {
    u16* q = hb + (size_t)row * D + col;
    float4 o;
    if (rin32) o = *(const float4*)(rin32 + (size_t)row * D + col);
    else { const uint2 r = *(const uint2*)q; o = make_float4(__uint_as_float(r.x << 16), __uint_as_float(r.x & 0xffff0000u), __uint_as_float(r.y << 16), __uint_as_float(r.y & 0xffff0000u)); }
    o.x += v[0]; o.y += v[1]; o.z += v[2]; o.w += v[3];
    *(uint2*)q = make_uint2(pack2(o.x, o.y), pack2(o.z, o.w));
    return rss ? o.x * o.x + o.y * o.y + o.z * o.z + o.w * o.w : 0.f;
  }
  __device__ __forceinline__ void row_end(int row, float ss, int fq) const {
    if (rss) {
      ss += __shfl_xor(ss, 16, 64);
      ss += __shfl_xor(ss, 32, 64);
      if (fq == 0) unsafeAtomicAdd(rss + row, ss);
    }
  }
};

struct EpiGate {
  static constexpr bool GATE = true;
  const __attribute__((address_space(4))) void* kp; int layer; int rssoff;
  __device__ __forceinline__ float row_scale(int) const { return 1.f; }
  __device__ __forceinline__ float operator()(int, int, f32x4, float) const { return 0.f; }
  __device__ __forceinline__ void row_end(int, float, int) const {}
};

template <int M, int N, int K, int TAIL, class Epi>
__device__ __forceinline__ void gemm_phase(int wv, const u16* __restrict__ A, const u16* __restrict__ Bt, Epi epi, u16* shm) {
  const int tix = tidx(wv);
#define SA(b, h) (shm + ((b) * 2 + (h)) * HT)
#define SB(b, h) (shm + (4 + (b) * 2 + (h)) * HT)
#define STAGE(P, BASE, br, kt) do { const u16* _gb = BASE + ((long)(br) * K + (long)(kt0 + (kt)) * BK); \
    for (int _i = 0; _i < 2; ++_i) { int _b = tix * 16 + _i * 8192; \
      __builtin_amdgcn_global_load_lds((const unsigned*)(_gb + toff[_i]), \
        (__attribute__((address_space(3))) unsigned*)((char*)(P) + _b), 16, 0, 0); } } while (0)
#define LDA(dst, b, h) for (int m = 0; m < 4; ++m) for (int k = 0; k < 2; ++k) \
    dst[m][k] = *reinterpret_cast<const bf16x8*>((char*)SA(b, h) + lds_byte(wr * 64 + m * 16 + fr, k * 32 + fq * 8))
#define LDB(dst, b, h) for (int n = 0; n < 2; ++n) for (int k = 0; k < 2; ++k) \
    dst[n][k] = *reinterpret_cast<const bf16x8*>((char*)SB(b, h) + lds_byte(wc * 32 + n * 16 + fr, k * 32 + fq * 8))
#define MMA(ai, bj, At_, Bt_) do { __builtin_amdgcn_s_setprio(1); \
    for (int m = 0; m < 4; ++m) for (int n = 0; n < 2; ++n) for (int k = 0; k < 2; ++k) \
      acc[ai][bj][m][n] = __builtin_amdgcn_mfma_f32_16x16x32_bf16(Bt_[n][k], At_[m][k], acc[ai][bj][m][n], 0, 0, 0); \
    __builtin_amdgcn_s_setprio(0); } while (0)
#define WAIT_V(n) asm volatile("s_waitcnt vmcnt(" #n ")" ::: "memory")
#define WAIT_L(n) asm volatile("s_waitcnt lgkmcnt(" #n ")" ::: "memory")
#define BAR __builtin_amdgcn_s_barrier()
#define SCHED __builtin_amdgcn_sched_barrier(0)
  const int nM = M / BM, nN = N / BM, nwg = nM * nN, G = gridDim.x;
  const int nunits = nwg;
  const int wid = tix >> 6, lane = tix & 63, wr = wid >> 2, wc = wid & 3, fr = lane & 15, fq = lane >> 4;
  const int nt_total = K / BK;
  unsigned toff[2];
  for (int _i = 0; _i < 2; ++_i) { int _b = tix * 16 + _i * 8192; int _r, _c; stage_rc(_b, _r, _c); toff[_i] = (unsigned)(_r * K + _c); }
  for (int vw = blockIdx.x; vw < nunits; vw += G) {
    int pm, pn;
    tile_coords(vw, nM, nN, pm, pn);
    const int brow = pm * BM, bcol = pn * BM;
    constexpr int kt0 = 0, nt = nt_total;
    f32x4 acc[2][2][4][2];
    for (int a = 0; a < 2; ++a) for (int b = 0; b < 2; ++b) for (int m = 0; m < 4; ++m) for (int n = 0; n < 2; ++n) acc[a][b][m][n] = f32x4{0.f, 0.f, 0.f, 0.f};
    bf16x8 At[4][2], B0[2][2], B1[2][2];
    STAGE(SB(0, 0), Bt, bcol, 0); STAGE(SA(0, 0), A, brow, 0);
    STAGE(SB(0, 1), Bt, bcol + HALF, 0); STAGE(SA(0, 1), A, brow + HALF, 0);
    if (wr == 1) BAR;
    WAIT_V(4); BAR;
    STAGE(SB(1, 0), Bt, bcol, 1); STAGE(SA(1, 0), A, brow, 1); STAGE(SB(1, 1), Bt, bcol + HALF, 1);
    WAIT_V(6); BAR;
    for (int t = 0; t < nt - 2; t += 2) {
      LDB(B0, 0, 0); SCHED; LDA(At, 0, 0); STAGE(SA(1, 1), A, brow + HALF, t + 1);
      WAIT_L(8); BAR; WAIT_L(0); MMA(0, 0, At, B0); BAR; SCHED;
      LDB(B1, 0, 1); STAGE(SB(0, 0), Bt, bcol, t + 2);
      BAR; WAIT_L(0); MMA(0, 1, At, B1); BAR;
      LDA(At, 0, 1); STAGE(SA(0, 0), A, brow, t + 2);
      BAR; WAIT_L(0); MMA(1, 0, At, B0); BAR; SCHED;
      STAGE(SB(0, 1), Bt, bcol + HALF, t + 2);
      WAIT_V(6); BAR; MMA(1, 1, At, B1); BAR;
      LDB(B0, 1, 0); SCHED; LDA(At, 1, 0); STAGE(SA(0, 1), A, brow + HALF, t + 2);
      WAIT_L(8); BAR; WAIT_L(0); MMA(0, 0, At, B0); BAR; SCHED;
      LDB(B1, 1, 1); STAGE(SB(1, 0), Bt, bcol, t + 3);
      BAR; WAIT_L(0); MMA(0, 1, At, B1); BAR;
      LDA(At, 1, 1); STAGE(SA(1, 0), A, brow, t + 3);
      BAR; WAIT_L(0); MMA(1, 0, At, B0); BAR; SCHED;
      STAGE(SB(1, 1), Bt, bcol + HALF, t + 3);
      WAIT_V(6); BAR; MMA(1, 1, At, B1); BAR;
    }
    { LDB(B0, 0, 0); LDA(At, 0, 0); STAGE(SA(1, 1), A, brow + HALF, nt - 1);
      BAR; WAIT_L(0); MMA(0, 0, At, B0); BAR;
      LDB(B1, 0, 1); BAR; WAIT_L(0); MMA(0, 1, At, B1); BAR;
      LDA(At, 0, 1); WAIT_V(4); BAR; WAIT_L(0); MMA(1, 0, At, B0); MMA(1, 1, At, B1); BAR; }
    { LDB(B0, 1, 0); LDA(At, 1, 0); WAIT_V(2); BAR; WAIT_L(0); MMA(0, 0, At, B0); BAR;
      LDB(B1, 1, 1); WAIT_V(0); BAR; WAIT_L(0); MMA(0, 1, At, B1); BAR;
      LDA(At, 1, 1); BAR; WAIT_L(0); MMA(1, 0, At, B0); MMA(1, 1, At, B1); BAR; }
    if (wr == 0) BAR;
    if constexpr (Epi::GATE) {
      constexpr int LS = 136;
      u16* La = shm;
      u16* Lu = shm + 256 * LS;
      const __attribute__((address_space(4))) Params* gkp = (const __attribute__((address_space(4))) Params*)epi.kp;
      asm volatile("" : "+s"(gkp));
      int e_pm = pm, e_pn = pn, e_tix = tix;
      asm volatile("" : "+s"(e_pm), "+s"(e_pn));
      asm volatile("" : "+v"(e_tix));
      const int e_brow = e_pm * BM;
      {
        const int e_lane = e_tix & 63, e_wid = e_tix >> 6, e_wr = e_wid >> 2, e_wc = e_wid & 3, e_fr = e_lane & 15, e_fq = e_lane >> 4;
        const float* rss = (const float*)(gkp->ws + OFF_RSS) + epi.rssoff;
        _Pragma("unroll") for (int ai = 0; ai < 2; ++ai) _Pragma("unroll") for (int m = 0; m < 4; ++m) {
          const int rl = ai * HALF + e_wr * 64 + m * 16 + e_fr;
          const float sc = rsqrtf(rss[e_brow + rl] * (1.f / D) + EPS);
          _Pragma("unroll") for (int n = 0; n < 2; ++n) {
            const f32x4 a = acc[ai][0][m][n], uu = acc[ai][1][m][n];
            const int lo = rl * LS + e_wc * 32 + n * 16 + e_fq * 4;
            *(uint2*)(La + lo) = make_uint2(pack2(a[0] * sc, a[1] * sc), pack2(a[2] * sc, a[3] * sc));
            *(uint2*)(Lu + lo) = make_uint2(pack2(uu[0] * sc, uu[1] * sc), pack2(uu[2] * sc, uu[3] * sc));
          }
        }
      }
      WAIT_L(0); BAR; asm volatile("" ::: "memory");
      {
        const bool samp = e_brow >= MP;
        const int layer = epi.layer;
        u16* gg = (u16*)(gkp->ws + OFF_R);
        u16* side = (u16*)(gkp->ws + OFF_SIDE);
        const float* cw = gkp->in[19] + (size_t)layer * 3 * DFF;
        const float* cb = gkp->in[20] + (size_t)layer * DFF;
        const float* cache = gkp->in[5] + (size_t)layer * 8 * 2 * DFF;
        float* cvo = gkp->out + (samp ? O_CVS + (size_t)layer * 8 * 2 * DFF : O_CVP + (size_t)layer * 4 * 2 * DFF);
        const int cg = e_tix & 15, r0 = e_tix >> 4, c = e_pn * 128 + cg * 8;
        float w0[8], w1[8], w2[8], bb[8];
        _Pragma("unroll") for (int e = 0; e < 8; ++e) { w0[e] = cw[c + e]; w1[e] = cw[DFF + c + e]; w2[e] = cw[2 * DFF + c + e]; bb[e] = cb[c + e]; }
        _Pragma("unroll 1") for (int it = 0; it < 8; ++it) {
          const int rl = it * 32 + r0;
          const int t = samp ? (rl & 63) : ((e_pm & 7) * 256 + rl);
          const int sb = (e_pm - 32) * 4 + (rl >> 6);
          float a[8], uu[8], am1[8], am2[8], y[8];
          ld8(La + rl * LS + cg * 8, a);
          ld8(Lu + rl * LS + cg * 8, uu);
          _Pragma("unroll") for (int e = 0; e < 8; ++e) { am1[e] = 0.f; am2[e] = 0.f; }
          if (t >= 1 && rl >= 1) ld8(La + (rl - 1) * LS + cg * 8, am1);
          if (t >= 2 && rl >= 2) ld8(La + (rl - 2) * LS + cg * 8, am2);
          if (samp && t < 2) {
            const float* c1 = cache + (size_t)(sb * 2 + 1) * DFF + c;
            if (t == 0) {
              const float* c0 = cache + (size_t)(sb * 2 + 0) * DFF + c;
              _Pragma("unroll") for (int e = 0; e < 8; ++e) { am2[e] = c0[e]; am1[e] = c1[e]; }
            } else {
              _Pragma("unroll") for (int e = 0; e < 8; ++e) am2[e] = c1[e];
            }
          }
          if (!(t >= 2 && rl < 2)) {
            _Pragma("unroll") for (int e = 0; e < 8; ++e) { float cv = bb[e] + w0[e] * am2[e] + w1[e] * am1[e] + w2[e] * a[e]; y[e] = siluf_(cv) * uu[e]; }
            st8(gg + (size_t)(e_brow + rl) * DFF + c, y);
          } else {
            st8(side + (size_t)(e_pm * 2 + rl) * DFF + c, a);
            st8(side + SZ_SIDE1 / 2 + (size_t)(e_pm * 2 + rl) * DFF + c, uu);
          }
          if (rl >= 254) st8(side + SZ_SIDE1 + (size_t)(e_pm * 2 + rl - 254) * DFF + c, a);
          int crow = -1;
          if (!samp) { if ((e_pm & 7) == 7 && rl >= 254) crow = (e_pm >> 3) * 2 + rl - 254; }
          else { if ((rl & 63) >= 62) crow = sb * 2 + (rl & 63) - 62; }
          if (crow >= 0) {
            float* dst = cvo + (size_t)crow * DFF + c;
            *(float4*)dst = make_float4(a[0], a[1], a[2], a[3]);
            *(float4*)(dst + 4) = make_float4(a[4], a[5], a[6], a[7]);
          }
        }
      }
      WAIT_L(0); BAR; asm volatile("" ::: "memory");
    } else {
    for (int ai = 0; ai < 2; ++ai) for (int m = 0; m < 4; ++m) {
      const int row = brow + ai * HALF + wr * 64 + m * 16 + fr;
      const float sc = epi.row_scale(row);
      float ss = 0.f;
      for (int bj = 0; bj < 2; ++bj) for (int n = 0; n < 2; ++n)
        ss += epi(row, bcol + bj * HALF + wc * 32 + n * 16 + fq * 4, acc[ai][bj][m][n], sc);
      epi.row_end(row, ss, fq);
      if (m & 1) asm volatile("" ::: "memory");
    }
    }
  }
#undef SA
#undef SB
#undef STAGE
#undef LDA
#undef LDB
#undef MMA
}


template <int K>
__device__ __forceinline__ void gemm_tail_phase(int wv, const u16* __restrict__ A, const u16* __restrict__ Bt, float* lds, u16* __restrict__ hb, float* __restrict__ rss, const float* __restrict__ rin32_tail) {
  const int tix = tidx(wv);
  const int tid = tix, w = tid >> 6, lane = tid & 63, fr = lane & 15, fq = lane >> 4;
  for (int u = blockIdx.x; u < 256; u += gridDim.x) {
    const int tm = u >> 5, tn = u & 31;
    const u16* Ab = A + (size_t)(MP + tm * 64 + fr) * K + fq * 8;
    const u16* Bb = Bt + (size_t)(tn * 64 + fr) * K + fq * 8;
    f32x4 acc[4][4];
#pragma unroll
    for (int i = 0; i < 4; ++i)
#pragma unroll
      for (int j = 0; j < 4; ++j) acc[i][j] = f32x4{0.f, 0.f, 0.f, 0.f};
    const u16* Ab2 = A + (size_t)(MP + tm * 64 + fr) * K + fq * 16;
    const u16* Bb2 = Bt + (size_t)(tn * 64 + fr) * K + fq * 16;
#pragma unroll 1
    for (int ks = w; ks < K / 64; ks += 8) {
      bf16x8 a[4][2], b[4][2];
#pragma unroll
      for (int i = 0; i < 4; ++i) {
        a[i][0] = *(const bf16x8*)(Ab2 + (size_t)i * 16 * K + ks * 64);
        a[i][1] = *(const bf16x8*)(Ab2 + (size_t)i * 16 * K + ks * 64 + 8);
        b[i][0] = *(const bf16x8*)(Bb2 + (size_t)i * 16 * K + ks * 64);
        b[i][1] = *(const bf16x8*)(Bb2 + (size_t)i * 16 * K + ks * 64 + 8);
      }
#pragma unroll
      for (int mb = 0; mb < 4; ++mb)
#pragma unroll
        for (int nb = 0; nb < 4; ++nb) {
          acc[mb][nb] = __builtin_amdgcn_mfma_f32_16x16x32_bf16(b[nb][0], a[mb][0], acc[mb][nb], 0, 0, 0);
          acc[mb][nb] = __builtin_amdgcn_mfma_f32_16x16x32_bf16(b[nb][1], a[mb][1], acc[mb][nb], 0, 0, 0);
        }
    }
    __syncthreads();
#pragma unroll
    for (int mb = 0; mb < 4; ++mb)
#pragma unroll
      for (int nb = 0; nb < 4; ++nb) *(f32x4*)(lds + w * 4096 + (mb * 16 + fr) * 64 + nb * 16 + fq * 4) = acc[mb][nb];
    __syncthreads();
    const int e = tid * 8, row = e >> 6, col = e & 63;
    float4 s0 = make_float4(0.f, 0.f, 0.f, 0.f), s1 = s0;
#pragma unroll
    for (int ww = 0; ww < 8; ++ww) {
      float4 x0 = *(const float4*)(lds + ww * 4096 + e), x1 = *(const float4*)(lds + ww * 4096 + e + 4);
      s0.x += x0.x; s0.y += x0.y; s0.z += x0.z; s0.w += x0.w;
      s1.x += x1.x; s1.y += x1.y; s1.z += x1.z; s1.w += x1.w;
    }
    const int grow = MP + tm * 64 + row;
    u16* q = hb + (size_t)grow * D + tn * 64 + col;
    float r8[8];
    if (rin32_tail) {
      const float* rq_ = rin32_tail + (size_t)(tm * 64 + row) * D + tn * 64 + col;
      const float4 a0 = *(const float4*)rq_, a1 = *(const float4*)(rq_ + 4);
      r8[0] = a0.x; r8[1] = a0.y; r8[2] = a0.z; r8[3] = a0.w; r8[4] = a1.x; r8[5] = a1.y; r8[6] = a1.z; r8[7] = a1.w;
    } else ld8(q, r8);
    r8[0] += s0.x; r8[1] += s0.y; r8[2] += s0.z; r8[3] += s0.w; r8[4] += s1.x; r8[5] += s1.y; r8[6] += s1.z; r8[7] += s1.w;
    st8(q, r8);
    if (rss) {
      float ss = 0.f;
#pragma unroll
      for (int e2 = 0; e2 < 8; ++e2) ss += r8[e2] * r8[e2];
      ss += __shfl_xor(ss, 1, 64); ss += __shfl_xor(ss, 2, 64); ss += __shfl_xor(ss, 4, 64);
      if ((tid & 7) == 0) unsafeAtomicAdd(rss + grow, ss);
    }
  }
}

template <int MODE>
__device__ __forceinline__ void prep_range(int wv, const Params& p, int u0, int u1, int ustride, unsigned char* shm) {
  const int tix = tidx(wv);
  constexpr int K = (MODE == 2) ? 256 : 128;
  constexpr int V = (MODE == 0) ? 256 : (MODE == 1 ? 128 : 512);
  constexpr int H = (MODE == 1) ? 8 : 4;
  constexpr int LD = (MODE == 2) ? NINO_PAD : NINE;
  constexpr int NSEG = 4, TL = 16, KS = K + 8, VS = V + 8, NPASS = K / 128;
  constexpr int NQ = K / 64, NV = V / 64;
  constexpr bool PFV = false;
  const int tid = tix, seg = tid >> 7;
  const u16* proj = (const u16*)(p.ws + OFF_BIG);
  unsigned char* R = p.ws + OFF_R;
  u16* qin = (u16*)(R + (MODE == 0 ? R_QA : MODE == 1 ? R_QB : R_QC));
  u16* koT = (u16*)(R + (MODE == 0 ? R_KA : MODE == 1 ? R_KB : R_KC));
  u16* vT = (u16*)(R + (MODE == 0 ? R_VA : MODE == 1 ? R_VB : R_VC));
  u16* Pm = (u16*)(R + (MODE == 0 ? R_PA : MODE == 1 ? R_PB : R_PC));
  float* dL = (float*)(R + (MODE == 0 ? R_DA : MODE == 1 ? R_DB : R_DC));
  u16* qs = (u16*)shm;
  u16* ksm = qs + 64 * KS;
  float* segtot = (float*)(ksm + 64 * KS);
  float* gl = segtot + NSEG * K;
  u16* rq = (u16*)(gl + 64 * 16);
  u16* rk = rq + 64 * KS;
  u16* rv = PFV ? rk + 64 * KS : rq;
  typedef __attribute__((ext_vector_type(4))) unsigned u32x4_t;
  u32x4_t rqr[NQ], rkr[NQ], rvr[PFV ? NV : 1];
#define PREP_ISSUE(uu_) do { \
    const int c_i = (uu_) / H, h_i = (uu_) % H; \
    const int row0_i = (c_i < 128) ? (c_i >> 5) * 2048 + (c_i & 31) * 64 : MP + (c_i - 128) * 64; \
    const u16* prow_i = proj + (size_t)row0_i * LD; \
    const int cq_i = (MODE == 0) ? h_i * 128 : (MODE == 1 ? 3072 + h_i * 128 : h_i * 256); \
    const int ck_i = (MODE == 0) ? 512 + h_i * 128 : (MODE == 1 ? 4096 + h_i * 128 : 1024 + h_i * 256); \
    const int vc_i = (MODE == 0) ? 1024 + h_i * 256 : (MODE == 1 ? 5120 + h_i * 128 : 2048 + h_i * 512); \
    _Pragma("unroll") for (int i = 0; i < NQ; ++i) { \
      const int idx = tid + i * 512, r = idx / (K / 8), cc = idx % (K / 8); \
      rqr[i] = *(const u32x4_t*)(prow_i + (size_t)r * LD + cq_i + cc * 8); \
      rkr[i] = *(const u32x4_t*)(prow_i + (size_t)r * LD + ck_i + cc * 8); \
    } \
    if constexpr (PFV) { \
      _Pragma("unroll") for (int i = 0; i < NV; ++i) { \
        const int idx = tid + i * 512, r = idx / (V / 8), cc = idx % (V / 8); \
        rvr[i] = *(const u32x4_t*)(prow_i + (size_t)r * LD + vc_i + cc * 8); \
      } \
    } } while (0)
  if (u0 < u1) PREP_ISSUE(u0);
#pragma unroll 1
  for (int uu = u0; uu < u1; uu += ustride) {
  const int c = uu / H, h = uu % H;
  int row0, pos0;
  if (c < 128) { row0 = (c >> 5) * 2048 + (c & 31) * 64; pos0 = (c & 31) * 64; }
  else { row0 = MP + (c - 128) * 64; pos0 = 1024; }
  const size_t u = (size_t)c * H + h;
  const u16* prow = proj + (size_t)row0 * LD;
  const int vc0 = (MODE == 0) ? 1024 + h * 256 : (MODE == 1 ? 5120 + h * 128 : 2048 + h * 512);
  __syncthreads();
#pragma unroll
  for (int i = 0; i < NQ; ++i) {
    const int idx = tid + i * 512, r = idx / (K / 8), cc = idx % (K / 8);
    *(u32x4_t*)(rq + r * KS + cc * 8) = rqr[i];
    *(u32x4_t*)(rk + r * KS + cc * 8) = rkr[i];
  }
  if constexpr (PFV) {
#pragma unroll
    for (int i = 0; i < NV; ++i) {
      const int idx = tid + i * 512, r = idx / (V / 8), cc = idx % (V / 8);
      *(u32x4_t*)(rv + r * VS + cc * 8) = rvr[i];
    }
  }
  if (MODE == 2) {
    for (int i = tid; i < 64 * 2; i += 512) {
      const int r = i >> 1, hh = i & 1;
      uint4 g4 = *(const uint4*)(prow + (size_t)r * LD + 6144 + hh * 8);
      float* d = gl + r * 16 + hh * 8;
      d[0] = __uint_as_float(g4.x << 16); d[1] = __uint_as_float(g4.x & 0xffff0000u);
      d[2] = __uint_as_float(g4.y << 16); d[3] = __uint_as_float(g4.y & 0xffff0000u);
      d[4] = __uint_as_float(g4.z << 16); d[5] = __uint_as_float(g4.z & 0xffff0000u);
      d[6] = __uint_as_float(g4.w << 16); d[7] = __uint_as_float(g4.w & 0xffff0000u);
    }
  }
  if (uu + ustride < u1) PREP_ISSUE(uu + ustride);
  __builtin_amdgcn_sched_barrier(0);
  __syncthreads();
#pragma unroll 1
  for (int pass = 0; pass < NPASS; ++pass) {
  const int kk = pass * 128 + (tid & 127);
  float qv[TL], kv[TL], bc[TL];
  if (MODE == 0) {
    const int j = kk & 63;
    const float invr = exp2f(-(float)j * (13.287712379549449f / 64.f)) * 0.15915494309189535f;
    const float lgam = log1pf(-exp2f(-5.f - (float)h));
#pragma unroll
    for (int i = 0; i < TL; ++i) {
      const int l = seg * TL + i;
      float rev = (float)(pos0 + l) * invr;
      rev -= floorf(rev);
      const float sn = __builtin_amdgcn_sinf(rev), cs = __builtin_amdgcn_cosf(rev);
      const float q1 = bf2f(rq[l * KS + j]), q2 = bf2f(rq[l * KS + j + 64]), k1 = bf2f(rk[l * KS + j]), k2 = bf2f(rk[l * KS + j + 64]);
      const float qr = (kk < 64) ? q1 * cs - q2 * sn : q1 * sn + q2 * cs;
      const float kr = (kk < 64) ? k1 * cs - k2 * sn : k1 * sn + k2 * cs;
      qv[i] = qr; kv[i] = kr * 0.08838834764831845f;
      bc[i] = lgam;
    }
  } else if (MODE == 1) {
    const int ch = h * 128 + kk;
    const float* lbp = p.in[11];
    float e0 = __expf(lbp[ch]), e1 = __expf(lbp[1024 + ch]), e2 = __expf(lbp[2048 + ch]);
    const float lb = e0 / (e0 + e1 + e2);
#pragma unroll
    for (int i = 0; i < TL; ++i) {
      const int l = seg * TL + i;
      const float qx = bf2f(rq[l * KS + kk]), fx = bf2f(rk[l * KS + kk]);
      qv[i] = siluf_(qx) * 0.08838834764831845f;
      const float sg = sigmoidf_(fx);
      const float f = lb + (1.f - lb) * sg;
      kv[i] = (1.f - lb) * (1.f - sg);
      bc[i] = __logf(f);
    }
  } else {
    const int ch = h * 256 + kk;
    const float* w2 = p.in[14];
    float wvv[16];
#pragma unroll
    for (int r = 0; r < 16; ++r) wvv[r] = w2[r * 1024 + ch];
    const float bias = p.in[15][ch];
#pragma unroll
    for (int i = 0; i < TL; ++i) {
      const int l = seg * TL + i;
      qv[i] = bf2f(rq[l * KS + kk]) * 0.0625f;
      kv[i] = bf2f(rk[l * KS + kk]);
      float x = bias;
#pragma unroll
      for (int r = 0; r < 16; ++r) x += gl[l * 16 + r] * wvv[r];
      const float ls = fminf(x, 0.f) - log1pf(__expf(-fabsf(x)));
      bc[i] = ls * (1.f / 16.f);
    }
  }
#pragma unroll
  for (int i = 1; i < TL; ++i) bc[i] += bc[i - 1];
  segtot[seg * K + kk] = bc[TL - 1];
  __syncthreads();
  float pre = 0.f, bL = 0.f;
#pragma unroll
  for (int sg = 0; sg < NSEG; ++sg) { float t = segtot[sg * K + kk]; bL += t; if (sg < seg) pre += t; }
  if (seg == 0) dL[u * K + kk] = __expf(bL);
  unsigned kop[TL / 2];
#pragma unroll
  for (int i = 0; i < TL; i += 2) {
    float ko2[2];
#pragma unroll
    for (int e = 0; e < 2; ++e) {
      const int l = seg * TL + i + e;
      const float b = bc[i + e] + pre;
      const float qi = qv[i + e] * __expf(b);
      const float ki = kv[i + e] * __expf(-b);
      ko2[e] = kv[i + e] * __expf(bL - b);
      const u16 qb = f2bf(qi);
      qs[l * KS + kk] = qb;
      ksm[l * KS + kk] = f2bf(ki);
    }
    kop[i / 2] = pack2(ko2[0], ko2[1]);
  }
  {
#pragma unroll
    for (int i = 0; i < TL / 8; ++i) {
      const int cc = seg * 2 + i;
      uint4* dst = (uint4*)(koT + u * K * 64 + ((((kk >> 4) * 2 + (cc >> 2)) * 64 + (cc & 3) * 16 + (kk & 15)) << 3));
      *dst = make_uint4(kop[i * 4 + 0], kop[i * 4 + 1], kop[i * 4 + 2], kop[i * 4 + 3]);
    }
  }
  }
  __syncthreads();
  for (int i = tid; i < 64 * (K / 8); i += 512) {
    const int r = i / (K / 8), cc = i % (K / 8);
    *(uint4*)(qin + u * 64 * K + ((((r >> 4) * (K / 32) + (cc >> 2)) * 64 + (cc & 3) * 16 + (r & 15)) << 3)) = *(const uint4*)(qs + r * KS + cc * 8);
  }
  {
    const int w = tid >> 6, lane = tid & 63, fr = lane & 15, fq = lane >> 4;
#pragma unroll 1
    for (int bi = 0; bi < 2; ++bi) {
      const int blk = w + bi * 8, lb = blk >> 2, sb = blk & 3;
      f32x4 acc = {0.f, 0.f, 0.f, 0.f};
      if (sb <= lb) {
#pragma unroll
        for (int kst = 0; kst < K / 32; ++kst) {
          bf16x8 a = *(const bf16x8*)(ksm + (sb * 16 + fr) * KS + kst * 32 + fq * 8);
          bf16x8 b = *(const bf16x8*)(qs + (lb * 16 + fr) * KS + kst * 32 + fq * 8);
          acc = __builtin_amdgcn_mfma_f32_16x16x32_bf16(a, b, acc, 0, 0, 0);
        }
      }
      const int l = lb * 16 + fr, s0 = sb * 16 + fq * 4;
      float v0 = (s0 + 0 <= l) ? acc[0] : 0.f, v1 = (s0 + 1 <= l) ? acc[1] : 0.f;
      float v2 = (s0 + 2 <= l) ? acc[2] : 0.f, v3 = (s0 + 3 <= l) ? acc[3] : 0.f;
      *(uint2*)(Pm + u * 4096 + ((((lb * 2 + (s0 >> 5)) * 64 + ((s0 & 31) >> 3) * 16 + fr) << 3) + (s0 & 7))) = make_uint2(pack2(v0, v1), pack2(v2, v3));
    }
  }
  }
}

template <int K, int V>
__device__ __forceinline__ void seq_unit(int wv, const u16* __restrict__ qin, const u16* __restrict__ koT, const u16* __restrict__ Pm, const u16* __restrict__ vsrc, int vld,
                         const float* __restrict__ dL, int H, int c0, int nch, int h, int vs,
                         const float* __restrict__ s0, float* __restrict__ sout, u16* __restrict__ o, int row0, int ocol, unsigned char* shm) {
  const int tix = tidx(wv);
  constexpr int NKB = K / 128, SST = K + 8;
  u16* ST = (u16*)shm;
  const int tid = tix, w = tid >> 6, lane = tid & 63, fr = lane & 15, fq = lane >> 4;
  f32x4 accS[NKB][2];
  __syncthreads();
#pragma unroll
  for (int kb = 0; kb < NKB; ++kb)
#pragma unroll
    for (int vb = 0; vb < 2; ++vb) {
      const int k = (w * NKB + kb) * 16 + fq * 4, vcol = vb * 16 + fr;
#pragma unroll
      for (int j = 0; j < 4; ++j) accS[kb][vb][j] = s0 ? s0[(size_t)(k + j) * V + vs * 32 + vcol] : 0.f;
      *(uint2*)(ST + vcol * SST + k) = make_uint2(pack2(accS[kb][vb][0], accS[kb][vb][1]), pack2(accS[kb][vb][2], accS[kb][vb][3]));
    }
  constexpr int VTS = 72;
  u16* VT = ST + 2 * 32 * SST;
  const int v_s = (tid >> 2) & 63, v_p = tid & 3;
  const u16* vrow = vsrc + (size_t)v_s * vld + v_p * 8;
  u32x4_t vreg = {0u, 0u, 0u, 0u};
  if (tid < 256) {
    vreg = *(const u32x4_t*)vrow;
#pragma unroll
    for (int j = 0; j < 4; ++j) {
      VT[(v_p * 8 + 2 * j) * VTS + v_s] = (u16)(vreg[j] & 0xffffu);
      VT[(v_p * 8 + 2 * j + 1) * VTS + v_s] = (u16)(vreg[j] >> 16);
    }
  }
  __syncthreads();
  int cur = 0;
  const int lb = w >> 1, ovb = w & 1;
  struct FragsO { bf16x8 op[2], oq[K / 32]; };
  struct FragsS { bf16x8 ka[NKB][2]; float4 d[NKB]; };
  auto load_o = [&](int ci, FragsO& f) {
    const size_t u = (size_t)(c0 + ci) * H + h;
    const u16* Pu = Pm + u * 4096;
    const u16* qu = qin + u * 64 * K;
#pragma unroll
    for (int ss = 0; ss < 2; ++ss) f.op[ss] = *(const bf16x8*)(Pu + (((lb * 2 + ss) * 64 + lane) << 3));
#pragma unroll
    for (int kst = 0; kst < K / 32; ++kst) f.oq[kst] = *(const bf16x8*)(qu + (((lb * (K / 32) + kst) * 64 + lane) << 3));
  };
  auto load_s = [&](int ci, FragsS& f) {
    const size_t u = (size_t)(c0 + ci) * H + h;
    const u16* ku = koT + u * K * 64;
    const float* du = dL + u * K;
#pragma unroll
    for (int kb = 0; kb < NKB; ++kb) {
      const int kbase = (w * NKB + kb) * 16;
      f.d[kb] = *(const float4*)(du + kbase + fq * 4);
      f.ka[kb][0] = *(const bf16x8*)(ku + ((((w * NKB + kb) * 2 + 0) * 64 + lane) << 3));
      f.ka[kb][1] = *(const bf16x8*)(ku + ((((w * NKB + kb) * 2 + 1) * 64 + lane) << 3));
    }
  };
  FragsO fo;
  FragsS f0;
  load_o(0, fo);
  load_s(0, f0);
  for (int ci = 0; ci < nch; ++ci) {
    const int cn = ci + 1 < nch ? ci + 1 : ci;
    FragsO fo1;
    FragsS f1;
    load_o(cn, fo1);
    load_s(cn, f1);
    if (tid < 256) vreg = *(const u32x4_t*)(vrow + (size_t)cn * 64 * vld);
    __builtin_amdgcn_sched_barrier(0);
    const u16* STc = ST + cur * 32 * SST;
    u16* STn = ST + (cur ^ 1) * 32 * SST;
    const u16* VTc = VT + cur * 32 * VTS;
    u16* VTn = VT + (cur ^ 1) * 32 * VTS;
    bf16x8 vf[2][2];
#pragma unroll
    for (int vb = 0; vb < 2; ++vb)
#pragma unroll
      for (int ss = 0; ss < 2; ++ss) vf[vb][ss] = *(const bf16x8*)(VTc + (vb * 16 + fr) * VTS + ss * 32 + fq * 8);
    f32x4 ao = {0.f, 0.f, 0.f, 0.f};
#pragma unroll
    for (int ss = 0; ss < 2; ++ss) {
      bf16x8 a = *(const bf16x8*)(VTc + (ovb * 16 + fr) * VTS + ss * 32 + fq * 8);
      ao = __builtin_amdgcn_mfma_f32_16x16x32_bf16(a, fo.op[ss], ao, 0, 0, 0);
    }
#pragma unroll
    for (int kst = 0; kst < K / 32; ++kst) {
      bf16x8 a = *(const bf16x8*)(STc + (ovb * 16 + fr) * SST + kst * 32 + fq * 8);
      ao = __builtin_amdgcn_mfma_f32_16x16x32_bf16(a, fo.oq[kst], ao, 0, 0, 0);
    }
    *(uint2*)(o + (size_t)(row0 + ci * 64 + lb * 16 + fr) * D + ocol + vs * 32 + ovb * 16 + fq * 4) =
        make_uint2(pack2(ao[0], ao[1]), pack2(ao[2], ao[3]));
#pragma unroll
    for (int kb = 0; kb < NKB; ++kb) {
      const int kbase = (w * NKB + kb) * 16;
      const float4 d4 = f0.d[kb];
#pragma unroll
      for (int vb = 0; vb < 2; ++vb) {
        f32x4 sv = accS[kb][vb];
        sv[0] *= d4.x; sv[1] *= d4.y; sv[2] *= d4.z; sv[3] *= d4.w;
        sv = __builtin_amdgcn_mfma_f32_16x16x32_bf16(f0.ka[kb][0], vf[vb][0], sv, 0, 0, 0);
        sv = __builtin_amdgcn_mfma_f32_16x16x32_bf16(f0.ka[kb][1], vf[vb][1], sv, 0, 0, 0);
        accS[kb][vb] = sv;
        *(uint2*)(STn + (vb * 16 + fr) * SST + kbase + fq * 4) = make_uint2(pack2(sv[0], sv[1]), pack2(sv[2], sv[3]));
      }
    }
    if (tid < 256) {
#pragma unroll
      for (int j = 0; j < 4; ++j) {
        VTn[(v_p * 8 + 2 * j) * VTS + v_s] = (u16)(vreg[j] & 0xffffu);
        VTn[(v_p * 8 + 2 * j + 1) * VTS + v_s] = (u16)(vreg[j] >> 16);
      }
    }
    asm volatile("s_waitcnt lgkmcnt(0)" ::: "memory");
    __builtin_amdgcn_s_barrier();
    asm volatile("" ::: "memory");
    cur ^= 1;
    f0 = f1;
    fo = fo1;
  }
#pragma unroll
  for (int kb = 0; kb < NKB; ++kb)
#pragma unroll
    for (int vb = 0; vb < 2; ++vb) {
      const int k = (w * NKB + kb) * 16 + fq * 4, vcol = vb * 16 + fr;
#pragma unroll
      for (int j = 0; j < 4; ++j) sout[(size_t)(k + j) * V + vs * 32 + vcol] = accS[kb][vb][j];
    }
}

__device__ __forceinline__ void seq_even_phase(int wv, const Params& p, unsigned char* shm) {
  unsigned char* R = p.ws + OFF_R;
  u16* o = (u16*)(p.ws + OFF_H);
  for (int u = blockIdx.x; u < 768; u += gridDim.x) {
    if (u < 256) {
      const int x = u & 7, y = u >> 3;
      if (y < 16) {
        const int g = x * 2 + (y >> 3), b = g >> 2, h = g & 3, vs = y & 7;
        seq_unit<128, 256>(wv, (u16*)(R + R_QA), (u16*)(R + R_KA), (u16*)(R + R_PA), (const u16*)(p.ws + OFF_BIG) + (size_t)(b * 2048) * NINE + 1024 + h * 256 + vs * 32, NINE, (float*)(R + R_DA), 4, b * 32, 32, h, vs,
                           nullptr, p.out + O_RETP + (size_t)(b * 4 + h) * 128 * 256, o, b * 2048, h * 256, shm);
      } else {
        const int yy = y - 16, g = x * 4 + (yy >> 2), b = g >> 3, h = g & 7, vs = yy & 3;
        seq_unit<128, 128>(wv, (u16*)(R + R_QB), (u16*)(R + R_KB), (u16*)(R + R_PB), (const u16*)(p.ws + OFF_BIG) + (size_t)(b * 2048) * NINE + 5120 + h * 128 + vs * 32, NINE, (float*)(R + R_DB), 8, b * 32, 32, h, vs,
                           nullptr, p.out + O_HGP + (size_t)(b * 8 + h) * 128 * 128, o, b * 2048, 1024 + h * 128, shm);
      }
    } else if (u < 512) {
      int x = u - 256, b = x >> 5, h = (x >> 3) & 3, vs = x & 7;
      seq_unit<128, 256>(wv, (u16*)(R + R_QA), (u16*)(R + R_KA), (u16*)(R + R_PA), (const u16*)(p.ws + OFF_BIG) + (size_t)(MP + b * 64) * NINE + 1024 + h * 256 + vs * 32, NINE, (float*)(R + R_DA), 4, 128 + b, 1, h, vs,
                         p.in[2] + (size_t)(b * 4 + h) * 128 * 256, p.out + O_RETS + (size_t)(b * 4 + h) * 128 * 256, o, MP + b * 64, h * 256, shm);
    } else {
      int x = u - 512, b = x >> 5, h = (x >> 2) & 7, vs = x & 3;
      seq_unit<128, 128>(wv, (u16*)(R + R_QB), (u16*)(R + R_KB), (u16*)(R + R_PB), (const u16*)(p.ws + OFF_BIG) + (size_t)(MP + b * 64) * NINE + 5120 + h * 128 + vs * 32, NINE, (float*)(R + R_DB), 8, 128 + b, 1, h, vs,
                         p.in[3] + (size_t)(b * 8 + h) * 128 * 128, p.out + O_HGS + (size_t)(b * 8 + h) * 128 * 128, o, MP + b * 64, 1024 + h * 128, shm);
    }
  }
}
__device__ __forceinline__ void seq_odd_phase(int wv, const Params& p, unsigned char* shm) {
  unsigned char* R = p.ws + OFF_R;
  u16* o = (u16*)(p.ws + OFF_H);
  for (int u = blockIdx.x; u < 768; u += gridDim.x) {
    if (u < 256) {
      const int x = u & 7, y = u >> 3, g = x * 2 + (y >> 4), b = g >> 2, h = g & 3, vs = y & 15;
      seq_unit<256, 512>(wv, (u16*)(R + R_QC), (u16*)(R + R_KC), (u16*)(R + R_PC), (const u16*)(p.ws + OFF_BIG) + (size_t)(b * 2048) * NINO_PAD + 2048 + h * 512 + vs * 32, NINO_PAD, (float*)(R + R_DC), 4, b * 32, 32, h, vs,
                         nullptr, p.out + O_GLP + (size_t)(b * 4 + h) * 256 * 512, o, b * 2048, h * 512, shm);
    } else {
      int x = u - 256, b = x >> 6, h = (x >> 4) & 3, vs = x & 15;
      seq_unit<256, 512>(wv, (u16*)(R + R_QC), (u16*)(R + R_KC), (u16*)(R + R_PC), (const u16*)(p.ws + OFF_BIG) + (size_t)(MP + b * 64) * NINO_PAD + 2048 + h * 512 + vs * 32, NINO_PAD, (float*)(R + R_DC), 4, 128 + b, 1, h, vs,
                         p.in[4] + (size_t)(b * 4 + h) * 256 * 512, p.out + O_GLS + (size_t)(b * 4 + h) * 256 * 512, o, MP + b * 64, h * 512, shm);
    }
  }
}

__device__ __forceinline__ void up8(u32x4_t v, float* f) {
  f[0] = __uint_as_float(v[0] << 16); f[1] = __uint_as_float(v[0] & 0xffff0000u);
  f[2] = __uint_as_float(v[1] << 16); f[3] = __uint_as_float(v[1] & 0xffff0000u);
  f[4] = __uint_as_float(v[2] << 16); f[5] = __uint_as_float(v[2] & 0xffff0000u);
  f[6] = __uint_as_float(v[3] << 16); f[7] = __uint_as_float(v[3] & 0xffff0000u);
}
template <int ODD>
__device__ __forceinline__ void post_phase(int wv, const Params& p) {
  const int tix = tidx(wv);
  const int lane = tix & 63, gw = blockIdx.x * 8 + (tix >> 6), nw = gridDim.x * 8;
  const u16* o = (const u16*)(p.ws + OFF_H);
  const u16* proj = (const u16*)(p.ws + OFF_BIG);
  u16* ao = (u16*)(p.ws + OFF_R);
#define POST_LOAD(xr_, gr_, row_) do { const int r_ = (row_); \
    _Pragma("unroll") for (int i = 0; i < 4; ++i) { const int col_ = i * 512 + lane * 8; \
      xr_[i] = *(const u32x4_t*)(o + (size_t)r_ * D + col_); \
      gr_[i] = *(const u32x4_t*)(proj + (size_t)r_ * (ODD ? NINO_PAD : NINE) + (ODD ? 4096 + col_ : (i < 2 ? 2048 + col_ : 6144 + (col_ - 1024)))); } } while (0)
  u32x4_t xr[4], gr[4];
  if (gw < MT) POST_LOAD(xr, gr, gw);
#pragma unroll 1
  for (int row = gw; row < MT; row += nw) {
    u32x4_t xn[4], gn4[4];
    if (row + nw < MT) POST_LOAD(xn, gn4, row + nw);
    else {
#pragma unroll
      for (int i = 0; i < 4; ++i) { xn[i] = xr[i]; gn4[i] = gr[i]; }
    }
    __builtin_amdgcn_sched_barrier(0);
#pragma unroll
    for (int i = 0; i < 4; ++i) {
      const int col = i * 512 + lane * 8;
      float x[8], g[8], y[8];
      up8(xr[i], x);
      up8(gr[i], g);
      if (ODD) {
        float ss = 0.f;
#pragma unroll
        for (int e = 0; e < 8; ++e) ss += x[e] * x[e];
#pragma unroll
        for (int off = 32; off > 0; off >>= 1) ss += __shfl_xor(ss, off, 64);
        const float rs = rsqrtf(ss * (1.f / 512.f) + EPS);
        const float* gn = p.in[16] + lane * 8;
#pragma unroll
        for (int e = 0; e < 8; ++e) y[e] = x[e] * rs * gn[e] * siluf_(g[e]);
      } else if (i < 2) {
        float s1 = 0.f;
#pragma unroll
        for (int e = 0; e < 8; ++e) s1 += x[e];
#pragma unroll
        for (int off = 16; off > 0; off >>= 1) s1 += __shfl_xor(s1, off, 64);
        const float mu = s1 * (1.f / 256.f);
        float s2 = 0.f;
#pragma unroll
        for (int e = 0; e < 8; ++e) { float dlt = x[e] - mu; s2 += dlt * dlt; }
#pragma unroll
        for (int off = 16; off > 0; off >>= 1) s2 += __shfl_xor(s2, off, 64);
        const float rs = rsqrtf(s2 * (1.f / 256.f) + EPS);
#pragma unroll
        for (int e = 0; e < 8; ++e) y[e] = (x[e] - mu) * rs * siluf_(g[e]);
      } else {
        float ss = 0.f;
#pragma unroll
        for (int e = 0; e < 8; ++e) ss += x[e] * x[e];
#pragma unroll
        for (int off = 8; off > 0; off >>= 1) ss += __shfl_xor(ss, off, 64);
        const float rs = rsqrtf(ss * (1.f / 128.f) + EPS);
        const float* gn = p.in[12] + (lane & 15) * 8;
#pragma unroll
        for (int e = 0; e < 8; ++e) y[e] = x[e] * rs * gn[e] * siluf_(g[e]);
      }
      st8(ao + (size_t)row * D + col, y);
    }
#pragma unroll
    for (int i = 0; i < 4; ++i) { xr[i] = xn[i]; gr[i] = gn4[i]; }
  }
#undef POST_LOAD
}


__device__ __forceinline__ void final_norm_phase(int wv, const Params& p) {
  const int tix = tidx(wv);
  const int lane = tix & 63, gw = blockIdx.x * 8 + (tix >> 6), nw = gridDim.x * 8;
  const u16* hb = (const u16*)(p.ws + OFF_HN);
  const float* w = p.in[8];
  u32x4_t v[4];
  if (gw < MT) {
#pragma unroll
    for (int i = 0; i < 4; ++i) v[i] = *(const u32x4_t*)(hb + (size_t)gw * D + i * 512 + lane * 8);
  }
#pragma unroll 1
  for (int row = gw; row < MT; row += nw) {
    u32x4_t nx[4];
    const int nrow = row + nw < MT ? row + nw : row;
#pragma unroll
    for (int i = 0; i < 4; ++i) nx[i] = *(const u32x4_t*)(hb + (size_t)nrow * D + i * 512 + lane * 8);
    __builtin_amdgcn_sched_barrier(0);
    float x[4][8];
    float ss = 0.f;
#pragma unroll
    for (int i = 0; i < 4; ++i) {
      up8(v[i], x[i]);
#pragma unroll
      for (int e = 0; e < 8; ++e) ss += x[i][e] * x[i][e];
    }
#pragma unroll
    for (int o = 32; o > 0; o >>= 1) ss += __shfl_xor(ss, o, 64);
    const float rs = rsqrtf(ss * (1.f / D) + EPS);
    float* dst = (row < MP) ? p.out + O_YP + (size_t)row * D : p.out + O_YS + (size_t)(row - MP) * D;
#pragma unroll
    for (int i = 0; i < 4; ++i) {
      const int col = i * 512 + lane * 8;
      const float4 w0 = *(const float4*)(w + col), w1 = *(const float4*)(w + col + 4);
      *(float4*)(dst + col) = make_float4(x[i][0] * rs * w0.x, x[i][1] * rs * w0.y, x[i][2] * rs * w0.z, x[i][3] * rs * w0.w);
      *(float4*)(dst + col + 4) = make_float4(x[i][4] * rs * w1.x, x[i][5] * rs * w1.y, x[i][6] * rs * w1.z, x[i][7] * rs * w1.w);
    }
#pragma unroll
    for (int i = 0; i < 4; ++i) v[i] = nx[i];
  }
}

__device__ __forceinline__ void gate_phase(int wv, const Params& p, int layer) {
  const int tix = tidx(wv);
  const u16* au = (const u16*)(p.ws + OFF_BIG);
  u16* gg = (u16*)(p.ws + OFF_R);
  const float* cw = p.in[19] + (size_t)layer * 3 * DFF;
  const float* cb = p.in[20] + (size_t)layer * DFF;
  const float* cache = p.in[5] + (size_t)layer * 8 * 2 * DFF;
  const int nitems = (MT / 16) * (DFF / 8);
  for (int it = blockIdx.x * 512 + tix; it < nitems; it += gridDim.x * 512) {
    const int cg8 = it % (DFF / 8), rb = it / (DFF / 8), c0 = cg8 * 8, r0 = rb * 16;
    float w0[8], w1[8], w2[8], bb[8], am2[8], am1[8];
#pragma unroll
    for (int e = 0; e < 8; ++e) { w0[e] = cw[c0 + e]; w1[e] = cw[DFF + c0 + e]; w2[e] = cw[2 * DFF + c0 + e]; bb[e] = cb[c0 + e]; }
    int t0, T, b; bool samp = r0 >= MP;
    if (!samp) { b = r0 >> 11; t0 = r0 & 2047; T = 2048; } else { b = (r0 - MP) >> 6; t0 = (r0 - MP) & 63; T = 64; }
    if (t0 == 0) {
      if (samp) {
#pragma unroll
        for (int e = 0; e < 8; ++e) { am2[e] = cache[(size_t)(b * 2 + 0) * DFF + c0 + e]; am1[e] = cache[(size_t)(b * 2 + 1) * DFF + c0 + e]; }
      } else {
#pragma unroll
        for (int e = 0; e < 8; ++e) { am2[e] = 0.f; am1[e] = 0.f; }
      }
    } else {
      ld8(au + (size_t)(r0 - 2) * NUP + c0, am2);
      ld8(au + (size_t)(r0 - 1) * NUP + c0, am1);
    }
#pragma unroll 4
    for (int i = 0; i < 16; ++i) {
      float a[8], uu[8], y[8];
      ld8(au + (size_t)(r0 + i) * NUP + c0, a);
      ld8(au + (size_t)(r0 + i) * NUP + DFF + c0, uu);
#pragma unroll
      for (int e = 0; e < 8; ++e) {
        float cv = bb[e] + w0[e] * am2[e] + w1[e] * am1[e] + w2[e] * a[e];
        y[e] = siluf_(cv) * uu[e];
        am2[e] = am1[e]; am1[e] = a[e];
      }
      st8(gg + (size_t)(r0 + i) * DFF + c0, y);
    }
    if (t0 + 16 == T) {
      float* dst = samp ? p.out + O_CVS + (size_t)(layer * 8 + b) * 2 * DFF : p.out + O_CVP + (size_t)(layer * 4 + b) * 2 * DFF;
#pragma unroll
      for (int e = 0; e < 8; ++e) { dst[c0 + e] = am2[e]; dst[DFF + c0 + e] = am1[e]; }
    }
  }
}


__device__ __forceinline__ void gate_fixup(int wv, const Params& p, int layer) {
  const int tix = tidx(wv);
  const u16* side = (const u16*)(p.ws + OFF_SIDE);
  u16* gg = (u16*)(p.ws + OFF_R);
  const float* cw = p.in[19] + (size_t)layer * 3 * DFF;
  const float* cb = p.in[20] + (size_t)layer * DFF;
  for (int vw = blockIdx.x; vw < (MP / BM) * (D / BM); vw += gridDim.x) {
    int pm, pn;
    tile_coords(vw, MP / BM, D / BM, pm, pn);
    if ((pm & 7) == 0) continue;
    for (int c8 = tix; c8 < DFF / 8; c8 += 512) {
      const int c = c8 * 8;
      float a0[8], a1[8], u0[8], u1[8], q2[8], q1[8], y0[8], y1[8];
      ld8(side + (size_t)(pm * 2 + 0) * DFF + c, a0);
      ld8(side + (size_t)(pm * 2 + 1) * DFF + c, a1);
      ld8(side + SZ_SIDE1 / 2 + (size_t)(pm * 2 + 0) * DFF + c, u0);
      ld8(side + SZ_SIDE1 / 2 + (size_t)(pm * 2 + 1) * DFF + c, u1);
      ld8(side + SZ_SIDE1 + (size_t)((pm - 1) * 2 + 0) * DFF + c, q2);
      ld8(side + SZ_SIDE1 + (size_t)((pm - 1) * 2 + 1) * DFF + c, q1);
#pragma unroll
      for (int e = 0; e < 8; ++e) {
        const float w0 = cw[c + e], w1 = cw[DFF + c + e], w2 = cw[2 * DFF + c + e], bb = cb[c + e];
        y0[e] = siluf_(bb + w0 * q2[e] + w1 * q1[e] + w2 * a0[e]) * u0[e];
        y1[e] = siluf_(bb + w0 * q1[e] + w1 * a0[e] + w2 * a1[e]) * u1[e];
      }
      st8(gg + (size_t)(pm * 256 + 0) * DFF + c, y0);
      st8(gg + (size_t)(pm * 256 + 1) * DFF + c, y1);
    }
  }
  asm volatile("s_waitcnt vmcnt(0)" ::: "memory");
  __syncthreads();
}

#define XB_TMO      128
#define XB_XCNT(j)  (256  + 64 * (j))
#define XB_XSUB(j)  (1280 + 64 * (j))
#define XB_XGEN(j)  (2304 + 64 * (j))
#define XB_TOP      3328
#define XB_TOPGEN   3392
#define XCD_BAR_WORDS 3456
#define XB_SPIN_CAP (1u << 22)
#define LAS __attribute__((address_space(3)))
__device__ __forceinline__ unsigned xb_ld(unsigned* p)              { return __hip_atomic_load(p, __ATOMIC_RELAXED, __HIP_MEMORY_SCOPE_AGENT); }
__device__ __forceinline__ unsigned xb_add(unsigned* p, unsigned v) { return __hip_atomic_fetch_add(p, v, __ATOMIC_RELAXED, __HIP_MEMORY_SCOPE_AGENT); }
__device__ __forceinline__ unsigned xb_xcc_id() { return (unsigned)__builtin_amdgcn_s_getreg((3 << 11) | 20) & 0xFu; }
#define XB_SPIN(cond, bar) do { unsigned _sp = 0; while (cond) { __builtin_amdgcn_s_sleep(1); \
    if ((++_sp & 255u) == 0u) { if (xb_ld(&(bar)[XB_TMO])) break; if (_sp > XB_SPIN_CAP) { atomicAdd(&(bar)[XB_TMO], 1u); break; } } } } while (0)
struct XcdBarrier { unsigned* bar; unsigned x; volatile LAS unsigned* st; };
__device__ __forceinline__ XcdBarrier xcd_barrier_post(int wv, unsigned* bar, volatile LAS unsigned* st) {
  XcdBarrier b; b.bar = bar; b.x = xb_xcc_id(); b.st = st;
  if (tidx(wv) == 0) (void)xb_add(&bar[XB_XCNT(b.x)], 1u);
  return b;
}
__device__ __forceinline__ void xcd_barrier_complete(unsigned* bar, unsigned x, unsigned& nloc, unsigned& nx) {
  const unsigned G = gridDim.x * gridDim.y * gridDim.z;
  unsigned sum, cnt, mine, sp = 0u;
  for (;;) {
    sum = 0u; cnt = 0u; mine = 0u;
#pragma unroll
    for (unsigned j = 0; j < 16; ++j) { const unsigned c = xb_ld(&bar[XB_XCNT(j)]); sum += c; cnt += (c > 0u) ? 1u : 0u; mine = (j == x) ? c : mine; }
    if (sum == G) break;
    __builtin_amdgcn_s_sleep(1);
    if ((++sp & 255u) == 0u) { if (xb_ld(&bar[XB_TMO])) break; if (sp > XB_SPIN_CAP) { atomicAdd(&bar[XB_TMO], 1u); break; } }
  }
  nloc = mine > 0u ? mine : 1u; nx = cnt > 0u ? cnt : 1u;
}
__device__ __forceinline__ void xcd_barrier(int wv, const XcdBarrier& b) {
  asm volatile("s_waitcnt vmcnt(0)" ::: "memory");
  __syncthreads();
  if (tidx(wv) == 0) {
    unsigned* bar = b.bar;
    __builtin_amdgcn_s_waitcnt(0);
    unsigned nloc = b.st[0], nx = b.st[1];
    if (nloc == 0u) { xcd_barrier_complete(bar, b.x, nloc, nx); b.st[0] = nloc; b.st[1] = nx; }
    const unsigned old = xb_add(&bar[XB_XSUB(b.x)], 1u);
    const unsigned gen = old / nloc;
    if (old + 1u == (gen + 1u) * nloc) {
      __builtin_amdgcn_fence(__ATOMIC_RELEASE, "agent");
      asm volatile("s_waitcnt vmcnt(0)" ::: "memory");
      const unsigned og = xb_add(&bar[XB_TOP], 1u);
      const unsigned tg = og / nx;
      if (og + 1u == (tg + 1u) * nx) xb_add(&bar[XB_TOPGEN], 1u);
      else XB_SPIN(xb_ld(&bar[XB_TOPGEN]) == tg, bar);
      __builtin_amdgcn_fence(__ATOMIC_ACQUIRE, "agent");
      xb_add(&bar[XB_XGEN(b.x)], 1u);
      asm volatile("s_waitcnt vmcnt(0)" ::: "memory");
    } else {
      XB_SPIN(xb_ld(&bar[XB_XGEN(b.x)]) == gen, bar);
      __builtin_amdgcn_fence(__ATOMIC_ACQUIRE, "agent");
      asm volatile("s_waitcnt vmcnt(0)" ::: "memory");
    }
  }
  __syncthreads();
}

constexpr int NPHASE = 21;
#ifndef PHMASK
#define PHMASK 0xFFFFFFFFu
#endif
#define PH_ON(k) (((PHMASK) >> (k)) & 1u)
constexpr int LDS_BYTES = 147456;

typedef const __attribute__((address_space(4))) Params* KParamsPtr;
#ifndef XSYNC
#define XSYNC 0
#endif
#ifndef DUPMASK
#define DUPMASK 0u
#endif
#define DUP_ON(k) (((DUPMASK) >> (k)) & 1u)
__device__ __forceinline__ bool ph_in(KParamsPtr& kp, int k) { asm volatile("" : "+s"(kp)); return kp->ph_lo <= k && k < kp->ph_hi; }
#define PH_IN(k) ph_in(kp, (k))
#define PHASE(k, ...) if (PH_IN(k)) { if (PH_ON(k)) { for (int rep = 0; rep < 1 + (int)DUP_ON(k); ++rep) { asm volatile("" : "+s"(kp)); Params p; __builtin_memcpy(&p, kp, sizeof(Params)); unsigned char* ws = p.ws; __VA_ARGS__ } } \
    asm volatile("" : "+s"(kp)); \
    if (kp->coop && (k) + 1 < kp->ph_hi) { XcdBarrier xb; xb.bar = (unsigned*)(kp->ws + OFF_BAR); xb.x = xb_xcc_id(); xb.st = (volatile LAS unsigned*)&xb_words; xcd_barrier(wv, xb); if (XSYNC) xcd_barrier(wv, xb); } }
#define PHASE_X(k, ...) if (PH_IN(k)) { asm volatile("" : "+s"(kp)); Params p; __builtin_memcpy(&p, kp, sizeof(Params)); unsigned char* ws = p.ws; __VA_ARGS__ }
#define GEMM_ACC(k, Aoff, Woff, KK, RSSP, FIXL, RINP, RINS) PHASE(k, { float* rssp = (RSSP); if ((FIXL) >= 0) gate_fixup(wv, p, FIXL); \
    gemm_phase<MP, D, KK, 0>(wv, (const u16*)(ws + Aoff), (const u16*)(ws + Woff), EpiAccum{(u16*)(ws + OFF_HN), rssp, (RINP)}, (u16*)shm); \
    gemm_tail_phase<KK>(wv, (const u16*)(ws + Aoff), (const u16*)(ws + Woff), (float*)shm, (u16*)(ws + OFF_HN), rssp, (RINS)); })

__global__ void __launch_bounds__(512) fwd_kernel(Params p_) {
  extern __shared__ __attribute__((aligned(16))) unsigned char shm[];
  cg::grid_group grid = cg::this_grid();
  KParamsPtr kp = (KParamsPtr)__builtin_amdgcn_kernarg_segment_ptr();
  const int wv = __builtin_amdgcn_readfirstlane((int)(threadIdx.x >> 6));
  __shared__ uint4 xb_words;
  if (tidx(wv) == 0) xb_words = make_uint4(0u, 0u, 0u, 0u);
  __syncthreads();
  if (kp->coop == 2) grid.sync();
  (void)xcd_barrier_post(wv, (unsigned*)(kp->ws + OFF_BAR), (volatile LAS unsigned*)&xb_words);
  PHASE(0,
        convert_w(wv, p.in[9], (u16*)(ws + OFF_WINE), D, NINE, NINE, (u16*)shm);
        convert_w(wv, p.in[10], (u16*)(ws + OFF_WOUTE), D, D, D, (u16*)shm);
        convert_w(wv, p.in[13], (u16*)(ws + OFF_WINO), D, NINO, NINO_PAD, (u16*)shm, p.in[6] + D);
        convert_w(wv, p.in[17], (u16*)(ws + OFF_WOUTO), D, D, D, (u16*)shm);
        convert_w(wv, p.in[18], (u16*)(ws + OFF_WUP0), D, NUP, NUP, (u16*)shm, p.in[7], 1);
        convert_w(wv, p.in[18] + (size_t)D * NUP, (u16*)(ws + OFF_WUP1), D, NUP, NUP, (u16*)shm, p.in[7] + D, 1);
        convert_w(wv, p.in[21], (u16*)(ws + OFF_WDN0), DFF, D, D, (u16*)shm);
        convert_w(wv, p.in[21] + (size_t)DFF * D, (u16*)(ws + OFF_WDN1), DFF, D, D, (u16*)shm);
        for (int i = blockIdx.x * 512 + tidx(wv); i < 3 * MT; i += gridDim.x * 512) ((float*)(ws + OFF_RSS))[i] = 0.f;
        rmsnorm_phase<0>(wv, p, p.in[6]);)
  PHASE(1, gemm_phase<MT, NINE, D, 0>(wv, (const u16*)(ws + OFF_HN), (const u16*)(ws + OFF_WINE), EpiStoreBf16{(u16*)(ws + OFF_BIG), NINE, nullptr}, (u16*)shm);)
  PHASE(2, { const int b_ = blockIdx.x, G_ = gridDim.x;
        prep_range<0>(wv, p, b_, NCH * 4, G_, shm);
        const int first1 = ((NCH * 4 - b_ + G_ - 1) / G_) * G_ + b_ - NCH * 4;
        prep_range<1>(wv, p, first1, NCH * 8, G_, shm); })
  PHASE(3, seq_even_phase(wv, p, shm);)
  PHASE(4, post_phase<0>(wv, p);)
  GEMM_ACC(5, OFF_R, OFF_WOUTE, D, (float*)(ws + OFF_RSS), -1, p.in[0], p.in[1])
  PHASE(7, gemm_phase<MT, NUP, D, 0>(wv, (const u16*)(ws + OFF_HN), (const u16*)(ws + OFF_WUP0), EpiGate{(const __attribute__((address_space(4))) void*)kp, 0, 0}, (u16*)shm);)
  GEMM_ACC(9, OFF_R, OFF_WDN0, DFF, (float*)(ws + OFF_RSS) + MT, 0, (const float*)nullptr, (const float*)nullptr)
  PHASE(11, gemm_phase<MT, NINO_PAD, D, 0>(wv, (const u16*)(ws + OFF_HN), (const u16*)(ws + OFF_WINO), EpiStoreBf16{(u16*)(ws + OFF_BIG), NINO_PAD, (const float*)(ws + OFF_RSS) + MT}, (u16*)shm);)
  PHASE(12, prep_range<2>(wv, p, blockIdx.x, NCH * 4, gridDim.x, shm);)
  PHASE(13, seq_odd_phase(wv, p, shm);)
  PHASE(14, post_phase<1>(wv, p);)
  GEMM_ACC(15, OFF_R, OFF_WOUTO, D, (float*)(ws + OFF_RSS) + 2 * MT, -1, (const float*)nullptr, (const float*)nullptr)
  PHASE(17, gemm_phase<MT, NUP, D, 0>(wv, (const u16*)(ws + OFF_HN), (const u16*)(ws + OFF_WUP1), EpiGate{(const __attribute__((address_space(4))) void*)kp, 1, 2 * MT}, (u16*)shm);)
  GEMM_ACC(19, OFF_R, OFF_WDN1, DFF, (float*)nullptr, 1, (const float*)nullptr, (const float*)nullptr)
  PHASE(20, final_norm_phase(wv, p);)
}

extern "C" void kernel_launch(void* const* d_in, const int* in_sizes, int n_in, void* d_out, int out_size, void* d_ws, size_t ws_size,
                              hipStream_t stream) {
  static int grid_blocks = 0;
  if (grid_blocks == 0) {
    int dev = 0, cus = 0, per_cu = 0;
    hipGetDevice(&dev);
    hipDeviceGetAttribute(&cus, hipDeviceAttributeMultiprocessorCount, dev);
    hipFuncSetAttribute((const void*)fwd_kernel, hipFuncAttributeMaxDynamicSharedMemorySize, LDS_BYTES);
    hipOccupancyMaxActiveBlocksPerMultiprocessor(&per_cu, (const void*)fwd_kernel, 512, LDS_BYTES);
    if (per_cu < 1) per_cu = 1;
    grid_blocks = cus * per_cu;
    (void)hipGetLastError();
  }
  if (n_in != 22 || ws_size < WS_NEED || (size_t)out_size != O_END) {
    fprintf(stderr, "kernel_launch: unexpected sizes n_in=%d ws=%zu need=%zu out=%d\n", n_in, ws_size, (size_t)WS_NEED, out_size);
    hipMemsetAsync(d_out, 0, (size_t)out_size * 4, stream);
    return;
  }
  Params p{};
  for (int i = 0; i < 22; ++i) p.in[i] = (const float*)d_in[i];
  p.out = (float*)d_out;
  p.ws = (unsigned char*)d_ws;
#if 0
  for (int ph = 0; ph < NPHASE; ++ph) {
    p.ph_lo = ph; p.ph_hi = ph + 1; p.coop = 0;
    hipLaunchKernelGGL(fwd_kernel, dim3(grid_blocks), dim3(512), LDS_BYTES, stream, p);
  }
#else
  p.ph_lo = 0; p.ph_hi = NPHASE; p.coop = 1;
  hipMemsetAsync((unsigned char*)d_ws + OFF_BAR, 0, XCD_BAR_WORDS * 4, stream);
  void* args[] = {&p};
  hipError_t e = hipLaunchCooperativeKernel((const void*)fwd_kernel, dim3(grid_blocks), dim3(512), args, LDS_BYTES, stream);
  if (e != hipSuccess) fprintf(stderr, "cooperative launch failed: %s (grid %d)\n", hipGetErrorString(e), grid_blocks);
#endif
}
```

```cpp
#include <hip/hip_runtime.h>
#include <hip/hip_bf16.h>
#include <hip/hip_cooperative_groups.h>
#include <cstdio>
namespace cg = cooperative_groups;

typedef unsigned short u16;
using bf16x8 = __attribute__((ext_vector_type(8))) short;
using f32x4 = __attribute__((ext_vector_type(4))) float;
typedef __attribute__((ext_vector_type(4))) unsigned u32x4_t;

constexpr int MP = 8192, MS = 512, MT = 8704, D = 2048;
constexpr int DFF = 5504, NUP = 11008;
constexpr int NINE = 7168, NINO = 6160, NINO_PAD = 6400;
constexpr int NCH = 136;
constexpr float EPS = 1e-6f;

constexpr size_t SZ_WINE = (size_t)NINE * D * 2, SZ_WOUT = (size_t)D * D * 2, SZ_WINO = (size_t)NINO_PAD * D * 2;
constexpr size_t SZ_WUP = (size_t)NUP * D * 2, SZ_WDN = (size_t)D * DFF * 2;
constexpr size_t OFF_WINE = 0;
constexpr size_t OFF_WOUTE = OFF_WINE + SZ_WINE;
constexpr size_t OFF_WINO = OFF_WOUTE + SZ_WOUT;
constexpr size_t OFF_WOUTO = OFF_WINO + SZ_WINO;
constexpr size_t OFF_WUP0 = OFF_WOUTO + SZ_WOUT;
constexpr size_t OFF_WUP1 = OFF_WUP0 + SZ_WUP;
constexpr size_t OFF_WDN0 = OFF_WUP1 + SZ_WUP;
constexpr size_t OFF_WDN1 = OFF_WDN0 + SZ_WDN;
constexpr size_t OFF_H = OFF_WDN1 + SZ_WDN;
constexpr size_t OFF_HN = OFF_H + (size_t)MT * D * 4;
constexpr size_t OFF_BIG = OFF_HN + (size_t)MT * D * 2;
constexpr size_t OFF_R = OFF_BIG + (size_t)MT * NUP * 2;
constexpr size_t SZ_R = 104ull * 1048576;
constexpr size_t OFF_RSS = OFF_R + SZ_R;
constexpr size_t OFF_SIDE = OFF_RSS + 3ull * MT * 4 + 256;
constexpr size_t SZ_SIDE1 = 34ull * 2 * DFF * 2;
constexpr size_t OFF_BAR = OFF_SIDE + 3 * SZ_SIDE1 + 256;
constexpr size_t WS_NEED = OFF_BAR + 16384;
constexpr size_t R_QA = 0;
constexpr size_t R_KA = R_QA + (size_t)NCH * 4 * 64 * 128 * 2;
constexpr size_t R_VA = R_KA + (size_t)NCH * 4 * 64 * 128 * 2;
constexpr size_t R_PA = R_VA + (size_t)NCH * 4 * 256 * 64 * 2;
constexpr size_t R_DA = R_PA + (size_t)NCH * 4 * 4096 * 2;
constexpr size_t R_QB = R_DA + (size_t)NCH * 4 * 128 * 4;
constexpr size_t R_KB = R_QB + (size_t)NCH * 8 * 64 * 128 * 2;
constexpr size_t R_VB = R_KB + (size_t)NCH * 8 * 64 * 128 * 2;
constexpr size_t R_PB = R_VB + (size_t)NCH * 8 * 128 * 64 * 2;
constexpr size_t R_DB = R_PB + (size_t)NCH * 8 * 4096 * 2;
constexpr size_t R_END_EVEN = R_DB + (size_t)NCH * 8 * 128 * 4;
constexpr size_t R_QC = 0;
constexpr size_t R_KC = R_QC + (size_t)NCH * 4 * 64 * 256 * 2;
constexpr size_t R_VC = R_KC + (size_t)NCH * 4 * 64 * 256 * 2;
constexpr size_t R_PC = R_VC + (size_t)NCH * 4 * 512 * 64 * 2;
constexpr size_t R_DC = R_PC + (size_t)NCH * 4 * 4096 * 2;
constexpr size_t R_END_ODD = R_DC + (size_t)NCH * 4 * 256 * 4;
static_assert(R_END_EVEN <= SZ_R && R_END_ODD <= SZ_R && (size_t)MT * DFF * 2 <= SZ_R, "R region too small");

constexpr size_t O_YP = 0;
constexpr size_t O_YS = O_YP + (size_t)MP * D;
constexpr size_t O_RETP = O_YS + (size_t)MS * D;
constexpr size_t O_RETS = O_RETP + 4ull * 4 * 128 * 256;
constexpr size_t O_HGP = O_RETS + 8ull * 4 * 128 * 256;
constexpr size_t O_HGS = O_HGP + 4ull * 8 * 128 * 128;
constexpr size_t O_GLP = O_HGS + 8ull * 8 * 128 * 128;
constexpr size_t O_GLS = O_GLP + 4ull * 4 * 256 * 512;
constexpr size_t O_CVP = O_GLS + 8ull * 4 * 256 * 512;
constexpr size_t O_CVS = O_CVP + 2ull * 4 * 2 * DFF;
constexpr size_t O_END = O_CVS + 2ull * 8 * 2 * DFF;

struct Params {
  const float* in[22];
  float* out;
  unsigned char* ws;
  int ph_lo, ph_hi, coop, pad;
};

__device__ __forceinline__ u16 f2bf(float f) {
  unsigned u = __float_as_uint(f);
  u += 0x7fffu + ((u >> 16) & 1u);
  return (u16)(u >> 16);
}
__device__ __forceinline__ float bf2f(u16 h) { return __uint_as_float(((unsigned)h) << 16); }
__device__ __forceinline__ unsigned pack2(float a, float b) { return (unsigned)f2bf(a) | ((unsigned)f2bf(b) << 16); }
__device__ __forceinline__ float sigmoidf_(float x) { return 1.f / (1.f + __expf(-x)); }
__device__ __forceinline__ float siluf_(float x) { return x / (1.f + __expf(-x)); }

__device__ __forceinline__ int tidx(int wv) { int l; asm volatile("v_mbcnt_lo_u32_b32 %0, -1, 0\n\tv_mbcnt_hi_u32_b32 %0, -1, %0" : "=v"(l)); return wv * 64 + l; }

__device__ __forceinline__ void convert_w(int wv, const float* __restrict__ src, u16* __restrict__ dst, int K, int N, int Npad, u16* tile, const float* __restrict__ kscale = nullptr, int upperm = 0) {
  const int tix = tidx(wv);
  constexpr int TS = 262;
  const int tn = (Npad + 255) / 256, tk = K / 64, nt = tn * tk, tid = tix;
  for (int t = blockIdx.x; t < nt; t += gridDim.x) {
    const int n0 = (t % tn) * 256, k0 = (t / tn) * 64;
    float4 v[8];
#pragma unroll
    for (int i = 0; i < 8; ++i) {
      const int idx = tid + i * 512, kk = idx >> 6, n = n0 + (idx & 63) * 4;
      v[i] = make_float4(0.f, 0.f, 0.f, 0.f);
      if (n < N) v[i] = *(const float4*)(src + (size_t)(k0 + kk) * N + n);
      if (kscale) { const float sc = kscale[k0 + kk]; v[i].x *= sc; v[i].y *= sc; v[i].z *= sc; v[i].w *= sc; }
    }
    __syncthreads();
#pragma unroll
    for (int i = 0; i < 8; ++i) {
      const int idx = tid + i * 512, kk = idx >> 6, nl = (idx & 63) * 4;
      *(unsigned*)(tile + kk * TS + nl) = pack2(v[i].x, v[i].y);
      *(unsigned*)(tile + kk * TS + nl + 2) = pack2(v[i].z, v[i].w);
    }
    __syncthreads();
#pragma unroll
    for (int i = 0; i < 4; ++i) {
      const int item = tid + i * 512, ks = item & 7, n = item >> 3;
      if (n0 + n < Npad) {
        const u16* tp = tile + (ks * 8) * TS + n;
        uint4 o;
        o.x = (unsigned)tp[0] | ((unsigned)tp[TS] << 16);
        o.y = (unsigned)tp[2 * TS] | ((unsigned)tp[3 * TS] << 16);
        o.z = (unsigned)tp[4 * TS] | ((unsigned)tp[5 * TS] << 16);
        o.w = (unsigned)tp[6 * TS] | ((unsigned)tp[7 * TS] << 16);
        int nr = n0 + n;
        if (upperm) nr = (nr < DFF) ? ((nr >> 7) * 256 + (nr & 127)) : ((((nr - DFF) >> 7) * 256) + 128 + ((nr - DFF) & 127));
        *(uint4*)(dst + (size_t)nr * K + k0 + ks * 8) = o;
      }
    }
  }
}

template <int MODE>
__device__ __forceinline__ void rmsnorm_phase(int wv, const Params& p, const float* __restrict__ w) {
  const int tix = tidx(wv);
  const int lane = tix & 63, gw = blockIdx.x * 8 + (tix >> 6), nw = gridDim.x * 8;
  const float* h = (const float*)(p.ws + OFF_H);
  u16* hn = (u16*)(p.ws + OFF_HN);
#define RMS_LOAD(dst, row_) do { const int r_ = (row_); const float* src_; \
    if (MODE == 0) src_ = (r_ < MP) ? p.in[0] + (size_t)r_ * D : p.in[1] + (size_t)(r_ - MP) * D; \
    else src_ = h + (size_t)r_ * D; \
    _Pragma("unroll") for (int i = 0; i < 8; ++i) dst[i] = *(const f32x4*)(src_ + (i * 64 + lane) * 4); } while (0)
  f32x4 v[8];
  if (gw < MT) RMS_LOAD(v, gw);
#pragma unroll 1
  for (int row = gw; row < MT; row += nw) {
    f32x4 nx[8];
    if (row + nw < MT) RMS_LOAD(nx, row + nw);
    else {
#pragma unroll
      for (int i = 0; i < 8; ++i) nx[i] = v[i];
    }
    __builtin_amdgcn_sched_barrier(0);
    float ss = 0.f;
#pragma unroll
    for (int i = 0; i < 8; ++i) ss += v[i][0] * v[i][0] + v[i][1] * v[i][1] + v[i][2] * v[i][2] + v[i][3] * v[i][3];
#pragma unroll
    for (int o = 32; o > 0; o >>= 1) ss += __shfl_xor(ss, o, 64);
    const float rs = rsqrtf(ss * (1.f / D) + EPS);
#pragma unroll
    for (int i = 0; i < 8; ++i) {
      const int col = (i * 64 + lane) * 4;
      const float4 wv4 = *(const float4*)(w + col);
      const float4 y = make_float4(v[i][0] * rs * wv4.x, v[i][1] * rs * wv4.y, v[i][2] * rs * wv4.z, v[i][3] * rs * wv4.w);
      if (MODE == 2) {
        float* dst = (row < MP) ? p.out + O_YP + (size_t)row * D : p.out + O_YS + (size_t)(row - MP) * D;
        *(float4*)(dst + col) = y;
      } else {
        *(uint2*)(hn + (size_t)row * D + col) = make_uint2(pack2(y.x, y.y), pack2(y.z, y.w));
      }
    }
#pragma unroll
    for (int i = 0; i < 8; ++i) v[i] = nx[i];
  }
#undef RMS_LOAD
}

__device__ __forceinline__ void ld8(const u16* p, float* f) {
  uint4 v = *(const uint4*)p;
  f[0] = __uint_as_float(v.x << 16); f[1] = __uint_as_float(v.x & 0xffff0000u);
  f[2] = __uint_as_float(v.y << 16); f[3] = __uint_as_float(v.y & 0xffff0000u);
  f[4] = __uint_as_float(v.z << 16); f[5] = __uint_as_float(v.z & 0xffff0000u);
  f[6] = __uint_as_float(v.w << 16); f[7] = __uint_as_float(v.w & 0xffff0000u);
}
__device__ __forceinline__ void st8(u16* p, const float* f) {
  *(uint4*)p = make_uint4(pack2(f[0], f[1]), pack2(f[2], f[3]), pack2(f[4], f[5]), pack2(f[6], f[7]));
}

constexpr int BM = 256, BK = 64, HALF = 128, NXCD = 8, WGM = 8, HT = HALF * BK;

__device__ __forceinline__ int lds_byte(int r, int c) {
  int st = (r >> 4) * 2 + (c >> 5), rr = r & 15, cc = c & 31, ob = rr * 64 + cc * 2;
  return st * 1024 + (ob ^ (((ob >> 9) & 1) << 5));
}
__device__ __forceinline__ void stage_rc(int b, int& R, int& C) {
  int st = b / 1024, sb = b % 1024, swz = sb ^ (((sb >> 9) & 1) << 5);
  R = (st >> 1) * 16 + swz / 64; C = (st & 1) * 32 + (swz % 64) / 2;
}

__device__ __forceinline__ void tile_coords(int wgid, int nM, int nN, int& pm, int& pn) {
  const int nwg = nM * nN;
  { int q = nwg / NXCD, r = nwg % NXCD, xcd = wgid % NXCD, off = wgid / NXCD;
    wgid = (xcd < r ? xcd * (q + 1) : r * (q + 1) + (xcd - r) * q) + off; }
  const int nig = WGM * nN, gid = wgid / nig, fm = gid * WGM, gsz = min(nM - fm, WGM);
  pm = fm + ((wgid % nig) % gsz); pn = (wgid % nig) / gsz;
}

struct EpiStoreBf16 {
  static constexpr bool GATE = false;
  static constexpr bool LDSST = true;
  u16* out; int ldo; const float* rss;
  __device__ __forceinline__ float row_scale(int row) const { return rss ? rsqrtf(rss[row] * (1.f / D) + EPS) : 1.f; }
  __device__ __forceinline__ float operator()(int row, int col, f32x4 v, float sc) const {
    uint2 pk = make_uint2(pack2(v[0] * sc, v[1] * sc), pack2(v[2] * sc, v[3] * sc));
    *(uint2*)(out + (size_t)row * ldo + col) = pk;
    return 0.f;
  }
  __device__ __forceinline__ void row_end(int, float, int) const {}
};
struct EpiAccum {
  static constexpr bool GATE = false;
  static constexpr bool LDSST = false;
  u16* hb; float* rss; const float* rin32;
  __device__ __forceinline__ float row_scale(int) const { return 1.f; }
  __device__ __forceinline__ float operator()(int row, int col, f32x4 v, float) const {
    u16* q = hb + (size_t)row * D + col;
    float4 o;
    if (rin32) o = *(const float4*)(rin32 + (size_t)row * D + col);
    else { const uint2 r = *(const uint2*)q; o = make_float4(__uint_as_float(r.x << 16), __uint_as_float(r.x & 0xffff0000u), __uint_as_float(r.y << 16), __uint_as_float(r.y & 0xffff0000u)); }
    o.x += v[0]; o.y += v[1]; o.z += v[2]; o.w += v[3];
    *(uint2*)q = make_uint2(pack2(o.x, o.y), pack2(o.z, o.w));
    return rss ? o.x * o.x + o.y * o.y + o.z * o.z + o.w * o.w : 0.f;
  }
  __device__ __forceinline__ void row_end(int row, float ss, int fq) const {
    if (rss) {
      ss += __shfl_xor(ss, 16, 64);
      ss += __shfl_xor(ss, 32, 64);
      if (fq == 0) unsafeAtomicAdd(rss + row, ss);
    }
  }
};

struct EpiGate {
  static constexpr bool GATE = true;
  static constexpr bool LDSST = false;
  const __attribute__((address_space(4))) void* kp; int layer; int rssoff;
  __device__ __forceinline__ float row_scale(int) const { return 1.f; }
  __device__ __forceinline__ float operator()(int, int, f32x4, float) const { return 0.f; }
  __device__ __forceinline__ void row_end(int, float, int) const {}
};

template <int M, int N, int K, int TAIL, class Epi>
__device__ __forceinline__ void gemm_phase(int wv, const u16* __restrict__ A, const u16* __restrict__ Bt, Epi epi, u16* shm) {
  const int tix = tidx(wv);
#define SA(b, h) (shm + ((b) * 2 + (h)) * HT)
#define SB(b, h) (shm + (4 + (b) * 2 + (h)) * HT)
#define STAGE(P, BASE, br, kt) do { const u16* _gb = BASE + ((long)(br) * K + (long)(kt0 + (kt)) * BK); \
    for (int _i = 0; _i < 2; ++_i) { int _b = tix * 16 + _i * 8192; \
      __builtin_amdgcn_global_load_lds((const unsigned*)(_gb + toff[_i]), \
        (__attribute__((address_space(3))) unsigned*)((char*)(P) + _b), 16, 0, 0); } } while (0)
#define LDA(dst, b, h) for (int m = 0; m < 4; ++m) for (int k = 0; k < 2; ++k) \
    dst[m][k] = *reinterpret_cast<const bf16x8*>((char*)SA(b, h) + lds_byte(wr * 64 + m * 16 + fr, k * 32 + fq * 8))
#define LDB(dst, b, h) for (int n = 0; n < 2; ++n) for (int k = 0; k < 2; ++k) \
    dst[n][k] = *reinterpret_cast<const bf16x8*>((char*)SB(b, h) + lds_byte(wc * 32 + n * 16 + fr, k * 32 + fq * 8))
#define MMA(ai, bj, At_, Bt_) do { __builtin_amdgcn_s_setprio(1); \
    for (int m = 0; m < 4; ++m) for (int n = 0; n < 2; ++n) for (int k = 0; k < 2; ++k) \
      acc[ai][bj][m][n] = __builtin_amdgcn_mfma_f32_16x16x32_bf16(Bt_[n][k], At_[m][k], acc[ai][bj][m][n], 0, 0, 0); \
    __builtin_amdgcn_s_setprio(0); } while (0)
#define WAIT_V(n) asm volatile("s_waitcnt vmcnt(" #n ")" ::: "memory")
#define WAIT_L(n) asm volatile("s_waitcnt lgkmcnt(" #n ")" ::: "memory")
#define BAR __builtin_amdgcn_s_barrier()
#define SCHED __builtin_amdgcn_sched_barrier(0)
  const int nM = M / BM, nN = N / BM, nwg = nM * nN, G = gridDim.x;
  const int nunits = nwg;
  const int wid = tix >> 6, lane = tix & 63, wr = wid >> 2, wc = wid & 3, fr = lane & 15, fq = lane >> 4;
  const int nt_total = K / BK;
  unsigned toff[2];
  for (int _i = 0; _i < 2; ++_i) { int _b = tix * 16 + _i * 8192; int _r, _c; stage_rc(_b, _r, _c); toff[_i] = (unsigned)(_r * K + _c); }
  for (int vw = blockIdx.x; vw < nunits; vw += G) {
    int pm, pn;
    tile_coords(vw, nM, nN, pm, pn);
    const int brow = pm * BM, bcol = pn * BM;
    constexpr int kt0 = 0, nt = nt_total;
    f32x4 acc[2][2][4][2];
    for (int a = 0; a < 2; ++a) for (int b = 0; b < 2; ++b) for (int m = 0; m < 4; ++m) for (int n = 0; n < 2; ++n) acc[a][b][m][n] = f32x4{0.f, 0.f, 0.f, 0.f};
    bf16x8 At[4][2], B0[2][2], B1[2][2];
    STAGE(SB(0, 0), Bt, bcol, 0); STAGE(SA(0, 0), A, brow, 0);
    STAGE(SB(0, 1), Bt, bcol + HALF, 0); STAGE(SA(0, 1), A, brow + HALF, 0);
    if (wr == 1) BAR;
    WAIT_V(4); BAR;
    STAGE(SB(1, 0), Bt, bcol, 1); STAGE(SA(1, 0), A, brow, 1); STAGE(SB(1, 1), Bt, bcol + HALF, 1);
    WAIT_V(6); BAR;
    for (int t = 0; t < nt - 2; t += 2) {
      LDB(B0, 0, 0); SCHED; LDA(At, 0, 0); STAGE(SA(1, 1), A, brow + HALF, t + 1);
      WAIT_L(8); BAR; WAIT_L(0); MMA(0, 0, At, B0); BAR; SCHED;
      LDB(B1, 0, 1); STAGE(SB(0, 0), Bt, bcol, t + 2);
      BAR; WAIT_L(0); MMA(0, 1, At, B1); BAR;
      LDA(At, 0, 1); STAGE(SA(0, 0), A, brow, t + 2);
      BAR; WAIT_L(0); MMA(1, 0, At, B0); BAR; SCHED;
      STAGE(SB(0, 1), Bt, bcol + HALF, t + 2);
      WAIT_V(6); BAR; MMA(1, 1, At, B1); BAR;
      LDB(B0, 1, 0); SCHED; LDA(At, 1, 0); STAGE(SA(0, 1), A, brow + HALF, t + 2);
      WAIT_L(8); BAR; WAIT_L(0); MMA(0, 0, At, B0); BAR; SCHED;
      LDB(B1, 1, 1); STAGE(SB(1, 0), Bt, bcol, t + 3);
      BAR; WAIT_L(0); MMA(0, 1, At, B1); BAR;
      LDA(At, 1, 1); STAGE(SA(1, 0), A, brow, t + 3);
      BAR; WAIT_L(0); MMA(1, 0, At, B0); BAR; SCHED;
      STAGE(SB(1, 1), Bt, bcol + HALF, t + 3);
      WAIT_V(6); BAR; MMA(1, 1, At, B1); BAR;
    }
    { LDB(B0, 0, 0); LDA(At, 0, 0); STAGE(SA(1, 1), A, brow + HALF, nt - 1);
      BAR; WAIT_L(0); MMA(0, 0, At, B0); BAR;
      LDB(B1, 0, 1); BAR; WAIT_L(0); MMA(0, 1, At, B1); BAR;
      LDA(At, 0, 1); WAIT_V(4); BAR; WAIT_L(0); MMA(1, 0, At, B0); MMA(1, 1, At, B1); BAR; }
    { LDB(B0, 1, 0); LDA(At, 1, 0); WAIT_V(2); BAR; WAIT_L(0); MMA(0, 0, At, B0); BAR;
      LDB(B1, 1, 1); WAIT_V(0); BAR; WAIT_L(0); MMA(0, 1, At, B1); BAR;
      LDA(At, 1, 1); BAR; WAIT_L(0); MMA(1, 0, At, B0); MMA(1, 1, At, B1); BAR; }
    if (wr == 0) BAR;
    if constexpr (Epi::GATE) {
      constexpr int LS = 136;
      u16* La = shm;
      u16* Lu = shm + 256 * LS;
      const __attribute__((address_space(4))) Params* gkp = (const __attribute__((address_space(4))) Params*)epi.kp;
      asm volatile("" : "+s"(gkp));
      int e_pm = pm, e_pn = pn, e_tix = tix;
      asm volatile("" : "+s"(e_pm), "+s"(e_pn));
      asm volatile("" : "+v"(e_tix));
      const int e_brow = e_pm * BM;
      {
        const int e_lane = e_tix & 63, e_wid = e_tix >> 6, e_wr = e_wid >> 2, e_wc = e_wid & 3, e_fr = e_lane & 15, e_fq = e_lane >> 4;
        const float* rss = (const float*)(gkp->ws + OFF_RSS) + epi.rssoff;
        _Pragma("unroll") for (int ai = 0; ai < 2; ++ai) _Pragma("unroll") for (int m = 0; m < 4; ++m) {
          const int rl = ai * HALF + e_wr * 64 + m * 16 + e_fr;
          const float sc = rsqrtf(rss[e_brow + rl] * (1.f / D) + EPS);
          _Pragma("unroll") for (int n = 0; n < 2; ++n) {
            const f32x4 a = acc[ai][0][m][n], uu = acc[ai][1][m][n];
            const int lo = rl * LS + e_wc * 32 + n * 16 + e_fq * 4;
            *(uint2*)(La + lo) = make_uint2(pack2(a[0] * sc, a[1] * sc), pack2(a[2] * sc, a[3] * sc));
            *(uint2*)(Lu + lo) = make_uint2(pack2(uu[0] * sc, uu[1] * sc), pack2(uu[2] * sc, uu[3] * sc));
          }
        }
      }
      WAIT_L(0); BAR; asm volatile("" ::: "memory");
      {
        const bool samp = e_brow >= MP;
        const int layer = epi.layer;
        u16* gg = (u16*)(gkp->ws + OFF_R);
        u16* side = (u16*)(gkp->ws + OFF_SIDE);
        const float* cw = gkp->in[19] + (size_t)layer * 3 * DFF;
        const float* cb = gkp->in[20] + (size_t)layer * DFF;
        const float* cache = gkp->in[5] + (size_t)layer * 8 * 2 * DFF;
        float* cvo = gkp->out + (samp ? O_CVS + (size_t)layer * 8 * 2 * DFF : O_CVP + (size_t)layer * 4 * 2 * DFF);
        const int cg = e_tix & 15, r0 = e_tix >> 4, c = e_pn * 128 + cg * 8;
        float w0[8], w1[8], w2[8], bb[8];
        _Pragma("unroll") for (int e = 0; e < 8; ++e) { w0[e] = cw[c + e]; w1[e] = cw[DFF + c + e]; w2[e] = cw[2 * DFF + c + e]; bb[e] = cb[c + e]; }
        _Pragma("unroll 1") for (int it = 0; it < 8; ++it) {
          const int rl = it * 32 + r0;
          const int t = samp ? (rl & 63) : ((e_pm & 7) * 256 + rl);
          const int sb = (e_pm - 32) * 4 + (rl >> 6);
          float a[8], uu[8], am1[8], am2[8], y[8];
          ld8(La + rl * LS + cg * 8, a);
          ld8(Lu + rl * LS + cg * 8, uu);
          _Pragma("unroll") for (int e = 0; e < 8; ++e) { am1[e] = 0.f; am2[e] = 0.f; }
          if (t >= 1 && rl >= 1) ld8(La + (rl - 1) * LS + cg * 8, am1);
          if (t >= 2 && rl >= 2) ld8(La + (rl - 2) * LS + cg * 8, am2);
          if (samp && t < 2) {
            const float* c1 = cache + (size_t)(sb * 2 + 1) * DFF + c;
            if (t == 0) {
              const float* c0 = cache + (size_t)(sb * 2 + 0) * DFF + c;
              _Pragma("unroll") for (int e = 0; e < 8; ++e) { am2[e] = c0[e]; am1[e] = c1[e]; }
            } else {
              _Pragma("unroll") for (int e = 0; e < 8; ++e) am2[e] = c1[e];
            }
          }
          if (!(t >= 2 && rl < 2)) {
            _Pragma("unroll") for (int e = 0; e < 8; ++e) { float cv = bb[e] + w0[e] * am2[e] + w1[e] * am1[e] + w2[e] * a[e]; y[e] = siluf_(cv) * uu[e]; }
            st8(gg + (size_t)(e_brow + rl) * DFF + c, y);
          } else {
            st8(side + (size_t)(e_pm * 2 + rl) * DFF + c, a);
            st8(side + SZ_SIDE1 / 2 + (size_t)(e_pm * 2 + rl) * DFF + c, uu);
          }
          if (rl >= 254) st8(side + SZ_SIDE1 + (size_t)(e_pm * 2 + rl - 254) * DFF + c, a);
          int crow = -1;
          if (!samp) { if ((e_pm & 7) == 7 && rl >= 254) crow = (e_pm >> 3) * 2 + rl - 254; }
          else { if ((rl & 63) >= 62) crow = sb * 2 + (rl & 63) - 62; }
          if (crow >= 0) {
            float* dst = cvo + (size_t)crow * DFF + c;
            *(float4*)dst = make_float4(a[0], a[1], a[2], a[3]);
            *(float4*)(dst + 4) = make_float4(a[4], a[5], a[6], a[7]);
          }
        }
      }
      WAIT_L(0); BAR; asm volatile("" ::: "memory");
    } else if constexpr (Epi::LDSST) {
      constexpr int LS = 136;
      u16* L0 = shm;
      u16* L1 = shm + 256 * LS;
      int e_brow = brow, e_bcol = bcol, e_tix = tix;
      asm volatile("" : "+s"(e_brow), "+s"(e_bcol));
      asm volatile("" : "+v"(e_tix));
      {
        const int e_lane = e_tix & 63, e_wid = e_tix >> 6, e_wr = e_wid >> 2, e_wc = e_wid & 3, e_fr = e_lane & 15, e_fq = e_lane >> 4;
        _Pragma("unroll") for (int ai = 0; ai < 2; ++ai) _Pragma("unroll") for (int m = 0; m < 4; ++m) {
          const int rl = ai * HALF + e_wr * 64 + m * 16 + e_fr;
          const float sc = epi.row_scale(e_brow + rl);
          _Pragma("unroll") for (int n = 0; n < 2; ++n) {
            const f32x4 c0 = acc[ai][0][m][n], c1 = acc[ai][1][m][n];
            const int lo = rl * LS + e_wc * 32 + n * 16 + e_fq * 4;
            *(uint2*)(L0 + lo) = make_uint2(pack2(c0[0] * sc, c0[1] * sc), pack2(c0[2] * sc, c0[3] * sc));
            *(uint2*)(L1 + lo) = make_uint2(pack2(c1[0] * sc, c1[1] * sc), pack2(c1[2] * sc, c1[3] * sc));
          }
        }
      }
      WAIT_L(0); BAR; asm volatile("" ::: "memory");
      {
        const int cg = e_tix & 15, r0 = e_tix >> 4;
        _Pragma("unroll 1") for (int it = 0; it < 8; ++it) {
          const int rl = it * 32 + r0;
          const uint4 x0 = *(const uint4*)(L0 + rl * LS + cg * 8), x1 = *(const uint4*)(L1 + rl * LS + cg * 8);
          u16* dst = epi.out + (size_t)(e_brow + rl) * epi.ldo + e_bcol + cg * 8;
          *(uint4*)dst = x0;
          *(uint4*)(dst + 128) = x1;
        }
      }
      WAIT_L(0); BAR; asm volatile("" ::: "memory");
    } else {
    for (int ai = 0; ai < 2; ++ai) for (int m = 0; m < 4; ++m) {
      const int row = brow + ai * HALF + wr * 64 + m * 16 + fr;
      const float sc = epi.row_scale(row);
      float ss = 0.f;
      for (int bj = 0; bj < 2; ++bj) for (int n = 0; n < 2; ++n)
        ss += epi(row, bcol + bj * HALF + wc * 32 + n * 16 + fq * 4, acc[ai][bj][m][n], sc);
      epi.row_end(row, ss, fq);
      if (m & 1) asm volatile("" ::: "memory");
    }
    }
  }
#undef SA
#undef SB
#undef STAGE
#undef LDA
#undef LDB
#undef MMA
}


template <int K>
__device__ __forceinline__ void gemm_tail_phase(int wv, const u16* __restrict__ A, const u16* __restrict__ Bt, float* lds, u16* __restrict__ hb, float* __restrict__ rss, const float* __restrict__ rin32_tail) {
  const int tix = tidx(wv);
  const int tid = tix, w = tid >> 6, lane = tid & 63, fr = lane & 15, fq = lane >> 4;
  for (int u = blockIdx.x; u < 256; u += gridDim.x) {
    const int tm = u >> 5, tn = u & 31;
    const u16* Ab = A + (size_t)(MP + tm * 64 + fr) * K + fq * 8;
    const u16* Bb = Bt + (size_t)(tn * 64 + fr) * K + fq * 8;
    f32x4 acc[4][4];
#pragma unroll
    for (int i = 0; i < 4; ++i)
#pragma unroll
      for (int j = 0; j < 4; ++j) acc[i][j] = f32x4{0.f, 0.f, 0.f, 0.f};
    const u16* Ab2 = A + (size_t)(MP + tm * 64 + fr) * K + fq * 16;
    const u16* Bb2 = Bt + (size_t)(tn * 64 + fr) * K + fq * 16;
#pragma unroll 1
    for (int ks = w; ks < K / 64; ks += 8) {
      bf16x8 a[4][2], b[4][2];
#pragma unroll
      for (int i = 0; i < 4; ++i) {
        a[i][0] = *(const bf16x8*)(Ab2 + (size_t)i * 16 * K + ks * 64);
        a[i][1] = *(const bf16x8*)(Ab2 + (size_t)i * 16 * K + ks * 64 + 8);
        b[i][0] = *(const bf16x8*)(Bb2 + (size_t)i * 16 * K + ks * 64);
        b[i][1] = *(const bf16x8*)(Bb2 + (size_t)i * 16 * K + ks * 64 + 8);
      }
#pragma unroll
      for (int mb = 0; mb < 4; ++mb)
#pragma unroll
        for (int nb = 0; nb < 4; ++nb) {
          acc[mb][nb] = __builtin_amdgcn_mfma_f32_16x16x32_bf16(b[nb][0], a[mb][0], acc[mb][nb], 0, 0, 0);
          acc[mb][nb] = __builtin_amdgcn_mfma_f32_16x16x32_bf16(b[nb][1], a[mb][1], acc[mb][nb], 0, 0, 0);
        }
    }
    __syncthreads();
#pragma unroll
    for (int mb = 0; mb < 4; ++mb)
#pragma unroll
      for (int nb = 0; nb < 4; ++nb) *(f32x4*)(lds + w * 4096 + (mb * 16 + fr) * 64 + nb * 16 + fq * 4) = acc[mb][nb];
    __syncthreads();
    const int e = tid * 8, row = e >> 6, col = e & 63;
    float4 s0 = make_float4(0.f, 0.f, 0.f, 0.f), s1 = s0;
#pragma unroll
    for (int ww = 0; ww < 8; ++ww) {
      float4 x0 = *(const float4*)(lds + ww * 4096 + e), x1 = *(const float4*)(lds + ww * 4096 + e + 4);
      s0.x += x0.x; s0.y += x0.y; s0.z += x0.z; s0.w += x0.w;
      s1.x += x1.x; s1.y += x1.y; s1.z += x1.z; s1.w += x1.w;
    }
    const int grow = MP + tm * 64 + row;
    u16* q = hb + (size_t)grow * D + tn * 64 + col;
    float r8[8];
    if (rin32_tail) {
      const float* rq_ = rin32_tail + (size_t)(tm * 64 + row) * D + tn * 64 + col;
      const float4 a0 = *(const float4*)rq_, a1 = *(const float4*)(rq_ + 4);
      r8[0] = a0.x; r8[1] = a0.y; r8[2] = a0.z; r8[3] = a0.w; r8[4] = a1.x; r8[5] = a1.y; r8[6] = a1.z; r8[7] = a1.w;
    } else ld8(q, r8);
    r8[0] += s0.x; r8[1] += s0.y; r8[2] += s0.z; r8[3] += s0.w; r8[4] += s1.x; r8[5] += s1.y; r8[6] += s1.z; r8[7] += s1.w;
    st8(q, r8);
    if (rss) {
      float ss = 0.f;
#pragma unroll
      for (int e2 = 0; e2 < 8; ++e2) ss += r8[e2] * r8[e2];
      ss += __shfl_xor(ss, 1, 64); ss += __shfl_xor(ss, 2, 64); ss += __shfl_xor(ss, 4, 64);
      if ((tid & 7) == 0) unsafeAtomicAdd(rss + grow, ss);
    }
  }
}

template <int MODE>
__device__ __forceinline__ void prep_range(int wv, const Params& p, int u0, int u1, int ustride, unsigned char* shm) {
  const int tix = tidx(wv);
  constexpr int K = (MODE == 2) ? 256 : 128;
  constexpr int V = (MODE == 0) ? 256 : (MODE == 1 ? 128 : 512);
  constexpr int H = (MODE == 1) ? 8 : 4;
  constexpr int LD = (MODE == 2) ? NINO_PAD : NINE;
  constexpr int NSEG = 4, TL = 16, KS = K + 8, VS = V + 8, NPASS = K / 128;
  constexpr int NQ = K / 64, NV = V / 64;
  constexpr bool PFV = false;
  const int tid = tix, seg = tid >> 7;
  const u16* proj = (const u16*)(p.ws + OFF_BIG);
  unsigned char* R = p.ws + OFF_R;
  u16* qin = (u16*)(R + (MODE == 0 ? R_QA : MODE == 1 ? R_QB : R_QC));
  u16* koT = (u16*)(R + (MODE == 0 ? R_KA : MODE == 1 ? R_KB : R_KC));
  u16* vT = (u16*)(R + (MODE == 0 ? R_VA : MODE == 1 ? R_VB : R_VC));
  u16* Pm = (u16*)(R + (MODE == 0 ? R_PA : MODE == 1 ? R_PB : R_PC));
  float* dL = (float*)(R + (MODE == 0 ? R_DA : MODE == 1 ? R_DB : R_DC));
  u16* qs = (u16*)shm;
  u16* ksm = qs + 64 * KS;
  float* segtot = (float*)(ksm + 64 * KS);
  float* gl = segtot + NSEG * K;
  u16* rq = (u16*)(gl + 64 * 16);
  u16* rk = rq + 64 * KS;
  u16* rv = PFV ? rk + 64 * KS : rq;
  typedef __attribute__((ext_vector_type(4))) unsigned u32x4_t;
  u32x4_t rqr[NQ], rkr[NQ], rvr[PFV ? NV : 1];
#define PREP_ISSUE(uu_) do { \
    const int c_i = (uu_) / H, h_i = (uu_) % H; \
    const int row0_i = (c_i < 128) ? (c_i >> 5) * 2048 + (c_i & 31) * 64 : MP + (c_i - 128) * 64; \
    const u16* prow_i = proj + (size_t)row0_i * LD; \
    const int cq_i = (MODE == 0) ? h_i * 128 : (MODE == 1 ? 3072 + h_i * 128 : h_i * 256); \
    const int ck_i = (MODE == 0) ? 512 + h_i * 128 : (MODE == 1 ? 4096 + h_i * 128 : 1024 + h_i * 256); \
    const int vc_i = (MODE == 0) ? 1024 + h_i * 256 : (MODE == 1 ? 5120 + h_i * 128 : 2048 + h_i * 512); \
    _Pragma("unroll") for (int i = 0; i < NQ; ++i) { \
      const int idx = tid + i * 512, r = idx / (K / 8), cc = idx % (K / 8); \
      rqr[i] = *(const u32x4_t*)(prow_i + (size_t)r * LD + cq_i + cc * 8); \
      rkr[i] = *(const u32x4_t*)(prow_i + (size_t)r * LD + ck_i + cc * 8); \
    } \
    if constexpr (PFV) { \
      _Pragma("unroll") for (int i = 0; i < NV; ++i) { \
        const int idx = tid + i * 512, r = idx / (V / 8), cc = idx % (V / 8); \
        rvr[i] = *(const u32x4_t*)(prow_i + (size_t)r * LD + vc_i + cc * 8); \
      } \
    } } while (0)
  if (u0 < u1) PREP_ISSUE(u0);
#pragma unroll 1
  for (int uu = u0; uu < u1; uu += ustride) {
  const int c = uu / H, h = uu % H;
  int row0, pos0;
  if (c < 128) { row0 = (c >> 5) * 2048 + (c & 31) * 64; pos0 = (c & 31) * 64; }
  else { row0 = MP + (c - 128) * 64; pos0 = 1024; }
  const size_t u = (size_t)c * H + h;
  const u16* prow = proj + (size_t)row0 * LD;
  const int vc0 = (MODE == 0) ? 1024 + h * 256 : (MODE == 1 ? 5120 + h * 128 : 2048 + h * 512);
  __syncthreads();
#pragma unroll
  for (int i = 0; i < NQ; ++i) {
    const int idx = tid + i * 512, r = idx / (K / 8), cc = idx % (K / 8);
    *(u32x4_t*)(rq + r * KS + cc * 8) = rqr[i];
    *(u32x4_t*)(rk + r * KS + cc * 8) = rkr[i];
  }
  if constexpr (PFV) {
#pragma unroll
    for (int i = 0; i < NV; ++i) {
      const int idx = tid + i * 512, r = idx / (V / 8), cc = idx % (V / 8);
      *(u32x4_t*)(rv + r * VS + cc * 8) = rvr[i];
    }
  }
  if (MODE == 2) {
    for (int i = tid; i < 64 * 2; i += 512) {
      const int r = i >> 1, hh = i & 1;
      uint4 g4 = *(const uint4*)(prow + (size_t)r * LD + 6144 + hh * 8);
      float* d = gl + r * 16 + hh * 8;
      d[0] = __uint_as_float(g4.x << 16); d[1] = __uint_as_float(g4.x & 0xffff0000u);
      d[2] = __uint_as_float(g4.y << 16); d[3] = __uint_as_float(g4.y & 0xffff0000u);
      d[4] = __uint_as_float(g4.z << 16); d[5] = __uint_as_float(g4.z & 0xffff0000u);
      d[6] = __uint_as_float(g4.w << 16); d[7] = __uint_as_float(g4.w & 0xffff0000u);
    }
  }
  if (uu + ustride < u1) PREP_ISSUE(uu + ustride);
  __builtin_amdgcn_sched_barrier(0);
  __syncthreads();
#pragma unroll 1
  for (int pass = 0; pass < NPASS; ++pass) {
  const int kk = pass * 128 + (tid & 127);
  float qv[TL], kv[TL], bc[TL];
  if (MODE == 0) {
    const int j = kk & 63;
    const float invr = exp2f(-(float)j * (13.287712379549449f / 64.f)) * 0.15915494309189535f;
    const float lgam = log1pf(-exp2f(-5.f - (float)h));
#pragma unroll
    for (int i = 0; i < TL; ++i) {
      const int l = seg * TL + i;
      float rev = (float)(pos0 + l) * invr;
      rev -= floorf(rev);
      const float sn = __builtin_amdgcn_sinf(rev), cs = __builtin_amdgcn_cosf(rev);
      const float q1 = bf2f(rq[l * KS + j]), q2 = bf2f(rq[l * KS + j + 64]), k1 = bf2f(rk[l * KS + j]), k2 = bf2f(rk[l * KS + j + 64]);
      const float qr = (kk < 64) ? q1 * cs - q2 * sn : q1 * sn + q2 * cs;
      const float kr = (kk < 64) ? k1 * cs - k2 * sn : k1 * sn + k2 * cs;
      qv[i] = qr; kv[i] = kr * 0.08838834764831845f;
      bc[i] = lgam;
    }
  } else if (MODE == 1) {
    const int ch = h * 128 + kk;
    const float* lbp = p.in[11];
    float e0 = __expf(lbp[ch]), e1 = __expf(lbp[1024 + ch]), e2 = __expf(lbp[2048 + ch]);
    const float lb = e0 / (e0 + e1 + e2);
#pragma unroll
    for (int i = 0; i < TL; ++i) {
      const int l = seg * TL + i;
      const float qx = bf2f(rq[l * KS + kk]), fx = bf2f(rk[l * KS + kk]);
      qv[i] = siluf_(qx) * 0.08838834764831845f;
      const float sg = sigmoidf_(fx);
      const float f = lb + (1.f - lb) * sg;
      kv[i] = (1.f - lb) * (1.f - sg);
      bc[i] = __logf(f);
    }
  } else {
    const int ch = h * 256 + kk;
    const float* w2 = p.in[14];
    float wvv[16];
#pragma unroll
    for (int r = 0; r < 16; ++r) wvv[r] = w2[r * 1024 + ch];
    const float bias = p.in[15][ch];
#pragma unroll
    for (int i = 0; i < TL; ++i) {
      const int l = seg * TL + i;
      qv[i] = bf2f(rq[l * KS + kk]) * 0.0625f;
      kv[i] = bf2f(rk[l * KS + kk]);
      float x = bias;
#pragma unroll
      for (int r = 0; r < 16; ++r) x += gl[l * 16 + r] * wvv[r];
      const float ls = fminf(x, 0.f) - log1pf(__expf(-fabsf(x)));
      bc[i] = ls * (1.f / 16.f);
    }
  }
#pragma unroll
  for (int i = 1; i < TL; ++i) bc[i] += bc[i - 1];
  segtot[seg * K + kk] = bc[TL - 1];
  __syncthreads();
  float pre = 0.f, bL = 0.f;
#pragma unroll
  for (int sg = 0; sg < NSEG; ++sg) { float t = segtot[sg * K + kk]; bL += t; if (sg < seg) pre += t; }
  if (seg == 0) dL[u * K + kk] = __expf(bL);
  unsigned kop[TL / 2];
#pragma unroll
  for (int i = 0; i < TL; i += 2) {
    float ko2[2];
#pragma unroll
    for (int e = 0; e < 2; ++e) {
      const int l = seg * TL + i + e;
      const float b = bc[i + e] + pre;
      const float qi = qv[i + e] * __expf(b);
      const float ki = kv[i + e] * __expf(-b);
      ko2[e] = kv[i + e] * __expf(bL - b);
      const u16 qb = f2bf(qi);
      qs[l * KS + kk] = qb;
      ksm[l * KS + kk] = f2bf(ki);
    }
    kop[i / 2] = pack2(ko2[0], ko2[1]);
  }
  {
#pragma unroll
    for (int i = 0; i < TL / 8; ++i) {
      const int cc = seg * 2 + i;
      uint4* dst = (uint4*)(koT + u * K * 64 + ((((kk >> 4) * 2 + (cc >> 2)) * 64 + (cc & 3) * 16 + (kk & 15)) << 3));
      *dst = make_uint4(kop[i * 4 + 0], kop[i * 4 + 1], kop[i * 4 + 2], kop[i * 4 + 3]);
    }
  }
  }
  __syncthreads();
  for (int i = tid; i < 64 * (K / 8); i += 512) {
    const int r = i / (K / 8), cc = i % (K / 8);
    *(uint4*)(qin + u * 64 * K + ((((r >> 4) * (K / 32) + (cc >> 2)) * 64 + (cc & 3) * 16 + (r & 15)) << 3)) = *(const uint4*)(qs + r * KS + cc * 8);
  }
  {
    const int w = tid >> 6, lane = tid & 63, fr = lane & 15, fq = lane >> 4;
#pragma unroll 1
    for (int bi = 0; bi < 2; ++bi) {
      const int blk = w + bi * 8, lb = blk >> 2, sb = blk & 3;
      f32x4 acc = {0.f, 0.f, 0.f, 0.f};
      if (sb <= lb) {
#pragma unroll
        for (int kst = 0; kst < K / 32; ++kst) {
          bf16x8 a = *(const bf16x8*)(ksm + (sb * 16 + fr) * KS + kst * 32 + fq * 8);
          bf16x8 b = *(const bf16x8*)(qs + (lb * 16 + fr) * KS + kst * 32 + fq * 8);
          acc = __builtin_amdgcn_mfma_f32_16x16x32_bf16(a, b, acc, 0, 0, 0);
        }
      }
      const int l = lb * 16 + fr, s0 = sb * 16 + fq * 4;
      float v0 = (s0 + 0 <= l) ? acc[0] : 0.f, v1 = (s0 + 1 <= l) ? acc[1] : 0.f;
      float v2 = (s0 + 2 <= l) ? acc[2] : 0.f, v3 = (s0 + 3 <= l) ? acc[3] : 0.f;
      *(uint2*)(Pm + u * 4096 + ((((lb * 2 + (s0 >> 5)) * 64 + ((s0 & 31) >> 3) * 16 + fr) << 3) + (s0 & 7))) = make_uint2(pack2(v0, v1), pack2(v2, v3));
    }
  }
  }
}

template <int K, int V>
__device__ __forceinline__ void seq_unit(int wv, const u16* __restrict__ qin, const u16* __restrict__ koT, const u16* __restrict__ Pm, const u16* __restrict__ vsrc, int vld,
                         const float* __restrict__ dL, int H, int c0, int nch, int h, int vs,
                         const float* __restrict__ s0, float* __restrict__ sout, u16* __restrict__ o, int row0, int ocol, unsigned char* shm) {
  const int tix = tidx(wv);
  constexpr int NKB = K / 128, SST = K + 8;
  u16* ST = (u16*)shm;
  const int tid = tix, w = tid >> 6, lane = tid & 63, fr = lane & 15, fq = lane >> 4;
  f32x4 accS[NKB][2];
  __syncthreads();
#pragma unroll
  for (int kb = 0; kb < NKB; ++kb)
#pragma unroll
    for (int vb = 0; vb < 2; ++vb) {
      const int k = (w * NKB + kb) * 16 + fq * 4, vcol = vb * 16 + fr;
#pragma unroll
      for (int j = 0; j < 4; ++j) accS[kb][vb][j] = s0 ? s0[(size_t)(k + j) * V + vs * 32 + vcol] : 0.f;
      *(uint2*)(ST + vcol * SST + k) = make_uint2(pack2(accS[kb][vb][0], accS[kb][vb][1]), pack2(accS[kb][vb][2], accS[kb][vb][3]));
    }
  constexpr int VTS = 72;
  u16* VT = ST + 2 * 32 * SST;
  const int v_s = (tid >> 2) & 63, v_p = tid & 3;
  const u16* vrow = vsrc + (size_t)v_s * vld + v_p * 8;
  u32x4_t vreg = {0u, 0u, 0u, 0u};
  if (tid < 256) {
    vreg = *(const u32x4_t*)vrow;
#pragma unroll
    for (int j = 0; j < 4; ++j) {
      VT[(v_p * 8 + 2 * j) * VTS + v_s] = (u16)(vreg[j] & 0xffffu);
      VT[(v_p * 8 + 2 * j + 1) * VTS + v_s] = (u16)(vreg[j] >> 16);
    }
  }
  __syncthreads();
  int cur = 0;
  const int lb = w >> 1, ovb = w & 1;
  struct FragsO { bf16x8 op[2], oq[K / 32]; };
  struct FragsS { bf16x8 ka[NKB][2]; float4 d[NKB]; };
  auto load_o = [&](int ci, FragsO& f) {
    const size_t u = (size_t)(c0 + ci) * H + h;
    const u16* Pu = Pm + u * 4096;
    const u16* qu = qin + u * 64 * K;
#pragma unroll
    for (int ss = 0; ss < 2; ++ss) f.op[ss] = *(const bf16x8*)(Pu + (((lb * 2 + ss) * 64 + lane) << 3));
#pragma unroll
    for (int kst = 0; kst < K / 32; ++kst) f.oq[kst] = *(const bf16x8*)(qu + (((lb * (K / 32) + kst) * 64 + lane) << 3));
  };
  auto load_s = [&](int ci, FragsS& f) {
    const size_t u = (size_t)(c0 + ci) * H + h;
    const u16* ku = koT + u * K * 64;
    const float* du = dL + u * K;
#pragma unroll
    for (int kb = 0; kb < NKB; ++kb) {
      const int kbase = (w * NKB + kb) * 16;
      f.d[kb] = *(const float4*)(du + kbase + fq * 4);
      f.ka[kb][0] = *(const bf16x8*)(ku + ((((w * NKB + kb) * 2 + 0) * 64 + lane) << 3));
      f.ka[kb][1] = *(const bf16x8*)(ku + ((((w * NKB + kb) * 2 + 1) * 64 + lane) << 3));
    }
  };
  FragsO fo;
  FragsS f0;
  load_o(0, fo);
  load_s(0, f0);
  for (int ci = 0; ci < nch; ++ci) {
    const int cn = ci + 1 < nch ? ci + 1 : ci;
    FragsO fo1;
    FragsS f1;
    load_o(cn, fo1);
    load_s(cn, f1);
    if (tid < 256) vreg = *(const u32x4_t*)(vrow + (size_t)cn * 64 * vld);
    __builtin_amdgcn_sched_barrier(0);
    const u16* STc = ST + cur * 32 * SST;
    u16* STn = ST + (cur ^ 1) * 32 * SST;
    const u16* VTc = VT + cur * 32 * VTS;
    u16* VTn = VT + (cur ^ 1) * 32 * VTS;
    bf16x8 vf[2][2];
#pragma unroll
    for (int vb = 0; vb < 2; ++vb)
#pragma unroll
      for (int ss = 0; ss < 2; ++ss) vf[vb][ss] = *(const bf16x8*)(VTc + (vb * 16 + fr) * VTS + ss * 32 + fq * 8);
    f32x4 ao = {0.f, 0.f, 0.f, 0.f};
#pragma unroll
    for (int ss = 0; ss < 2; ++ss) {
      bf16x8 a = *(const bf16x8*)(VTc + (ovb * 16 + fr) * VTS + ss * 32 + fq * 8);
      ao = __builtin_amdgcn_mfma_f32_16x16x32_bf16(a, fo.op[ss], ao, 0, 0, 0);
    }
#pragma unroll
    for (int kst = 0; kst < K / 32; ++kst) {
      bf16x8 a = *(const bf16x8*)(STc + (ovb * 16 + fr) * SST + kst * 32 + fq * 8);
      ao = __builtin_amdgcn_mfma_f32_16x16x32_bf16(a, fo.oq[kst], ao, 0, 0, 0);
    }
    *(uint2*)(o + (size_t)(row0 + ci * 64 + lb * 16 + fr) * D + ocol + vs * 32 + ovb * 16 + fq * 4) =
        make_uint2(pack2(ao[0], ao[1]), pack2(ao[2], ao[3]));
#pragma unroll
    for (int kb = 0; kb < NKB; ++kb) {
      const int kbase = (w * NKB + kb) * 16;
      const float4 d4 = f0.d[kb];
#pragma unroll
      for (int vb = 0; vb < 2; ++vb) {
        f32x4 sv = accS[kb][vb];
        sv[0] *= d4.x; sv[1] *= d4.y; sv[2] *= d4.z; sv[3] *= d4.w;
        sv = __builtin_amdgcn_mfma_f32_16x16x32_bf16(f0.ka[kb][0], vf[vb][0], sv, 0, 0, 0);
        sv = __builtin_amdgcn_mfma_f32_16x16x32_bf16(f0.ka[kb][1], vf[vb][1], sv, 0, 0, 0);
        accS[kb][vb] = sv;
        *(uint2*)(STn + (vb * 16 + fr) * SST + kbase + fq * 4) = make_uint2(pack2(sv[0], sv[1]), pack2(sv[2], sv[3]));
      }
    }
    if (tid < 256) {
#pragma unroll
      for (int j = 0; j < 4; ++j) {
        VTn[(v_p * 8 + 2 * j) * VTS + v_s] = (u16)(vreg[j] & 0xffffu);
        VTn[(v_p * 8 + 2 * j + 1) * VTS + v_s] = (u16)(vreg[j] >> 16);
      }
    }
    asm volatile("s_waitcnt lgkmcnt(0)" ::: "memory");
    __builtin_amdgcn_s_barrier();
    asm volatile("" ::: "memory");
    cur ^= 1;
    f0 = f1;
    fo = fo1;
  }
#pragma unroll
  for (int kb = 0; kb < NKB; ++kb)
#pragma unroll
    for (int vb = 0; vb < 2; ++vb) {
      const int k = (w * NKB + kb) * 16 + fq * 4, vcol = vb * 16 + fr;
#pragma unroll
      for (int j = 0; j < 4; ++j) sout[(size_t)(k + j) * V + vs * 32 + vcol] = accS[kb][vb][j];
    }
}

__device__ __forceinline__ void seq_even_phase(int wv, const Params& p, unsigned char* shm) {
  unsigned char* R = p.ws + OFF_R;
  u16* o = (u16*)(p.ws + OFF_H);
  for (int u = blockIdx.x; u < 768; u += gridDim.x) {
    if (u < 256) {
      const int x = u & 7, y = u >> 3;
      if (y < 16) {
        const int g = x * 2 + (y >> 3), b = g >> 2, h = g & 3, vs = y & 7;
        seq_unit<128, 256>(wv, (u16*)(R + R_QA), (u16*)(R + R_KA), (u16*)(R + R_PA), (const u16*)(p.ws + OFF_BIG) + (size_t)(b * 2048) * NINE + 1024 + h * 256 + vs * 32, NINE, (float*)(R + R_DA), 4, b * 32, 32, h, vs,
                           nullptr, p.out + O_RETP + (size_t)(b * 4 + h) * 128 * 256, o, b * 2048, h * 256, shm);
      } else {
        const int yy = y - 16, g = x * 4 + (yy >> 2), b = g >> 3, h = g & 7, vs = yy & 3;
        seq_unit<128, 128>(wv, (u16*)(R + R_QB), (u16*)(R + R_KB), (u16*)(R + R_PB), (const u16*)(p.ws + OFF_BIG) + (size_t)(b * 2048) * NINE + 5120 + h * 128 + vs * 32, NINE, (float*)(R + R_DB), 8, b * 32, 32, h, vs,
                           nullptr, p.out + O_HGP + (size_t)(b * 8 + h) * 128 * 128, o, b * 2048, 1024 + h * 128, shm);
      }
    } else if (u < 512) {
      int x = u - 256, b = x >> 5, h = (x >> 3) & 3, vs = x & 7;
      seq_unit<128, 256>(wv, (u16*)(R + R_QA), (u16*)(R + R_KA), (u16*)(R + R_PA), (const u16*)(p.ws + OFF_BIG) + (size_t)(MP + b * 64) * NINE + 1024 + h * 256 + vs * 32, NINE, (float*)(R + R_DA), 4, 128 + b, 1, h, vs,
                         p.in[2] + (size_t)(b * 4 + h) * 128 * 256, p.out + O_RETS + (size_t)(b * 4 + h) * 128 * 256, o, MP + b * 64, h * 256, shm);
    } else {
      int x = u - 512, b = x >> 5, h = (x >> 2) & 7, vs = x & 3;
      seq_unit<128, 128>(wv, (u16*)(R + R_QB), (u16*)(R + R_KB), (u16*)(R + R_PB), (const u16*)(p.ws + OFF_BIG) + (size_t)(MP + b * 64) * NINE + 5120 + h * 128 + vs * 32, NINE, (float*)(R + R_DB), 8, 128 + b, 1, h, vs,
                         p.in[3] + (size_t)(b * 8 + h) * 128 * 128, p.out + O_HGS + (size_t)(b * 8 + h) * 128 * 128, o, MP + b * 64, 1024 + h * 128, shm);
    }
  }
}
__device__ __forceinline__ void seq_odd_phase(int wv, const Params& p, unsigned char* shm) {
  unsigned char* R = p.ws + OFF_R;
  u16* o = (u16*)(p.ws + OFF_H);
  for (int u = blockIdx.x; u < 768; u += gridDim.x) {
    if (u < 256) {
      const int x = u & 7, y = u >> 3, g = x * 2 + (y >> 4), b = g >> 2, h = g & 3, vs = y & 15;
      seq_unit<256, 512>(wv, (u16*)(R + R_QC), (u16*)(R + R_KC), (u16*)(R + R_PC), (const u16*)(p.ws + OFF_BIG) + (size_t)(b * 2048) * NINO_PAD + 2048 + h * 512 + vs * 32, NINO_PAD, (float*)(R + R_DC), 4, b * 32, 32, h, vs,
                         nullptr, p.out + O_GLP + (size_t)(b * 4 + h) * 256 * 512, o, b * 2048, h * 512, shm);
    } else {
      int x = u - 256, b = x >> 6, h = (x >> 4) & 3, vs = x & 15;
      seq_unit<256, 512>(wv, (u16*)(R + R_QC), (u16*)(R + R_KC), (u16*)(R + R_PC), (const u16*)(p.ws + OFF_BIG) + (size_t)(MP + b * 64) * NINO_PAD + 2048 + h * 512 + vs * 32, NINO_PAD, (float*)(R + R_DC), 4, 128 + b, 1, h, vs,
                         p.in[4] + (size_t)(b * 4 + h) * 256 * 512, p.out + O_GLS + (size_t)(b * 4 + h) * 256 * 512, o, MP + b * 64, h * 512, shm);
    }
  }
}

__device__ __forceinline__ void up8(u32x4_t v, float* f) {
  f[0] = __uint_as_float(v[0] << 16); f[1] = __uint_as_float(v[0] & 0xffff0000u);
  f[2] = __uint_as_float(v[1] << 16); f[3] = __uint_as_float(v[1] & 0xffff0000u);
  f[4] = __uint_as_float(v[2] << 16); f[5] = __uint_as_float(v[2] & 0xffff0000u);
  f[6] = __uint_as_float(v[3] << 16); f[7] = __uint_as_float(v[3] & 0xffff0000u);
}
template <int ODD>
__device__ __forceinline__ void post_phase(int wv, const Params& p) {
  const int tix = tidx(wv);
  const int lane = tix & 63, gw = blockIdx.x * 8 + (tix >> 6), nw = gridDim.x * 8;
  const u16* o = (const u16*)(p.ws + OFF_H);
  const u16* proj = (const u16*)(p.ws + OFF_BIG);
  u16* ao = (u16*)(p.ws + OFF_R);
#define POST_LOAD(xr_, gr_, row_) do { const int r_ = (row_); \
    _Pragma("unroll") for (int i = 0; i < 4; ++i) { const int col_ = i * 512 + lane * 8; \
      xr_[i] = *(const u32x4_t*)(o + (size_t)r_ * D + col_); \
      gr_[i] = *(const u32x4_t*)(proj + (size_t)r_ * (ODD ? NINO_PAD : NINE) + (ODD ? 4096 + col_ : (i < 2 ? 2048 + col_ : 6144 + (col_ - 1024)))); } } while (0)
  u32x4_t xr[4], gr[4];
  if (gw < MT) POST_LOAD(xr, gr, gw);
#pragma unroll 1
  for (int row = gw; row < MT; row += nw) {
    u32x4_t xn[4], gn4[4];
    if (row + nw < MT) POST_LOAD(xn, gn4, row + nw);
    else {
#pragma unroll
      for (int i = 0; i < 4; ++i) { xn[i] = xr[i]; gn4[i] = gr[i]; }
    }
    __builtin_amdgcn_sched_barrier(0);
#pragma unroll
    for (int i = 0; i < 4; ++i) {
      const int col = i * 512 + lane * 8;
      float x[8], g[8], y[8];
      up8(xr[i], x);
      up8(gr[i], g);
      if (ODD) {
        float ss = 0.f;
#pragma unroll
        for (int e = 0; e < 8; ++e) ss += x[e] * x[e];
#pragma unroll
        for (int off = 32; off > 0; off >>= 1) ss += __shfl_xor(ss, off, 64);
        const float rs = rsqrtf(ss * (1.f / 512.f) + EPS);
        const float* gn = p.in[16] + lane * 8;
#pragma unroll
        for (int e = 0; e < 8; ++e) y[e] = x[e] * rs * gn[e] * siluf_(g[e]);
      } else if (i < 2) {
        float s1 = 0.f;
#pragma unroll
        for (int e = 0; e < 8; ++e) s1 += x[e];
#pragma unroll
        for (int off = 16; off > 0; off >>= 1) s1 += __shfl_xor(s1, off, 64);
        const float mu = s1 * (1.f / 256.f);
        float s2 = 0.f;
#pragma unroll
        for (int e = 0; e < 8; ++e) { float dlt = x[e] - mu; s2 += dlt * dlt; }
#pragma unroll
        for (int off = 16; off > 0; off >>= 1) s2 += __shfl_xor(s2, off, 64);
        const float rs = rsqrtf(s2 * (1.f / 256.f) + EPS);
#pragma unroll
        for (int e = 0; e < 8; ++e) y[e] = (x[e] - mu) * rs * siluf_(g[e]);
      } else {
        float ss = 0.f;
#pragma unroll
        for (int e = 0; e < 8; ++e) ss += x[e] * x[e];
#pragma unroll
        for (int off = 8; off > 0; off >>= 1) ss += __shfl_xor(ss, off, 64);
        const float rs = rsqrtf(ss * (1.f / 128.f) + EPS);
        const float* gn = p.in[12] + (lane & 15) * 8;
#pragma unroll
        for (int e = 0; e < 8; ++e) y[e] = x[e] * rs * gn[e] * siluf_(g[e]);
      }
      st8(ao + (size_t)row * D + col, y);
    }
#pragma unroll
    for (int i = 0; i < 4; ++i) { xr[i] = xn[i]; gr[i] = gn4[i]; }
  }
#undef POST_LOAD
}


__device__ __forceinline__ void final_norm_phase(int wv, const Params& p) {
  const int tix = tidx(wv);
  const int lane = tix & 63, gw = blockIdx.x * 8 + (tix >> 6), nw = gridDim.x * 8;
  const u16* hb = (const u16*)(p.ws + OFF_HN);
  const float* w = p.in[8];
  u32x4_t v[4];
  if (gw < MT) {
#pragma unroll
    for (int i = 0; i < 4; ++i) v[i] = *(const u32x4_t*)(hb + (size_t)gw * D + i * 512 + lane * 8);
  }
#pragma unroll 1
  for (int row = gw; row < MT; row += nw) {
    u32x4_t nx[4];
    const int nrow = row + nw < MT ? row + nw : row;
#pragma unroll
    for (int i = 0; i < 4; ++i) nx[i] = *(const u32x4_t*)(hb + (size_t)nrow * D + i * 512 + lane * 8);
    __builtin_amdgcn_sched_barrier(0);
    float x[4][8];
    float ss = 0.f;
#pragma unroll
    for (int i = 0; i < 4; ++i) {
      up8(v[i], x[i]);
#pragma unroll
      for (int e = 0; e < 8; ++e) ss += x[i][e] * x[i][e];
    }
#pragma unroll
    for (int o = 32; o > 0; o >>= 1) ss += __shfl_xor(ss, o, 64);
    const float rs = rsqrtf(ss * (1.f / D) + EPS);
    float* dst = (row < MP) ? p.out + O_YP + (size_t)row * D : p.out + O_YS + (size_t)(row - MP) * D;
#pragma unroll
    for (int i = 0; i < 4; ++i) {
      const int col = i * 512 + lane * 8;
      const float4 w0 = *(const float4*)(w + col), w1 = *(const float4*)(w + col + 4);
      *(float4*)(dst + col) = make_float4(x[i][0] * rs * w0.x, x[i][1] * rs * w0.y, x[i][2] * rs * w0.z, x[i][3] * rs * w0.w);
      *(float4*)(dst + col + 4) = make_float4(x[i][4] * rs * w1.x, x[i][5] * rs * w1.y, x[i][6] * rs * w1.z, x[i][7] * rs * w1.w);
    }
#pragma unroll
    for (int i = 0; i < 4; ++i) v[i] = nx[i];
  }
}

__device__ __forceinline__ void gate_phase(int wv, const Params& p, int layer) {
  const int tix = tidx(wv);
  const u16* au = (const u16*)(p.ws + OFF_BIG);
  u16* gg = (u16*)(p.ws + OFF_R);
  const float* cw = p.in[19] + (size_t)layer * 3 * DFF;
  const float* cb = p.in[20] + (size_t)layer * DFF;
  const float* cache = p.in[5] + (size_t)layer * 8 * 2 * DFF;
  const int nitems = (MT / 16) * (DFF / 8);
  for (int it = blockIdx.x * 512 + tix; it < nitems; it += gridDim.x * 512) {
    const int cg8 = it % (DFF / 8), rb = it / (DFF / 8), c0 = cg8 * 8, r0 = rb * 16;
    float w0[8], w1[8], w2[8], bb[8], am2[8], am1[8];
#pragma unroll
    for (int e = 0; e < 8; ++e) { w0[e] = cw[c0 + e]; w1[e] = cw[DFF + c0 + e]; w2[e] = cw[2 * DFF + c0 + e]; bb[e] = cb[c0 + e]; }
    int t0, T, b; bool samp = r0 >= MP;
    if (!samp) { b = r0 >> 11; t0 = r0 & 2047; T = 2048; } else { b = (r0 - MP) >> 6; t0 = (r0 - MP) & 63; T = 64; }
    if (t0 == 0) {
      if (samp) {
#pragma unroll
        for (int e = 0; e < 8; ++e) { am2[e] = cache[(size_t)(b * 2 + 0) * DFF + c0 + e]; am1[e] = cache[(size_t)(b * 2 + 1) * DFF + c0 + e]; }
      } else {
#pragma unroll
        for (int e = 0; e < 8; ++e) { am2[e] = 0.f; am1[e] = 0.f; }
      }
    } else {
      ld8(au + (size_t)(r0 - 2) * NUP + c0, am2);
      ld8(au + (size_t)(r0 - 1) * NUP + c0, am1);
    }
#pragma unroll 4
    for (int i = 0; i < 16; ++i) {
      float a[8], uu[8], y[8];
      ld8(au + (size_t)(r0 + i) * NUP + c0, a);
      ld8(au + (size_t)(r0 + i) * NUP + DFF + c0, uu);
#pragma unroll
      for (int e = 0; e < 8; ++e) {
        float cv = bb[e] + w0[e] * am2[e] + w1[e] * am1[e] + w2[e] * a[e];
        y[e] = siluf_(cv) * uu[e];
        am2[e] = am1[e]; am1[e] = a[e];
      }
      st8(gg + (size_t)(r0 + i) * DFF + c0, y);
    }
    if (t0 + 16 == T) {
      float* dst = samp ? p.out + O_CVS + (size_t)(layer * 8 + b) * 2 * DFF : p.out + O_CVP + (size_t)(layer * 4 + b) * 2 * DFF;
#pragma unroll
      for (int e = 0; e < 8; ++e) { dst[c0 + e] = am2[e]; dst[DFF + c0 + e] = am1[e]; }
    }
  }
}


__device__ __forceinline__ void gate_fixup(int wv, const Params& p, int layer) {
  const int tix = tidx(wv);
  const u16* side = (const u16*)(p.ws + OFF_SIDE);
  u16* gg = (u16*)(p.ws + OFF_R);
  const float* cw = p.in[19] + (size_t)layer * 3 * DFF;
  const float* cb = p.in[20] + (size_t)layer * DFF;
  for (int vw = blockIdx.x; vw < (MP / BM) * (D / BM); vw += gridDim.x) {
    int pm, pn;
    tile_coords(vw, MP / BM, D / BM, pm, pn);
    if ((pm & 7) == 0) continue;
    for (int c8 = tix; c8 < DFF / 8; c8 += 512) {
      const int c = c8 * 8;
      float a0[8], a1[8], u0[8], u1[8], q2[8], q1[8], y0[8], y1[8];
      ld8(side + (size_t)(pm * 2 + 0) * DFF + c, a0);
      ld8(side + (size_t)(pm * 2 + 1) * DFF + c, a1);
      ld8(side + SZ_SIDE1 / 2 + (size_t)(pm * 2 + 0) * DFF + c, u0);
      ld8(side + SZ_SIDE1 / 2 + (size_t)(pm * 2 + 1) * DFF + c, u1);
      ld8(side + SZ_SIDE1 + (size_t)((pm - 1) * 2 + 0) * DFF + c, q2);
      ld8(side + SZ_SIDE1 + (size_t)((pm - 1) * 2 + 1) * DFF + c, q1);
#pragma unroll
      for (int e = 0; e < 8; ++e) {
        const float w0 = cw[c + e], w1 = cw[DFF + c + e], w2 = cw[2 * DFF + c + e], bb = cb[c + e];
        y0[e] = siluf_(bb + w0 * q2[e] + w1 * q1[e] + w2 * a0[e]) * u0[e];
        y1[e] = siluf_(bb + w0 * q1[e] + w1 * a0[e] + w2 * a1[e]) * u1[e];
      }
      st8(gg + (size_t)(pm * 256 + 0) * DFF + c, y0);
      st8(gg + (size_t)(pm * 256 + 1) * DFF + c, y1);
    }
  }
  asm volatile("s_waitcnt vmcnt(0)" ::: "memory");
  __syncthreads();
}

#define XB_TMO      128
#define XB_XCNT(j)  (256  + 64 * (j))
#define XB_XSUB(j)  (1280 + 64 * (j))
#define XB_XGEN(j)  (2304 + 64 * (j))
#define XB_TOP      3328
#define XB_TOPGEN   3392
#define XCD_BAR_WORDS 3456
#define XB_SPIN_CAP (1u << 22)
#define LAS __attribute__((address_space(3)))
__device__ __forceinline__ unsigned xb_ld(unsigned* p)              { return __hip_atomic_load(p, __ATOMIC_RELAXED, __HIP_MEMORY_SCOPE_AGENT); }
__device__ __forceinline__ unsigned xb_add(unsigned* p, unsigned v) { return __hip_atomic_fetch_add(p, v, __ATOMIC_RELAXED, __HIP_MEMORY_SCOPE_AGENT); }
__device__ __forceinline__ unsigned xb_xcc_id() { return (unsigned)__builtin_amdgcn_s_getreg((3 << 11) | 20) & 0xFu; }
#define XB_SPIN(cond, bar) do { unsigned _sp = 0; while (cond) { __builtin_amdgcn_s_sleep(1); \
    if ((++_sp & 255u) == 0u) { if (xb_ld(&(bar)[XB_TMO])) break; if (_sp > XB_SPIN_CAP) { atomicAdd(&(bar)[XB_TMO], 1u); break; } } } } while (0)
struct XcdBarrier { unsigned* bar; unsigned x; volatile LAS unsigned* st; };
__device__ __forceinline__ XcdBarrier xcd_barrier_post(int wv, unsigned* bar, volatile LAS unsigned* st) {
  XcdBarrier b; b.bar = bar; b.x = xb_xcc_id(); b.st = st;
  if (tidx(wv) == 0) (void)xb_add(&bar[XB_XCNT(b.x)], 1u);
  return b;
}
__device__ __forceinline__ void xcd_barrier_complete(unsigned* bar, unsigned x, unsigned& nloc, unsigned& nx) {
  const unsigned G = gridDim.x * gridDim.y * gridDim.z;
  unsigned sum, cnt, mine, sp = 0u;
  for (;;) {
    sum = 0u; cnt = 0u; mine = 0u;
#pragma unroll
    for (unsigned j = 0; j < 16; ++j) { const unsigned c = xb_ld(&bar[XB_XCNT(j)]); sum += c; cnt += (c > 0u) ? 1u : 0u; mine = (j == x) ? c : mine; }
    if (sum == G) break;
    __builtin_amdgcn_s_sleep(1);
    if ((++sp & 255u) == 0u) { if (xb_ld(&bar[XB_TMO])) break; if (sp > XB_SPIN_CAP) { atomicAdd(&bar[XB_TMO], 1u); break; } }
  }
  nloc = mine > 0u ? mine : 1u; nx = cnt > 0u ? cnt : 1u;
}
__device__ __forceinline__ void xcd_barrier(int wv, const XcdBarrier& b) {
  asm volatile("s_waitcnt vmcnt(0)" ::: "memory");
  __syncthreads();
  if (tidx(wv) == 0) {
    unsigned* bar = b.bar;
    __builtin_amdgcn_s_waitcnt(0);
    unsigned nloc = b.st[0], nx = b.st[1];
    if (nloc == 0u) { xcd_barrier_complete(bar, b.x, nloc, nx); b.st[0] = nloc; b.st[1] = nx; }
    const unsigned old = xb_add(&bar[XB_XSUB(b.x)], 1u);
    const unsigned gen = old / nloc;
    if (old + 1u == (gen + 1u) * nloc) {
      __builtin_amdgcn_fence(__ATOMIC_RELEASE, "agent");
      asm volatile("s_waitcnt vmcnt(0)" ::: "memory");
      const unsigned og = xb_add(&bar[XB_TOP], 1u);
      const unsigned tg = og / nx;
      if (og + 1u == (tg + 1u) * nx) xb_add(&bar[XB_TOPGEN], 1u);
      else XB_SPIN(xb_ld(&bar[XB_TOPGEN]) == tg, bar);
      __builtin_amdgcn_fence(__ATOMIC_ACQUIRE, "agent");
      xb_add(&bar[XB_XGEN(b.x)], 1u);
      asm volatile("s_waitcnt vmcnt(0)" ::: "memory");
    } else {
      XB_SPIN(xb_ld(&bar[XB_XGEN(b.x)]) == gen, bar);
      __builtin_amdgcn_fence(__ATOMIC_ACQUIRE, "agent");
      asm volatile("s_waitcnt vmcnt(0)" ::: "memory");
    }
  }
  __syncthreads();
}

constexpr int NPHASE = 21;
#ifndef PHMASK
#define PHMASK 0xFFFFFFFFu
#endif
#define PH_ON(k) (((PHMASK) >> (k)) & 1u)
constexpr int LDS_BYTES = 147456;

typedef const __attribute__((address_space(4))) Params* KParamsPtr;
#ifndef XSYNC
#define XSYNC 0
#endif
#ifndef DUPMASK
#define DUPMASK 0u
#endif
#define DUP_ON(k) (((DUPMASK) >> (k)) & 1u)
__device__ __forceinline__ bool ph_in(KParamsPtr& kp, int k) { asm volatile("" : "+s"(kp)); return kp->ph_lo <= k && k < kp->ph_hi; }
#define PH_IN(k) ph_in(kp, (k))
#define PHASE(k, ...) if (PH_IN(k)) { if (PH_ON(k)) { for (int rep = 0; rep < 1 + (int)DUP_ON(k); ++rep) { asm volatile("" : "+s"(kp)); Params p; __builtin_memcpy(&p, kp, sizeof(Params)); unsigned char* ws = p.ws; __VA_ARGS__ } } \
    asm volatile("" : "+s"(kp)); \
    if (kp->coop && (k) + 1 < kp->ph_hi) { XcdBarrier xb; xb.bar = (unsigned*)(kp->ws + OFF_BAR); xb.x = xb_xcc_id(); xb.st = (volatile LAS unsigned*)&xb_words; xcd_barrier(wv, xb); if (XSYNC) xcd_barrier(wv, xb); } }
#define PHASE_X(k, ...) if (PH_IN(k)) { asm volatile("" : "+s"(kp)); Params p; __builtin_memcpy(&p, kp, sizeof(Params)); unsigned char* ws = p.ws; __VA_ARGS__ }
#define GEMM_ACC(k, Aoff, Woff, KK, RSSP, FIXL, RINP, RINS) PHASE(k, { float* rssp = (RSSP); if ((FIXL) >= 0) gate_fixup(wv, p, FIXL); \
    gemm_phase<MP, D, KK, 0>(wv, (const u16*)(ws + Aoff), (const u16*)(ws + Woff), EpiAccum{(u16*)(ws + OFF_HN), rssp, (RINP)}, (u16*)shm); \
    gemm_tail_phase<KK>(wv, (const u16*)(ws + Aoff), (const u16*)(ws + Woff), (float*)shm, (u16*)(ws + OFF_HN), rssp, (RINS)); })

__global__ void __launch_bounds__(512) fwd_kernel(Params p_) {
  extern __shared__ __attribute__((aligned(16))) unsigned char shm[];
  cg::grid_group grid = cg::this_grid();
  KParamsPtr kp = (KParamsPtr)__builtin_amdgcn_kernarg_segment_ptr();
  const int wv = __builtin_amdgcn_readfirstlane((int)(threadIdx.x >> 6));
  __shared__ uint4 xb_words;
  if (tidx(wv) == 0) xb_words = make_uint4(0u, 0u, 0u, 0u);
  __syncthreads();
  if (kp->coop == 2) grid.sync();
  (void)xcd_barrier_post(wv, (unsigned*)(kp->ws + OFF_BAR), (volatile LAS unsigned*)&xb_words);
  PHASE(0,
        convert_w(wv, p.in[9], (u16*)(ws + OFF_WINE), D, NINE, NINE, (u16*)shm);
        convert_w(wv, p.in[10], (u16*)(ws + OFF_WOUTE), D, D, D, (u16*)shm);
        convert_w(wv, p.in[13], (u16*)(ws + OFF_WINO), D, NINO, NINO_PAD, (u16*)shm, p.in[6] + D);
        convert_w(wv, p.in[17], (u16*)(ws + OFF_WOUTO), D, D, D, (u16*)shm);
        convert_w(wv, p.in[18], (u16*)(ws + OFF_WUP0), D, NUP, NUP, (u16*)shm, p.in[7], 1);
        convert_w(wv, p.in[18] + (size_t)D * NUP, (u16*)(ws + OFF_WUP1), D, NUP, NUP, (u16*)shm, p.in[7] + D, 1);
        convert_w(wv, p.in[21], (u16*)(ws + OFF_WDN0), DFF, D, D, (u16*)shm);
        convert_w(wv, p.in[21] + (size_t)DFF * D, (u16*)(ws + OFF_WDN1), DFF, D, D, (u16*)shm);
        for (int i = blockIdx.x * 512 + tidx(wv); i < 3 * MT; i += gridDim.x * 512) ((float*)(ws + OFF_RSS))[i] = 0.f;
        rmsnorm_phase<0>(wv, p, p.in[6]);)
  PHASE(1, gemm_phase<MT, NINE, D, 0>(wv, (const u16*)(ws + OFF_HN), (const u16*)(ws + OFF_WINE), EpiStoreBf16{(u16*)(ws + OFF_BIG), NINE, nullptr}, (u16*)shm);)
  PHASE(2, { const int b_ = blockIdx.x, G_ = gridDim.x;
        prep_range<0>(wv, p, b_, NCH * 4, G_, shm);
        const int first1 = ((NCH * 4 - b_ + G_ - 1) / G_) * G_ + b_ - NCH * 4;
        prep_range<1>(wv, p, first1, NCH * 8, G_, shm); })
  PHASE(3, seq_even_phase(wv, p, shm);)
  PHASE(4, post_phase<0>(wv, p);)
  GEMM_ACC(5, OFF_R, OFF_WOUTE, D, (float*)(ws + OFF_RSS), -1, p.in[0], p.in[1])
  PHASE(7, gemm_phase<MT, NUP, D, 0>(wv, (const u16*)(ws + OFF_HN), (const u16*)(ws + OFF_WUP0), EpiGate{(const __attribute__((address_space(4))) void*)kp, 0, 0}, (u16*)shm);)
  GEMM_ACC(9, OFF_R, OFF_WDN0, DFF, (float*)(ws + OFF_RSS) + MT, 0, (const float*)nullptr, (const float*)nullptr)
  PHASE(11, gemm_phase<MT, NINO_PAD, D, 0>(wv, (const u16*)(ws + OFF_HN), (const u16*)(ws + OFF_WINO), EpiStoreBf16{(u16*)(ws + OFF_BIG), NINO_PAD, (const float*)(ws + OFF_RSS) + MT}, (u16*)shm);)
  PHASE(12, prep_range<2>(wv, p, blockIdx.x, NCH * 4, gridDim.x, shm);)
  PHASE(13, seq_odd_phase(wv, p, shm);)
  PHASE(14, post_phase<1>(wv, p);)
  GEMM_ACC(15, OFF_R, OFF_WOUTO, D, (float*)(ws + OFF_RSS) + 2 * MT, -1, (const float*)nullptr, (const float*)nullptr)
  PHASE(17, gemm_phase<MT, NUP, D, 0>(wv, (const u16*)(ws + OFF_HN), (const u16*)(ws + OFF_WUP1), EpiGate{(const __attribute__((address_space(4))) void*)kp, 1, 2 * MT}, (u16*)shm);)
  GEMM_ACC(19, OFF_R, OFF_WDN1, DFF, (float*)nullptr, 1, (const float*)nullptr, (const float*)nullptr)
  PHASE(20, final_norm_phase(wv, p);)
}

extern "C" void kernel_launch(void* const* d_in, const int* in_sizes, int n_in, void* d_out, int out_size, void* d_ws, size_t ws_size,
                              hipStream_t stream) {
  static int grid_blocks = 0;
  if (grid_blocks == 0) {
    int dev = 0, cus = 0, per_cu = 0;
    hipGetDevice(&dev);
    hipDeviceGetAttribute(&cus, hipDeviceAttributeMultiprocessorCount, dev);
    hipFuncSetAttribute((const void*)fwd_kernel, hipFuncAttributeMaxDynamicSharedMemorySize, LDS_BYTES);
    hipOccupancyMaxActiveBlocksPerMultiprocessor(&per_cu, (const void*)fwd_kernel, 512, LDS_BYTES);
    if (per_cu < 1) per_cu = 1;
    grid_blocks = cus * per_cu;
    (void)hipGetLastError();
  }
  if (n_in != 22 || ws_size < WS_NEED || (size_t)out_size != O_END) {
    fprintf(stderr, "kernel_launch: unexpected sizes n_in=%d ws=%zu need=%zu out=%d\n", n_in, ws_size, (size_t)WS_NEED, out_size);
    hipMemsetAsync(d_out, 0, (size_t)out_size * 4, stream);
    return;
  }
  Params p{};
  for (int i = 0; i < 22; ++i) p.in[i] = (const float*)d_in[i];
  p.out = (float*)d_out;
  p.ws = (unsigned char*)d_ws;
#if 0
  for (int ph = 0; ph < NPHASE; ++ph) {
    p.ph_lo = ph; p.ph_hi = ph + 1; p.coop = 0;
    hipLaunchKernelGGL(fwd_kernel, dim3(grid_blocks), dim3(512), LDS_BYTES, stream, p);
  }
#else
  p.ph_lo = 0; p.ph_hi = NPHASE; p.coop = 1;
  hipMemsetAsync((unsigned char*)d_ws + OFF_BAR, 0, XCD_BAR_WORDS * 4, stream);
  void* args[] = {&p};
  hipError_t e = hipLaunchCooperativeKernel((const void*)fwd_kernel, dim3(grid_blocks), dim3(512), args, LDS_BYTES, stream);
  if (e != hipSuccess) fprintf(stderr, "cooperative launch failed: %s (grid %d)\n", hipGetErrorString(e), grid_blocks);
#endif
}
```

```cpp
#include <hip/hip_runtime.h>
#include <hip/hip_bf16.h>
#include <hip/hip_cooperative_groups.h>
#include <cstdio>
namespace cg = cooperative_groups;

typedef unsigned short u16;
using bf16x8 = __attribute__((ext_vector_type(8))) short;
using f32x4 = __attribute__((ext_vector_type(4))) float;
typedef __attribute__((ext_vector_type(4))) unsigned u32x4_t;

constexpr int MP = 8192, MS = 512, MT = 8704, D = 2048;
constexpr int DFF = 5504, NUP = 11008;
constexpr int NINE = 7168, NINO = 6160, NINO_PAD = 6400;
constexpr int NCH = 136;
constexpr float EPS = 1e-6f;

constexpr size_t SZ_WINE = (size_t)NINE * D * 2, SZ_WOUT = (size_t)D * D * 2, SZ_WINO = (size_t)NINO_PAD * D * 2;
constexpr size_t SZ_WUP = (size_t)NUP * D * 2, SZ_WDN = (size_t)D * DFF * 2;
constexpr size_t OFF_WINE = 0;
constexpr size_t OFF_WOUTE = OFF_WINE + SZ_WINE;
constexpr size_t OFF_WINO = OFF_WOUTE + SZ_WOUT;
constexpr size_t OFF_WOUTO = OFF_WINO + SZ_WINO;
constexpr size_t OFF_WUP0 = OFF_WOUTO + SZ_WOUT;
constexpr size_t OFF_WUP1 = OFF_WUP0 + SZ_WUP;
constexpr size_t OFF_WDN0 = OFF_WUP1 + SZ_WUP;
constexpr size_t OFF_WDN1 = OFF_WDN0 + SZ_WDN;
constexpr size_t OFF_H = OFF_WDN1 + SZ_WDN;
constexpr size_t OFF_HN = OFF_H + (size_t)MT * D * 4;
constexpr size_t OFF_BIG = OFF_HN + (size_t)MT * D * 2;
constexpr size_t OFF_R = OFF_BIG + (size_t)MT * NUP * 2;
constexpr size_t SZ_R = 104ull * 1048576;
constexpr size_t OFF_RSS = OFF_R + SZ_R;
constexpr size_t OFF_SIDE = OFF_RSS + 3ull * MT * 4 + 256;
constexpr size_t SZ_SIDE1 = 34ull * 2 * DFF * 2;
constexpr size_t OFF_BAR = OFF_SIDE + 3 * SZ_SIDE1 + 256;
constexpr size_t WS_NEED = OFF_BAR + 16384;
constexpr size_t R_QA = 0;
constexpr size_t R_KA = R_QA + (size_t)NCH * 4 * 64 * 128 * 2;
constexpr size_t R_VA = R_KA + (size_t)NCH * 4 * 64 * 128 * 2;
constexpr size_t R_PA = R_VA + (size_t)NCH * 4 * 256 * 64 * 2;
constexpr size_t R_DA = R_PA + (size_t)NCH * 4 * 4096 * 2;
constexpr size_t R_QB = R_DA + (size_t)NCH * 4 * 128 * 4;
constexpr size_t R_KB = R_QB + (size_t)NCH * 8 * 64 * 128 * 2;
constexpr size_t R_VB = R_KB + (size_t)NCH * 8 * 64 * 128 * 2;
constexpr size_t R_PB = R_VB + (size_t)NCH * 8 * 128 * 64 * 2;
constexpr size_t R_DB = R_PB + (size_t)NCH * 8 * 4096 * 2;
constexpr size_t R_END_EVEN = R_DB + (size_t)NCH * 8 * 128 * 4;
constexpr size_t R_QC = 0;
constexpr size_t R_KC = R_QC + (size_t)NCH * 4 * 64 * 256 * 2;
constexpr size_t R_VC = R_KC + (size_t)NCH * 4 * 64 * 256 * 2;
constexpr size_t R_PC = R_VC + (size_t)NCH * 4 * 512 * 64 * 2;
constexpr size_t R_DC = R_PC + (size_t)NCH * 4 * 4096 * 2;
constexpr size_t R_END_ODD = R_DC + (size_t)NCH * 4 * 256 * 4;
static_assert(R_END_EVEN <= SZ_R && R_END_ODD <= SZ_R && (size_t)MT * DFF * 2 <= SZ_R, "R region too small");

constexpr size_t O_YP = 0;
constexpr size_t O_YS = O_YP + (size_t)MP * D;
constexpr size_t O_RETP = O_YS + (size_t)MS * D;
constexpr size_t O_RETS = O_RETP + 4ull * 4 * 128 * 256;
constexpr size_t O_HGP = O_RETS + 8ull * 4 * 128 * 256;
constexpr size_t O_HGS = O_HGP + 4ull * 8 * 128 * 128;
constexpr size_t O_GLP = O_HGS + 8ull * 8 * 128 * 128;
constexpr size_t O_GLS = O_GLP + 4ull * 4 * 256 * 512;
constexpr size_t O_CVP = O_GLS + 8ull * 4 * 256 * 512;
constexpr size_t O_CVS = O_CVP + 2ull * 4 * 2 * DFF;
constexpr size_t O_END = O_CVS + 2ull * 8 * 2 * DFF;

struct Params {
  const float* in[22];
  float* out;
  unsigned char* ws;
  int ph_lo, ph_hi, coop, pad;
};

__device__ __forceinline__ u16 f2bf(float f) {
  unsigned u = __float_as_uint(f);
  u += 0x7fffu + ((u >> 16) & 1u);
  return (u16)(u >> 16);
}
__device__ __forceinline__ float bf2f(u16 h) { return __uint_as_float(((unsigned)h) << 16); }
__device__ __forceinline__ unsigned pack2(float a, float b) { return (unsigned)f2bf(a) | ((unsigned)f2bf(b) << 16); }
__device__ __forceinline__ float sigmoidf_(float x) { return 1.f / (1.f + __expf(-x)); }
__device__ __forceinline__ float siluf_(float x) { return x / (1.f + __expf(-x)); }

__device__ __forceinline__ int tidx(int wv) { int l; asm volatile("v_mbcnt_lo_u32_b32 %0, -1, 0\n\tv_mbcnt_hi_u32_b32 %0, -1, %0" : "=v"(l)); return wv * 64 + l; }

__device__ __forceinline__ void convert_w(int wv, const float* __restrict__ src, u16* __restrict__ dst, int K, int N, int Npad, u16* tile, const float* __restrict__ kscale = nullptr, int upperm = 0) {
  const int tix = tidx(wv);
  constexpr int TS = 262;
  const int tn = (Npad + 255) / 256, tk = K / 64, nt = tn * tk, tid = tix;
  for (int t = blockIdx.x; t < nt; t += gridDim.x) {
    const int n0 = (t % tn) * 256, k0 = (t / tn) * 64;
    float4 v[8];
#pragma unroll
    for (int i = 0; i < 8; ++i) {
      const int idx = tid + i * 512, kk = idx >> 6, n = n0 + (idx & 63) * 4;
      v[i] = make_float4(0.f, 0.f, 0.f, 0.f);
      if (n < N) v[i] = *(const float4*)(src + (size_t)(k0 + kk) * N + n);
      if (kscale) { const float sc = kscale[k0 + kk]; v[i].x *= sc; v[i].y *= sc; v[i].z *= sc; v[i].w *= sc; }
    }
    __syncthreads();
#pragma unroll
    for (int i = 0; i < 8; ++i) {
      const int idx = tid + i * 512, kk = idx >> 6, nl = (idx & 63) * 4;
      *(unsigned*)(tile + kk * TS + nl) = pack2(v[i].x, v[i].y);
      *(unsigned*)(tile + kk * TS + nl + 2) = pack2(v[i].z, v[i].w);
    }
    __syncthreads();
#pragma unroll
    for (int i = 0; i < 4; ++i) {
      const int item = tid + i * 512, ks = item & 7, n = item >> 3;
      if (n0 + n < Npad) {
        const u16* tp = tile + (ks * 8) * TS + n;
        uint4 o;
        o.x = (unsigned)tp[0] | ((unsigned)tp[TS] << 16);
        o.y = (unsigned)tp[2 * TS] | ((unsigned)tp[3 * TS] << 16);
        o.z = (unsigned)tp[4 * TS] | ((unsigned)tp[5 * TS] << 16);
        o.w = (unsigned)tp[6 * TS] | ((unsigned)tp[7 * TS] << 16);
        int nr = n0 + n;
        if (upperm) nr = (nr < DFF) ? ((nr >> 7) * 256 + (nr & 127)) : ((((nr - DFF) >> 7) * 256) + 128 + ((nr - DFF) & 127));
        *(uint4*)(dst + (size_t)nr * K + k0 + ks * 8) = o;
      }
    }
  }
}

template <int MODE>
__device__ __forceinline__ void rmsnorm_phase(int wv, const Params& p, const float* __restrict__ w) {
  const int tix = tidx(wv);
  const int lane = tix & 63, gw = blockIdx.x * 8 + (tix >> 6), nw = gridDim.x * 8;
  const float* h = (const float*)(p.ws + OFF_H);
  u16* hn = (u16*)(p.ws + OFF_HN);
#define RMS_LOAD(dst, row_) do { const int r_ = (row_); const float* src_; \
    if (MODE == 0) src_ = (r_ < MP) ? p.in[0] + (size_t)r_ * D : p.in[1] + (size_t)(r_ - MP) * D; \
    else src_ = h + (size_t)r_ * D; \
    _Pragma("unroll") for (int i = 0; i < 8; ++i) dst[i] = *(const f32x4*)(src_ + (i * 64 + lane) * 4); } while (0)
  f32x4 v[8];
  if (gw < MT) RMS_LOAD(v, gw);
#pragma unroll 1
  for (int row = gw; row < MT; row += nw) {
    f32x4 nx[8];
    if (row + nw < MT) RMS_LOAD(nx, row + nw);
    else {
#pragma unroll
      for (int i = 0; i < 8; ++i) nx[i] = v[i];
    }
    __builtin_amdgcn_sched_barrier(0);
    float ss = 0.f;
#pragma unroll
    for (int i = 0; i < 8; ++i) ss += v[i][0] * v[i][0] + v[i][1] * v[i][1] + v[i][2] * v[i][2] + v[i][3] * v[i][3];
#pragma unroll
    for (int o = 32; o > 0; o >>= 1) ss += __shfl_xor(ss, o, 64);
    const float rs = rsqrtf(ss * (1.f / D) + EPS);
#pragma unroll
    for (int i = 0; i < 8; ++i) {
      const int col = (i * 64 + lane) * 4;
      const float4 wv4 = *(const float4*)(w + col);
      const float4 y = make_float4(v[i][0] * rs * wv4.x, v[i][1] * rs * wv4.y, v[i][2] * rs * wv4.z, v[i][3] * rs * wv4.w);
      if (MODE == 2) {
        float* dst = (row < MP) ? p.out + O_YP + (size_t)row * D : p.out + O_YS + (size_t)(row - MP) * D;
        *(float4*)(dst + col) = y;
      } else {
        *(uint2*)(hn + (size_t)row * D + col) = make_uint2(pack2(y.x, y.y), pack2(y.z, y.w));
      }
    }
#pragma unroll
    for (int i = 0; i < 8; ++i) v[i] = nx[i];
  }
#undef RMS_LOAD
}

__device__ __forceinline__ void ld8(const u16* p, float* f) {
  uint4 v = *(const uint4*)p;
  f[0] = __uint_as_float(v.x << 16); f[1] = __uint_as_float(v.x & 0xffff0000u);
  f[2] = __uint_as_float(v.y << 16); f[3] = __uint_as_float(v.y & 0xffff0000u);
  f[4] = __uint_as_float(v.z << 16); f[5] = __uint_as_float(v.z & 0xffff0000u);
  f[6] = __uint_as_float(v.w << 16); f[7] = __uint_as_float(v.w & 0xffff0000u);
}
__device__ __forceinline__ void st8(u16* p, const float* f) {
  *(uint4*)p = make_uint4(pack2(f[0], f[1]), pack2(f[2], f[3]), pack2(f[4], f[5]), pack2(f[6], f[7]));
}

constexpr int BM = 256, BK = 64, HALF = 128, NXCD = 8, WGM = 8, HT = HALF * BK;

__device__ __forceinline__ int lds_byte(int r, int c) {
  int st = (r >> 4) * 2 + (c >> 5), rr = r & 15, cc = c & 31, ob = rr * 64 + cc * 2;
  return st * 1024 + (ob ^ (((ob >> 9) & 1) << 5));
}
__device__ __forceinline__ void stage_rc(int b, int& R, int& C) {
  int st = b / 1024, sb = b % 1024, swz = sb ^ (((sb >> 9) & 1) << 5);
  R = (st >> 1) * 16 + swz / 64; C = (st & 1) * 32 + (swz % 64) / 2;
}

__device__ __forceinline__ void tile_coords(int wgid, int nM, int nN, int& pm, int& pn) {
  const int nwg = nM * nN;
  { int q = nwg / NXCD, r = nwg % NXCD, xcd = wgid % NXCD, off = wgid / NXCD;
    wgid = (xcd < r ? xcd * (q + 1) : r * (q + 1) + (xcd - r) * q) + off; }
  const int nig = WGM * nN, gid = wgid / nig, fm = gid * WGM, gsz = min(nM - fm, WGM);
  pm = fm + ((wgid % nig) % gsz); pn = (wgid % nig) / gsz;
}

struct EpiStoreBf16 {
  static constexpr bool GATE = false;
  static constexpr bool LDSST = true;
  u16* out; int ldo; const float* rss;
  __device__ __forceinline__ float row_scale(int row) const { return rss ? rsqrtf(rss[row] * (1.f / D) + EPS) : 1.f; }
  __device__ __forceinline__ float operator()(int row, int col, f32x4 v, float sc) const {
    uint2 pk = make_uint2(pack2(v[0] * sc, v[1] * sc), pack2(v[2] * sc, v[3] * sc));
    *(uint2*)(out + (size_t)row * ldo + col) = pk;
    return 0.f;
  }
  __device__ __forceinline__ void row_end(int, float, int) const {}
  __device__ __forceinline__ f32x4 finalize(int, int, f32x4 v, float sc, float&) const { return f32x4{v[0] * sc, v[1] * sc, v[2] * sc, v[3] * sc}; }
};
struct EpiAccum {
  static constexpr bool GATE = false;
  static constexpr bool LDSST = true;
  u16* out; float* rss; const float* rin32; static constexpr int ldo = D;
  __device__ __forceinline__ float row_scale(int) const { return 1.f; }
  __device__ __forceinline__ float operator()(int, int, f32x4, float) const { return 0.f; }
  __device__ __forceinline__ f32x4 finalize(int row, int col, f32x4 v, float, float& ss) const {
    float4 o;
    if (rin32) o = *(const float4*)(rin32 + (size_t)row * D + col);
    else { const uint2 r = *(const uint2*)(out + (size_t)row * D + col); o = make_float4(__uint_as_float(r.x << 16), __uint_as_float(r.x & 0xffff0000u), __uint_as_float(r.y << 16), __uint_as_float(r.y & 0xffff0000u)); }
    o.x += v[0]; o.y += v[1]; o.z += v[2]; o.w += v[3];
    if (rss) ss += o.x * o.x + o.y * o.y + o.z * o.z + o.w * o.w;
    return f32x4{o.x, o.y, o.z, o.w};
  }
  __device__ __forceinline__ void row_end(int row, float ss, int fq) const {
    if (rss) {
      ss += __shfl_xor(ss, 16, 64);
      ss += __shfl_xor(ss, 32, 64);
      if (fq == 0) unsafeAtomicAdd(rss + row, ss);
    }
  }
};

struct EpiGate {
  static constexpr bool GATE = true;
  static constexpr bool LDSST = false;
  const __attribute__((address_space(4))) void* kp; int layer; int rssoff;
  __device__ __forceinline__ float row_scale(int) const { return 1.f; }
  __device__ __forceinline__ float operator()(int, int, f32x4, float) const { return 0.f; }
  __device__ __forceinline__ void row_end(int, float, int) const {}
};

template <int M, int N, int K, int TAIL, class Epi>
__device__ __forceinline__ void gemm_phase(int wv, const u16* __restrict__ A, const u16* __restrict__ Bt, Epi epi, u16* shm) {
  const int tix = tidx(wv);
#define SA(b, h) (shm + ((b) * 2 + (h)) * HT)
#define SB(b, h) (shm + (4 + (b) * 2 + (h)) * HT)
#define STAGE(P, BASE, br, kt) do { const u16* _gb = BASE + ((long)(br) * K + (long)(kt0 + (kt)) * BK); \
    for (int _i = 0; _i < 2; ++_i) { int _b = tix * 16 + _i * 8192; \
      __builtin_amdgcn_global_load_lds((const unsigned*)(_gb + toff[_i]), \
        (__attribute__((address_space(3))) unsigned*)((char*)(P) + _b), 16, 0, 0); } } while (0)
#define LDA(dst, b, h) for (int m = 0; m < 4; ++m) for (int k = 0; k < 2; ++k) \
    dst[m][k] = *reinterpret_cast<const bf16x8*>((char*)SA(b, h) + lds_byte(wr * 64 + m * 16 + fr, k * 32 + fq * 8))
#define LDB(dst, b, h) for (int n = 0; n < 2; ++n) for (int k = 0; k < 2; ++k) \
    dst[n][k] = *reinterpret_cast<const bf16x8*>((char*)SB(b, h) + lds_byte(wc * 32 + n * 16 + fr, k * 32 + fq * 8))
#define MMA(ai, bj, At_, Bt_) do { __builtin_amdgcn_s_setprio(1); \
    for (int m = 0; m < 4; ++m) for (int n = 0; n < 2; ++n) for (int k = 0; k < 2; ++k) \
      acc[ai][bj][m][n] = __builtin_amdgcn_mfma_f32_16x16x32_bf16(Bt_[n][k], At_[m][k], acc[ai][bj][m][n], 0, 0, 0); \
    __builtin_amdgcn_s_setprio(0); } while (0)
#define WAIT_V(n) asm volatile("s_waitcnt vmcnt(" #n ")" ::: "memory")
#define WAIT_L(n) asm volatile("s_waitcnt lgkmcnt(" #n ")" ::: "memory")
#define BAR __builtin_amdgcn_s_barrier()
#define SCHED __builtin_amdgcn_sched_barrier(0)
  const int nM = M / BM, nN = N / BM, nwg = nM * nN, G = gridDim.x;
  const int nunits = nwg;
  const int wid = tix >> 6, lane = tix & 63, wr = wid >> 2, wc = wid & 3, fr = lane & 15, fq = lane >> 4;
  const int nt_total = K / BK;
  unsigned toff[2];
  for (int _i = 0; _i < 2; ++_i) { int _b = tix * 16 + _i * 8192; int _r, _c; stage_rc(_b, _r, _c); toff[_i] = (unsigned)(_r * K + _c); }
  for (int vw = blockIdx.x; vw < nunits; vw += G) {
    int pm, pn;
    tile_coords(vw, nM, nN, pm, pn);
    const int brow = pm * BM, bcol = pn * BM;
    constexpr int kt0 = 0, nt = nt_total;
    f32x4 acc[2][2][4][2];
    for (int a = 0; a < 2; ++a) for (int b = 0; b < 2; ++b) for (int m = 0; m < 4; ++m) for (int n = 0; n < 2; ++n) acc[a][b][m][n] = f32x4{0.f, 0.f, 0.f, 0.f};
    bf16x8 At[4][2], B0[2][2], B1[2][2];
    STAGE(SB(0, 0), Bt, bcol, 0); STAGE(SA(0, 0), A, brow, 0);
    STAGE(SB(0, 1), Bt, bcol + HALF, 0); STAGE(SA(0, 1), A, brow + HALF, 0);
    if (wr == 1) BAR;
    WAIT_V(4); BAR;
    STAGE(SB(1, 0), Bt, bcol, 1); STAGE(SA(1, 0), A, brow, 1); STAGE(SB(1, 1), Bt, bcol + HALF, 1);
    WAIT_V(6); BAR;
    for (int t = 0; t < nt - 2; t += 2) {
      LDB(B0, 0, 0); SCHED; LDA(At, 0, 0); STAGE(SA(1, 1), A, brow + HALF, t + 1);
      WAIT_L(8); BAR; WAIT_L(0); MMA(0, 0, At, B0); BAR; SCHED;
      LDB(B1, 0, 1); STAGE(SB(0, 0), Bt, bcol, t + 2);
      BAR; WAIT_L(0); MMA(0, 1, At, B1); BAR;
      LDA(At, 0, 1); STAGE(SA(0, 0), A, brow, t + 2);
      BAR; WAIT_L(0); MMA(1, 0, At, B0); BAR; SCHED;
      STAGE(SB(0, 1), Bt, bcol + HALF, t + 2);
      WAIT_V(6); BAR; MMA(1, 1, At, B1); BAR;
      LDB(B0, 1, 0); SCHED; LDA(At, 1, 0); STAGE(SA(0, 1), A, brow + HALF, t + 2);
      WAIT_L(8); BAR; WAIT_L(0); MMA(0, 0, At, B0); BAR; SCHED;
      LDB(B1, 1, 1); STAGE(SB(1, 0), Bt, bcol, t + 3);
      BAR; WAIT_L(0); MMA(0, 1, At, B1); BAR;
      LDA(At, 1, 1); STAGE(SA(1, 0), A, brow, t + 3);
      BAR; WAIT_L(0); MMA(1, 0, At, B0); BAR; SCHED;
      STAGE(SB(1, 1), Bt, bcol + HALF, t + 3);
      WAIT_V(6); BAR; MMA(1, 1, At, B1); BAR;
    }
    { LDB(B0, 0, 0); LDA(At, 0, 0); STAGE(SA(1, 1), A, brow + HALF, nt - 1);
      BAR; WAIT_L(0); MMA(0, 0, At, B0); BAR;
      LDB(B1, 0, 1); BAR; WAIT_L(0); MMA(0, 1, At, B1); BAR;
      LDA(At, 0, 1); WAIT_V(4); BAR; WAIT_L(0); MMA(1, 0, At, B0); MMA(1, 1, At, B1); BAR; }
    { LDB(B0, 1, 0); LDA(At, 1, 0); WAIT_V(2); BAR; WAIT_L(0); MMA(0, 0, At, B0); BAR;
      LDB(B1, 1, 1); WAIT_V(0); BAR; WAIT_L(0); MMA(0, 1, At, B1); BAR;
      LDA(At, 1, 1); BAR; WAIT_L(0); MMA(1, 0, At, B0); MMA(1, 1, At, B1); BAR; }
    if (wr == 0) BAR;
    if constexpr (Epi::GATE) {
      constexpr int LS = 136;
      u16* La = shm;
      u16* Lu = shm + 256 * LS;
      const __attribute__((address_space(4))) Params* gkp = (const __attribute__((address_space(4))) Params*)epi.kp;
      asm volatile("" : "+s"(gkp));
      int e_pm = pm, e_pn = pn, e_tix = tix;
      asm volatile("" : "+s"(e_pm), "+s"(e_pn));
      asm volatile("" : "+v"(e_tix));
      const int e_brow = e_pm * BM;
      {
        const int e_lane = e_tix & 63, e_wid = e_tix >> 6, e_wr = e_wid >> 2, e_wc = e_wid & 3, e_fr = e_lane & 15, e_fq = e_lane >> 4;
        const float* rss = (const float*)(gkp->ws + OFF_RSS) + epi.rssoff;
        _Pragma("unroll") for (int ai = 0; ai < 2; ++ai) _Pragma("unroll") for (int m = 0; m < 4; ++m) {
          const int rl = ai * HALF + e_wr * 64 + m * 16 + e_fr;
          const float sc = rsqrtf(rss[e_brow + rl] * (1.f / D) + EPS);
          _Pragma("unroll") for (int n = 0; n < 2; ++n) {
            const f32x4 a = acc[ai][0][m][n], uu = acc[ai][1][m][n];
            const int lo = rl * LS + e_wc * 32 + n * 16 + e_fq * 4;
            *(uint2*)(La + lo) = make_uint2(pack2(a[0] * sc, a[1] * sc), pack2(a[2] * sc, a[3] * sc));
            *(uint2*)(Lu + lo) = make_uint2(pack2(uu[0] * sc, uu[1] * sc), pack2(uu[2] * sc, uu[3] * sc));
          }
        }
      }
      WAIT_L(0); BAR; asm volatile("" ::: "memory");
      {
        const bool samp = e_brow >= MP;
        const int layer = epi.layer;
        u16* gg = (u16*)(gkp->ws + OFF_R);
        u16* side = (u16*)(gkp->ws + OFF_SIDE);
        const float* cw = gkp->in[19] + (size_t)layer * 3 * DFF;
        const float* cb = gkp->in[20] + (size_t)layer * DFF;
        const float* cache = gkp->in[5] + (size_t)layer * 8 * 2 * DFF;
        float* cvo = gkp->out + (samp ? O_CVS + (size_t)layer * 8 * 2 * DFF : O_CVP + (size_t)layer * 4 * 2 * DFF);
        const int cg = e_tix & 15, r0 = e_tix >> 4, c = e_pn * 128 + cg * 8;
        float w0[8], w1[8], w2[8], bb[8];
        _Pragma("unroll") for (int e = 0; e < 8; ++e) { w0[e] = cw[c + e]; w1[e] = cw[DFF + c + e]; w2[e] = cw[2 * DFF + c + e]; bb[e] = cb[c + e]; }
        _Pragma("unroll 1") for (int it = 0; it < 8; ++it) {
          const int rl = it * 32 + r0;
          const int t = samp ? (rl & 63) : ((e_pm & 7) * 256 + rl);
          const int sb = (e_pm - 32) * 4 + (rl >> 6);
          float a[8], uu[8], am1[8], am2[8], y[8];
          ld8(La + rl * LS + cg * 8, a);
          ld8(Lu + rl * LS + cg * 8, uu);
          _Pragma("unroll") for (int e = 0; e < 8; ++e) { am1[e] = 0.f; am2[e] = 0.f; }
          if (t >= 1 && rl >= 1) ld8(La + (rl - 1) * LS + cg * 8, am1);
          if (t >= 2 && rl >= 2) ld8(La + (rl - 2) * LS + cg * 8, am2);
          if (samp && t < 2) {
            const float* c1 = cache + (size_t)(sb * 2 + 1) * DFF + c;
            if (t == 0) {
              const float* c0 = cache + (size_t)(sb * 2 + 0) * DFF + c;
              _Pragma("unroll") for (int e = 0; e < 8; ++e) { am2[e] = c0[e]; am1[e] = c1[e]; }
            } else {
              _Pragma("unroll") for (int e = 0; e < 8; ++e) am2[e] = c1[e];
            }
          }
          if (!(t >= 2 && rl < 2)) {
            _Pragma("unroll") for (int e = 0; e < 8; ++e) { float cv = bb[e] + w0[e] * am2[e] + w1[e] * am1[e] + w2[e] * a[e]; y[e] = siluf_(cv) * uu[e]; }
            st8(gg + (size_t)(e_brow + rl) * DFF + c, y);
          } else {
            st8(side + (size_t)(e_pm * 2 + rl) * DFF + c, a);
            st8(side + SZ_SIDE1 / 2 + (size_t)(e_pm * 2 + rl) * DFF + c, uu);
          }
          if (rl >= 254) st8(side + SZ_SIDE1 + (size_t)(e_pm * 2 + rl - 254) * DFF + c, a);
          int crow = -1;
          if (!samp) { if ((e_pm & 7) == 7 && rl >= 254) crow = (e_pm >> 3) * 2 + rl - 254; }
          else { if ((rl & 63) >= 62) crow = sb * 2 + (rl & 63) - 62; }
          if (crow >= 0) {
            float* dst = cvo + (size_t)crow * DFF + c;
            *(float4*)dst = make_float4(a[0], a[1], a[2], a[3]);
            *(float4*)(dst + 4) = make_float4(a[4], a[5], a[6], a[7]);
          }
        }
      }
      WAIT_L(0); BAR; asm volatile("" ::: "memory");
    } else if constexpr (Epi::LDSST) {
      constexpr int LS = 136;
      u16* L0 = shm;
      u16* L1 = shm + 256 * LS;
      int e_brow = brow, e_bcol = bcol, e_tix = tix;
      asm volatile("" : "+s"(e_brow), "+s"(e_bcol));
      asm volatile("" : "+v"(e_tix));
      {
        const int e_lane = e_tix & 63, e_wid = e_tix >> 6, e_wr = e_wid >> 2, e_wc = e_wid & 3, e_fr = e_lane & 15, e_fq = e_lane >> 4;
        _Pragma("unroll") for (int ai = 0; ai < 2; ++ai) _Pragma("unroll") for (int m = 0; m < 4; ++m) {
          const int rl = ai * HALF + e_wr * 64 + m * 16 + e_fr;
          const float sc = epi.row_scale(e_brow + rl);
          float ss = 0.f;
          _Pragma("unroll") for (int n = 0; n < 2; ++n) {
            const int cl = e_wc * 32 + n * 16 + e_fq * 4;
            const f32x4 c0 = epi.finalize(e_brow + rl, e_bcol + cl, acc[ai][0][m][n], sc, ss);
            const f32x4 c1 = epi.finalize(e_brow + rl, e_bcol + 128 + cl, acc[ai][1][m][n], sc, ss);
            const int lo = rl * LS + cl;
            *(uint2*)(L0 + lo) = make_uint2(pack2(c0[0], c0[1]), pack2(c0[2], c0[3]));
            *(uint2*)(L1 + lo) = make_uint2(pack2(c1[0], c1[1]), pack2(c1[2], c1[3]));
          }
          epi.row_end(e_brow + rl, ss, e_fq);
          if (m & 1) asm volatile("" ::: "memory");
        }
      }
      WAIT_L(0); BAR; asm volatile("" ::: "memory");
      {
        const int cg = e_tix & 15, r0 = e_tix >> 4;
        _Pragma("unroll 1") for (int it = 0; it < 8; ++it) {
          const int rl = it * 32 + r0;
          const uint4 x0 = *(const uint4*)(L0 + rl * LS + cg * 8), x1 = *(const uint4*)(L1 + rl * LS + cg * 8);
          u16* dst = epi.out + (size_t)(e_brow + rl) * epi.ldo + e_bcol + cg * 8;
          *(uint4*)dst = x0;
          *(uint4*)(dst + 128) = x1;
        }
      }
      WAIT_L(0); BAR; asm volatile("" ::: "memory");
    } else {
    for (int ai = 0; ai < 2; ++ai) for (int m = 0; m < 4; ++m) {
      const int row = brow + ai * HALF + wr * 64 + m * 16 + fr;
      const float sc = epi.row_scale(row);
      float ss = 0.f;
      for (int bj = 0; bj < 2; ++bj) for (int n = 0; n < 2; ++n)
        ss += epi(row, bcol + bj * HALF + wc * 32 + n * 16 + fq * 4, acc[ai][bj][m][n], sc);
      epi.row_end(row, ss, fq);
      if (m & 1) asm volatile("" ::: "memory");
    }
    }
  }
#undef SA
#undef SB
#undef STAGE
#undef LDA
#undef LDB
#undef MMA
}


template <int K>
__device__ __forceinline__ void gemm_tail_phase(int wv, const u16* __restrict__ A, const u16* __restrict__ Bt, float* lds, u16* __restrict__ hb, float* __restrict__ rss, const float* __restrict__ rin32_tail) {
  const int tix = tidx(wv);
  const int tid = tix, w = tid >> 6, lane = tid & 63, fr = lane & 15, fq = lane >> 4;
  for (int u = blockIdx.x; u < 256; u += gridDim.x) {
    const int tm = u >> 5, tn = u & 31;
    const u16* Ab = A + (size_t)(MP + tm * 64 + fr) * K + fq * 8;
    const u16* Bb = Bt + (size_t)(tn * 64 + fr) * K + fq * 8;
    f32x4 acc[4][4];
#pragma unroll
    for (int i = 0; i < 4; ++i)
#pragma unroll
      for (int j = 0; j < 4; ++j) acc[i][j] = f32x4{0.f, 0.f, 0.f, 0.f};
    const u16* Ab2 = A + (size_t)(MP + tm * 64 + fr) * K + fq * 16;
    const u16* Bb2 = Bt + (size_t)(tn * 64 + fr) * K + fq * 16;
#pragma unroll 1
    for (int ks = w; ks < K / 64; ks += 8) {
      bf16x8 a[4][2], b[4][2];
#pragma unroll
      for (int i = 0; i < 4; ++i) {
        a[i][0] = *(const bf16x8*)(Ab2 + (size_t)i * 16 * K + ks * 64);
        a[i][1] = *(const bf16x8*)(Ab2 + (size_t)i * 16 * K + ks * 64 + 8);
        b[i][0] = *(const bf16x8*)(Bb2 + (size_t)i * 16 * K + ks * 64);
        b[i][1] = *(const bf16x8*)(Bb2 + (size_t)i * 16 * K + ks * 64 + 8);
      }
#pragma unroll
      for (int mb = 0; mb < 4; ++mb)
#pragma unroll
        for (int nb = 0; nb < 4; ++nb) {
          acc[mb][nb] = __builtin_amdgcn_mfma_f32_16x16x32_bf16(b[nb][0], a[mb][0], acc[mb][nb], 0, 0, 0);
          acc[mb][nb] = __builtin_amdgcn_mfma_f32_16x16x32_bf16(b[nb][1], a[mb][1], acc[mb][nb], 0, 0, 0);
        }
    }
    __syncthreads();
#pragma unroll
    for (int mb = 0; mb < 4; ++mb)
#pragma unroll
      for (int nb = 0; nb < 4; ++nb) *(f32x4*)(lds + w * 4096 + (mb * 16 + fr) * 64 + nb * 16 + fq * 4) = acc[mb][nb];
    __syncthreads();
    const int e = tid * 8, row = e >> 6, col = e & 63;
    float4 s0 = make_float4(0.f, 0.f, 0.f, 0.f), s1 = s0;
#pragma unroll
    for (int ww = 0; ww < 8; ++ww) {
      float4 x0 = *(const float4*)(lds + ww * 4096 + e), x1 = *(const float4*)(lds + ww * 4096 + e + 4);
      s0.x += x0.x; s0.y += x0.y; s0.z += x0.z; s0.w += x0.w;
      s1.x += x1.x; s1.y += x1.y; s1.z += x1.z; s1.w += x1.w;
    }
    const int grow = MP + tm * 64 + row;
    u16* q = hb + (size_t)grow * D + tn * 64 + col;
    float r8[8];
    if (rin32_tail) {
      const float* rq_ = rin32_tail + (size_t)(tm * 64 + row) * D + tn * 64 + col;
      const float4 a0 = *(const float4*)rq_, a1 = *(const float4*)(rq_ + 4);
      r8[0] = a0.x; r8[1] = a0.y; r8[2] = a0.z; r8[3] = a0.w; r8[4] = a1.x; r8[5] = a1.y; r8[6] = a1.z; r8[7] = a1.w;
    } else ld8(q, r8);
    r8[0] += s0.x; r8[1] += s0.y; r8[2] += s0.z; r8[3] += s0.w; r8[4] += s1.x; r8[5] += s1.y; r8[6] += s1.z; r8[7] += s1.w;
    st8(q, r8);
    if (rss) {
      float ss = 0.f;
#pragma unroll
      for (int e2 = 0; e2 < 8; ++e2) ss += r8[e2] * r8[e2];
      ss += __shfl_xor(ss, 1, 64); ss += __shfl_xor(ss, 2, 64); ss += __shfl_xor(ss, 4, 64);
      if ((tid & 7) == 0) unsafeAtomicAdd(rss + grow, ss);
    }
  }
}

template <int MODE>
__device__ __forceinline__ void prep_range(int wv, const Params& p, int u0, int u1, int ustride, unsigned char* shm) {
  const int tix = tidx(wv);
  constexpr int K = (MODE == 2) ? 256 : 128;
  constexpr int V = (MODE == 0) ? 256 : (MODE == 1 ? 128 : 512);
  constexpr int H = (MODE == 1) ? 8 : 4;
  constexpr int LD = (MODE == 2) ? NINO_PAD : NINE;
  constexpr int NSEG = 4, TL = 16, KS = K + 8, VS = V + 8, NPASS = K / 128;
  constexpr int NQ = K / 64, NV = V / 64;
  constexpr bool PFV = false;
  const int tid = tix, seg = tid >> 7;
  const u16* proj = (const u16*)(p.ws + OFF_BIG);
  unsigned char* R = p.ws + OFF_R;
  u16* qin = (u16*)(R + (MODE == 0 ? R_QA : MODE == 1 ? R_QB : R_QC));
  u16* koT = (u16*)(R + (MODE == 0 ? R_KA : MODE == 1 ? R_KB : R_KC));
  u16* vT = (u16*)(R + (MODE == 0 ? R_VA : MODE == 1 ? R_VB : R_VC));
  u16* Pm = (u16*)(R + (MODE == 0 ? R_PA : MODE == 1 ? R_PB : R_PC));
  float* dL = (float*)(R + (MODE == 0 ? R_DA : MODE == 1 ? R_DB : R_DC));
  u16* qs = (u16*)shm;
  u16* ksm = qs + 64 * KS;
  float* segtot = (float*)(ksm + 64 * KS);
  float* gl = segtot + NSEG * K;
  u16* rq = (u16*)(gl + 64 * 16);
  u16* rk = rq + 64 * KS;
  u16* rv = PFV ? rk + 64 * KS : rq;
  typedef __attribute__((ext_vector_type(4))) unsigned u32x4_t;
  u32x4_t rqr[NQ], rkr[NQ], rvr[PFV ? NV : 1];
#define PREP_ISSUE(uu_) do { \
    const int c_i = (uu_) / H, h_i = (uu_) % H; \
    const int row0_i = (c_i < 128) ? (c_i >> 5) * 2048 + (c_i & 31) * 64 : MP + (c_i - 128) * 64; \
    const u16* prow_i = proj + (size_t)row0_i * LD; \
    const int cq_i = (MODE == 0) ? h_i * 128 : (MODE == 1 ? 3072 + h_i * 128 : h_i * 256); \
    const int ck_i = (MODE == 0) ? 512 + h_i * 128 : (MODE == 1 ? 4096 + h_i * 128 : 1024 + h_i * 256); \
    const int vc_i = (MODE == 0) ? 1024 + h_i * 256 : (MODE == 1 ? 5120 + h_i * 128 : 2048 + h_i * 512); \
    _Pragma("unroll") for (int i = 0; i < NQ; ++i) { \
      const int idx = tid + i * 512, r = idx / (K / 8), cc = idx % (K / 8); \
      rqr[i] = *(const u32x4_t*)(prow_i + (size_t)r * LD + cq_i + cc * 8); \
      rkr[i] = *(const u32x4_t*)(prow_i + (size_t)r * LD + ck_i + cc * 8); \
    } \
    if constexpr (PFV) { \
      _Pragma("unroll") for (int i = 0; i < NV; ++i) { \
        const int idx = tid + i * 512, r = idx / (V / 8), cc = idx % (V / 8); \
        rvr[i] = *(const u32x4_t*)(prow_i + (size_t)r * LD + vc_i + cc * 8); \
      } \
    } } while (0)
  if (u0 < u1) PREP_ISSUE(u0);
#pragma unroll 1
  for (int uu = u0; uu < u1; uu += ustride) {
  const int c = uu / H, h = uu % H;
  int row0, pos0;
  if (c < 128) { row0 = (c >> 5) * 2048 + (c & 31) * 64; pos0 = (c & 31) * 64; }
  else { row0 = MP + (c - 128) * 64; pos0 = 1024; }
  const size_t u = (size_t)c * H + h;
  const u16* prow = proj + (size_t)row0 * LD;
  const int vc0 = (MODE == 0) ? 1024 + h * 256 : (MODE == 1 ? 5120 + h * 128 : 2048 + h * 512);
  __syncthreads();
#pragma unroll
  for (int i = 0; i < NQ; ++i) {
    const int idx = tid + i * 512, r = idx / (K / 8), cc = idx % (K / 8);
    *(u32x4_t*)(rq + r * KS + cc * 8) = rqr[i];
    *(u32x4_t*)(rk + r * KS + cc * 8) = rkr[i];
  }
  if constexpr (PFV) {
#pragma unroll
    for (int i = 0; i < NV; ++i) {
      const int idx = tid + i * 512, r = idx / (V / 8), cc = idx % (V / 8);
      *(u32x4_t*)(rv + r * VS + cc * 8) = rvr[i];
    }
  }
  if (MODE == 2) {
    for (int i = tid; i < 64 * 2; i += 512) {
      const int r = i >> 1, hh = i & 1;
      uint4 g4 = *(const uint4*)(prow + (size_t)r * LD + 6144 + hh * 8);
      float* d = gl + r * 16 + hh * 8;
      d[0] = __uint_as_float(g4.x << 16); d[1] = __uint_as_float(g4.x & 0xffff0000u);
      d[2] = __uint_as_float(g4.y << 16); d[3] = __uint_as_float(g4.y & 0xffff0000u);
      d[4] = __uint_as_float(g4.z << 16); d[5] = __uint_as_float(g4.z & 0xffff0000u);
      d[6] = __uint_as_float(g4.w << 16); d[7] = __uint_as_float(g4.w & 0xffff0000u);
    }
  }
  if (uu + ustride < u1) PREP_ISSUE(uu + ustride);
  __builtin_amdgcn_sched_barrier(0);
  __syncthreads();
#pragma unroll 1
  for (int pass = 0; pass < NPASS; ++pass) {
  const int kk = pass * 128 + (tid & 127);
  float qv[TL], kv[TL], bc[TL];
  if (MODE == 0) {
    const int j = kk & 63;
    const float invr = exp2f(-(float)j * (13.287712379549449f / 64.f)) * 0.15915494309189535f;
    const float lgam = log1pf(-exp2f(-5.f - (float)h));
#pragma unroll
    for (int i = 0; i < TL; ++i) {
      const int l = seg * TL + i;
      float rev = (float)(pos0 + l) * invr;
      rev -= floorf(rev);
      const float sn = __builtin_amdgcn_sinf(rev), cs = __builtin_amdgcn_cosf(rev);
      const float q1 = bf2f(rq[l * KS + j]), q2 = bf2f(rq[l * KS + j + 64]), k1 = bf2f(rk[l * KS + j]), k2 = bf2f(rk[l * KS + j + 64]);
      const float qr = (kk < 64) ? q1 * cs - q2 * sn : q1 * sn + q2 * cs;
      const float kr = (kk < 64) ? k1 * cs - k2 * sn : k1 * sn + k2 * cs;
      qv[i] = qr; kv[i] = kr * 0.08838834764831845f;
      bc[i] = lgam;
    }
  } else if (MODE == 1) {
    const int ch = h * 128 + kk;
    const float* lbp = p.in[11];
    float e0 = __expf(lbp[ch]), e1 = __expf(lbp[1024 + ch]), e2 = __expf(lbp[2048 + ch]);
    const float lb = e0 / (e0 + e1 + e2);
#pragma unroll
    for (int i = 0; i < TL; ++i) {
      const int l = seg * TL + i;
      const float qx = bf2f(rq[l * KS + kk]), fx = bf2f(rk[l * KS + kk]);
      qv[i] = siluf_(qx) * 0.08838834764831845f;
      const float sg = sigmoidf_(fx);
      const float f = lb + (1.f - lb) * sg;
      kv[i] = (1.f - lb) * (1.f - sg);
      bc[i] = __logf(f);
    }
  } else {
    const int ch = h * 256 + kk;
    const float* w2 = p.in[14];
    float wvv[16];
#pragma unroll
    for (int r = 0; r < 16; ++r) wvv[r] = w2[r * 1024 + ch];
    const float bias = p.in[15][ch];
#pragma unroll
    for (int i = 0; i < TL; ++i) {
      const int l = seg * TL + i;
      qv[i] = bf2f(rq[l * KS + kk]) * 0.0625f;
      kv[i] = bf2f(rk[l * KS + kk]);
      float x = bias;
#pragma unroll
      for (int r = 0; r < 16; ++r) x += gl[l * 16 + r] * wvv[r];
      const float ls = fminf(x, 0.f) - log1pf(__expf(-fabsf(x)));
      bc[i] = ls * (1.f / 16.f);
    }
  }
#pragma unroll
  for (int i = 1; i < TL; ++i) bc[i] += bc[i - 1];
  segtot[seg * K + kk] = bc[TL - 1];
  __syncthreads();
  float pre = 0.f, bL = 0.f;
#pragma unroll
  for (int sg = 0; sg < NSEG; ++sg) { float t = segtot[sg * K + kk]; bL += t; if (sg < seg) pre += t; }
  if (seg == 0) dL[u * K + kk] = __expf(bL);
  unsigned kop[TL / 2];
#pragma unroll
  for (int i = 0; i < TL; i += 2) {
    float ko2[2];
#pragma unroll
    for (int e = 0; e < 2; ++e) {
      const int l = seg * TL + i + e;
      const float b = bc[i + e] + pre;
      const float qi = qv[i + e] * __expf(b);
      const float ki = kv[i + e] * __expf(-b);
      ko2[e] = kv[i + e] * __expf(bL - b);
      const u16 qb = f2bf(qi);
      qs[l * KS + kk] = qb;
      ksm[l * KS + kk] = f2bf(ki);
    }
    kop[i / 2] = pack2(ko2[0], ko2[1]);
  }
  {
#pragma unroll
    for (int i = 0; i < TL / 8; ++i) {
      const int cc = seg * 2 + i;
      uint4* dst = (uint4*)(koT + u * K * 64 + ((((kk >> 4) * 2 + (cc >> 2)) * 64 + (cc & 3) * 16 + (kk & 15)) << 3));
      *dst = make_uint4(kop[i * 4 + 0], kop[i * 4 + 1], kop[i * 4 + 2], kop[i * 4 + 3]);
    }
  }
  }
  __syncthreads();
  for (int i = tid; i < 64 * (K / 8); i += 512) {
    const int r = i / (K / 8), cc = i % (K / 8);
    *(uint4*)(qin + u * 64 * K + ((((r >> 4) * (K / 32) + (cc >> 2)) * 64 + (cc & 3) * 16 + (r & 15)) << 3)) = *(const uint4*)(qs + r * KS + cc * 8);
  }
  {
    const int w = tid >> 6, lane = tid & 63, fr = lane & 15, fq = lane >> 4;
#pragma unroll 1
    for (int bi = 0; bi < 2; ++bi) {
      const int blk = w + bi * 8, lb = blk >> 2, sb = blk & 3;
      f32x4 acc = {0.f, 0.f, 0.f, 0.f};
      if (sb <= lb) {
#pragma unroll
        for (int kst = 0; kst < K / 32; ++kst) {
          bf16x8 a = *(const bf16x8*)(ksm + (sb * 16 + fr) * KS + kst * 32 + fq * 8);
          bf16x8 b = *(const bf16x8*)(qs + (lb * 16 + fr) * KS + kst * 32 + fq * 8);
          acc = __builtin_amdgcn_mfma_f32_16x16x32_bf16(a, b, acc, 0, 0, 0);
        }
      }
      const int l = lb * 16 + fr, s0 = sb * 16 + fq * 4;
      float v0 = (s0 + 0 <= l) ? acc[0] : 0.f, v1 = (s0 + 1 <= l) ? acc[1] : 0.f;
      float v2 = (s0 + 2 <= l) ? acc[2] : 0.f, v3 = (s0 + 3 <= l) ? acc[3] : 0.f;
      *(uint2*)(Pm + u * 4096 + ((((lb * 2 + (s0 >> 5)) * 64 + ((s0 & 31) >> 3) * 16 + fr) << 3) + (s0 & 7))) = make_uint2(pack2(v0, v1), pack2(v2, v3));
    }
  }
  }
}

template <int K, int V>
__device__ __forceinline__ void seq_unit(int wv, const u16* __restrict__ qin, const u16* __restrict__ koT, const u16* __restrict__ Pm, const u16* __restrict__ vsrc, int vld,
                         const float* __restrict__ dL, int H, int c0, int nch, int h, int vs,
                         const float* __restrict__ s0, float* __restrict__ sout, u16* __restrict__ o, int row0, int ocol, unsigned char* shm) {
  const int tix = tidx(wv);
  constexpr int NKB = K / 128, SST = K + 8;
  u16* ST = (u16*)shm;
  const int tid = tix, w = tid >> 6, lane = tid & 63, fr = lane & 15, fq = lane >> 4;
  f32x4 accS[NKB][2];
  __syncthreads();
#pragma unroll
  for (int kb = 0; kb < NKB; ++kb)
#pragma unroll
    for (int vb = 0; vb < 2; ++vb) {
      const int k = (w * NKB + kb) * 16 + fq * 4, vcol = vb * 16 + fr;
#pragma unroll
      for (int j = 0; j < 4; ++j) accS[kb][vb][j] = s0 ? s0[(size_t)(k + j) * V + vs * 32 + vcol] : 0.f;
      *(uint2*)(ST + vcol * SST + k) = make_uint2(pack2(accS[kb][vb][0], accS[kb][vb][1]), pack2(accS[kb][vb][2], accS[kb][vb][3]));
    }
  constexpr int VTS = 72;
  u16* VT = ST + 2 * 32 * SST;
  const int v_s = (tid >> 2) & 63, v_p = tid & 3;
  const u16* vrow = vsrc + (size_t)v_s * vld + v_p * 8;
  u32x4_t vreg = {0u, 0u, 0u, 0u};
  if (tid < 256) {
    vreg = *(const u32x4_t*)vrow;
#pragma unroll
    for (int j = 0; j < 4; ++j) {
      VT[(v_p * 8 + 2 * j) * VTS + v_s] = (u16)(vreg[j] & 0xffffu);
      VT[(v_p * 8 + 2 * j + 1) * VTS + v_s] = (u16)(vreg[j] >> 16);
    }
  }
  __syncthreads();
  int cur = 0;
  const int lb = w >> 1, ovb = w & 1;
  struct FragsO { bf16x8 op[2], oq[K / 32]; };
  struct FragsS { bf16x8 ka[NKB][2]; float4 d[NKB]; };
  auto load_o = [&](int ci, FragsO& f) {
    const size_t u = (size_t)(c0 + ci) * H + h;
    const u16* Pu = Pm + u * 4096;
    const u16* qu = qin + u * 64 * K;
#pragma unroll
    for (int ss = 0; ss < 2; ++ss) f.op[ss] = *(const bf16x8*)(Pu + (((lb * 2 + ss) * 64 + lane) << 3));
#pragma unroll
    for (int kst = 0; kst < K / 32; ++kst) f.oq[kst] = *(const bf16x8*)(qu + (((lb * (K / 32) + kst) * 64 + lane) << 3));
  };
  auto load_s = [&](int ci, FragsS& f) {
    const size_t u = (size_t)(c0 + ci) * H + h;
    const u16* ku = koT + u * K * 64;
    const float* du = dL + u * K;
#pragma unroll
    for (int kb = 0; kb < NKB; ++kb) {
      const int kbase = (w * NKB + kb) * 16;
      f.d[kb] = *(const float4*)(du + kbase + fq * 4);
      f.ka[kb][0] = *(const bf16x8*)(ku + ((((w * NKB + kb) * 2 + 0) * 64 + lane) << 3));
      f.ka[kb][1] = *(const bf16x8*)(ku + ((((w * NKB + kb) * 2 + 1) * 64 + lane) << 3));
    }
  };
  FragsO fo;
  FragsS f0;
  load_o(0, fo);
  load_s(0, f0);
  for (int ci = 0; ci < nch; ++ci) {
    const int cn = ci + 1 < nch ? ci + 1 : ci;
    FragsO fo1;
    FragsS f1;
    load_o(cn, fo1);
    load_s(cn, f1);
    if (tid < 256) vreg = *(const u32x4_t*)(vrow + (size_t)cn * 64 * vld);
    __builtin_amdgcn_sched_barrier(0);
    const u16* STc = ST + cur * 32 * SST;
    u16* STn = ST + (cur ^ 1) * 32 * SST;
    const u16* VTc = VT + cur * 32 * VTS;
    u16* VTn = VT + (cur ^ 1) * 32 * VTS;
    bf16x8 vf[2][2];
#pragma unroll
    for (int vb = 0; vb < 2; ++vb)
#pragma unroll
      for (int ss = 0; ss < 2; ++ss) vf[vb][ss] = *(const bf16x8*)(VTc + (vb * 16 + fr) * VTS + ss * 32 + fq * 8);
    f32x4 ao = {0.f, 0.f, 0.f, 0.f};
#pragma unroll
    for (int ss = 0; ss < 2; ++ss) {
      bf16x8 a = *(const bf16x8*)(VTc + (ovb * 16 + fr) * VTS + ss * 32 + fq * 8);
      ao = __builtin_amdgcn_mfma_f32_16x16x32_bf16(a, fo.op[ss], ao, 0, 0, 0);
    }
#pragma unroll
    for (int kst = 0; kst < K / 32; ++kst) {
      bf16x8 a = *(const bf16x8*)(STc + (ovb * 16 + fr) * SST + kst * 32 + fq * 8);
      ao = __builtin_amdgcn_mfma_f32_16x16x32_bf16(a, fo.oq[kst], ao, 0, 0, 0);
    }
    *(uint2*)(o + (size_t)(row0 + ci * 64 + lb * 16 + fr) * D + ocol + vs * 32 + ovb * 16 + fq * 4) =
        make_uint2(pack2(ao[0], ao[1]), pack2(ao[2], ao[3]));
#pragma unroll
    for (int kb = 0; kb < NKB; ++kb) {
      const int kbase = (w * NKB + kb) * 16;
      const float4 d4 = f0.d[kb];
#pragma unroll
      for (int vb = 0; vb < 2; ++vb) {
        f32x4 sv = accS[kb][vb];
        sv[0] *= d4.x; sv[1] *= d4.y; sv[2] *= d4.z; sv[3] *= d4.w;
        sv = __builtin_amdgcn_mfma_f32_16x16x32_bf16(f0.ka[kb][0], vf[vb][0], sv, 0, 0, 0);
        sv = __builtin_amdgcn_mfma_f32_16x16x32_bf16(f0.ka[kb][1], vf[vb][1], sv, 0, 0, 0);
        accS[kb][vb] = sv;
        *(uint2*)(STn + (vb * 16 + fr) * SST + kbase + fq * 4) = make_uint2(pack2(sv[0], sv[1]), pack2(sv[2], sv[3]));
      }
    }
    if (tid < 256) {
#pragma unroll
      for (int j = 0; j < 4; ++j) {
        VTn[(v_p * 8 + 2 * j) * VTS + v_s] = (u16)(vreg[j] & 0xffffu);
        VTn[(v_p * 8 + 2 * j + 1) * VTS + v_s] = (u16)(vreg[j] >> 16);
      }
    }
    asm volatile("s_waitcnt lgkmcnt(0)" ::: "memory");
    __builtin_amdgcn_s_barrier();
    asm volatile("" ::: "memory");
    cur ^= 1;
    f0 = f1;
    fo = fo1;
  }
#pragma unroll
  for (int kb = 0; kb < NKB; ++kb)
#pragma unroll
    for (int vb = 0; vb < 2; ++vb) {
      const int k = (w * NKB + kb) * 16 + fq * 4, vcol = vb * 16 + fr;
#pragma unroll
      for (int j = 0; j < 4; ++j) sout[(size_t)(k + j) * V + vs * 32 + vcol] = accS[kb][vb][j];
    }
}

__device__ __forceinline__ void seq_even_phase(int wv, const Params& p, unsigned char* shm) {
  unsigned char* R = p.ws + OFF_R;
  u16* o = (u16*)(p.ws + OFF_H);
  for (int u = blockIdx.x; u < 768; u += gridDim.x) {
    if (u < 256) {
      const int x = u & 7, y = u >> 3;
      if (y < 16) {
        const int g = x * 2 + (y >> 3), b = g >> 2, h = g & 3, vs = y & 7;
        seq_unit<128, 256>(wv, (u16*)(R + R_QA), (u16*)(R + R_KA), (u16*)(R + R_PA), (const u16*)(p.ws + OFF_BIG) + (size_t)(b * 2048) * NINE + 1024 + h * 256 + vs * 32, NINE, (float*)(R + R_DA), 4, b * 32, 32, h, vs,
                           nullptr, p.out + O_RETP + (size_t)(b * 4 + h) * 128 * 256, o, b * 2048, h * 256, shm);
      } else {
        const int yy = y - 16, g = x * 4 + (yy >> 2), b = g >> 3, h = g & 7, vs = yy & 3;
        seq_unit<128, 128>(wv, (u16*)(R + R_QB), (u16*)(R + R_KB), (u16*)(R + R_PB), (const u16*)(p.ws + OFF_BIG) + (size_t)(b * 2048) * NINE + 5120 + h * 128 + vs * 32, NINE, (float*)(R + R_DB), 8, b * 32, 32, h, vs,
                           nullptr, p.out + O_HGP + (size_t)(b * 8 + h) * 128 * 128, o, b * 2048, 1024 + h * 128, shm);
      }
    } else if (u < 512) {
      int x = u - 256, b = x >> 5, h = (x >> 3) & 3, vs = x & 7;
      seq_unit<128, 256>(wv, (u16*)(R + R_QA), (u16*)(R + R_KA), (u16*)(R + R_PA), (const u16*)(p.ws + OFF_BIG) + (size_t)(MP + b * 64) * NINE + 1024 + h * 256 + vs * 32, NINE, (float*)(R + R_DA), 4, 128 + b, 1, h, vs,
                         p.in[2] + (size_t)(b * 4 + h) * 128 * 256, p.out + O_RETS + (size_t)(b * 4 + h) * 128 * 256, o, MP + b * 64, h * 256, shm);
    } else {
      int x = u - 512, b = x >> 5, h = (x >> 2) & 7, vs = x & 3;
      seq_unit<128, 128>(wv, (u16*)(R + R_QB), (u16*)(R + R_KB), (u16*)(R + R_PB), (const u16*)(p.ws + OFF_BIG) + (size_t)(MP + b * 64) * NINE + 5120 + h * 128 + vs * 32, NINE, (float*)(R + R_DB), 8, 128 + b, 1, h, vs,
                         p.in[3] + (size_t)(b * 8 + h) * 128 * 128, p.out + O_HGS + (size_t)(b * 8 + h) * 128 * 128, o, MP + b * 64, 1024 + h * 128, shm);
    }
  }
}
__device__ __forceinline__ void seq_odd_phase(int wv, const Params& p, unsigned char* shm) {
  unsigned char* R = p.ws + OFF_R;
  u16* o = (u16*)(p.ws + OFF_H);
  for (int u = blockIdx.x; u < 768; u += gridDim.x) {
    if (u < 256) {
      const int x = u & 7, y = u >> 3, g = x * 2 + (y >> 4), b = g >> 2, h = g & 3, vs = y & 15;
      seq_unit<256, 512>(wv, (u16*)(R + R_QC), (u16*)(R + R_KC), (u16*)(R + R_PC), (const u16*)(p.ws + OFF_BIG) + (size_t)(b * 2048) * NINO_PAD + 2048 + h * 512 + vs * 32, NINO_PAD, (float*)(R + R_DC), 4, b * 32, 32, h, vs,
                         nullptr, p.out + O_GLP + (size_t)(b * 4 + h) * 256 * 512, o, b * 2048, h * 512, shm);
    } else {
      int x = u - 256, b = x >> 6, h = (x >> 4) & 3, vs = x & 15;
      seq_unit<256, 512>(wv, (u16*)(R + R_QC), (u16*)(R + R_KC), (u16*)(R + R_PC), (const u16*)(p.ws + OFF_BIG) + (size_t)(MP + b * 64) * NINO_PAD + 2048 + h * 512 + vs * 32, NINO_PAD, (float*)(R + R_DC), 4, 128 + b, 1, h, vs,
                         p.in[4] + (size_t)(b * 4 + h) * 256 * 512, p.out + O_GLS + (size_t)(b * 4 + h) * 256 * 512, o, MP + b * 64, h * 512, shm);
    }
  }
}

__device__ __forceinline__ void up8(u32x4_t v, float* f) {
  f[0] = __uint_as_float(v[0] << 16); f[1] = __uint_as_float(v[0] & 0xffff0000u);
  f[2] = __uint_as_float(v[1] << 16); f[3] = __uint_as_float(v[1] & 0xffff0000u);
  f[4] = __uint_as_float(v[2] << 16); f[5] = __uint_as_float(v[2] & 0xffff0000u);
  f[6] = __uint_as_float(v[3] << 16); f[7] = __uint_as_float(v[3] & 0xffff0000u);
}
template <int ODD>
__device__ __forceinline__ void post_phase(int wv, const Params& p) {
  const int tix = tidx(wv);
  const int lane = tix & 63, gw = blockIdx.x * 8 + (tix >> 6), nw = gridDim.x * 8;
  const u16* o = (const u16*)(p.ws + OFF_H);
  const u16* proj = (const u16*)(p.ws + OFF_BIG);
  u16* ao = (u16*)(p.ws + OFF_R);
#define POST_LOAD(xr_, gr_, row_) do { const int r_ = (row_); \
    _Pragma("unroll") for (int i = 0; i < 4; ++i) { const int col_ = i * 512 + lane * 8; \
      xr_[i] = *(const u32x4_t*)(o + (size_t)r_ * D + col_); \
      gr_[i] = *(const u32x4_t*)(proj + (size_t)r_ * (ODD ? NINO_PAD : NINE) + (ODD ? 4096 + col_ : (i < 2 ? 2048 + col_ : 6144 + (col_ - 1024)))); } } while (0)
  u32x4_t xr[4], gr[4];
  if (gw < MT) POST_LOAD(xr, gr, gw);
#pragma unroll 1
  for (int row = gw; row < MT; row += nw) {
    u32x4_t xn[4], gn4[4];
    if (row + nw < MT) POST_LOAD(xn, gn4, row + nw);
    else {
#pragma unroll
      for (int i = 0; i < 4; ++i) { xn[i] = xr[i]; gn4[i] = gr[i]; }
    }
    __builtin_amdgcn_sched_barrier(0);
#pragma unroll
    for (int i = 0; i < 4; ++i) {
      const int col = i * 512 + lane * 8;
      float x[8], g[8], y[8];
      up8(xr[i], x);
      up8(gr[i], g);
      if (ODD) {
        float ss = 0.f;
#pragma unroll
        for (int e = 0; e < 8; ++e) ss += x[e] * x[e];
#pragma unroll
        for (int off = 32; off > 0; off >>= 1) ss += __shfl_xor(ss, off, 64);
        const float rs = rsqrtf(ss * (1.f / 512.f) + EPS);
        const float* gn = p.in[16] + lane * 8;
#pragma unroll
        for (int e = 0; e < 8; ++e) y[e] = x[e] * rs * gn[e] * siluf_(g[e]);
      } else if (i < 2) {
        float s1 = 0.f;
#pragma unroll
        for (int e = 0; e < 8; ++e) s1 += x[e];
#pragma unroll
        for (int off = 16; off > 0; off >>= 1) s1 += __shfl_xor(s1, off, 64);
        const float mu = s1 * (1.f / 256.f);
        float s2 = 0.f;
#pragma unroll
        for (int e = 0; e < 8; ++e) { float dlt = x[e] - mu; s2 += dlt * dlt; }
#pragma unroll
        for (int off = 16; off > 0; off >>= 1) s2 += __shfl_xor(s2, off, 64);
        const float rs = rsqrtf(s2 * (1.f / 256.f) + EPS);
#pragma unroll
        for (int e = 0; e < 8; ++e) y[e] = (x[e] - mu) * rs * siluf_(g[e]);
      } else {
        float ss = 0.f;
#pragma unroll
        for (int e = 0; e < 8; ++e) ss += x[e] * x[e];
#pragma unroll
        for (int off = 8; off > 0; off >>= 1) ss += __shfl_xor(ss, off, 64);
        const float rs = rsqrtf(ss * (1.f / 128.f) + EPS);
        const float* gn = p.in[12] + (lane & 15) * 8;
#pragma unroll
        for (int e = 0; e < 8; ++e) y[e] = x[e] * rs * gn[e] * siluf_(g[e]);
      }
      st8(ao + (size_t)row * D + col, y);
    }
#pragma unroll
    for (int i = 0; i < 4; ++i) { xr[i] = xn[i]; gr[i] = gn4[i]; }
  }
#undef POST_LOAD
}


__device__ __forceinline__ void final_norm_phase(int wv, const Params& p) {
  const int tix = tidx(wv);
  const int lane = tix & 63, gw = blockIdx.x * 8 + (tix >> 6), nw = gridDim.x * 8;
  const u16* hb = (const u16*)(p.ws + OFF_HN);
  const float* w = p.in[8];
  u32x4_t v[4];
  if (gw < MT) {
#pragma unroll
    for (int i = 0; i < 4; ++i) v[i] = *(const u32x4_t*)(hb + (size_t)gw * D + i * 512 + lane * 8);
  }
#pragma unroll 1
  for (int row = gw; row < MT; row += nw) {
    u32x4_t nx[4];
    const int nrow = row + nw < MT ? row + nw : row;
#pragma unroll
    for (int i = 0; i < 4; ++i) nx[i] = *(const u32x4_t*)(hb + (size_t)nrow * D + i * 512 + lane * 8);
    __builtin_amdgcn_sched_barrier(0);
    float x[4][8];
    float ss = 0.f;
#pragma unroll
    for (int i = 0; i < 4; ++i) {
      up8(v[i], x[i]);
#pragma unroll
      for (int e = 0; e < 8; ++e) ss += x[i][e] * x[i][e];
    }
#pragma unroll
    for (int o = 32; o > 0; o >>= 1) ss += __shfl_xor(ss, o, 64);
    const float rs = rsqrtf(ss * (1.f / D) + EPS);
    float* dst = (row < MP) ? p.out + O_YP + (size_t)row * D : p.out + O_YS + (size_t)(row - MP) * D;
#pragma unroll
    for (int i = 0; i < 4; ++i) {
      const int col = i * 512 + lane * 8;
      const float4 w0 = *(const float4*)(w + col), w1 = *(const float4*)(w + col + 4);
      *(float4*)(dst + col) = make_float4(x[i][0] * rs * w0.x, x[i][1] * rs * w0.y, x[i][2] * rs * w0.z, x[i][3] * rs * w0.w);
      *(float4*)(dst + col + 4) = make_float4(x[i][4] * rs * w1.x, x[i][5] * rs * w1.y, x[i][6] * rs * w1.z, x[i][7] * rs * w1.w);
    }
#pragma unroll
    for (int i = 0; i < 4; ++i) v[i] = nx[i];
  }
}

__device__ __forceinline__ void gate_phase(int wv, const Params& p, int layer) {
  const int tix = tidx(wv);
  const u16* au = (const u16*)(p.ws + OFF_BIG);
  u16* gg = (u16*)(p.ws + OFF_R);
  const float* cw = p.in[19] + (size_t)layer * 3 * DFF;
  const float* cb = p.in[20] + (size_t)layer * DFF;
  const float* cache = p.in[5] + (size_t)layer * 8 * 2 * DFF;
  const int nitems = (MT / 16) * (DFF / 8);
  for (int it = blockIdx.x * 512 + tix; it < nitems; it += gridDim.x * 512) {
    const int cg8 = it % (DFF / 8), rb = it / (DFF / 8), c0 = cg8 * 8, r0 = rb * 16;
    float w0[8], w1[8], w2[8], bb[8], am2[8], am1[8];
#pragma unroll
    for (int e = 0; e < 8; ++e) { w0[e] = cw[c0 + e]; w1[e] = cw[DFF + c0 + e]; w2[e] = cw[2 * DFF + c0 + e]; bb[e] = cb[c0 + e]; }
    int t0, T, b; bool samp = r0 >= MP;
    if (!samp) { b = r0 >> 11; t0 = r0 & 2047; T = 2048; } else { b = (r0 - MP) >> 6; t0 = (r0 - MP) & 63; T = 64; }
    if (t0 == 0) {
      if (samp) {
#pragma unroll
        for (int e = 0; e < 8; ++e) { am2[e] = cache[(size_t)(b * 2 + 0) * DFF + c0 + e]; am1[e] = cache[(size_t)(b * 2 + 1) * DFF + c0 + e]; }
      } else {
#pragma unroll
        for (int e = 0; e < 8; ++e) { am2[e] = 0.f; am1[e] = 0.f; }
      }
    } else {
      ld8(au + (size_t)(r0 - 2) * NUP + c0, am2);
      ld8(au + (size_t)(r0 - 1) * NUP + c0, am1);
    }
#pragma unroll 4
    for (int i = 0; i < 16; ++i) {
      float a[8], uu[8], y[8];
      ld8(au + (size_t)(r0 + i) * NUP + c0, a);
      ld8(au + (size_t)(r0 + i) * NUP + DFF + c0, uu);
#pragma unroll
      for (int e = 0; e < 8; ++e) {
        float cv = bb[e] + w0[e] * am2[e] + w1[e] * am1[e] + w2[e] * a[e];
        y[e] = siluf_(cv) * uu[e];
        am2[e] = am1[e]; am1[e] = a[e];
      }
      st8(gg + (size_t)(r0 + i) * DFF + c0, y);
    }
    if (t0 + 16 == T) {
      float* dst = samp ? p.out + O_CVS + (size_t)(layer * 8 + b) * 2 * DFF : p.out + O_CVP + (size_t)(layer * 4 + b) * 2 * DFF;
#pragma unroll
      for (int e = 0; e < 8; ++e) { dst[c0 + e] = am2[e]; dst[DFF + c0 + e] = am1[e]; }
    }
  }
}


__device__ __forceinline__ void gate_fixup(int wv, const Params& p, int layer) {
  const int tix = tidx(wv);
  const u16* side = (const u16*)(p.ws + OFF_SIDE);
  u16* gg = (u16*)(p.ws + OFF_R);
  const float* cw = p.in[19] + (size_t)layer * 3 * DFF;
  const float* cb = p.in[20] + (size_t)layer * DFF;
  for (int vw = blockIdx.x; vw < (MP / BM) * (D / BM); vw += gridDim.x) {
    int pm, pn;
    tile_coords(vw, MP / BM, D / BM, pm, pn);
    if ((pm & 7) == 0) continue;
    for (int c8 = tix; c8 < DFF / 8; c8 += 512) {
      const int c = c8 * 8;
      float a0[8], a1[8], u0[8], u1[8], q2[8], q1[8], y0[8], y1[8];
      ld8(side + (size_t)(pm * 2 + 0) * DFF + c, a0);
      ld8(side + (size_t)(pm * 2 + 1) * DFF + c, a1);
      ld8(side + SZ_SIDE1 / 2 + (size_t)(pm * 2 + 0) * DFF + c, u0);
      ld8(side + SZ_SIDE1 / 2 + (size_t)(pm * 2 + 1) * DFF + c, u1);
      ld8(side + SZ_SIDE1 + (size_t)((pm - 1) * 2 + 0) * DFF + c, q2);
      ld8(side + SZ_SIDE1 + (size_t)((pm - 1) * 2 + 1) * DFF + c, q1);
#pragma unroll
      for (int e = 0; e < 8; ++e) {
        const float w0 = cw[c + e], w1 = cw[DFF + c + e], w2 = cw[2 * DFF + c + e], bb = cb[c + e];
        y0[e] = siluf_(bb + w0 * q2[e] + w1 * q1[e] + w2 * a0[e]) * u0[e];
        y1[e] = siluf_(bb + w0 * q1[e] + w1 * a0[e] + w2 * a1[e]) * u1[e];
      }
      st8(gg + (size_t)(pm * 256 + 0) * DFF + c, y0);
      st8(gg + (size_t)(pm * 256 + 1) * DFF + c, y1);
    }
  }
  asm volatile("s_waitcnt vmcnt(0)" ::: "memory");
  __syncthreads();
}

#define XB_TMO      128
#define XB_XCNT(j)  (256  + 64 * (j))
#define XB_XSUB(j)  (1280 + 64 * (j))
#define XB_XGEN(j)  (2304 + 64 * (j))
#define XB_TOP      3328
#define XB_TOPGEN   3392
#define XCD_BAR_WORDS 3456
#define XB_SPIN_CAP (1u << 22)
#define LAS __attribute__((address_space(3)))
__device__ __forceinline__ unsigned xb_ld(unsigned* p)              { return __hip_atomic_load(p, __ATOMIC_RELAXED, __HIP_MEMORY_SCOPE_AGENT); }
__device__ __forceinline__ unsigned xb_add(unsigned* p, unsigned v) { return __hip_atomic_fetch_add(p, v, __ATOMIC_RELAXED, __HIP_MEMORY_SCOPE_AGENT); }
__device__ __forceinline__ unsigned xb_xcc_id() { return (unsigned)__builtin_amdgcn_s_getreg((3 << 11) | 20) & 0xFu; }
#define XB_SPIN(cond, bar) do { unsigned _sp = 0; while (cond) { __builtin_amdgcn_s_sleep(1); \
    if ((++_sp & 255u) == 0u) { if (xb_ld(&(bar)[XB_TMO])) break; if (_sp > XB_SPIN_CAP) { atomicAdd(&(bar)[XB_TMO], 1u); break; } } } } while (0)
struct XcdBarrier { unsigned* bar; unsigned x; volatile LAS unsigned* st; };
__device__ __forceinline__ XcdBarrier xcd_barrier_post(int wv, unsigned* bar, volatile LAS unsigned* st) {
  XcdBarrier b; b.bar = bar; b.x = xb_xcc_id(); b.st = st;
  if (tidx(wv) == 0) (void)xb_add(&bar[XB_XCNT(b.x)], 1u);
  return b;
}
__device__ __forceinline__ void xcd_barrier_complete(unsigned* bar, unsigned x, unsigned& nloc, unsigned& nx) {
  const unsigned G = gridDim.x * gridDim.y * gridDim.z;
  unsigned sum, cnt, mine, sp = 0u;
  for (;;) {
    sum = 0u; cnt = 0u; mine = 0u;
#pragma unroll
    for (unsigned j = 0; j < 16; ++j) { const unsigned c = xb_ld(&bar[XB_XCNT(j)]); sum += c; cnt += (c > 0u) ? 1u : 0u; mine = (j == x) ? c : mine; }
    if (sum == G) break;
    __builtin_amdgcn_s_sleep(1);
    if ((++sp & 255u) == 0u) { if (xb_ld(&bar[XB_TMO])) break; if (sp > XB_SPIN_CAP) { atomicAdd(&bar[XB_TMO], 1u); break; } }
  }
  nloc = mine > 0u ? mine : 1u; nx = cnt > 0u ? cnt : 1u;
}
__device__ __forceinline__ void xcd_barrier(int wv, const XcdBarrier& b) {
  asm volatile("s_waitcnt vmcnt(0)" ::: "memory");
  __syncthreads();
  if (tidx(wv) == 0) {
    unsigned* bar = b.bar;
    __builtin_amdgcn_s_waitcnt(0);
    unsigned nloc = b.st[0], nx = b.st[1];
    if (nloc == 0u) { xcd_barrier_complete(bar, b.x, nloc, nx); b.st[0] = nloc; b.st[1] = nx; }
    const unsigned old = xb_add(&bar[XB_XSUB(b.x)], 1u);
    const unsigned gen = old / nloc;
    if (old + 1u == (gen + 1u) * nloc) {
      __builtin_amdgcn_fence(__ATOMIC_RELEASE, "agent");
      asm volatile("s_waitcnt vmcnt(0)" ::: "memory");
      const unsigned og = xb_add(&bar[XB_TOP], 1u);
      const unsigned tg = og / nx;
      if (og + 1u == (tg + 1u) * nx) xb_add(&bar[XB_TOPGEN], 1u);
      else XB_SPIN(xb_ld(&bar[XB_TOPGEN]) == tg, bar);
      __builtin_amdgcn_fence(__ATOMIC_ACQUIRE, "agent");
      xb_add(&bar[XB_XGEN(b.x)], 1u);
      asm volatile("s_waitcnt vmcnt(0)" ::: "memory");
    } else {
      XB_SPIN(xb_ld(&bar[XB_XGEN(b.x)]) == gen, bar);
      __builtin_amdgcn_fence(__ATOMIC_ACQUIRE, "agent");
      asm volatile("s_waitcnt vmcnt(0)" ::: "memory");
    }
  }
  __syncthreads();
}

constexpr int NPHASE = 21;
#ifndef PHMASK
#define PHMASK 0xFFFFFFFFu
#endif
#define PH_ON(k) (((PHMASK) >> (k)) & 1u)
constexpr int LDS_BYTES = 147456;

typedef const __attribute__((address_space(4))) Params* KParamsPtr;
#ifndef XSYNC
#define XSYNC 0
#endif
#ifndef DUPMASK
#define DUPMASK 0u
#endif
#define DUP_ON(k) (((DUPMASK) >> (k)) & 1u)
__device__ __forceinline__ bool ph_in(KParamsPtr& kp, int k) { asm volatile("" : "+s"(kp)); return kp->ph_lo <= k && k < kp->ph_hi; }
#define PH_IN(k) ph_in(kp, (k))
#define PHASE(k, ...) if (PH_IN(k)) { if (PH_ON(k)) { for (int rep = 0; rep < 1 + (int)DUP_ON(k); ++rep) { asm volatile("" : "+s"(kp)); Params p; __builtin_memcpy(&p, kp, sizeof(Params)); unsigned char* ws = p.ws; __VA_ARGS__ } } \
    asm volatile("" : "+s"(kp)); \
    if (kp->coop && (k) + 1 < kp->ph_hi) { XcdBarrier xb; xb.bar = (unsigned*)(kp->ws + OFF_BAR); xb.x = xb_xcc_id(); xb.st = (volatile LAS unsigned*)&xb_words; xcd_barrier(wv, xb); if (XSYNC) xcd_barrier(wv, xb); } }
#define PHASE_X(k, ...) if (PH_IN(k)) { asm volatile("" : "+s"(kp)); Params p; __builtin_memcpy(&p, kp, sizeof(Params)); unsigned char* ws = p.ws; __VA_ARGS__ }
#define GEMM_ACC(k, Aoff, Woff, KK, RSSP, FIXL, RINP, RINS) PHASE(k, { float* rssp = (RSSP); if ((FIXL) >= 0) gate_fixup(wv, p, FIXL); \
    gemm_phase<MP, D, KK, 0>(wv, (const u16*)(ws + Aoff), (const u16*)(ws + Woff), EpiAccum{(u16*)(ws + OFF_HN), rssp, (RINP)}, (u16*)shm); \
    gemm_tail_phase<KK>(wv, (const u16*)(ws + Aoff), (const u16*)(ws + Woff), (float*)shm, (u16*)(ws + OFF_HN), rssp, (RINS)); })

__global__ void __launch_bounds__(512) fwd_kernel(Params p_) {
  extern __shared__ __attribute__((aligned(16))) unsigned char shm[];
  cg::grid_group grid = cg::this_grid();
  KParamsPtr kp = (KParamsPtr)__builtin_amdgcn_kernarg_segment_ptr();
  const int wv = __builtin_amdgcn_readfirstlane((int)(threadIdx.x >> 6));
  __shared__ uint4 xb_words;
  if (tidx(wv) == 0) xb_words = make_uint4(0u, 0u, 0u, 0u);
  __syncthreads();
  if (kp->coop == 2) grid.sync();
  (void)xcd_barrier_post(wv, (unsigned*)(kp->ws + OFF_BAR), (volatile LAS unsigned*)&xb_words);
  PHASE(0,
        convert_w(wv, p.in[9], (u16*)(ws + OFF_WINE), D, NINE, NINE, (u16*)shm);
        convert_w(wv, p.in[10], (u16*)(ws + OFF_WOUTE), D, D, D, (u16*)shm);
        convert_w(wv, p.in[13], (u16*)(ws + OFF_WINO), D, NINO, NINO_PAD, (u16*)shm, p.in[6] + D);
        convert_w(wv, p.in[17], (u16*)(ws + OFF_WOUTO), D, D, D, (u16*)shm);
        convert_w(wv, p.in[18], (u16*)(ws + OFF_WUP0), D, NUP, NUP, (u16*)shm, p.in[7], 1);
        convert_w(wv, p.in[18] + (size_t)D * NUP, (u16*)(ws + OFF_WUP1), D, NUP, NUP, (u16*)shm, p.in[7] + D, 1);
        convert_w(wv, p.in[21], (u16*)(ws + OFF_WDN0), DFF, D, D, (u16*)shm);
        convert_w(wv, p.in[21] + (size_t)DFF * D, (u16*)(ws + OFF_WDN1), DFF, D, D, (u16*)shm);
        for (int i = blockIdx.x * 512 + tidx(wv); i < 3 * MT; i += gridDim.x * 512) ((float*)(ws + OFF_RSS))[i] = 0.f;
        rmsnorm_phase<0>(wv, p, p.in[6]);)
  PHASE(1, gemm_phase<MT, NINE, D, 0>(wv, (const u16*)(ws + OFF_HN), (const u16*)(ws + OFF_WINE), EpiStoreBf16{(u16*)(ws + OFF_BIG), NINE, nullptr}, (u16*)shm);)
  PHASE(2, { const int b_ = blockIdx.x, G_ = gridDim.x;
        prep_range<0>(wv, p, b_, NCH * 4, G_, shm);
        const int first1 = ((NCH * 4 - b_ + G_ - 1) / G_) * G_ + b_ - NCH * 4;
        prep_range<1>(wv, p, first1, NCH * 8, G_, shm); })
  PHASE(3, seq_even_phase(wv, p, shm);)
  PHASE(4, post_phase<0>(wv, p);)
  GEMM_ACC(5, OFF_R, OFF_WOUTE, D, (float*)(ws + OFF_RSS), -1, p.in[0], p.in[1])
  PHASE(7, gemm_phase<MT, NUP, D, 0>(wv, (const u16*)(ws + OFF_HN), (const u16*)(ws + OFF_WUP0), EpiGate{(const __attribute__((address_space(4))) void*)kp, 0, 0}, (u16*)shm);)
  GEMM_ACC(9, OFF_R, OFF_WDN0, DFF, (float*)(ws + OFF_RSS) + MT, 0, (const float*)nullptr, (const float*)nullptr)
  PHASE(11, gemm_phase<MT, NINO_PAD, D, 0>(wv, (const u16*)(ws + OFF_HN), (const u16*)(ws + OFF_WINO), EpiStoreBf16{(u16*)(ws + OFF_BIG), NINO_PAD, (const float*)(ws + OFF_RSS) + MT}, (u16*)shm);)
  PHASE(12, prep_range<2>(wv, p, blockIdx.x, NCH * 4, gridDim.x, shm);)
  PHASE(13, seq_odd_phase(wv, p, shm);)
  PHASE(14, post_phase<1>(wv, p);)
  GEMM_ACC(15, OFF_R, OFF_WOUTO, D, (float*)(ws + OFF_RSS) + 2 * MT, -1, (const float*)nullptr, (const float*)nullptr)
  PHASE(17, gemm_phase<MT, NUP, D, 0>(wv, (const u16*)(ws + OFF_HN), (const u16*)(ws + OFF_WUP1), EpiGate{(const __attribute__((address_space(4))) void*)kp, 1, 2 * MT}, (u16*)shm);)
  GEMM_ACC(19, OFF_R, OFF_WDN1, DFF, (float*)nullptr, 1, (const float*)nullptr, (const float*)nullptr)
  PHASE(20, final_norm_phase(wv, p);)
}

extern "C" void kernel_launch(void* const* d_in, const int* in_sizes, int n_in, void* d_out, int out_size, void* d_ws, size_t ws_size,
                              hipStream_t stream) {
  static int grid_blocks = 0;
  if (grid_blocks == 0) {
    int dev = 0, cus = 0, per_cu = 0;
    hipGetDevice(&dev);
    hipDeviceGetAttribute(&cus, hipDeviceAttributeMultiprocessorCount, dev);
    hipFuncSetAttribute((const void*)fwd_kernel, hipFuncAttributeMaxDynamicSharedMemorySize, LDS_BYTES);
    hipOccupancyMaxActiveBlocksPerMultiprocessor(&per_cu, (const void*)fwd_kernel, 512, LDS_BYTES);
    if (per_cu < 1) per_cu = 1;
    grid_blocks = cus * per_cu;
    (void)hipGetLastError();
  }
  if (n_in != 22 || ws_size < WS_NEED || (size_t)out_size != O_END) {
    fprintf(stderr, "kernel_launch: unexpected sizes n_in=%d ws=%zu need=%zu out=%d\n", n_in, ws_size, (size_t)WS_NEED, out_size);
    hipMemsetAsync(d_out, 0, (size_t)out_size * 4, stream);
    return;
  }
  Params p{};
  for (int i = 0; i < 22; ++i) p.in[i] = (const float*)d_in[i];
  p.out = (float*)d_out;
  p.ws = (unsigned char*)d_ws;
#if 0
  for (int ph = 0; ph < NPHASE; ++ph) {
    p.ph_lo = ph; p.ph_hi = ph + 1; p.coop = 0;
    hipLaunchKernelGGL(fwd_kernel, dim3(grid_blocks), dim3(512), LDS_BYTES, stream, p);
  }
#else
  p.ph_lo = 0; p.ph_hi = NPHASE; p.coop = 1;
  hipMemsetAsync((unsigned char*)d_ws + OFF_BAR, 0, XCD_BAR_WORDS * 4, stream);
  void* args[] = {&p};
  hipError_t e = hipLaunchCooperativeKernel((const void*)fwd_kernel, dim3(grid_blocks), dim3(512), args, LDS_BYTES, stream);
  if (e != hipSuccess) fprintf(stderr, "cooperative launch failed: %s (grid %d)\n", hipGetErrorString(e), grid_blocks);
#endif
}
```

```cpp
#include <hip/hip_runtime.h>
#include <hip/hip_bf16.h>
#include <hip/hip_cooperative_groups.h>
#include <cstdio>
namespace cg = cooperative_groups;

typedef unsigned short u16;
using bf16x8 = __attribute__((ext_vector_type(8))) short;
using f32x4 = __attribute__((ext_vector_type(4))) float;
typedef __attribute__((ext_vector_type(4))) unsigned u32x4_t;

constexpr int MP = 8192, MS = 512, MT = 8704, D = 2048;
constexpr int DFF = 5504, NUP = 11008;
constexpr int NINE = 7168, NINO = 6160, NINO_PAD = 6400;
constexpr int NCH = 136;
constexpr float EPS = 1e-6f;

constexpr size_t SZ_WINE = (size_t)NINE * D * 2, SZ_WOUT = (size_t)D * D * 2, SZ_WINO = (size_t)NINO_PAD * D * 2;
constexpr size_t SZ_WUP = (size_t)NUP * D * 2, SZ_WDN = (size_t)D * DFF * 2;
constexpr size_t OFF_WINE = 0;
constexpr size_t OFF_WOUTE = OFF_WINE + SZ_WINE;
constexpr size_t OFF_WINO = OFF_WOUTE + SZ_WOUT;
constexpr size_t OFF_WOUTO = OFF_WINO + SZ_WINO;
constexpr size_t OFF_WUP0 = OFF_WOUTO + SZ_WOUT;
constexpr size_t OFF_WUP1 = OFF_WUP0 + SZ_WUP;
constexpr size_t OFF_WDN0 = OFF_WUP1 + SZ_WUP;
constexpr size_t OFF_WDN1 = OFF_WDN0 + SZ_WDN;
constexpr size_t OFF_H = OFF_WDN1 + SZ_WDN;
constexpr size_t OFF_HN = OFF_H + (size_t)MT * D * 4;
constexpr size_t OFF_BIG = OFF_HN + (size_t)MT * D * 2;
constexpr size_t OFF_R = OFF_BIG + (size_t)MT * NUP * 2;
constexpr size_t SZ_R = 104ull * 1048576;
constexpr size_t OFF_RSS = OFF_R + SZ_R;
constexpr size_t OFF_SIDE = OFF_RSS + 3ull * MT * 4 + 256;
constexpr size_t SZ_SIDE1 = 34ull * 2 * DFF * 2;
constexpr size_t OFF_BAR = OFF_SIDE + 3 * SZ_SIDE1 + 256;
constexpr size_t WS_NEED = OFF_BAR + 16384;
constexpr size_t R_QA = 0;
constexpr size_t R_KA = R_QA + (size_t)NCH * 4 * 64 * 128 * 2;
constexpr size_t R_VA = R_KA + (size_t)NCH * 4 * 64 * 128 * 2;
constexpr size_t R_PA = R_VA + (size_t)NCH * 4 * 256 * 64 * 2;
constexpr size_t R_DA = R_PA + (size_t)NCH * 4 * 4096 * 2;
constexpr size_t R_QB = R_DA + (size_t)NCH * 4 * 128 * 4;
constexpr size_t R_KB = R_QB + (size_t)NCH * 8 * 64 * 128 * 2;
constexpr size_t R_VB = R_KB + (size_t)NCH * 8 * 64 * 128 * 2;
constexpr size_t R_PB = R_VB + (size_t)NCH * 8 * 128 * 64 * 2;
constexpr size_t R_DB = R_PB + (size_t)NCH * 8 * 4096 * 2;
constexpr size_t R_END_EVEN = R_DB + (size_t)NCH * 8 * 128 * 4;
constexpr size_t R_QC = 0;
constexpr size_t R_KC = R_QC + (size_t)NCH * 4 * 64 * 256 * 2;
constexpr size_t R_VC = R_KC + (size_t)NCH * 4 * 64 * 256 * 2;
constexpr size_t R_PC = R_VC + (size_t)NCH * 4 * 512 * 64 * 2;
constexpr size_t R_DC = R_PC + (size_t)NCH * 4 * 4096 * 2;
constexpr size_t R_END_ODD = R_DC + (size_t)NCH * 4 * 256 * 4;
static_assert(R_END_EVEN <= SZ_R && R_END_ODD <= SZ_R && (size_t)MT * DFF * 2 <= SZ_R, "R region too small");

constexpr size_t O_YP = 0;
constexpr size_t O_YS = O_YP + (size_t)MP * D;
constexpr size_t O_RETP = O_YS + (size_t)MS * D;
constexpr size_t O_RETS = O_RETP + 4ull * 4 * 128 * 256;
constexpr size_t O_HGP = O_RETS + 8ull * 4 * 128 * 256;
constexpr size_t O_HGS = O_HGP + 4ull * 8 * 128 * 128;
constexpr size_t O_GLP = O_HGS + 8ull * 8 * 128 * 128;
constexpr size_t O_GLS = O_GLP + 4ull * 4 * 256 * 512;
constexpr size_t O_CVP = O_GLS + 8ull * 4 * 256 * 512;
constexpr size_t O_CVS = O_CVP + 2ull * 4 * 2 * DFF;
constexpr size_t O_END = O_CVS + 2ull * 8 * 2 * DFF;

struct Params {
  const float* in[22];
  float* out;
  unsigned char* ws;
  int ph_lo, ph_hi, coop, pad;
};

__device__ __forceinline__ u16 f2bf(float f) {
  unsigned u = __float_as_uint(f);
  u += 0x7fffu + ((u >> 16) & 1u);
  return (u16)(u >> 16);
}
__device__ __forceinline__ float bf2f(u16 h) { return __uint_as_float(((unsigned)h) << 16); }
__device__ __forceinline__ unsigned pack2(float a, float b) { return (unsigned)f2bf(a) | ((unsigned)f2bf(b) << 16); }
__device__ __forceinline__ float sigmoidf_(float x) { return 1.f / (1.f + __expf(-x)); }
__device__ __forceinline__ float siluf_(float x) { return x / (1.f + __expf(-x)); }

__device__ __forceinline__ int tidx(int wv) { int l; asm volatile("v_mbcnt_lo_u32_b32 %0, -1, 0\n\tv_mbcnt_hi_u32_b32 %0, -1, %0" : "=v"(l)); return wv * 64 + l; }

__device__ __forceinline__ void convert_w(int wv, const float* __restrict__ src, u16* __restrict__ dst, int K, int N, int Npad, u16* tile, const float* __restrict__ kscale = nullptr, int upperm = 0) {
  const int tix = tidx(wv);
  constexpr int TS = 262;
  const int tn = (Npad + 255) / 256, tk = K / 64, nt = tn * tk, tid = tix;
  for (int t = blockIdx.x; t < nt; t += gridDim.x) {
    const int n0 = (t % tn) * 256, k0 = (t / tn) * 64;
    float4 v[8];
#pragma unroll
    for (int i = 0; i < 8; ++i) {
      const int idx = tid + i * 512, kk = idx >> 6, n = n0 + (idx & 63) * 4;
      v[i] = make_float4(0.f, 0.f, 0.f, 0.f);
      if (n < N) { const f32x4 t_ = __builtin_nontemporal_load((const f32x4*)(src + (size_t)(k0 + kk) * N + n)); v[i] = make_float4(t_[0], t_[1], t_[2], t_[3]); }
      if (kscale) { const float sc = kscale[k0 + kk]; v[i].x *= sc; v[i].y *= sc; v[i].z *= sc; v[i].w *= sc; }
    }
    __syncthreads();
#pragma unroll
    for (int i = 0; i < 8; ++i) {
      const int idx = tid + i * 512, kk = idx >> 6, nl = (idx & 63) * 4;
      *(unsigned*)(tile + kk * TS + nl) = pack2(v[i].x, v[i].y);
      *(unsigned*)(tile + kk * TS + nl + 2) = pack2(v[i].z, v[i].w);
    }
    __syncthreads();
#pragma unroll
    for (int i = 0; i < 4; ++i) {
      const int item = tid + i * 512, ks = item & 7, n = item >> 3;
      if (n0 + n < Npad) {
        const u16* tp = tile + (ks * 8) * TS + n;
        uint4 o;
        o.x = (unsigned)tp[0] | ((unsigned)tp[TS] << 16);
        o.y = (unsigned)tp[2 * TS] | ((unsigned)tp[3 * TS] << 16);
        o.z = (unsigned)tp[4 * TS] | ((unsigned)tp[5 * TS] << 16);
        o.w = (unsigned)tp[6 * TS] | ((unsigned)tp[7 * TS] << 16);
        int nr = n0 + n;
        if (upperm) nr = (nr < DFF) ? ((nr >> 7) * 256 + (nr & 127)) : ((((nr - DFF) >> 7) * 256) + 128 + ((nr - DFF) & 127));
        *(uint4*)(dst + (size_t)nr * K + k0 + ks * 8) = o;
      }
    }
  }
}

template <int MODE>
__device__ __forceinline__ void rmsnorm_phase(int wv, const Params& p, const float* __restrict__ w) {
  const int tix = tidx(wv);
  const int lane = tix & 63, gw = blockIdx.x * 8 + (tix >> 6), nw = gridDim.x * 8;
  const float* h = (const float*)(p.ws + OFF_H);
  u16* hn = (u16*)(p.ws + OFF_HN);
#define RMS_LOAD(dst, row_) do { const int r_ = (row_); const float* src_; \
    if (MODE == 0) src_ = (r_ < MP) ? p.in[0] + (size_t)r_ * D : p.in[1] + (size_t)(r_ - MP) * D; \
    else src_ = h + (size_t)r_ * D; \
    _Pragma("unroll") for (int i = 0; i < 8; ++i) dst[i] = (MODE == 0) ? __builtin_nontemporal_load((const f32x4*)(src_ + (i * 64 + lane) * 4)) : *(const f32x4*)(src_ + (i * 64 + lane) * 4); } while (0)
  f32x4 v[8];
  if (gw < MT) RMS_LOAD(v, gw);
#pragma unroll 1
  for (int row = gw; row < MT; row += nw) {
    f32x4 nx[8];
    if (row + nw < MT) RMS_LOAD(nx, row + nw);
    else {
#pragma unroll
      for (int i = 0; i < 8; ++i) nx[i] = v[i];
    }
    __builtin_amdgcn_sched_barrier(0);
    float ss = 0.f;
#pragma unroll
    for (int i = 0; i < 8; ++i) ss += v[i][0] * v[i][0] + v[i][1] * v[i][1] + v[i][2] * v[i][2] + v[i][3] * v[i][3];
#pragma unroll
    for (int o = 32; o > 0; o >>= 1) ss += __shfl_xor(ss, o, 64);
    const float rs = rsqrtf(ss * (1.f / D) + EPS);
#pragma unroll
    for (int i = 0; i < 8; ++i) {
      const int col = (i * 64 + lane) * 4;
      const float4 wv4 = *(const float4*)(w + col);
      const float4 y = make_float4(v[i][0] * rs * wv4.x, v[i][1] * rs * wv4.y, v[i][2] * rs * wv4.z, v[i][3] * rs * wv4.w);
      if (MODE == 2) {
        float* dst = (row < MP) ? p.out + O_YP + (size_t)row * D : p.out + O_YS + (size_t)(row - MP) * D;
        *(float4*)(dst + col) = y;
      } else {
        *(uint2*)(hn + (size_t)row * D + col) = make_uint2(pack2(y.x, y.y), pack2(y.z, y.w));
      }
    }
#pragma unroll
    for (int i = 0; i < 8; ++i) v[i] = nx[i];
  }
#undef RMS_LOAD
}

__device__ __forceinline__ void ld8(const u16* p, float* f) {
  uint4 v = *(const uint4*)p;
  f[0] = __uint_as_float(v.x << 16); f[1] = __uint_as_float(v.x & 0xffff0000u);
  f[2] = __uint_as_float(v.y << 16); f[3] = __uint_as_float(v.y & 0xffff0000u);
  f[4] = __uint_as_float(v.z << 16); f[5] = __uint_as_float(v.z & 0xffff0000u);
  f[6] = __uint_as_float(v.w << 16); f[7] = __uint_as_float(v.w & 0xffff0000u);
}
__device__ __forceinline__ void st8(u16* p, const float* f) {
  *(uint4*)p = make_uint4(pack2(f[0], f[1]), pack2(f[2], f[3]), pack2(f[4], f[5]), pack2(f[6], f[7]));
}

constexpr int BM = 256, BK = 64, HALF = 128, NXCD = 8, WGM = 8, HT = HALF * BK;

__device__ __forceinline__ int lds_byte(int r, int c) {
  int st = (r >> 4) * 2 + (c >> 5), rr = r & 15, cc = c & 31, ob = rr * 64 + cc * 2;
  return st * 1024 + (ob ^ (((ob >> 9) & 1) << 5));
}
__device__ __forceinline__ void stage_rc(int b, int& R, int& C) {
  int st = b / 1024, sb = b % 1024, swz = sb ^ (((sb >> 9) & 1) << 5);
  R = (st >> 1) * 16 + swz / 64; C = (st & 1) * 32 + (swz % 64) / 2;
}

__device__ __forceinline__ void tile_coords(int wgid, int nM, int nN, int& pm, int& pn) {
  const int nwg = nM * nN;
  { int q = nwg / NXCD, r = nwg % NXCD, xcd = wgid % NXCD, off = wgid / NXCD;
    wgid = (xcd < r ? xcd * (q + 1) : r * (q + 1) + (xcd - r) * q) + off; }
  const int nig = WGM * nN, gid = wgid / nig, fm = gid * WGM, gsz = min(nM - fm, WGM);
  pm = fm + ((wgid % nig) % gsz); pn = (wgid % nig) / gsz;
}

struct EpiStoreBf16 {
  static constexpr bool GATE = false;
  static constexpr bool LDSST = true;
  u16* out; int ldo; const float* rss;
  __device__ __forceinline__ float row_scale(int row) const { return rss ? rsqrtf(rss[row] * (1.f / D) + EPS) : 1.f; }
  __device__ __forceinline__ float operator()(int row, int col, f32x4 v, float sc) const {
    uint2 pk = make_uint2(pack2(v[0] * sc, v[1] * sc), pack2(v[2] * sc, v[3] * sc));
    *(uint2*)(out + (size_t)row * ldo + col) = pk;
    return 0.f;
  }
  __device__ __forceinline__ void row_end(int, float, int) const {}
  __device__ __forceinline__ f32x4 finalize(int, int, f32x4 v, float sc, float&) const { return f32x4{v[0] * sc, v[1] * sc, v[2] * sc, v[3] * sc}; }
};
struct EpiAccum {
  static constexpr bool GATE = false;
  static constexpr bool LDSST = true;
  u16* out; float* rss; const float* rin32; static constexpr int ldo = D;
  __device__ __forceinline__ float row_scale(int) const { return 1.f; }
  __device__ __forceinline__ float operator()(int, int, f32x4, float) const { return 0.f; }
  __device__ __forceinline__ f32x4 finalize(int row, int col, f32x4 v, float, float& ss) const {
    float4 o;
    if (rin32) o = *(const float4*)(rin32 + (size_t)row * D + col);
    else { const uint2 r = *(const uint2*)(out + (size_t)row * D + col); o = make_float4(__uint_as_float(r.x << 16), __uint_as_float(r.x & 0xffff0000u), __uint_as_float(r.y << 16), __uint_as_float(r.y & 0xffff0000u)); }
    o.x += v[0]; o.y += v[1]; o.z += v[2]; o.w += v[3];
    if (rss) ss += o.x * o.x + o.y * o.y + o.z * o.z + o.w * o.w;
    return f32x4{o.x, o.y, o.z, o.w};
  }
  __device__ __forceinline__ void row_end(int row, float ss, int fq) const {
    if (rss) {
      ss += __shfl_xor(ss, 16, 64);
      ss += __shfl_xor(ss, 32, 64);
      if (fq == 0) unsafeAtomicAdd(rss + row, ss);
    }
  }
};

struct EpiGate {
  static constexpr bool GATE = true;
  static constexpr bool LDSST = false;
  const __attribute__((address_space(4))) void* kp; int layer; int rssoff;
  __device__ __forceinline__ float row_scale(int) const { return 1.f; }
  __device__ __forceinline__ float operator()(int, int, f32x4, float) const { return 0.f; }
  __device__ __forceinline__ void row_end(int, float, int) const {}
};

template <int M, int N, int K, int TAIL, class Epi>
__device__ __forceinline__ void gemm_phase(int wv, const u16* __restrict__ A, const u16* __restrict__ Bt, Epi epi, u16* shm) {
  const int tix = tidx(wv);
#define SA(b, h) (shm + ((b) * 2 + (h)) * HT)
#define SB(b, h) (shm + (4 + (b) * 2 + (h)) * HT)
#define STAGE(P, BASE, br, kt) do { const u16* _gb = BASE + ((long)(br) * K + (long)(kt0 + (kt)) * BK); \
    for (int _i = 0; _i < 2; ++_i) { int _b = tix * 16 + _i * 8192; \
      __builtin_amdgcn_global_load_lds((const unsigned*)(_gb + toff[_i]), \
        (__attribute__((address_space(3))) unsigned*)((char*)(P) + _b), 16, 0, 0); } } while (0)
#define LDA(dst, b, h) for (int m = 0; m < 4; ++m) for (int k = 0; k < 2; ++k) \
    dst[m][k] = *reinterpret_cast<const bf16x8*>((char*)SA(b, h) + lds_byte(wr * 64 + m * 16 + fr, k * 32 + fq * 8))
#define LDB(dst, b, h) for (int n = 0; n < 2; ++n) for (int k = 0; k < 2; ++k) \
    dst[n][k] = *reinterpret_cast<const bf16x8*>((char*)SB(b, h) + lds_byte(wc * 32 + n * 16 + fr, k * 32 + fq * 8))
#define MMA(ai, bj, At_, Bt_) do { __builtin_amdgcn_s_setprio(1); \
    for (int m = 0; m < 4; ++m) for (int n = 0; n < 2; ++n) for (int k = 0; k < 2; ++k) \
      acc[ai][bj][m][n] = __builtin_amdgcn_mfma_f32_16x16x32_bf16(Bt_[n][k], At_[m][k], acc[ai][bj][m][n], 0, 0, 0); \
    __builtin_amdgcn_s_setprio(0); } while (0)
#define WAIT_V(n) asm volatile("s_waitcnt vmcnt(" #n ")" ::: "memory")
#define WAIT_L(n) asm volatile("s_waitcnt lgkmcnt(" #n ")" ::: "memory")
#define BAR __builtin_amdgcn_s_barrier()
#define SCHED __builtin_amdgcn_sched_barrier(0)
  const int nM = M / BM, nN = N / BM, nwg = nM * nN, G = gridDim.x;
  const int nunits = nwg;
  const int wid = tix >> 6, lane = tix & 63, wr = wid >> 2, wc = wid & 3, fr = lane & 15, fq = lane >> 4;
  const int nt_total = K / BK;
  unsigned toff[2];
  for (int _i = 0; _i < 2; ++_i) { int _b = tix * 16 + _i * 8192; int _r, _c; stage_rc(_b, _r, _c); toff[_i] = (unsigned)(_r * K + _c); }
  for (int vw = blockIdx.x; vw < nunits; vw += G) {
    int pm, pn;
    tile_coords(vw, nM, nN, pm, pn);
    const int brow = pm * BM, bcol = pn * BM;
    constexpr int kt0 = 0, nt = nt_total;
    f32x4 acc[2][2][4][2];
    for (int a = 0; a < 2; ++a) for (int b = 0; b < 2; ++b) for (int m = 0; m < 4; ++m) for (int n = 0; n < 2; ++n) acc[a][b][m][n] = f32x4{0.f, 0.f, 0.f, 0.f};
    bf16x8 At[4][2], B0[2][2], B1[2][2];
    STAGE(SB(0, 0), Bt, bcol, 0); STAGE(SA(0, 0), A, brow, 0);
    STAGE(SB(0, 1), Bt, bcol + HALF, 0); STAGE(SA(0, 1), A, brow + HALF, 0);
    if (wr == 1) BAR;
    WAIT_V(4); BAR;
    STAGE(SB(1, 0), Bt, bcol, 1); STAGE(SA(1, 0), A, brow, 1); STAGE(SB(1, 1), Bt, bcol + HALF, 1);
    WAIT_V(6); BAR;
    for (int t = 0; t < nt - 2; t += 2) {
      LDB(B0, 0, 0); SCHED; LDA(At, 0, 0); STAGE(SA(1, 1), A, brow + HALF, t + 1);
      WAIT_L(8); BAR; WAIT_L(0); MMA(0, 0, At, B0); BAR; SCHED;
      LDB(B1, 0, 1); STAGE(SB(0, 0), Bt, bcol, t + 2);
      BAR; WAIT_L(0); MMA(0, 1, At, B1); BAR;
      LDA(At, 0, 1); STAGE(SA(0, 0), A, brow, t + 2);
      BAR; WAIT_L(0); MMA(1, 0, At, B0); BAR; SCHED;
      STAGE(SB(0, 1), Bt, bcol + HALF, t + 2);
      WAIT_V(6); BAR; MMA(1, 1, At, B1); BAR;
      LDB(B0, 1, 0); SCHED; LDA(At, 1, 0); STAGE(SA(0, 1), A, brow + HALF, t + 2);
      WAIT_L(8); BAR; WAIT_L(0); MMA(0, 0, At, B0); BAR; SCHED;
      LDB(B1, 1, 1); STAGE(SB(1, 0), Bt, bcol, t + 3);
      BAR; WAIT_L(0); MMA(0, 1, At, B1); BAR;
      LDA(At, 1, 1); STAGE(SA(1, 0), A, brow, t + 3);
      BAR; WAIT_L(0); MMA(1, 0, At, B0); BAR; SCHED;
      STAGE(SB(1, 1), Bt, bcol + HALF, t + 3);
      WAIT_V(6); BAR; MMA(1, 1, At, B1); BAR;
    }
    { LDB(B0, 0, 0); LDA(At, 0, 0); STAGE(SA(1, 1), A, brow + HALF, nt - 1);
      BAR; WAIT_L(0); MMA(0, 0, At, B0); BAR;
      LDB(B1, 0, 1); BAR; WAIT_L(0); MMA(0, 1, At, B1); BAR;
      LDA(At, 0, 1); WAIT_V(4); BAR; WAIT_L(0); MMA(1, 0, At, B0); MMA(1, 1, At, B1); BAR; }
    { LDB(B0, 1, 0); LDA(At, 1, 0); WAIT_V(2); BAR; WAIT_L(0); MMA(0, 0, At, B0); BAR;
      LDB(B1, 1, 1); WAIT_V(0); BAR; WAIT_L(0); MMA(0, 1, At, B1); BAR;
      LDA(At, 1, 1); BAR; WAIT_L(0); MMA(1, 0, At, B0); MMA(1, 1, At, B1); BAR; }
    if (wr == 0) BAR;
    if constexpr (Epi::GATE) {
      constexpr int LS = 136;
      u16* La = shm;
      u16* Lu = shm + 256 * LS;
      const __attribute__((address_space(4))) Params* gkp = (const __attribute__((address_space(4))) Params*)epi.kp;
      asm volatile("" : "+s"(gkp));
      int e_pm = pm, e_pn = pn, e_tix = tix;
      asm volatile("" : "+s"(e_pm), "+s"(e_pn));
      asm volatile("" : "+v"(e_tix));
      const int e_brow = e_pm * BM;
      {
        const int e_lane = e_tix & 63, e_wid = e_tix >> 6, e_wr = e_wid >> 2, e_wc = e_wid & 3, e_fr = e_lane & 15, e_fq = e_lane >> 4;
        const float* rss = (const float*)(gkp->ws + OFF_RSS) + epi.rssoff;
        _Pragma("unroll") for (int ai = 0; ai < 2; ++ai) _Pragma("unroll") for (int m = 0; m < 4; ++m) {
          const int rl = ai * HALF + e_wr * 64 + m * 16 + e_fr;
          const float sc = rsqrtf(rss[e_brow + rl] * (1.f / D) + EPS);
          _Pragma("unroll") for (int n = 0; n < 2; ++n) {
            const f32x4 a = acc[ai][0][m][n], uu = acc[ai][1][m][n];
            const int lo = rl * LS + e_wc * 32 + n * 16 + e_fq * 4;
            *(uint2*)(La + lo) = make_uint2(pack2(a[0] * sc, a[1] * sc), pack2(a[2] * sc, a[3] * sc));
            *(uint2*)(Lu + lo) = make_uint2(pack2(uu[0] * sc, uu[1] * sc), pack2(uu[2] * sc, uu[3] * sc));
          }
        }
      }
      WAIT_L(0); BAR; asm volatile("" ::: "memory");
      {
        const bool samp = e_brow >= MP;
        const int layer = epi.layer;
        u16* gg = (u16*)(gkp->ws + OFF_R);
        u16* side = (u16*)(gkp->ws + OFF_SIDE);
        const float* cw = gkp->in[19] + (size_t)layer * 3 * DFF;
        const float* cb = gkp->in[20] + (size_t)layer * DFF;
        const float* cache = gkp->in[5] + (size_t)layer * 8 * 2 * DFF;
        float* cvo = gkp->out + (samp ? O_CVS + (size_t)layer * 8 * 2 * DFF : O_CVP + (size_t)layer * 4 * 2 * DFF);
        const int cg = e_tix & 15, r0 = e_tix >> 4, c = e_pn * 128 + cg * 8;
        float w0[8], w1[8], w2[8], bb[8];
        _Pragma("unroll") for (int e = 0; e < 8; ++e) { w0[e] = cw[c + e]; w1[e] = cw[DFF + c + e]; w2[e] = cw[2 * DFF + c + e]; bb[e] = cb[c + e]; }
        _Pragma("unroll 1") for (int it = 0; it < 8; ++it) {
          const int rl = it * 32 + r0;
          const int t = samp ? (rl & 63) : ((e_pm & 7) * 256 + rl);
          const int sb = (e_pm - 32) * 4 + (rl >> 6);
          float a[8], uu[8], am1[8], am2[8], y[8];
          ld8(La + rl * LS + cg * 8, a);
          ld8(Lu + rl * LS + cg * 8, uu);
          _Pragma("unroll") for (int e = 0; e < 8; ++e) { am1[e] = 0.f; am2[e] = 0.f; }
          if (t >= 1 && rl >= 1) ld8(La + (rl - 1) * LS + cg * 8, am1);
          if (t >= 2 && rl >= 2) ld8(La + (rl - 2) * LS + cg * 8, am2);
          if (samp && t < 2) {
            const float* c1 = cache + (size_t)(sb * 2 + 1) * DFF + c;
            if (t == 0) {
              const float* c0 = cache + (size_t)(sb * 2 + 0) * DFF + c;
              _Pragma("unroll") for (int e = 0; e < 8; ++e) { am2[e] = c0[e]; am1[e] = c1[e]; }
            } else {
              _Pragma("unroll") for (int e = 0; e < 8; ++e) am2[e] = c1[e];
            }
          }
          if (!(t >= 2 && rl < 2)) {
            _Pragma("unroll") for (int e = 0; e < 8; ++e) { float cv = bb[e] + w0[e] * am2[e] + w1[e] * am1[e] + w2[e] * a[e]; y[e] = siluf_(cv) * uu[e]; }
            st8(gg + (size_t)(e_brow + rl) * DFF + c, y);
          } else {
            st8(side + (size_t)(e_pm * 2 + rl) * DFF + c, a);
            st8(side + SZ_SIDE1 / 2 + (size_t)(e_pm * 2 + rl) * DFF + c, uu);
          }
          if (rl >= 254) st8(side + SZ_SIDE1 + (size_t)(e_pm * 2 + rl - 254) * DFF + c, a);
          int crow = -1;
          if (!samp) { if ((e_pm & 7) == 7 && rl >= 254) crow = (e_pm >> 3) * 2 + rl - 254; }
          else { if ((rl & 63) >= 62) crow = sb * 2 + (rl & 63) - 62; }
          if (crow >= 0) {
            float* dst = cvo + (size_t)crow * DFF + c;
            *(float4*)dst = make_float4(a[0], a[1], a[2], a[3]);
            *(float4*)(dst + 4) = make_float4(a[4], a[5], a[6], a[7]);
          }
        }
      }
      WAIT_L(0); BAR; asm volatile("" ::: "memory");
    } else if constexpr (Epi::LDSST) {
      constexpr int LS = 136;
      u16* L0 = shm;
      u16* L1 = shm + 256 * LS;
      int e_brow = brow, e_bcol = bcol, e_tix = tix;
      asm volatile("" : "+s"(e_brow), "+s"(e_bcol));
      asm volatile("" : "+v"(e_tix));
      {
        const int e_lane = e_tix & 63, e_wid = e_tix >> 6, e_wr = e_wid >> 2, e_wc = e_wid & 3, e_fr = e_lane & 15, e_fq = e_lane >> 4;
        _Pragma("unroll") for (int ai = 0; ai < 2; ++ai) _Pragma("unroll") for (int m = 0; m < 4; ++m) {
          const int rl = ai * HALF + e_wr * 64 + m * 16 + e_fr;
          const float sc = epi.row_scale(e_brow + rl);
          float ss = 0.f;
          _Pragma("unroll") for (int n = 0; n < 2; ++n) {
            const int cl = e_wc * 32 + n * 16 + e_fq * 4;
            const f32x4 c0 = epi.finalize(e_brow + rl, e_bcol + cl, acc[ai][0][m][n], sc, ss);
            const f32x4 c1 = epi.finalize(e_brow + rl, e_bcol + 128 + cl, acc[ai][1][m][n], sc, ss);
            const int lo = rl * LS + cl;
            *(uint2*)(L0 + lo) = make_uint2(pack2(c0[0], c0[1]), pack2(c0[2], c0[3]));
            *(uint2*)(L1 + lo) = make_uint2(pack2(c1[0], c1[1]), pack2(c1[2], c1[3]));
          }
          epi.row_end(e_brow + rl, ss, e_fq);
          if (m & 1) asm volatile("" ::: "memory");
        }
      }
      WAIT_L(0); BAR; asm volatile("" ::: "memory");
      {
        const int cg = e_tix & 15, r0 = e_tix >> 4;
        _Pragma("unroll 1") for (int it = 0; it < 8; ++it) {
          const int rl = it * 32 + r0;
          const uint4 x0 = *(const uint4*)(L0 + rl * LS + cg * 8), x1 = *(const uint4*)(L1 + rl * LS + cg * 8);
          u16* dst = epi.out + (size_t)(e_brow + rl) * epi.ldo + e_bcol + cg * 8;
          *(uint4*)dst = x0;
          *(uint4*)(dst + 128) = x1;
        }
      }
      WAIT_L(0); BAR; asm volatile("" ::: "memory");
    } else {
    for (int ai = 0; ai < 2; ++ai) for (int m = 0; m < 4; ++m) {
      const int row = brow + ai * HALF + wr * 64 + m * 16 + fr;
      const float sc = epi.row_scale(row);
      float ss = 0.f;
      for (int bj = 0; bj < 2; ++bj) for (int n = 0; n < 2; ++n)
        ss += epi(row, bcol + bj * HALF + wc * 32 + n * 16 + fq * 4, acc[ai][bj][m][n], sc);
      epi.row_end(row, ss, fq);
      if (m & 1) asm volatile("" ::: "memory");
    }
    }
  }
#undef SA
#undef SB
#undef STAGE
#undef LDA
#undef LDB
#undef MMA
}


template <int K>
__device__ __forceinline__ void gemm_tail_phase(int wv, const u16* __restrict__ A, const u16* __restrict__ Bt, float* lds, u16* __restrict__ hb, float* __restrict__ rss, const float* __restrict__ rin32_tail) {
  const int tix = tidx(wv);
  const int tid = tix, w = tid >> 6, lane = tid & 63, fr = lane & 15, fq = lane >> 4;
  for (int u = blockIdx.x; u < 256; u += gridDim.x) {
    const int tm = u >> 5, tn = u & 31;
    const u16* Ab = A + (size_t)(MP + tm * 64 + fr) * K + fq * 8;
    const u16* Bb = Bt + (size_t)(tn * 64 + fr) * K + fq * 8;
    f32x4 acc[4][4];
#pragma unroll
    for (int i = 0; i < 4; ++i)
#pragma unroll
      for (int j = 0; j < 4; ++j) acc[i][j] = f32x4{0.f, 0.f, 0.f, 0.f};
    const u16* Ab2 = A + (size_t)(MP + tm * 64 + fr) * K + fq * 16;
    const u16* Bb2 = Bt + (size_t)(tn * 64 + fr) * K + fq * 16;
#pragma unroll 1
    for (int ks = w; ks < K / 64; ks += 8) {
      bf16x8 a[4][2], b[4][2];
#pragma unroll
      for (int i = 0; i < 4; ++i) {
        a[i][0] = *(const bf16x8*)(Ab2 + (size_t)i * 16 * K + ks * 64);
        a[i][1] = *(const bf16x8*)(Ab2 + (size_t)i * 16 * K + ks * 64 + 8);
        b[i][0] = *(const bf16x8*)(Bb2 + (size_t)i * 16 * K + ks * 64);
        b[i][1] = *(const bf16x8*)(Bb2 + (size_t)i * 16 * K + ks * 64 + 8);
      }
#pragma unroll
      for (int mb = 0; mb < 4; ++mb)
#pragma unroll
        for (int nb = 0; nb < 4; ++nb) {
          acc[mb][nb] = __builtin_amdgcn_mfma_f32_16x16x32_bf16(b[nb][0], a[mb][0], acc[mb][nb], 0, 0, 0);
          acc[mb][nb] = __builtin_amdgcn_mfma_f32_16x16x32_bf16(b[nb][1], a[mb][1], acc[mb][nb], 0, 0, 0);
        }
    }
    __syncthreads();
#pragma unroll
    for (int mb = 0; mb < 4; ++mb)
#pragma unroll
      for (int nb = 0; nb < 4; ++nb) *(f32x4*)(lds + w * 4096 + (mb * 16 + fr) * 64 + nb * 16 + fq * 4) = acc[mb][nb];
    __syncthreads();
    const int e = tid * 8, row = e >> 6, col = e & 63;
    float4 s0 = make_float4(0.f, 0.f, 0.f, 0.f), s1 = s0;
#pragma unroll
    for (int ww = 0; ww < 8; ++ww) {
      float4 x0 = *(const float4*)(lds + ww * 4096 + e), x1 = *(const float4*)(lds + ww * 4096 + e + 4);
      s0.x += x0.x; s0.y += x0.y; s0.z += x0.z; s0.w += x0.w;
      s1.x += x1.x; s1.y += x1.y; s1.z += x1.z; s1.w += x1.w;
    }
    const int grow = MP + tm * 64 + row;
    u16* q = hb + (size_t)grow * D + tn * 64 + col;
    float r8[8];
    if (rin32_tail) {
      const float* rq_ = rin32_tail + (size_t)(tm * 64 + row) * D + tn * 64 + col;
      const float4 a0 = *(const float4*)rq_, a1 = *(const float4*)(rq_ + 4);
      r8[0] = a0.x; r8[1] = a0.y; r8[2] = a0.z; r8[3] = a0.w; r8[4] = a1.x; r8[5] = a1.y; r8[6] = a1.z; r8[7] = a1.w;
    } else ld8(q, r8);
    r8[0] += s0.x; r8[1] += s0.y; r8[2] += s0.z; r8[3] += s0.w; r8[4] += s1.x; r8[5] += s1.y; r8[6] += s1.z; r8[7] += s1.w;
    st8(q, r8);
    if (rss) {
      float ss = 0.f;
#pragma unroll
      for (int e2 = 0; e2 < 8; ++e2) ss += r8[e2] * r8[e2];
      ss += __shfl_xor(ss, 1, 64); ss += __shfl_xor(ss, 2, 64); ss += __shfl_xor(ss, 4, 64);
      if ((tid & 7) == 0) unsafeAtomicAdd(rss + grow, ss);
    }
  }
}

template <int MODE>
__device__ __forceinline__ void prep_range(int wv, const Params& p, int u0, int u1, int ustride, unsigned char* shm) {
  const int tix = tidx(wv);
  constexpr int K = (MODE == 2) ? 256 : 128;
  constexpr int V = (MODE == 0) ? 256 : (MODE == 1 ? 128 : 512);
  constexpr int H = (MODE == 1) ? 8 : 4;
  constexpr int LD = (MODE == 2) ? NINO_PAD : NINE;
  constexpr int NSEG = 4, TL = 16, KS = K + 8, VS = V + 8, NPASS = K / 128;
  constexpr int NQ = K / 64, NV = V / 64;
  constexpr bool PFV = false;
  const int tid = tix, seg = tid >> 7;
  const u16* proj = (const u16*)(p.ws + OFF_BIG);
  unsigned char* R = p.ws + OFF_R;
  u16* qin = (u16*)(R + (MODE == 0 ? R_QA : MODE == 1 ? R_QB : R_QC));
  u16* koT = (u16*)(R + (MODE == 0 ? R_KA : MODE == 1 ? R_KB : R_KC));
  u16* vT = (u16*)(R + (MODE == 0 ? R_VA : MODE == 1 ? R_VB : R_VC));
  u16* Pm = (u16*)(R + (MODE == 0 ? R_PA : MODE == 1 ? R_PB : R_PC));
  float* dL = (float*)(R + (MODE == 0 ? R_DA : MODE == 1 ? R_DB : R_DC));
  u16* qs = (u16*)shm;
  u16* ksm = qs + 64 * KS;
  float* segtot = (float*)(ksm + 64 * KS);
  float* gl = segtot + NSEG * K;
  u16* rq = (u16*)(gl + 64 * 16);
  u16* rk = rq + 64 * KS;
  u16* rv = PFV ? rk + 64 * KS : rq;
  typedef __attribute__((ext_vector_type(4))) unsigned u32x4_t;
  u32x4_t rqr[NQ], rkr[NQ], rvr[PFV ? NV : 1];
#define PREP_ISSUE(uu_) do { \
    const int c_i = (uu_) / H, h_i = (uu_) % H; \
    const int row0_i = (c_i < 128) ? (c_i >> 5) * 2048 + (c_i & 31) * 64 : MP + (c_i - 128) * 64; \
    const u16* prow_i = proj + (size_t)row0_i * LD; \
    const int cq_i = (MODE == 0) ? h_i * 128 : (MODE == 1 ? 3072 + h_i * 128 : h_i * 256); \
    const int ck_i = (MODE == 0) ? 512 + h_i * 128 : (MODE == 1 ? 4096 + h_i * 128 : 1024 + h_i * 256); \
    const int vc_i = (MODE == 0) ? 1024 + h_i * 256 : (MODE == 1 ? 5120 + h_i * 128 : 2048 + h_i * 512); \
    _Pragma("unroll") for (int i = 0; i < NQ; ++i) { \
      const int idx = tid + i * 512, r = idx / (K / 8), cc = idx % (K / 8); \
      rqr[i] = *(const u32x4_t*)(prow_i + (size_t)r * LD + cq_i + cc * 8); \
      rkr[i] = *(const u32x4_t*)(prow_i + (size_t)r * LD + ck_i + cc * 8); \
    } \
    if constexpr (PFV) { \
      _Pragma("unroll") for (int i = 0; i < NV; ++i) { \
        const int idx = tid + i * 512, r = idx / (V / 8), cc = idx % (V / 8); \
        rvr[i] = *(const u32x4_t*)(prow_i + (size_t)r * LD + vc_i + cc * 8); \
      } \
    } } while (0)
  if (u0 < u1) PREP_ISSUE(u0);
#pragma unroll 1
  for (int uu = u0; uu < u1; uu += ustride) {
  const int c = uu / H, h = uu % H;
  int row0, pos0;
  if (c < 128) { row0 = (c >> 5) * 2048 + (c & 31) * 64; pos0 = (c & 31) * 64; }
  else { row0 = MP + (c - 128) * 64; pos0 = 1024; }
  const size_t u = (size_t)c * H + h;
  const u16* prow = proj + (size_t)row0 * LD;
  const int vc0 = (MODE == 0) ? 1024 + h * 256 : (MODE == 1 ? 5120 + h * 128 : 2048 + h * 512);
  __syncthreads();
#pragma unroll
  for (int i = 0; i < NQ; ++i) {
    const int idx = tid + i * 512, r = idx / (K / 8), cc = idx % (K / 8);
    *(u32x4_t*)(rq + r * KS + cc * 8) = rqr[i];
    *(u32x4_t*)(rk + r * KS + cc * 8) = rkr[i];
  }
  if constexpr (PFV) {
#pragma unroll
    for (int i = 0; i < NV; ++i) {
      const int idx = tid + i * 512, r = idx / (V / 8), cc = idx % (V / 8);
      *(u32x4_t*)(rv + r * VS + cc * 8) = rvr[i];
    }
  }
  if (MODE == 2) {
    for (int i = tid; i < 64 * 2; i += 512) {
      const int r = i >> 1, hh = i & 1;
      uint4 g4 = *(const uint4*)(prow + (size_t)r * LD + 6144 + hh * 8);
      float* d = gl + r * 16 + hh * 8;
      d[0] = __uint_as_float(g4.x << 16); d[1] = __uint_as_float(g4.x & 0xffff0000u);
      d[2] = __uint_as_float(g4.y << 16); d[3] = __uint_as_float(g4.y & 0xffff0000u);
      d[4] = __uint_as_float(g4.z << 16); d[5] = __uint_as_float(g4.z & 0xffff0000u);
      d[6] = __uint_as_float(g4.w << 16); d[7] = __uint_as_float(g4.w & 0xffff0000u);
    }
  }
  if (uu + ustride < u1) PREP_ISSUE(uu + ustride);
  __builtin_amdgcn_sched_barrier(0);
  __syncthreads();
#pragma unroll 1
  for (int pass = 0; pass < NPASS; ++pass) {
  const int kk = pass * 128 + (tid & 127);
  float qv[TL], kv[TL], bc[TL];
  if (MODE == 0) {
    const int j = kk & 63;
    const float invr = exp2f(-(float)j * (13.287712379549449f / 64.f)) * 0.15915494309189535f;
    const float lgam = log1pf(-exp2f(-5.f - (float)h));
#pragma unroll
    for (int i = 0; i < TL; ++i) {
      const int l = seg * TL + i;
      float rev = (float)(pos0 + l) * invr;
      rev -= floorf(rev);
      const float sn = __builtin_amdgcn_sinf(rev), cs = __builtin_amdgcn_cosf(rev);
      const float q1 = bf2f(rq[l * KS + j]), q2 = bf2f(rq[l * KS + j + 64]), k1 = bf2f(rk[l * KS + j]), k2 = bf2f(rk[l * KS + j + 64]);
      const float qr = (kk < 64) ? q1 * cs - q2 * sn : q1 * sn + q2 * cs;
      const float kr = (kk < 64) ? k1 * cs - k2 * sn : k1 * sn + k2 * cs;
      qv[i] = qr; kv[i] = kr * 0.08838834764831845f;
      bc[i] = lgam;
    }
  } else if (MODE == 1) {
    const int ch = h * 128 + kk;
    const float* lbp = p.in[11];
    float e0 = __expf(lbp[ch]), e1 = __expf(lbp[1024 + ch]), e2 = __expf(lbp[2048 + ch]);
    const float lb = e0 / (e0 + e1 + e2);
#pragma unroll
    for (int i = 0; i < TL; ++i) {
      const int l = seg * TL + i;
      const float qx = bf2f(rq[l * KS + kk]), fx = bf2f(rk[l * KS + kk]);
      qv[i] = siluf_(qx) * 0.08838834764831845f;
      const float sg = sigmoidf_(fx);
      const float f = lb + (1.f - lb) * sg;
      kv[i] = (1.f - lb) * (1.f - sg);
      bc[i] = __logf(f);
    }
  } else {
    const int ch = h * 256 + kk;
    const float* w2 = p.in[14];
    float wvv[16];
#pragma unroll
    for (int r = 0; r < 16; ++r) wvv[r] = w2[r * 1024 + ch];
    const float bias = p.in[15][ch];
#pragma unroll
    for (int i = 0; i < TL; ++i) {
      const int l = seg * TL + i;
      qv[i] = bf2f(rq[l * KS + kk]) * 0.0625f;
      kv[i] = bf2f(rk[l * KS + kk]);
      float x = bias;
#pragma unroll
      for (int r = 0; r < 16; ++r) x += gl[l * 16 + r] * wvv[r];
      const float ls = fminf(x, 0.f) - log1pf(__expf(-fabsf(x)));
      bc[i] = ls * (1.f / 16.f);
    }
  }
#pragma unroll
  for (int i = 1; i < TL; ++i) bc[i] += bc[i - 1];
  segtot[seg * K + kk] = bc[TL - 1];
  __syncthreads();
  float pre = 0.f, bL = 0.f;
#pragma unroll
  for (int sg = 0; sg < NSEG; ++sg) { float t = segtot[sg * K + kk]; bL += t; if (sg < seg) pre += t; }
  if (seg == 0) dL[u * K + kk] = __expf(bL);
  unsigned kop[TL / 2];
#pragma unroll
  for (int i = 0; i < TL; i += 2) {
    float ko2[2];
#pragma unroll
    for (int e = 0; e < 2; ++e) {
      const int l = seg * TL + i + e;
      const float b = bc[i + e] + pre;
      const float qi = qv[i + e] * __expf(b);
      const float ki = kv[i + e] * __expf(-b);
      ko2[e] = kv[i + e] * __expf(bL - b);
      const u16 qb = f2bf(qi);
      qs[l * KS + kk] = qb;
      ksm[l * KS + kk] = f2bf(ki);
    }
    kop[i / 2] = pack2(ko2[0], ko2[1]);
  }
  {
#pragma unroll
    for (int i = 0; i < TL / 8; ++i) {
      const int cc = seg * 2 + i;
      uint4* dst = (uint4*)(koT + u * K * 64 + ((((kk >> 4) * 2 + (cc >> 2)) * 64 + (cc & 3) * 16 + (kk & 15)) << 3));
      *dst = make_uint4(kop[i * 4 + 0], kop[i * 4 + 1], kop[i * 4 + 2], kop[i * 4 + 3]);
    }
  }
  }
  __syncthreads();
  for (int i = tid; i < 64 * (K / 8); i += 512) {
    const int r = i / (K / 8), cc = i % (K / 8);
    *(uint4*)(qin + u * 64 * K + ((((r >> 4) * (K / 32) + (cc >> 2)) * 64 + (cc & 3) * 16 + (r & 15)) << 3)) = *(const uint4*)(qs + r * KS + cc * 8);
  }
  {
    const int w = tid >> 6, lane = tid & 63, fr = lane & 15, fq = lane >> 4;
#pragma unroll 1
    for (int bi = 0; bi < 2; ++bi) {
      const int blk = w + bi * 8, lb = blk >> 2, sb = blk & 3;
      f32x4 acc = {0.f, 0.f, 0.f, 0.f};
      if (sb <= lb) {
#pragma unroll
        for (int kst = 0; kst < K / 32; ++kst) {
          bf16x8 a = *(const bf16x8*)(ksm + (sb * 16 + fr) * KS + kst * 32 + fq * 8);
          bf16x8 b = *(const bf16x8*)(qs + (lb * 16 + fr) * KS + kst * 32 + fq * 8);
          acc = __builtin_amdgcn_mfma_f32_16x16x32_bf16(a, b, acc, 0, 0, 0);
        }
      }
      const int l = lb * 16 + fr, s0 = sb * 16 + fq * 4;
      float v0 = (s0 + 0 <= l) ? acc[0] : 0.f, v1 = (s0 + 1 <= l) ? acc[1] : 0.f;
      float v2 = (s0 + 2 <= l) ? acc[2] : 0.f, v3 = (s0 + 3 <= l) ? acc[3] : 0.f;
      *(uint2*)(Pm + u * 4096 + ((((lb * 2 + (s0 >> 5)) * 64 + ((s0 & 31) >> 3) * 16 + fr) << 3) + (s0 & 7))) = make_uint2(pack2(v0, v1), pack2(v2, v3));
    }
  }
  }
}

template <int K, int V>
__device__ __forceinline__ void seq_unit(int wv, const u16* __restrict__ qin, const u16* __restrict__ koT, const u16* __restrict__ Pm, const u16* __restrict__ vsrc, int vld,
                         const float* __restrict__ dL, int H, int c0, int nch, int h, int vs,
                         const float* __restrict__ s0, float* __restrict__ sout, u16* __restrict__ o, int row0, int ocol, unsigned char* shm) {
  const int tix = tidx(wv);
  constexpr int NKB = K / 128, SST = K + 8;
  u16* ST = (u16*)shm;
  const int tid = tix, w = tid >> 6, lane = tid & 63, fr = lane & 15, fq = lane >> 4;
  f32x4 accS[NKB][2];
  __syncthreads();
#pragma unroll
  for (int kb = 0; kb < NKB; ++kb)
#pragma unroll
    for (int vb = 0; vb < 2; ++vb) {
      const int k = (w * NKB + kb) * 16 + fq * 4, vcol = vb * 16 + fr;
#pragma unroll
      for (int j = 0; j < 4; ++j) accS[kb][vb][j] = s0 ? s0[(size_t)(k + j) * V + vs * 32 + vcol] : 0.f;
      *(uint2*)(ST + vcol * SST + k) = make_uint2(pack2(accS[kb][vb][0], accS[kb][vb][1]), pack2(accS[kb][vb][2], accS[kb][vb][3]));
    }
  constexpr int VTS = 72;
  u16* VT = ST + 2 * 32 * SST;
  const int v_s = (tid >> 2) & 63, v_p = tid & 3;
  const u16* vrow = vsrc + (size_t)v_s * vld + v_p * 8;
  u32x4_t vreg = {0u, 0u, 0u, 0u};
  if (tid < 256) {
    vreg = *(const u32x4_t*)vrow;
#pragma unroll
    for (int j = 0; j < 4; ++j) {
      VT[(v_p * 8 + 2 * j) * VTS + v_s] = (u16)(vreg[j] & 0xffffu);
      VT[(v_p * 8 + 2 * j + 1) * VTS + v_s] = (u16)(vreg[j] >> 16);
    }
  }
  __syncthreads();
  int cur = 0;
  const int lb = w >> 1, ovb = w & 1;
  struct FragsO { bf16x8 op[2], oq[K / 32]; };
  struct FragsS { bf16x8 ka[NKB][2]; float4 d[NKB]; };
  auto load_o = [&](int ci, FragsO& f) {
    const size_t u = (size_t)(c0 + ci) * H + h;
    const u16* Pu = Pm + u * 4096;
    const u16* qu = qin + u * 64 * K;
#pragma unroll
    for (int ss = 0; ss < 2; ++ss) f.op[ss] = *(const bf16x8*)(Pu + (((lb * 2 + ss) * 64 + lane) << 3));
#pragma unroll
    for (int kst = 0; kst < K / 32; ++kst) f.oq[kst] = *(const bf16x8*)(qu + (((lb * (K / 32) + kst) * 64 + lane) << 3));
  };
  auto load_s = [&](int ci, FragsS& f) {
    const size_t u = (size_t)(c0 + ci) * H + h;
    const u16* ku = koT + u * K * 64;
    const float* du = dL + u * K;
#pragma unroll
    for (int kb = 0; kb < NKB; ++kb) {
      const int kbase = (w * NKB + kb) * 16;
      f.d[kb] = *(const float4*)(du + kbase + fq * 4);
      f.ka[kb][0] = *(const bf16x8*)(ku + ((((w * NKB + kb) * 2 + 0) * 64 + lane) << 3));
      f.ka[kb][1] = *(const bf16x8*)(ku + ((((w * NKB + kb) * 2 + 1) * 64 + lane) << 3));
    }
  };
  FragsO fo;
  FragsS f0;
  load_o(0, fo);
  load_s(0, f0);
  for (int ci = 0; ci < nch; ++ci) {
    const int cn = ci + 1 < nch ? ci + 1 : ci;
    FragsO fo1;
    FragsS f1;
    load_o(cn, fo1);
    load_s(cn, f1);
    if (tid < 256) vreg = *(const u32x4_t*)(vrow + (size_t)cn * 64 * vld);
    __builtin_amdgcn_sched_barrier(0);
    const u16* STc = ST + cur * 32 * SST;
    u16* STn = ST + (cur ^ 1) * 32 * SST;
    const u16* VTc = VT + cur * 32 * VTS;
    u16* VTn = VT + (cur ^ 1) * 32 * VTS;
    bf16x8 vf[2][2];
#pragma unroll
    for (int vb = 0; vb < 2; ++vb)
#pragma unroll
      for (int ss = 0; ss < 2; ++ss) vf[vb][ss] = *(const bf16x8*)(VTc + (vb * 16 + fr) * VTS + ss * 32 + fq * 8);
    f32x4 ao = {0.f, 0.f, 0.f, 0.f};
#pragma unroll
    for (int ss = 0; ss < 2; ++ss) {
      bf16x8 a = *(const bf16x8*)(VTc + (ovb * 16 + fr) * VTS + ss * 32 + fq * 8);
      ao = __builtin_amdgcn_mfma_f32_16x16x32_bf16(a, fo.op[ss], ao, 0, 0, 0);
    }
#pragma unroll
    for (int kst = 0; kst < K / 32; ++kst) {
      bf16x8 a = *(const bf16x8*)(STc + (ovb * 16 + fr) * SST + kst * 32 + fq * 8);
      ao = __builtin_amdgcn_mfma_f32_16x16x32_bf16(a, fo.oq[kst], ao, 0, 0, 0);
    }
    *(uint2*)(o + (size_t)(row0 + ci * 64 + lb * 16 + fr) * D + ocol + vs * 32 + ovb * 16 + fq * 4) =
        make_uint2(pack2(ao[0], ao[1]), pack2(ao[2], ao[3]));
#pragma unroll
    for (int kb = 0; kb < NKB; ++kb) {
      const int kbase = (w * NKB + kb) * 16;
      const float4 d4 = f0.d[kb];
#pragma unroll
      for (int vb = 0; vb < 2; ++vb) {
        f32x4 sv = accS[kb][vb];
        sv[0] *= d4.x; sv[1] *= d4.y; sv[2] *= d4.z; sv[3] *= d4.w;
        sv = __builtin_amdgcn_mfma_f32_16x16x32_bf16(f0.ka[kb][0], vf[vb][0], sv, 0, 0, 0);
        sv = __builtin_amdgcn_mfma_f32_16x16x32_bf16(f0.ka[kb][1], vf[vb][1], sv, 0, 0, 0);
        accS[kb][vb] = sv;
        *(uint2*)(STn + (vb * 16 + fr) * SST + kbase + fq * 4) = make_uint2(pack2(sv[0], sv[1]), pack2(sv[2], sv[3]));
      }
    }
    if (tid < 256) {
#pragma unroll
      for (int j = 0; j < 4; ++j) {
        VTn[(v_p * 8 + 2 * j) * VTS + v_s] = (u16)(vreg[j] & 0xffffu);
        VTn[(v_p * 8 + 2 * j + 1) * VTS + v_s] = (u16)(vreg[j] >> 16);
      }
    }
    asm volatile("s_waitcnt lgkmcnt(0)" ::: "memory");
    __builtin_amdgcn_s_barrier();
    asm volatile("" ::: "memory");
    cur ^= 1;
    f0 = f1;
    fo = fo1;
  }
#pragma unroll
  for (int kb = 0; kb < NKB; ++kb)
#pragma unroll
    for (int vb = 0; vb < 2; ++vb) {
      const int k = (w * NKB + kb) * 16 + fq * 4, vcol = vb * 16 + fr;
#pragma unroll
      for (int j = 0; j < 4; ++j) sout[(size_t)(k + j) * V + vs * 32 + vcol] = accS[kb][vb][j];
    }
}

__device__ __forceinline__ void seq_even_phase(int wv, const Params& p, unsigned char* shm) {
  unsigned char* R = p.ws + OFF_R;
  u16* o = (u16*)(p.ws + OFF_H);
  for (int u = blockIdx.x; u < 768; u += gridDim.x) {
    if (u < 256) {
      const int x = u & 7, y = u >> 3;
      if (y < 16) {
        const int g = x * 2 + (y >> 3), b = g >> 2, h = g & 3, vs = y & 7;
        seq_unit<128, 256>(wv, (u16*)(R + R_QA), (u16*)(R + R_KA), (u16*)(R + R_PA), (const u16*)(p.ws + OFF_BIG) + (size_t)(b * 2048) * NINE + 1024 + h * 256 + vs * 32, NINE, (float*)(R + R_DA), 4, b * 32, 32, h, vs,
                           nullptr, p.out + O_RETP + (size_t)(b * 4 + h) * 128 * 256, o, b * 2048, h * 256, shm);
      } else {
        const int yy = y - 16, g = x * 4 + (yy >> 2), b = g >> 3, h = g & 7, vs = yy & 3;
        seq_unit<128, 128>(wv, (u16*)(R + R_QB), (u16*)(R + R_KB), (u16*)(R + R_PB), (const u16*)(p.ws + OFF_BIG) + (size_t)(b * 2048) * NINE + 5120 + h * 128 + vs * 32, NINE, (float*)(R + R_DB), 8, b * 32, 32, h, vs,
                           nullptr, p.out + O_HGP + (size_t)(b * 8 + h) * 128 * 128, o, b * 2048, 1024 + h * 128, shm);
      }
    } else if (u < 512) {
      int x = u - 256, b = x >> 5, h = (x >> 3) & 3, vs = x & 7;
      seq_unit<128, 256>(wv, (u16*)(R + R_QA), (u16*)(R + R_KA), (u16*)(R + R_PA), (const u16*)(p.ws + OFF_BIG) + (size_t)(MP + b * 64) * NINE + 1024 + h * 256 + vs * 32, NINE, (float*)(R + R_DA), 4, 128 + b, 1, h, vs,
                         p.in[2] + (size_t)(b * 4 + h) * 128 * 256, p.out + O_RETS + (size_t)(b * 4 + h) * 128 * 256, o, MP + b * 64, h * 256, shm);
    } else {
      int x = u - 512, b = x >> 5, h = (x >> 2) & 7, vs = x & 3;
      seq_unit<128, 128>(wv, (u16*)(R + R_QB), (u16*)(R + R_KB), (u16*)(R + R_PB), (const u16*)(p.ws + OFF_BIG) + (size_t)(MP + b * 64) * NINE + 5120 + h * 128 + vs * 32, NINE, (float*)(R + R_DB), 8, 128 + b, 1, h, vs,
                         p.in[3] + (size_t)(b * 8 + h) * 128 * 128, p.out + O_HGS + (size_t)(b * 8 + h) * 128 * 128, o, MP + b * 64, 1024 + h * 128, shm);
    }
  }
}
__device__ __forceinline__ void seq_odd_phase(int wv, const Params& p, unsigned char* shm) {
  unsigned char* R = p.ws + OFF_R;
  u16* o = (u16*)(p.ws + OFF_H);
  for (int u = blockIdx.x; u < 768; u += gridDim.x) {
    if (u < 256) {
      const int x = u & 7, y = u >> 3, g = x * 2 + (y >> 4), b = g >> 2, h = g & 3, vs = y & 15;
      seq_unit<256, 512>(wv, (u16*)(R + R_QC), (u16*)(R + R_KC), (u16*)(R + R_PC), (const u16*)(p.ws + OFF_BIG) + (size_t)(b * 2048) * NINO_PAD + 2048 + h * 512 + vs * 32, NINO_PAD, (float*)(R + R_DC), 4, b * 32, 32, h, vs,
                         nullptr, p.out + O_GLP + (size_t)(b * 4 + h) * 256 * 512, o, b * 2048, h * 512, shm);
    } else {
      int x = u - 256, b = x >> 6, h = (x >> 4) & 3, vs = x & 15;
      seq_unit<256, 512>(wv, (u16*)(R + R_QC), (u16*)(R + R_KC), (u16*)(R + R_PC), (const u16*)(p.ws + OFF_BIG) + (size_t)(MP + b * 64) * NINO_PAD + 2048 + h * 512 + vs * 32, NINO_PAD, (float*)(R + R_DC), 4, 128 + b, 1, h, vs,
                         p.in[4] + (size_t)(b * 4 + h) * 256 * 512, p.out + O_GLS + (size_t)(b * 4 + h) * 256 * 512, o, MP + b * 64, h * 512, shm);
    }
  }
}

__device__ __forceinline__ void up8(u32x4_t v, float* f) {
  f[0] = __uint_as_float(v[0] << 16); f[1] = __uint_as_float(v[0] & 0xffff0000u);
  f[2] = __uint_as_float(v[1] << 16); f[3] = __uint_as_float(v[1] & 0xffff0000u);
  f[4] = __uint_as_float(v[2] << 16); f[5] = __uint_as_float(v[2] & 0xffff0000u);
  f[6] = __uint_as_float(v[3] << 16); f[7] = __uint_as_float(v[3] & 0xffff0000u);
}
template <int ODD>
__device__ __forceinline__ void post_phase(int wv, const Params& p) {
  const int tix = tidx(wv);
  const int lane = tix & 63, gw = blockIdx.x * 8 + (tix >> 6), nw = gridDim.x * 8;
  const u16* o = (const u16*)(p.ws + OFF_H);
  const u16* proj = (const u16*)(p.ws + OFF_BIG);
  u16* ao = (u16*)(p.ws + OFF_R);
#define POST_LOAD(xr_, gr_, row_) do { const int r_ = (row_); \
    _Pragma("unroll") for (int i = 0; i < 4; ++i) { const int col_ = i * 512 + lane * 8; \
      xr_[i] = *(const u32x4_t*)(o + (size_t)r_ * D + col_); \
      gr_[i] = *(const u32x4_t*)(proj + (size_t)r_ * (ODD ? NINO_PAD : NINE) + (ODD ? 4096 + col_ : (i < 2 ? 2048 + col_ : 6144 + (col_ - 1024)))); } } while (0)
  u32x4_t xr[4], gr[4];
  if (gw < MT) POST_LOAD(xr, gr, gw);
#pragma unroll 1
  for (int row = gw; row < MT; row += nw) {
    u32x4_t xn[4], gn4[4];
    if (row + nw < MT) POST_LOAD(xn, gn4, row + nw);
    else {
#pragma unroll
      for (int i = 0; i < 4; ++i) { xn[i] = xr[i]; gn4[i] = gr[i]; }
    }
    __builtin_amdgcn_sched_barrier(0);
#pragma unroll
    for (int i = 0; i < 4; ++i) {
      const int col = i * 512 + lane * 8;
      float x[8], g[8], y[8];
      up8(xr[i], x);
      up8(gr[i], g);
      if (ODD) {
        float ss = 0.f;
#pragma unroll
        for (int e = 0; e < 8; ++e) ss += x[e] * x[e];
#pragma unroll
        for (int off = 32; off > 0; off >>= 1) ss += __shfl_xor(ss, off, 64);
        const float rs = rsqrtf(ss * (1.f / 512.f) + EPS);
        const float* gn = p.in[16] + lane * 8;
#pragma unroll
        for (int e = 0; e < 8; ++e) y[e] = x[e] * rs * gn[e] * siluf_(g[e]);
      } else if (i < 2) {
        float s1 = 0.f;
#pragma unroll
        for (int e = 0; e < 8; ++e) s1 += x[e];
#pragma unroll
        for (int off = 16; off > 0; off >>= 1) s1 += __shfl_xor(s1, off, 64);
        const float mu = s1 * (1.f / 256.f);
        float s2 = 0.f;
#pragma unroll
        for (int e = 0; e < 8; ++e) { float dlt = x[e] - mu; s2 += dlt * dlt; }
#pragma unroll
        for (int off = 16; off > 0; off >>= 1) s2 += __shfl_xor(s2, off, 64);
        const float rs = rsqrtf(s2 * (1.f / 256.f) + EPS);
#pragma unroll
        for (int e = 0; e < 8; ++e) y[e] = (x[e] - mu) * rs * siluf_(g[e]);
      } else {
        float ss = 0.f;
#pragma unroll
        for (int e = 0; e < 8; ++e) ss += x[e] * x[e];
#pragma unroll
        for (int off = 8; off > 0; off >>= 1) ss += __shfl_xor(ss, off, 64);
        const float rs = rsqrtf(ss * (1.f / 128.f) + EPS);
        const float* gn = p.in[12] + (lane & 15) * 8;
#pragma unroll
        for (int e = 0; e < 8; ++e) y[e] = x[e] * rs * gn[e] * siluf_(g[e]);
      }
      st8(ao + (size_t)row * D + col, y);
    }
#pragma unroll
    for (int i = 0; i < 4; ++i) { xr[i] = xn[i]; gr[i] = gn4[i]; }
  }
#undef POST_LOAD
}


__device__ __forceinline__ void final_norm_phase(int wv, const Params& p) {
  const int tix = tidx(wv);
  const int lane = tix & 63, gw = blockIdx.x * 8 + (tix >> 6), nw = gridDim.x * 8;
  const u16* hb = (const u16*)(p.ws + OFF_HN);
  const float* w = p.in[8];
  u32x4_t v[4];
  if (gw < MT) {
#pragma unroll
    for (int i = 0; i < 4; ++i) v[i] = *(const u32x4_t*)(hb + (size_t)gw * D + i * 512 + lane * 8);
  }
#pragma unroll 1
  for (int row = gw; row < MT; row += nw) {
    u32x4_t nx[4];
    const int nrow = row + nw < MT ? row + nw : row;
#pragma unroll
    for (int i = 0; i < 4; ++i) nx[i] = *(const u32x4_t*)(hb + (size_t)nrow * D + i * 512 + lane * 8);
    __builtin_amdgcn_sched_barrier(0);
    float x[4][8];
    float ss = 0.f;
#pragma unroll
    for (int i = 0; i < 4; ++i) {
      up8(v[i], x[i]);
#pragma unroll
      for (int e = 0; e < 8; ++e) ss += x[i][e] * x[i][e];
    }
#pragma unroll
    for (int o = 32; o > 0; o >>= 1) ss += __shfl_xor(ss, o, 64);
    const float rs = rsqrtf(ss * (1.f / D) + EPS);
    float* dst = (row < MP) ? p.out + O_YP + (size_t)row * D : p.out + O_YS + (size_t)(row - MP) * D;
#pragma unroll
    for (int i = 0; i < 4; ++i) {
      const int col = i * 512 + lane * 8;
      const float4 w0 = *(const float4*)(w + col), w1 = *(const float4*)(w + col + 4);
      *(float4*)(dst + col) = make_float4(x[i][0] * rs * w0.x, x[i][1] * rs * w0.y, x[i][2] * rs * w0.z, x[i][3] * rs * w0.w);
      *(float4*)(dst + col + 4) = make_float4(x[i][4] * rs * w1.x, x[i][5] * rs * w1.y, x[i][6] * rs * w1.z, x[i][7] * rs * w1.w);
    }
#pragma unroll
    for (int i = 0; i < 4; ++i) v[i] = nx[i];
  }
}

__device__ __forceinline__ void gate_phase(int wv, const Params& p, int layer) {
  const int tix = tidx(wv);
  const u16* au = (const u16*)(p.ws + OFF_BIG);
  u16* gg = (u16*)(p.ws + OFF_R);
  const float* cw = p.in[19] + (size_t)layer * 3 * DFF;
  const float* cb = p.in[20] + (size_t)layer * DFF;
  const float* cache = p.in[5] + (size_t)layer * 8 * 2 * DFF;
  const int nitems = (MT / 16) * (DFF / 8);
  for (int it = blockIdx.x * 512 + tix; it < nitems; it += gridDim.x * 512) {
    const int cg8 = it % (DFF / 8), rb = it / (DFF / 8), c0 = cg8 * 8, r0 = rb * 16;
    float w0[8], w1[8], w2[8], bb[8], am2[8], am1[8];
#pragma unroll
    for (int e = 0; e < 8; ++e) { w0[e] = cw[c0 + e]; w1[e] = cw[DFF + c0 + e]; w2[e] = cw[2 * DFF + c0 + e]; bb[e] = cb[c0 + e]; }
    int t0, T, b; bool samp = r0 >= MP;
    if (!samp) { b = r0 >> 11; t0 = r0 & 2047; T = 2048; } else { b = (r0 - MP) >> 6; t0 = (r0 - MP) & 63; T = 64; }
    if (t0 == 0) {
      if (samp) {
#pragma unroll
        for (int e = 0; e < 8; ++e) { am2[e] = cache[(size_t)(b * 2 + 0) * DFF + c0 + e]; am1[e] = cache[(size_t)(b * 2 + 1) * DFF + c0 + e]; }
      } else {
#pragma unroll
        for (int e = 0; e < 8; ++e) { am2[e] = 0.f; am1[e] = 0.f; }
      }
    } else {
      ld8(au + (size_t)(r0 - 2) * NUP + c0, am2);
      ld8(au + (size_t)(r0 - 1) * NUP + c0, am1);
    }
#pragma unroll 4
    for (int i = 0; i < 16; ++i) {
      float a[8], uu[8], y[8];
      ld8(au + (size_t)(r0 + i) * NUP + c0, a);
      ld8(au + (size_t)(r0 + i) * NUP + DFF + c0, uu);
#pragma unroll
      for (int e = 0; e < 8; ++e) {
        float cv = bb[e] + w0[e] * am2[e] + w1[e] * am1[e] + w2[e] * a[e];
        y[e] = siluf_(cv) * uu[e];
        am2[e] = am1[e]; am1[e] = a[e];
      }
      st8(gg + (size_t)(r0 + i) * DFF + c0, y);
    }
    if (t0 + 16 == T) {
      float* dst = samp ? p.out + O_CVS + (size_t)(layer * 8 + b) * 2 * DFF : p.out + O_CVP + (size_t)(layer * 4 + b) * 2 * DFF;
#pragma unroll
      for (int e = 0; e < 8; ++e) { dst[c0 + e] = am2[e]; dst[DFF + c0 + e] = am1[e]; }
    }
  }
}


__device__ __forceinline__ void gate_fixup(int wv, const Params& p, int layer) {
  const int tix = tidx(wv);
  const u16* side = (const u16*)(p.ws + OFF_SIDE);
  u16* gg = (u16*)(p.ws + OFF_R);
  const float* cw = p.in[19] + (size_t)layer * 3 * DFF;
  const float* cb = p.in[20] + (size_t)layer * DFF;
  for (int vw = blockIdx.x; vw < (MP / BM) * (D / BM); vw += gridDim.x) {
    int pm, pn;
    tile_coords(vw, MP / BM, D / BM, pm, pn);
    if ((pm & 7) == 0) continue;
    for (int c8 = tix; c8 < DFF / 8; c8 += 512) {
      const int c = c8 * 8;
      float a0[8], a1[8], u0[8], u1[8], q2[8], q1[8], y0[8], y1[8];
      ld8(side + (size_t)(pm * 2 + 0) * DFF + c, a0);
      ld8(side + (size_t)(pm * 2 + 1) * DFF + c, a1);
      ld8(side + SZ_SIDE1 / 2 + (size_t)(pm * 2 + 0) * DFF + c, u0);
      ld8(side + SZ_SIDE1 / 2 + (size_t)(pm * 2 + 1) * DFF + c, u1);
      ld8(side + SZ_SIDE1 + (size_t)((pm - 1) * 2 + 0) * DFF + c, q2);
      ld8(side + SZ_SIDE1 + (size_t)((pm - 1) * 2 + 1) * DFF + c, q1);
#pragma unroll
      for (int e = 0; e < 8; ++e) {
        const float w0 = cw[c + e], w1 = cw[DFF + c + e], w2 = cw[2 * DFF + c + e], bb = cb[c + e];
        y0[e] = siluf_(bb + w0 * q2[e] + w1 * q1[e] + w2 * a0[e]) * u0[e];
        y1[e] = siluf_(bb + w0 * q1[e] + w1 * a0[e] + w2 * a1[e]) * u1[e];
      }
      st8(gg + (size_t)(pm * 256 + 0) * DFF + c, y0);
      st8(gg + (size_t)(pm * 256 + 1) * DFF + c, y1);
    }
  }
  asm volatile("s_waitcnt vmcnt(0)" ::: "memory");
  __syncthreads();
}

#define XB_TMO      128
#define XB_XCNT(j)  (256  + 64 * (j))
#define XB_XSUB(j)  (1280 + 64 * (j))
#define XB_XGEN(j)  (2304 + 64 * (j))
#define XB_TOP      3328
#define XB_TOPGEN   3392
#define XCD_BAR_WORDS 3456
#define XB_SPIN_CAP (1u << 22)
#define LAS __attribute__((address_space(3)))
__device__ __forceinline__ unsigned xb_ld(unsigned* p)              { return __hip_atomic_load(p, __ATOMIC_RELAXED, __HIP_MEMORY_SCOPE_AGENT); }
__device__ __forceinline__ unsigned xb_add(unsigned* p, unsigned v) { return __hip_atomic_fetch_add(p, v, __ATOMIC_RELAXED, __HIP_MEMORY_SCOPE_AGENT); }
__device__ __forceinline__ unsigned xb_xcc_id() { return (unsigned)__builtin_amdgcn_s_getreg((3 << 11) | 20) & 0xFu; }
#define XB_SPIN(cond, bar) do { unsigned _sp = 0; while (cond) { __builtin_amdgcn_s_sleep(1); \
    if ((++_sp & 255u) == 0u) { if (xb_ld(&(bar)[XB_TMO])) break; if (_sp > XB_SPIN_CAP) { atomicAdd(&(bar)[XB_TMO], 1u); break; } } } } while (0)
struct XcdBarrier { unsigned* bar; unsigned x; volatile LAS unsigned* st; };
__device__ __forceinline__ XcdBarrier xcd_barrier_post(int wv, unsigned* bar, volatile LAS unsigned* st) {
  XcdBarrier b; b.bar = bar; b.x = xb_xcc_id(); b.st = st;
  if (tidx(wv) == 0) (void)xb_add(&bar[XB_XCNT(b.x)], 1u);
  return b;
}
__device__ __forceinline__ void xcd_barrier_complete(unsigned* bar, unsigned x, unsigned& nloc, unsigned& nx) {
  const unsigned G = gridDim.x * gridDim.y * gridDim.z;
  unsigned sum, cnt, mine, sp = 0u;
  for (;;) {
    sum = 0u; cnt = 0u; mine = 0u;
#pragma unroll
    for (unsigned j = 0; j < 16; ++j) { const unsigned c = xb_ld(&bar[XB_XCNT(j)]); sum += c; cnt += (c > 0u) ? 1u : 0u; mine = (j == x) ? c : mine; }
    if (sum == G) break;
    __builtin_amdgcn_s_sleep(1);
    if ((++sp & 255u) == 0u) { if (xb_ld(&bar[XB_TMO])) break; if (sp > XB_SPIN_CAP) { atomicAdd(&bar[XB_TMO], 1u); break; } }
  }
  nloc = mine > 0u ? mine : 1u; nx = cnt > 0u ? cnt : 1u;
}
__device__ __forceinline__ void xcd_barrier(int wv, const XcdBarrier& b) {
  asm volatile("s_waitcnt vmcnt(0)" ::: "memory");
  __syncthreads();
  if (tidx(wv) == 0) {
    unsigned* bar = b.bar;
    __builtin_amdgcn_s_waitcnt(0);
    unsigned nloc = b.st[0], nx = b.st[1];
    if (nloc == 0u) { xcd_barrier_complete(bar, b.x, nloc, nx); b.st[0] = nloc; b.st[1] = nx; }
    const unsigned old = xb_add(&bar[XB_XSUB(b.x)], 1u);
    const unsigned gen = old / nloc;
    if (old + 1u == (gen + 1u) * nloc) {
      __builtin_amdgcn_fence(__ATOMIC_RELEASE, "agent");
      asm volatile("s_waitcnt vmcnt(0)" ::: "memory");
      const unsigned og = xb_add(&bar[XB_TOP], 1u);
      const unsigned tg = og / nx;
      if (og + 1u == (tg + 1u) * nx) xb_add(&bar[XB_TOPGEN], 1u);
      else XB_SPIN(xb_ld(&bar[XB_TOPGEN]) == tg, bar);
      __builtin_amdgcn_fence(__ATOMIC_ACQUIRE, "agent");
      xb_add(&bar[XB_XGEN(b.x)], 1u);
      asm volatile("s_waitcnt vmcnt(0)" ::: "memory");
    } else {
      XB_SPIN(xb_ld(&bar[XB_XGEN(b.x)]) == gen, bar);
      __builtin_amdgcn_fence(__ATOMIC_ACQUIRE, "agent");
      asm volatile("s_waitcnt vmcnt(0)" ::: "memory");
    }
  }
  __syncthreads();
}

constexpr int NPHASE = 21;
#ifndef PHMASK
#define PHMASK 0xFFFFFFFFu
#endif
#define PH_ON(k) (((PHMASK) >> (k)) & 1u)
constexpr int LDS_BYTES = 147456;

typedef const __attribute__((address_space(4))) Params* KParamsPtr;
#ifndef XSYNC
#define XSYNC 0
#endif
#ifndef DUPMASK
#define DUPMASK 0u
#endif
#define DUP_ON(k) (((DUPMASK) >> (k)) & 1u)
__device__ __forceinline__ bool ph_in(KParamsPtr& kp, int k) { asm volatile("" : "+s"(kp)); return kp->ph_lo <= k && k < kp->ph_hi; }
#define PH_IN(k) ph_in(kp, (k))
#define PHASE(k, ...) if (PH_IN(k)) { if (PH_ON(k)) { for (int rep = 0; rep < 1 + (int)DUP_ON(k); ++rep) { asm volatile("" : "+s"(kp)); Params p; __builtin_memcpy(&p, kp, sizeof(Params)); unsigned char* ws = p.ws; __VA_ARGS__ } } \
    asm volatile("" : "+s"(kp)); \
    if (kp->coop && (k) + 1 < kp->ph_hi) { XcdBarrier xb; xb.bar = (unsigned*)(kp->ws + OFF_BAR); xb.x = xb_xcc_id(); xb.st = (volatile LAS unsigned*)&xb_words; xcd_barrier(wv, xb); if (XSYNC) xcd_barrier(wv, xb); } }
#define PHASE_X(k, ...) if (PH_IN(k)) { asm volatile("" : "+s"(kp)); Params p; __builtin_memcpy(&p, kp, sizeof(Params)); unsigned char* ws = p.ws; __VA_ARGS__ }
#define GEMM_ACC(k, Aoff, Woff, KK, RSSP, FIXL, RINP, RINS) PHASE(k, { float* rssp = (RSSP); if ((FIXL) >= 0) gate_fixup(wv, p, FIXL); \
    gemm_phase<MP, D, KK, 0>(wv, (const u16*)(ws + Aoff), (const u16*)(ws + Woff), EpiAccum{(u16*)(ws + OFF_HN), rssp, (RINP)}, (u16*)shm); \
    gemm_tail_phase<KK>(wv, (const u16*)(ws + Aoff), (const u16*)(ws + Woff), (float*)shm, (u16*)(ws + OFF_HN), rssp, (RINS)); })

__global__ void __launch_bounds__(512) fwd_kernel(Params p_) {
  extern __shared__ __attribute__((aligned(16))) unsigned char shm[];
  cg::grid_group grid = cg::this_grid();
  KParamsPtr kp = (KParamsPtr)__builtin_amdgcn_kernarg_segment_ptr();
  const int wv = __builtin_amdgcn_readfirstlane((int)(threadIdx.x >> 6));
  __shared__ uint4 xb_words;
  if (tidx(wv) == 0) xb_words = make_uint4(0u, 0u, 0u, 0u);
  __syncthreads();
  if (kp->coop == 2) grid.sync();
  (void)xcd_barrier_post(wv, (unsigned*)(kp->ws + OFF_BAR), (volatile LAS unsigned*)&xb_words);
  PHASE(0,
        convert_w(wv, p.in[9], (u16*)(ws + OFF_WINE), D, NINE, NINE, (u16*)shm);
        convert_w(wv, p.in[10], (u16*)(ws + OFF_WOUTE), D, D, D, (u16*)shm);
        convert_w(wv, p.in[13], (u16*)(ws + OFF_WINO), D, NINO, NINO_PAD, (u16*)shm, p.in[6] + D);
        convert_w(wv, p.in[17], (u16*)(ws + OFF_WOUTO), D, D, D, (u16*)shm);
        convert_w(wv, p.in[18], (u16*)(ws + OFF_WUP0), D, NUP, NUP, (u16*)shm, p.in[7], 1);
        convert_w(wv, p.in[18] + (size_t)D * NUP, (u16*)(ws + OFF_WUP1), D, NUP, NUP, (u16*)shm, p.in[7] + D, 1);
        convert_w(wv, p.in[21], (u16*)(ws + OFF_WDN0), DFF, D, D, (u16*)shm);
        convert_w(wv, p.in[21] + (size_t)DFF * D, (u16*)(ws + OFF_WDN1), DFF, D, D, (u16*)shm);
        for (int i = blockIdx.x * 512 + tidx(wv); i < 3 * MT; i += gridDim.x * 512) ((float*)(ws + OFF_RSS))[i] = 0.f;
        rmsnorm_phase<0>(wv, p, p.in[6]);)
  PHASE(1, gemm_phase<MT, NINE, D, 0>(wv, (const u16*)(ws + OFF_HN), (const u16*)(ws + OFF_WINE), EpiStoreBf16{(u16*)(ws + OFF_BIG), NINE, nullptr}, (u16*)shm);)
  PHASE(2, { const int b_ = blockIdx.x, G_ = gridDim.x;
        prep_range<0>(wv, p, b_, NCH * 4, G_, shm);
        const int first1 = ((NCH * 4 - b_ + G_ - 1) / G_) * G_ + b_ - NCH * 4;
        prep_range<1>(wv, p, first1, NCH * 8, G_, shm); })
  PHASE(3, seq_even_phase(wv, p, shm);)
  PHASE(4, post_phase<0>(wv, p);)
  GEMM_ACC(5, OFF_R, OFF_WOUTE, D, (float*)(ws + OFF_RSS), -1, p.in[0], p.in[1])
  PHASE(7, gemm_phase<MT, NUP, D, 0>(wv, (const u16*)(ws + OFF_HN), (const u16*)(ws + OFF_WUP0), EpiGate{(const __attribute__((address_space(4))) void*)kp, 0, 0}, (u16*)shm);)
  GEMM_ACC(9, OFF_R, OFF_WDN0, DFF, (float*)(ws + OFF_RSS) + MT, 0, (const float*)nullptr, (const float*)nullptr)
  PHASE(11, gemm_phase<MT, NINO_PAD, D, 0>(wv, (const u16*)(ws + OFF_HN), (const u16*)(ws + OFF_WINO), EpiStoreBf16{(u16*)(ws + OFF_BIG), NINO_PAD, (const float*)(ws + OFF_RSS) + MT}, (u16*)shm);)
  PHASE(12, prep_range<2>(wv, p, blockIdx.x, NCH * 4, gridDim.x, shm);)
  PHASE(13, seq_odd_phase(wv, p, shm);)
  PHASE(14, post_phase<1>(wv, p);)
  GEMM_ACC(15, OFF_R, OFF_WOUTO, D, (float*)(ws + OFF_RSS) + 2 * MT, -1, (const float*)nullptr, (const float*)nullptr)
  PHASE(17, gemm_phase<MT, NUP, D, 0>(wv, (const u16*)(ws + OFF_HN), (const u16*)(ws + OFF_WUP1), EpiGate{(const __attribute__((address_space(4))) void*)kp, 1, 2 * MT}, (u16*)shm);)
  GEMM_ACC(19, OFF_R, OFF_WDN1, DFF, (float*)nullptr, 1, (const float*)nullptr, (const float*)nullptr)
  PHASE(20, final_norm_phase(wv, p);)
}

extern "C" void kernel_launch(void* const* d_in, const int* in_sizes, int n_in, void* d_out, int out_size, void* d_ws, size_t ws_size,
                              hipStream_t stream) {
  static int grid_blocks = 0;
  if (grid_blocks == 0) {
    int dev = 0, cus = 0, per_cu = 0;
    hipGetDevice(&dev);
    hipDeviceGetAttribute(&cus, hipDeviceAttributeMultiprocessorCount, dev);
    hipFuncSetAttribute((const void*)fwd_kernel, hipFuncAttributeMaxDynamicSharedMemorySize, LDS_BYTES);
    hipOccupancyMaxActiveBlocksPerMultiprocessor(&per_cu, (const void*)fwd_kernel, 512, LDS_BYTES);
    if (per_cu < 1) per_cu = 1;
    grid_blocks = cus * per_cu;
    (void)hipGetLastError();
  }
  if (n_in != 22 || ws_size < WS_NEED || (size_t)out_size != O_END) {
    fprintf(stderr, "kernel_launch: unexpected sizes n_in=%d ws=%zu need=%zu out=%d\n", n_in, ws_size, (size_t)WS_NEED, out_size);
    hipMemsetAsync(d_out, 0, (size_t)out_size * 4, stream);
    return;
  }
  Params p{};
  for (int i = 0; i < 22; ++i) p.in[i] = (const float*)d_in[i];
  p.out = (float*)d_out;
  p.ws = (unsigned char*)d_ws;
#if 0
  for (int ph = 0; ph < NPHASE; ++ph) {
    p.ph_lo = ph; p.ph_hi = ph + 1; p.coop = 0;
    hipLaunchKernelGGL(fwd_kernel, dim3(grid_blocks), dim3(512), LDS_BYTES, stream, p);
  }
#else
  p.ph_lo = 0; p.ph_hi = NPHASE; p.coop = 1;
  hipMemsetAsync((unsigned char*)d_ws + OFF_BAR, 0, XCD_BAR_WORDS * 4, stream);
  void* args[] = {&p};
  hipError_t e = hipLaunchCooperativeKernel((const void*)fwd_kernel, dim3(grid_blocks), dim3(512), args, LDS_BYTES, stream);
  if (e != hipSuccess) fprintf(stderr, "cooperative launch failed: %s (grid %d)\n", hipGetErrorString(e), grid_blocks);
#endif
}
```

```cpp
#include <hip/hip_runtime.h>
#include <hip/hip_bf16.h>
#include <hip/hip_cooperative_groups.h>
#include <cstdio>
namespace cg = cooperative_groups;

typedef unsigned short u16;
using bf16x8 = __attribute__((ext_vector_type(8))) short;
using f32x4 = __attribute__((ext_vector_type(4))) float;
typedef __attribute__((ext_vector_type(4))) unsigned u32x4_t;

constexpr int MP = 8192, MS = 512, MT = 8704, D = 2048;
constexpr int DFF = 5504, NUP = 11008;
constexpr int NINE = 7168, NINO = 6160, NINO_PAD = 6400;
constexpr int NCH = 136;
constexpr float EPS = 1e-6f;

constexpr size_t SZ_WINE = (size_t)NINE * D * 2, SZ_WOUT = (size_t)D * D * 2, SZ_WINO = (size_t)NINO_PAD * D * 2;
constexpr size_t SZ_WUP = (size_t)NUP * D * 2, SZ_WDN = (size_t)D * DFF * 2;
constexpr size_t OFF_WINE = 0;
constexpr size_t OFF_WOUTE = OFF_WINE + SZ_WINE;
constexpr size_t OFF_WINO = OFF_WOUTE + SZ_WOUT;
constexpr size_t OFF_WOUTO = OFF_WINO + SZ_WINO;
constexpr size_t OFF_WUP0 = OFF_WOUTO + SZ_WOUT;
constexpr size_t OFF_WUP1 = OFF_WUP0 + SZ_WUP;
constexpr size_t OFF_WDN0 = OFF_WUP1 + SZ_WUP;
constexpr size_t OFF_WDN1 = OFF_WDN0 + SZ_WDN;
constexpr size_t OFF_H = OFF_WDN1 + SZ_WDN;
constexpr size_t OFF_HN = OFF_H + (size_t)MT * D * 4;
constexpr size_t OFF_BIG = OFF_HN + (size_t)MT * D * 2;
constexpr size_t OFF_R = OFF_BIG + (size_t)MT * NUP * 2;
constexpr size_t SZ_R = 104ull * 1048576;
constexpr size_t OFF_RSS = OFF_R + SZ_R;
constexpr size_t OFF_SIDE = OFF_RSS + 3ull * MT * 4 + 256;
constexpr size_t SZ_SIDE1 = 34ull * 2 * DFF * 2;
constexpr size_t OFF_BAR = OFF_SIDE + 3 * SZ_SIDE1 + 256;
constexpr size_t WS_NEED = OFF_BAR + 16384;
constexpr size_t R_QA = 0;
constexpr size_t R_KA = R_QA + (size_t)NCH * 4 * 64 * 128 * 2;
constexpr size_t R_VA = R_KA + (size_t)NCH * 4 * 64 * 128 * 2;
constexpr size_t R_PA = R_VA + (size_t)NCH * 4 * 256 * 64 * 2;
constexpr size_t R_DA = R_PA + (size_t)NCH * 4 * 4096 * 2;
constexpr size_t R_QB = R_DA + (size_t)NCH * 4 * 128 * 4;
constexpr size_t R_KB = R_QB + (size_t)NCH * 8 * 64 * 128 * 2;
constexpr size_t R_VB = R_KB + (size_t)NCH * 8 * 64 * 128 * 2;
constexpr size_t R_PB = R_VB + (size_t)NCH * 8 * 128 * 64 * 2;
constexpr size_t R_DB = R_PB + (size_t)NCH * 8 * 4096 * 2;
constexpr size_t R_END_EVEN = R_DB + (size_t)NCH * 8 * 128 * 4;
constexpr size_t R_QC = 0;
constexpr size_t R_KC = R_QC + (size_t)NCH * 4 * 64 * 256 * 2;
constexpr size_t R_VC = R_KC + (size_t)NCH * 4 * 64 * 256 * 2;
constexpr size_t R_PC = R_VC + (size_t)NCH * 4 * 512 * 64 * 2;
constexpr size_t R_DC = R_PC + (size_t)NCH * 4 * 4096 * 2;
constexpr size_t R_END_ODD = R_DC + (size_t)NCH * 4 * 256 * 4;
static_assert(R_END_EVEN <= SZ_R && R_END_ODD <= SZ_R && (size_t)MT * DFF * 2 <= SZ_R, "R region too small");

constexpr size_t O_YP = 0;
constexpr size_t O_YS = O_YP + (size_t)MP * D;
constexpr size_t O_RETP = O_YS + (size_t)MS * D;
constexpr size_t O_RETS = O_RETP + 4ull * 4 * 128 * 256;
constexpr size_t O_HGP = O_RETS + 8ull * 4 * 128 * 256;
constexpr size_t O_HGS = O_HGP + 4ull * 8 * 128 * 128;
constexpr size_t O_GLP = O_HGS + 8ull * 8 * 128 * 128;
constexpr size_t O_GLS = O_GLP + 4ull * 4 * 256 * 512;
constexpr size_t O_CVP = O_GLS + 8ull * 4 * 256 * 512;
constexpr size_t O_CVS = O_CVP + 2ull * 4 * 2 * DFF;
constexpr size_t O_END = O_CVS + 2ull * 8 * 2 * DFF;

struct Params {
  const float* in[22];
  float* out;
  unsigned char* ws;
  int ph_lo, ph_hi, coop, pad;
};

__device__ __forceinline__ u16 f2bf(float f) {
  unsigned u = __float_as_uint(f);
  u += 0x7fffu + ((u >> 16) & 1u);
  return (u16)(u >> 16);
}
__device__ __forceinline__ float bf2f(u16 h) { return __uint_as_float(((unsigned)h) << 16); }
__device__ __forceinline__ unsigned pack2(float a, float b) { return (unsigned)f2bf(a) | ((unsigned)f2bf(b) << 16); }
__device__ __forceinline__ float sigmoidf_(float x) { return 1.f / (1.f + __expf(-x)); }
__device__ __forceinline__ float siluf_(float x) { return x / (1.f + __expf(-x)); }

__device__ __forceinline__ int tidx(int wv) { int l; asm volatile("v_mbcnt_lo_u32_b32 %0, -1, 0\n\tv_mbcnt_hi_u32_b32 %0, -1, %0" : "=v"(l)); return wv * 64 + l; }

__device__ __forceinline__ void convert_w(int wv, const float* __restrict__ src, u16* __restrict__ dst, int K, int N, int Npad, u16* tile, const float* __restrict__ kscale = nullptr, int upperm = 0) {
  const int tix = tidx(wv);
  constexpr int TS = 262;
  const int tn = (Npad + 255) / 256, tk = K / 64, nt = tn * tk, tid = tix;
  for (int t = blockIdx.x; t < nt; t += gridDim.x) {
    const int n0 = (t % tn) * 256, k0 = (t / tn) * 64;
    float4 v[8];
#pragma unroll
    for (int i = 0; i < 8; ++i) {
      const int idx = tid + i * 512, kk = idx >> 6, n = n0 + (idx & 63) * 4;
      v[i] = make_float4(0.f, 0.f, 0.f, 0.f);
      if (n < N) { const f32x4 t_ = __builtin_nontemporal_load((const f32x4*)(src + (size_t)(k0 + kk) * N + n)); v[i] = make_float4(t_[0], t_[1], t_[2], t_[3]); }
      if (kscale) { const float sc = kscale[k0 + kk]; v[i].x *= sc; v[i].y *= sc; v[i].z *= sc; v[i].w *= sc; }
    }
    __syncthreads();
#pragma unroll
    for (int i = 0; i < 8; ++i) {
      const int idx = tid + i * 512, kk = idx >> 6, nl = (idx & 63) * 4;
      *(unsigned*)(tile + kk * TS + nl) = pack2(v[i].x, v[i].y);
      *(unsigned*)(tile + kk * TS + nl + 2) = pack2(v[i].z, v[i].w);
    }
    __syncthreads();
#pragma unroll
    for (int i = 0; i < 4; ++i) {
      const int item = tid + i * 512, ks = item & 7, n = item >> 3;
      if (n0 + n < Npad) {
        const u16* tp = tile + (ks * 8) * TS + n;
        uint4 o;
        o.x = (unsigned)tp[0] | ((unsigned)tp[TS] << 16);
        o.y = (unsigned)tp[2 * TS] | ((unsigned)tp[3 * TS] << 16);
        o.z = (unsigned)tp[4 * TS] | ((unsigned)tp[5 * TS] << 16);
        o.w = (unsigned)tp[6 * TS] | ((unsigned)tp[7 * TS] << 16);
        int nr = n0 + n;
        if (upperm) nr = (nr < DFF) ? ((nr >> 7) * 256 + (nr & 127)) : ((((nr - DFF) >> 7) * 256) + 128 + ((nr - DFF) & 127));
        *(uint4*)(dst + (size_t)nr * K + k0 + ks * 8) = o;
      }
    }
  }
}

template <int MODE>
__device__ __forceinline__ void rmsnorm_phase(int wv, const Params& p, const float* __restrict__ w) {
  const int tix = tidx(wv);
  const int lane = tix & 63, gw = blockIdx.x * 8 + (tix >> 6), nw = gridDim.x * 8;
  const float* h = (const float*)(p.ws + OFF_H);
  u16* hn = (u16*)(p.ws + OFF_HN);
#define RMS_LOAD(dst, row_) do { const int r_ = (row_); const float* src_; \
    if (MODE == 0) src_ = (r_ < MP) ? p.in[0] + (size_t)r_ * D : p.in[1] + (size_t)(r_ - MP) * D; \
    else src_ = h + (size_t)r_ * D; \
    _Pragma("unroll") for (int i = 0; i < 8; ++i) dst[i] = (MODE == 0) ? __builtin_nontemporal_load((const f32x4*)(src_ + (i * 64 + lane) * 4)) : *(const f32x4*)(src_ + (i * 64 + lane) * 4); } while (0)
  f32x4 v[8];
  if (gw < MT) RMS_LOAD(v, gw);
#pragma unroll 1
  for (int row = gw; row < MT; row += nw) {
    f32x4 nx[8];
    if (row + nw < MT) RMS_LOAD(nx, row + nw);
    else {
#pragma unroll
      for (int i = 0; i < 8; ++i) nx[i] = v[i];
    }
    __builtin_amdgcn_sched_barrier(0);
    float ss = 0.f;
#pragma unroll
    for (int i = 0; i < 8; ++i) ss += v[i][0] * v[i][0] + v[i][1] * v[i][1] + v[i][2] * v[i][2] + v[i][3] * v[i][3];
#pragma unroll
    for (int o = 32; o > 0; o >>= 1) ss += __shfl_xor(ss, o, 64);
    const float rs = rsqrtf(ss * (1.f / D) + EPS);
#pragma unroll
    for (int i = 0; i < 8; ++i) {
      const int col = (i * 64 + lane) * 4;
      const float4 wv4 = *(const float4*)(w + col);
      const float4 y = make_float4(v[i][0] * rs * wv4.x, v[i][1] * rs * wv4.y, v[i][2] * rs * wv4.z, v[i][3] * rs * wv4.w);
      if (MODE == 2) {
        float* dst = (row < MP) ? p.out + O_YP + (size_t)row * D : p.out + O_YS + (size_t)(row - MP) * D;
        *(float4*)(dst + col) = y;
      } else {
        *(uint2*)(hn + (size_t)row * D + col) = make_uint2(pack2(y.x, y.y), pack2(y.z, y.w));
      }
    }
#pragma unroll
    for (int i = 0; i < 8; ++i) v[i] = nx[i];
  }
#undef RMS_LOAD
}

__device__ __forceinline__ void ld8(const u16* p, float* f) {
  uint4 v = *(const uint4*)p;
  f[0] = __uint_as_float(v.x << 16); f[1] = __uint_as_float(v.x & 0xffff0000u);
  f[2] = __uint_as_float(v.y << 16); f[3] = __uint_as_float(v.y & 0xffff0000u);
  f[4] = __uint_as_float(v.z << 16); f[5] = __uint_as_float(v.z & 0xffff0000u);
  f[6] = __uint_as_float(v.w << 16); f[7] = __uint_as_float(v.w & 0xffff0000u);
}
__device__ __forceinline__ void st8(u16* p, const float* f) {
  *(uint4*)p = make_uint4(pack2(f[0], f[1]), pack2(f[2], f[3]), pack2(f[4], f[5]), pack2(f[6], f[7]));
}

constexpr int BM = 256, BK = 64, HALF = 128, NXCD = 8, WGM = 8, HT = HALF * BK;

__device__ __forceinline__ int lds_byte(int r, int c) {
  int st = (r >> 4) * 2 + (c >> 5), rr = r & 15, cc = c & 31, ob = rr * 64 + cc * 2;
  return st * 1024 + (ob ^ (((ob >> 9) & 1) << 5));
}
__device__ __forceinline__ void stage_rc(int b, int& R, int& C) {
  int st = b / 1024, sb = b % 1024, swz = sb ^ (((sb >> 9) & 1) << 5);
  R = (st >> 1) * 16 + swz / 64; C = (st & 1) * 32 + (swz % 64) / 2;
}

__device__ __forceinline__ void tile_coords(int wgid, int nM, int nN, int& pm, int& pn) {
  const int nwg = nM * nN;
  { int q = nwg / NXCD, r = nwg % NXCD, xcd = wgid % NXCD, off = wgid / NXCD;
    wgid = (xcd < r ? xcd * (q + 1) : r * (q + 1) + (xcd - r) * q) + off; }
  const int nig = WGM * nN, gid = wgid / nig, fm = gid * WGM, gsz = min(nM - fm, WGM);
  pm = fm + ((wgid % nig) % gsz); pn = (wgid % nig) / gsz;
}

struct EpiStoreBf16 {
  static constexpr bool GATE = false;
  static constexpr bool LDSST = true;
  u16* out; int ldo; const float* rss;
  __device__ __forceinline__ float row_scale(int row) const { return rss ? rsqrtf(rss[row] * (1.f / D) + EPS) : 1.f; }
  __device__ __forceinline__ float operator()(int row, int col, f32x4 v, float sc) const {
    uint2 pk = make_uint2(pack2(v[0] * sc, v[1] * sc), pack2(v[2] * sc, v[3] * sc));
    *(uint2*)(out + (size_t)row * ldo + col) = pk;
    return 0.f;
  }
  __device__ __forceinline__ void row_end(int, float, int) const {}
  __device__ __forceinline__ f32x4 finalize(int, int, f32x4 v, float sc, float&) const { return f32x4{v[0] * sc, v[1] * sc, v[2] * sc, v[3] * sc}; }
};
struct EpiAccum {
  static constexpr bool GATE = false;
  static constexpr bool LDSST = true;
  u16* out; float* rss; const float* rin32; static constexpr int ldo = D;
  __device__ __forceinline__ float row_scale(int) const { return 1.f; }
  __device__ __forceinline__ float operator()(int, int, f32x4, float) const { return 0.f; }
  __device__ __forceinline__ f32x4 finalize(int row, int col, f32x4 v, float, float& ss) const {
    float4 o;
    if (rin32) o = *(const float4*)(rin32 + (size_t)row * D + col);
    else { const uint2 r = *(const uint2*)(out + (size_t)row * D + col); o = make_float4(__uint_as_float(r.x << 16), __uint_as_float(r.x & 0xffff0000u), __uint_as_float(r.y << 16), __uint_as_float(r.y & 0xffff0000u)); }
    o.x += v[0]; o.y += v[1]; o.z += v[2]; o.w += v[3];
    if (rss) ss += o.x * o.x + o.y * o.y + o.z * o.z + o.w * o.w;
    return f32x4{o.x, o.y, o.z, o.w};
  }
  __device__ __forceinline__ void row_end(int row, float ss, int fq) const {
    if (rss) {
      ss += __shfl_xor(ss, 16, 64);
      ss += __shfl_xor(ss, 32, 64);
      if (fq == 0) unsafeAtomicAdd(rss + row, ss);
    }
  }
};

struct EpiGate {
  static constexpr bool GATE = true;
  static constexpr bool LDSST = false;
  const __attribute__((address_space(4))) void* kp; int layer; int rssoff;
  __device__ __forceinline__ float row_scale(int) const { return 1.f; }
  __device__ __forceinline__ float operator()(int, int, f32x4, float) const { return 0.f; }
  __device__ __forceinline__ void row_end(int, float, int) const {}
};

template <int M, int N, int K, int TAIL, class Epi>
__device__ __forceinline__ void gemm_phase(int wv, const u16* __restrict__ A, const u16* __restrict__ Bt, Epi epi, u16* shm) {
  const int tix = tidx(wv);
#define SA(b, h) (shm + ((b) * 2 + (h)) * HT)
#define SB(b, h) (shm + (4 + (b) * 2 + (h)) * HT)
#define STAGE(P, BASE, br, kt) do { const u16* _gb = BASE + ((long)(br) * K + (long)(kt0 + (kt)) * BK); \
    for (int _i = 0; _i < 2; ++_i) { int _b = tix * 16 + _i * 8192; \
      __builtin_amdgcn_global_load_lds((const unsigned*)(_gb + toff[_i]), \
        (__attribute__((address_space(3))) unsigned*)((char*)(P) + _b), 16, 0, 0); } } while (0)
#define LDA(dst, b, h) for (int m = 0; m < 4; ++m) for (int k = 0; k < 2; ++k) \
    dst[m][k] = *reinterpret_cast<const bf16x8*>((char*)SA(b, h) + lds_byte(wr * 64 + m * 16 + fr, k * 32 + fq * 8))
#define LDB(dst, b, h) for (int n = 0; n < 2; ++n) for (int k = 0; k < 2; ++k) \
    dst[n][k] = *reinterpret_cast<const bf16x8*>((char*)SB(b, h) + lds_byte(wc * 32 + n * 16 + fr, k * 32 + fq * 8))
#define MMA(ai, bj, At_, Bt_) do { __builtin_amdgcn_s_setprio(1); \
    for (int m = 0; m < 4; ++m) for (int n = 0; n < 2; ++n) for (int k = 0; k < 2; ++k) \
      acc[ai][bj][m][n] = __builtin_amdgcn_mfma_f32_16x16x32_bf16(Bt_[n][k], At_[m][k], acc[ai][bj][m][n], 0, 0, 0); \
    __builtin_amdgcn_s_setprio(0); } while (0)
#define WAIT_V(n) asm volatile("s_waitcnt vmcnt(" #n ")" ::: "memory")
#define WAIT_L(n) asm volatile("s_waitcnt lgkmcnt(" #n ")" ::: "memory")
#define BAR __builtin_amdgcn_s_barrier()
#define SCHED __builtin_amdgcn_sched_barrier(0)
  const int nM = M / BM, nN = N / BM, nwg = nM * nN, G = gridDim.x;
  const int nunits = nwg;
  const int wid = tix >> 6, lane = tix & 63, wr = wid >> 2, wc = wid & 3, fr = lane & 15, fq = lane >> 4;
  const int nt_total = K / BK;
  unsigned toff[2];
  for (int _i = 0; _i < 2; ++_i) { int _b = tix * 16 + _i * 8192; int _r, _c; stage_rc(_b, _r, _c); toff[_i] = (unsigned)(_r * K + _c); }
  for (int vw = blockIdx.x; vw < nunits; vw += G) {
    int pm, pn;
    tile_coords(vw, nM, nN, pm, pn);
    const int brow = pm * BM, bcol = pn * BM;
    constexpr int kt0 = 0, nt = nt_total;
    f32x4 acc[2][2][4][2];
    for (int a = 0; a < 2; ++a) for (int b = 0; b < 2; ++b) for (int m = 0; m < 4; ++m) for (int n = 0; n < 2; ++n) acc[a][b][m][n] = f32x4{0.f, 0.f, 0.f, 0.f};
    bf16x8 At[4][2], B0[2][2], B1[2][2];
    STAGE(SB(0, 0), Bt, bcol, 0); STAGE(SA(0, 0), A, brow, 0);
    STAGE(SB(0, 1), Bt, bcol + HALF, 0); STAGE(SA(0, 1), A, brow + HALF, 0);
    if (wr == 1) BAR;
    WAIT_V(4); BAR;
    STAGE(SB(1, 0), Bt, bcol, 1); STAGE(SA(1, 0), A, brow, 1); STAGE(SB(1, 1), Bt, bcol + HALF, 1);
    WAIT_V(6); BAR;
    for (int t = 0; t < nt - 2; t += 2) {
      LDB(B0, 0, 0); SCHED; LDA(At, 0, 0); STAGE(SA(1, 1), A, brow + HALF, t + 1);
      WAIT_L(8); BAR; WAIT_L(0); MMA(0, 0, At, B0); BAR; SCHED;
      LDB(B1, 0, 1); STAGE(SB(0, 0), Bt, bcol, t + 2);
      BAR; WAIT_L(0); MMA(0, 1, At, B1); BAR;
      LDA(At, 0, 1); STAGE(SA(0, 0), A, brow, t + 2);
      BAR; WAIT_L(0); MMA(1, 0, At, B0); BAR; SCHED;
      STAGE(SB(0, 1), Bt, bcol + HALF, t + 2);
      WAIT_V(6); BAR; MMA(1, 1, At, B1); BAR;
      LDB(B0, 1, 0); SCHED; LDA(At, 1, 0); STAGE(SA(0, 1), A, brow + HALF, t + 2);
      WAIT_L(8); BAR; WAIT_L(0); MMA(0, 0, At, B0); BAR; SCHED;
      LDB(B1, 1, 1); STAGE(SB(1, 0), Bt, bcol, t + 3);
      BAR; WAIT_L(0); MMA(0, 1, At, B1); BAR;
      LDA(At, 1, 1); STAGE(SA(1, 0), A, brow, t + 3);
      BAR; WAIT_L(0); MMA(1, 0, At, B0); BAR; SCHED;
      STAGE(SB(1, 1), Bt, bcol + HALF, t + 3);
      WAIT_V(6); BAR; MMA(1, 1, At, B1); BAR;
    }
    { LDB(B0, 0, 0); LDA(At, 0, 0); STAGE(SA(1, 1), A, brow + HALF, nt - 1);
      BAR; WAIT_L(0); MMA(0, 0, At, B0); BAR;
      LDB(B1, 0, 1); BAR; WAIT_L(0); MMA(0, 1, At, B1); BAR;
      LDA(At, 0, 1); WAIT_V(4); BAR; WAIT_L(0); MMA(1, 0, At, B0); MMA(1, 1, At, B1); BAR; }
    { LDB(B0, 1, 0); LDA(At, 1, 0); WAIT_V(2); BAR; WAIT_L(0); MMA(0, 0, At, B0); BAR;
      LDB(B1, 1, 1); WAIT_V(0); BAR; WAIT_L(0); MMA(0, 1, At, B1); BAR;
      LDA(At, 1, 1); BAR; WAIT_L(0); MMA(1, 0, At, B0); MMA(1, 1, At, B1); BAR; }
    if (wr == 0) BAR;
    if constexpr (Epi::GATE) {
      constexpr int LS = 136;
      u16* La = shm;
      u16* Lu = shm + 256 * LS;
      const __attribute__((address_space(4))) Params* gkp = (const __attribute__((address_space(4))) Params*)epi.kp;
      asm volatile("" : "+s"(gkp));
      int e_pm = pm, e_pn = pn, e_tix = tix;
      asm volatile("" : "+s"(e_pm), "+s"(e_pn));
      asm volatile("" : "+v"(e_tix));
      const int e_brow = e_pm * BM;
      {
        const int e_lane = e_tix & 63, e_wid = e_tix >> 6, e_wr = e_wid >> 2, e_wc = e_wid & 3, e_fr = e_lane & 15, e_fq = e_lane >> 4;
        const float* rss = (const float*)(gkp->ws + OFF_RSS) + epi.rssoff;
        _Pragma("unroll") for (int ai = 0; ai < 2; ++ai) _Pragma("unroll") for (int m = 0; m < 4; ++m) {
          const int rl = ai * HALF + e_wr * 64 + m * 16 + e_fr;
          const float sc = rsqrtf(rss[e_brow + rl] * (1.f / D) + EPS);
          _Pragma("unroll") for (int n = 0; n < 2; ++n) {
            const f32x4 a = acc[ai][0][m][n], uu = acc[ai][1][m][n];
            const int lo = rl * LS + e_wc * 32 + n * 16 + e_fq * 4;
            *(uint2*)(La + lo) = make_uint2(pack2(a[0] * sc, a[1] * sc), pack2(a[2] * sc, a[3] * sc));
            *(uint2*)(Lu + lo) = make_uint2(pack2(uu[0] * sc, uu[1] * sc), pack2(uu[2] * sc, uu[3] * sc));
          }
        }
      }
      WAIT_L(0); BAR; asm volatile("" ::: "memory");
      {
        const bool samp = e_brow >= MP;
        const int layer = epi.layer;
        u16* gg = (u16*)(gkp->ws + OFF_R);
        u16* side = (u16*)(gkp->ws + OFF_SIDE);
        const float* cw = gkp->in[19] + (size_t)layer * 3 * DFF;
        const float* cb = gkp->in[20] + (size_t)layer * DFF;
        const float* cache = gkp->in[5] + (size_t)layer * 8 * 2 * DFF;
        float* cvo = gkp->out + (samp ? O_CVS + (size_t)layer * 8 * 2 * DFF : O_CVP + (size_t)layer * 4 * 2 * DFF);
        const int cg = e_tix & 15, r0 = e_tix >> 4, c = e_pn * 128 + cg * 8;
        float w0[8], w1[8], w2[8], bb[8];
        _Pragma("unroll") for (int e = 0; e < 8; ++e) { w0[e] = cw[c + e]; w1[e] = cw[DFF + c + e]; w2[e] = cw[2 * DFF + c + e]; bb[e] = cb[c + e]; }
        _Pragma("unroll 1") for (int it = 0; it < 8; ++it) {
          const int rl = it * 32 + r0;
          const int t = samp ? (rl & 63) : ((e_pm & 7) * 256 + rl);
          const int sb = (e_pm - 32) * 4 + (rl >> 6);
          float a[8], uu[8], am1[8], am2[8], y[8];
          ld8(La + rl * LS + cg * 8, a);
          ld8(Lu + rl * LS + cg * 8, uu);
          _Pragma("unroll") for (int e = 0; e < 8; ++e) { am1[e] = 0.f; am2[e] = 0.f; }
          if (t >= 1 && rl >= 1) ld8(La + (rl - 1) * LS + cg * 8, am1);
          if (t >= 2 && rl >= 2) ld8(La + (rl - 2) * LS + cg * 8, am2);
          if (samp && t < 2) {
            const float* c1 = cache + (size_t)(sb * 2 + 1) * DFF + c;
            if (t == 0) {
              const float* c0 = cache + (size_t)(sb * 2 + 0) * DFF + c;
              _Pragma("unroll") for (int e = 0; e < 8; ++e) { am2[e] = c0[e]; am1[e] = c1[e]; }
            } else {
              _Pragma("unroll") for (int e = 0; e < 8; ++e) am2[e] = c1[e];
            }
          }
          if (!(t >= 2 && rl < 2)) {
            _Pragma("unroll") for (int e = 0; e < 8; ++e) { float cv = bb[e] + w0[e] * am2[e] + w1[e] * am1[e] + w2[e] * a[e]; y[e] = siluf_(cv) * uu[e]; }
            st8(gg + (size_t)(e_brow + rl) * DFF + c, y);
          } else {
            st8(side + (size_t)(e_pm * 2 + rl) * DFF + c, a);
            st8(side + SZ_SIDE1 / 2 + (size_t)(e_pm * 2 + rl) * DFF + c, uu);
          }
          if (rl >= 254) st8(side + SZ_SIDE1 + (size_t)(e_pm * 2 + rl - 254) * DFF + c, a);
          int crow = -1;
          if (!samp) { if ((e_pm & 7) == 7 && rl >= 254) crow = (e_pm >> 3) * 2 + rl - 254; }
          else { if ((rl & 63) >= 62) crow = sb * 2 + (rl & 63) - 62; }
          if (crow >= 0) {
            float* dst = cvo + (size_t)crow * DFF + c;
            *(float4*)dst = make_float4(a[0], a[1], a[2], a[3]);
            *(float4*)(dst + 4) = make_float4(a[4], a[5], a[6], a[7]);
          }
        }
      }
      WAIT_L(0); BAR; asm volatile("" ::: "memory");
    } else if constexpr (Epi::LDSST) {
      constexpr int LS = 136;
      u16* L0 = shm;
      u16* L1 = shm + 256 * LS;
      int e_brow = brow, e_bcol = bcol, e_tix = tix;
      asm volatile("" : "+s"(e_brow), "+s"(e_bcol));
      asm volatile("" : "+v"(e_tix));
      {
        const int e_lane = e_tix & 63, e_wid = e_tix >> 6, e_wr = e_wid >> 2, e_wc = e_wid & 3, e_fr = e_lane & 15, e_fq = e_lane >> 4;
        _Pragma("unroll") for (int ai = 0; ai < 2; ++ai) _Pragma("unroll") for (int m = 0; m < 4; ++m) {
          const int rl = ai * HALF + e_wr * 64 + m * 16 + e_fr;
          const float sc = epi.row_scale(e_brow + rl);
          float ss = 0.f;
          _Pragma("unroll") for (int n = 0; n < 2; ++n) {
            const int cl = e_wc * 32 + n * 16 + e_fq * 4;
            const f32x4 c0 = epi.finalize(e_brow + rl, e_bcol + cl, acc[ai][0][m][n], sc, ss);
            const f32x4 c1 = epi.finalize(e_brow + rl, e_bcol + 128 + cl, acc[ai][1][m][n], sc, ss);
            const int lo = rl * LS + cl;
            *(uint2*)(L0 + lo) = make_uint2(pack2(c0[0], c0[1]), pack2(c0[2], c0[3]));
            *(uint2*)(L1 + lo) = make_uint2(pack2(c1[0], c1[1]), pack2(c1[2], c1[3]));
          }
          epi.row_end(e_brow + rl, ss, e_fq);
          if (m & 1) asm volatile("" ::: "memory");
        }
      }
      WAIT_L(0); BAR; asm volatile("" ::: "memory");
      {
        const int cg = e_tix & 15, r0 = e_tix >> 4;
        _Pragma("unroll 1") for (int it = 0; it < 8; ++it) {
          const int rl = it * 32 + r0;
          const uint4 x0 = *(const uint4*)(L0 + rl * LS + cg * 8), x1 = *(const uint4*)(L1 + rl * LS + cg * 8);
          u16* dst = epi.out + (size_t)(e_brow + rl) * epi.ldo + e_bcol + cg * 8;
          *(uint4*)dst = x0;
          *(uint4*)(dst + 128) = x1;
        }
      }
      WAIT_L(0); BAR; asm volatile("" ::: "memory");
    } else {
    for (int ai = 0; ai < 2; ++ai) for (int m = 0; m < 4; ++m) {
      const int row = brow + ai * HALF + wr * 64 + m * 16 + fr;
      const float sc = epi.row_scale(row);
      float ss = 0.f;
      for (int bj = 0; bj < 2; ++bj) for (int n = 0; n < 2; ++n)
        ss += epi(row, bcol + bj * HALF + wc * 32 + n * 16 + fq * 4, acc[ai][bj][m][n], sc);
      epi.row_end(row, ss, fq);
      if (m & 1) asm volatile("" ::: "memory");
    }
    }
  }
#undef SA
#undef SB
#undef STAGE
#undef LDA
#undef LDB
#undef MMA
}


template <int K>
__device__ __forceinline__ void gemm_tail_phase(int wv, const u16* __restrict__ A, const u16* __restrict__ Bt, float* lds, u16* __restrict__ hb, float* __restrict__ rss, const float* __restrict__ rin32_tail) {
  const int tix = tidx(wv);
  const int tid = tix, w = tid >> 6, lane = tid & 63, fr = lane & 15, fq = lane >> 4;
  for (int u = blockIdx.x; u < 256; u += gridDim.x) {
    const int tm = u >> 5, tn = u & 31;
    const u16* Ab = A + (size_t)(MP + tm * 64 + fr) * K + fq * 8;
    const u16* Bb = Bt + (size_t)(tn * 64 + fr) * K + fq * 8;
    f32x4 acc[4][4];
#pragma unroll
    for (int i = 0; i < 4; ++i)
#pragma unroll
      for (int j = 0; j < 4; ++j) acc[i][j] = f32x4{0.f, 0.f, 0.f, 0.f};
    const u16* Ab2 = A + (size_t)(MP + tm * 64 + fr) * K + fq * 16;
    const u16* Bb2 = Bt + (size_t)(tn * 64 + fr) * K + fq * 16;
#pragma unroll 1
    for (int ks = w; ks < K / 64; ks += 8) {
      bf16x8 a[4][2], b[4][2];
#pragma unroll
      for (int i = 0; i < 4; ++i) {
        a[i][0] = *(const bf16x8*)(Ab2 + (size_t)i * 16 * K + ks * 64);
        a[i][1] = *(const bf16x8*)(Ab2 + (size_t)i * 16 * K + ks * 64 + 8);
        b[i][0] = *(const bf16x8*)(Bb2 + (size_t)i * 16 * K + ks * 64);
        b[i][1] = *(const bf16x8*)(Bb2 + (size_t)i * 16 * K + ks * 64 + 8);
      }
#pragma unroll
      for (int mb = 0; mb < 4; ++mb)
#pragma unroll
        for (int nb = 0; nb < 4; ++nb) {
          acc[mb][nb] = __builtin_amdgcn_mfma_f32_16x16x32_bf16(b[nb][0], a[mb][0], acc[mb][nb], 0, 0, 0);
          acc[mb][nb] = __builtin_amdgcn_mfma_f32_16x16x32_bf16(b[nb][1], a[mb][1], acc[mb][nb], 0, 0, 0);
        }
    }
    __syncthreads();
#pragma unroll
    for (int mb = 0; mb < 4; ++mb)
#pragma unroll
      for (int nb = 0; nb < 4; ++nb) *(f32x4*)(lds + w * 4096 + (mb * 16 + fr) * 64 + nb * 16 + fq * 4) = acc[mb][nb];
    __syncthreads();
    const int e = tid * 8, row = e >> 6, col = e & 63;
    float4 s0 = make_float4(0.f, 0.f, 0.f, 0.f), s1 = s0;
#pragma unroll
    for (int ww = 0; ww < 8; ++ww) {
      float4 x0 = *(const float4*)(lds + ww * 4096 + e), x1 = *(const float4*)(lds + ww * 4096 + e + 4);
      s0.x += x0.x; s0.y += x0.y; s0.z += x0.z; s0.w += x0.w;
      s1.x += x1.x; s1.y += x1.y; s1.z += x1.z; s1.w += x1.w;
    }
    const int grow = MP + tm * 64 + row;
    u16* q = hb + (size_t)grow * D + tn * 64 + col;
    float r8[8];
    if (rin32_tail) {
      const float* rq_ = rin32_tail + (size_t)(tm * 64 + row) * D + tn * 64 + col;
      const float4 a0 = *(const float4*)rq_, a1 = *(const float4*)(rq_ + 4);
      r8[0] = a0.x; r8[1] = a0.y; r8[2] = a0.z; r8[3] = a0.w; r8[4] = a1.x; r8[5] = a1.y; r8[6] = a1.z; r8[7] = a1.w;
    } else ld8(q, r8);
    r8[0] += s0.x; r8[1] += s0.y; r8[2] += s0.z; r8[3] += s0.w; r8[4] += s1.x; r8[5] += s1.y; r8[6] += s1.z; r8[7] += s1.w;
    st8(q, r8);
    if (rss) {
      float ss = 0.f;
#pragma unroll
      for (int e2 = 0; e2 < 8; ++e2) ss += r8[e2] * r8[e2];
      ss += __shfl_xor(ss, 1, 64); ss += __shfl_xor(ss, 2, 64); ss += __shfl_xor(ss, 4, 64);
      if ((tid & 7) == 0) unsafeAtomicAdd(rss + grow, ss);
    }
  }
}

template <int MODE>
__device__ __forceinline__ void prep_range(int wv, const Params& p, int u0, int u1, int ustride, unsigned char* shm) {
  const int tix = tidx(wv);
  constexpr int K = (MODE == 2) ? 256 : 128;
  constexpr int V = (MODE == 0) ? 256 : (MODE == 1 ? 128 : 512);
  constexpr int H = (MODE == 1) ? 8 : 4;
  constexpr int LD = (MODE == 2) ? NINO_PAD : NINE;
  constexpr int NSEG = 4, TL = 16, KS = K + 8, VS = V + 8, NPASS = K / 128;
  constexpr int NQ = K / 64, NV = V / 64;
  constexpr bool PFV = false;
  const int tid = tix, seg = tid >> 7;
  const u16* proj = (const u16*)(p.ws + OFF_BIG);
  unsigned char* R = p.ws + OFF_R;
  u16* qin = (u16*)(R + (MODE == 0 ? R_QA : MODE == 1 ? R_QB : R_QC));
  u16* koT = (u16*)(R + (MODE == 0 ? R_KA : MODE == 1 ? R_KB : R_KC));
  u16* vT = (u16*)(R + (MODE == 0 ? R_VA : MODE == 1 ? R_VB : R_VC));
  u16* Pm = (u16*)(R + (MODE == 0 ? R_PA : MODE == 1 ? R_PB : R_PC));
  float* dL = (float*)(R + (MODE == 0 ? R_DA : MODE == 1 ? R_DB : R_DC));
  u16* qs = (u16*)shm;
  u16* ksm = qs + 64 * KS;
  float* segtot = (float*)(ksm + 64 * KS);
  float* gl = segtot + NSEG * K;
  u16* rq = (u16*)(gl + 64 * 16);
  u16* rk = rq + 64 * KS;
  u16* rv = PFV ? rk + 64 * KS : rq;
  typedef __attribute__((ext_vector_type(4))) unsigned u32x4_t;
  u32x4_t rqr[NQ], rkr[NQ], rvr[PFV ? NV : 1];
#define PREP_ISSUE(uu_) do { \
    const int c_i = (uu_) / H, h_i = (uu_) % H; \
    const int row0_i = (c_i < 128) ? (c_i >> 5) * 2048 + (c_i & 31) * 64 : MP + (c_i - 128) * 64; \
    const u16* prow_i = proj + (size_t)row0_i * LD; \
    const int cq_i = (MODE == 0) ? h_i * 128 : (MODE == 1 ? 3072 + h_i * 128 : h_i * 256); \
    const int ck_i = (MODE == 0) ? 512 + h_i * 128 : (MODE == 1 ? 4096 + h_i * 128 : 1024 + h_i * 256); \
    const int vc_i = (MODE == 0) ? 1024 + h_i * 256 : (MODE == 1 ? 5120 + h_i * 128 : 2048 + h_i * 512); \
    _Pragma("unroll") for (int i = 0; i < NQ; ++i) { \
      const int idx = tid + i * 512, r = idx / (K / 8), cc = idx % (K / 8); \
      rqr[i] = *(const u32x4_t*)(prow_i + (size_t)r * LD + cq_i + cc * 8); \
      rkr[i] = *(const u32x4_t*)(prow_i + (size_t)r * LD + ck_i + cc * 8); \
    } \
    if constexpr (PFV) { \
      _Pragma("unroll") for (int i = 0; i < NV; ++i) { \
        const int idx = tid + i * 512, r = idx / (V / 8), cc = idx % (V / 8); \
        rvr[i] = *(const u32x4_t*)(prow_i + (size_t)r * LD + vc_i + cc * 8); \
      } \
    } } while (0)
  if (u0 < u1) PREP_ISSUE(u0);
#pragma unroll 1
  for (int uu = u0; uu < u1; uu += ustride) {
  const int c = uu / H, h = uu % H;
  int row0, pos0;
  if (c < 128) { row0 = (c >> 5) * 2048 + (c & 31) * 64; pos0 = (c & 31) * 64; }
  else { row0 = MP + (c - 128) * 64; pos0 = 1024; }
  const size_t u = (size_t)c * H + h;
  const u16* prow = proj + (size_t)row0 * LD;
  const int vc0 = (MODE == 0) ? 1024 + h * 256 : (MODE == 1 ? 5120 + h * 128 : 2048 + h * 512);
  __syncthreads();
#pragma unroll
  for (int i = 0; i < NQ; ++i) {
    const int idx = tid + i * 512, r = idx / (K / 8), cc = idx % (K / 8);
    *(u32x4_t*)(rq + r * KS + cc * 8) = rqr[i];
    *(u32x4_t*)(rk + r * KS + cc * 8) = rkr[i];
  }
  if constexpr (PFV) {
#pragma unroll
    for (int i = 0; i < NV; ++i) {
      const int idx = tid + i * 512, r = idx / (V / 8), cc = idx % (V / 8);
      *(u32x4_t*)(rv + r * VS + cc * 8) = rvr[i];
    }
  }
  if (MODE == 2) {
    for (int i = tid; i < 64 * 2; i += 512) {
      const int r = i >> 1, hh = i & 1;
      uint4 g4 = *(const uint4*)(prow + (size_t)r * LD + 6144 + hh * 8);
      float* d = gl + r * 16 + hh * 8;
      d[0] = __uint_as_float(g4.x << 16); d[1] = __uint_as_float(g4.x & 0xffff0000u);
      d[2] = __uint_as_float(g4.y << 16); d[3] = __uint_as_float(g4.y & 0xffff0000u);
      d[4] = __uint_as_float(g4.z << 16); d[5] = __uint_as_float(g4.z & 0xffff0000u);
      d[6] = __uint_as_float(g4.w << 16); d[7] = __uint_as_float(g4.w & 0xffff0000u);
    }
  }
  if (uu + ustride < u1) PREP_ISSUE(uu + ustride);
  __builtin_amdgcn_sched_barrier(0);
  __syncthreads();
#pragma unroll 1
  for (int pass = 0; pass < NPASS; ++pass) {
  const int kk = pass * 128 + (tid & 127);
  float qv[TL], kv[TL], bc[TL];
  if (MODE == 0) {
    const int j = kk & 63;
    const float invr = exp2f(-(float)j * (13.287712379549449f / 64.f)) * 0.15915494309189535f;
    const float lgam = log1pf(-exp2f(-5.f - (float)h));
#pragma unroll
    for (int i = 0; i < TL; ++i) {
      const int l = seg * TL + i;
      float rev = (float)(pos0 + l) * invr;
      rev -= floorf(rev);
      const float sn = __builtin_amdgcn_sinf(rev), cs = __builtin_amdgcn_cosf(rev);
      const float q1 = bf2f(rq[l * KS + j]), q2 = bf2f(rq[l * KS + j + 64]), k1 = bf2f(rk[l * KS + j]), k2 = bf2f(rk[l * KS + j + 64]);
      const float qr = (kk < 64) ? q1 * cs - q2 * sn : q1 * sn + q2 * cs;
      const float kr = (kk < 64) ? k1 * cs - k2 * sn : k1 * sn + k2 * cs;
      qv[i] = qr; kv[i] = kr * 0.08838834764831845f;
      bc[i] = lgam;
    }
  } else if (MODE == 1) {
    const int ch = h * 128 + kk;
    const float* lbp = p.in[11];
    float e0 = __expf(lbp[ch]), e1 = __expf(lbp[1024 + ch]), e2 = __expf(lbp[2048 + ch]);
    const float lb = e0 / (e0 + e1 + e2);
#pragma unroll
    for (int i = 0; i < TL; ++i) {
      const int l = seg * TL + i;
      const float qx = bf2f(rq[l * KS + kk]), fx = bf2f(rk[l * KS + kk]);
      qv[i] = siluf_(qx) * 0.08838834764831845f;
      const float sg = sigmoidf_(fx);
      const float f = lb + (1.f - lb) * sg;
      kv[i] = (1.f - lb) * (1.f - sg);
      bc[i] = __logf(f);
    }
  } else {
    const int ch = h * 256 + kk;
    const float* w2 = p.in[14];
    float wvv[16];
#pragma unroll
    for (int r = 0; r < 16; ++r) wvv[r] = w2[r * 1024 + ch];
    const float bias = p.in[15][ch];
#pragma unroll
    for (int i = 0; i < TL; ++i) {
      const int l = seg * TL + i;
      qv[i] = bf2f(rq[l * KS + kk]) * 0.0625f;
      kv[i] = bf2f(rk[l * KS + kk]);
      float x = bias;
#pragma unroll
      for (int r = 0; r < 16; ++r) x += gl[l * 16 + r] * wvv[r];
      const float ls = fminf(x, 0.f) - log1pf(__expf(-fabsf(x)));
      bc[i] = ls * (1.f / 16.f);
    }
  }
#pragma unroll
  for (int i = 1; i < TL; ++i) bc[i] += bc[i - 1];
  segtot[seg * K + kk] = bc[TL - 1];
  __syncthreads();
  float pre = 0.f, bL = 0.f;
#pragma unroll
  for (int sg = 0; sg < NSEG; ++sg) { float t = segtot[sg * K + kk]; bL += t; if (sg < seg) pre += t; }
  if (seg == 0) dL[u * K + kk] = __expf(bL);
  unsigned kop[TL / 2];
#pragma unroll
  for (int i = 0; i < TL; i += 2) {
    float ko2[2];
#pragma unroll
    for (int e = 0; e < 2; ++e) {
      const int l = seg * TL + i + e;
      const float b = bc[i + e] + pre;
      const float qi = qv[i + e] * __expf(b);
      const float ki = kv[i + e] * __expf(-b);
      ko2[e] = kv[i + e] * __expf(bL - b);
      const u16 qb = f2bf(qi);
      qs[l * KS + kk] = qb;
      ksm[l * KS + kk] = f2bf(ki);
    }
    kop[i / 2] = pack2(ko2[0], ko2[1]);
  }
  {
#pragma unroll
    for (int i = 0; i < TL / 8; ++i) {
      const int cc = seg * 2 + i;
      uint4* dst = (uint4*)(koT + u * K * 64 + ((((kk >> 4) * 2 + (cc >> 2)) * 64 + (cc & 3) * 16 + (kk & 15)) << 3));
      *dst = make_uint4(kop[i * 4 + 0], kop[i * 4 + 1], kop[i * 4 + 2], kop[i * 4 + 3]);
    }
  }
  }
  __syncthreads();
  for (int i = tid; i < 64 * (K / 8); i += 512) {
    const int r = i / (K / 8), cc = i % (K / 8);
    *(uint4*)(qin + u * 64 * K + ((((r >> 4) * (K / 32) + (cc >> 2)) * 64 + (cc & 3) * 16 + (r & 15)) << 3)) = *(const uint4*)(qs + r * KS + cc * 8);
  }
  {
    const int w = tid >> 6, lane = tid & 63, fr = lane & 15, fq = lane >> 4;
#pragma unroll 1
    for (int bi = 0; bi < 2; ++bi) {
      const int blk = w + bi * 8, lb = blk >> 2, sb = blk & 3;
      f32x4 acc = {0.f, 0.f, 0.f, 0.f};
      if (sb <= lb) {
#pragma unroll
        for (int kst = 0; kst < K / 32; ++kst) {
          bf16x8 a = *(const bf16x8*)(ksm + (sb * 16 + fr) * KS + kst * 32 + fq * 8);
          bf16x8 b = *(const bf16x8*)(qs + (lb * 16 + fr) * KS + kst * 32 + fq * 8);
          acc = __builtin_amdgcn_mfma_f32_16x16x32_bf16(a, b, acc, 0, 0, 0);
        }
      }
      const int l = lb * 16 + fr, s0 = sb * 16 + fq * 4;
      float v0 = (s0 + 0 <= l) ? acc[0] : 0.f, v1 = (s0 + 1 <= l) ? acc[1] : 0.f;
      float v2 = (s0 + 2 <= l) ? acc[2] : 0.f, v3 = (s0 + 3 <= l) ? acc[3] : 0.f;
      if (lb >= 2 || sb < 2) *(uint2*)(Pm + u * 4096 + ((((lb * 2 + (s0 >> 5)) * 64 + ((s0 & 31) >> 3) * 16 + fr) << 3) + (s0 & 7))) = make_uint2(pack2(v0, v1), pack2(v2, v3));
    }
  }
  }
}

template <int K, int V>
__device__ __forceinline__ void seq_unit(int wv, const u16* __restrict__ qin, const u16* __restrict__ koT, const u16* __restrict__ Pm, const u16* __restrict__ vsrc, int vld,
                         const float* __restrict__ dL, int H, int c0, int nch, int h, int vs,
                         const float* __restrict__ s0, float* __restrict__ sout, u16* __restrict__ o, int row0, int ocol, unsigned char* shm) {
  const int tix = tidx(wv);
  constexpr int NKB = K / 128, SST = K + 8;
  u16* ST = (u16*)shm;
  const int tid = tix, w = tid >> 6, lane = tid & 63, fr = lane & 15, fq = lane >> 4;
  f32x4 accS[NKB][2];
  __syncthreads();
#pragma unroll
  for (int kb = 0; kb < NKB; ++kb)
#pragma unroll
    for (int vb = 0; vb < 2; ++vb) {
      const int k = (w * NKB + kb) * 16 + fq * 4, vcol = vb * 16 + fr;
#pragma unroll
      for (int j = 0; j < 4; ++j) accS[kb][vb][j] = s0 ? s0[(size_t)(k + j) * V + vs * 32 + vcol] : 0.f;
      *(uint2*)(ST + vcol * SST + k) = make_uint2(pack2(accS[kb][vb][0], accS[kb][vb][1]), pack2(accS[kb][vb][2], accS[kb][vb][3]));
    }
  constexpr int VTS = 72, LOS = 40;
  u16* VT = ST + 2 * 32 * SST;
  u16* LO = VT + 2 * 32 * VTS;
  const int v_s = (tid >> 2) & 63, v_p = tid & 3;
  const u16* vrow = vsrc + (size_t)v_s * vld + v_p * 8;
  u32x4_t vreg = {0u, 0u, 0u, 0u};
  if (tid < 256) {
    vreg = *(const u32x4_t*)vrow;
#pragma unroll
    for (int j = 0; j < 4; ++j) {
      VT[(v_p * 8 + 2 * j) * VTS + v_s] = (u16)(vreg[j] & 0xffffu);
      VT[(v_p * 8 + 2 * j + 1) * VTS + v_s] = (u16)(vreg[j] >> 16);
    }
  }
  __syncthreads();
  int cur = 0;
  const int lb = w >> 1, ovb = w & 1;
  struct FragsO { bf16x8 op[2], oq[K / 32]; };
  struct FragsS { bf16x8 ka[NKB][2]; float4 d[NKB]; };
  auto load_o = [&](int ci, FragsO& f) {
    const size_t u = (size_t)(c0 + ci) * H + h;
    const u16* Pu = Pm + u * 4096;
    const u16* qu = qin + u * 64 * K;
#pragma unroll
    for (int ss = 0; ss < 2; ++ss) { if (ss == 0 || lb >= 2) f.op[ss] = *(const bf16x8*)(Pu + (((lb * 2 + ss) * 64 + lane) << 3)); else f.op[ss] = bf16x8{0, 0, 0, 0, 0, 0, 0, 0}; }
#pragma unroll
    for (int kst = 0; kst < K / 32; ++kst) f.oq[kst] = *(const bf16x8*)(qu + (((lb * (K / 32) + kst) * 64 + lane) << 3));
  };
  auto load_s = [&](int ci, FragsS& f) {
    const size_t u = (size_t)(c0 + ci) * H + h;
    const u16* ku = koT + u * K * 64;
    const float* du = dL + u * K;
#pragma unroll
    for (int kb = 0; kb < NKB; ++kb) {
      const int kbase = (w * NKB + kb) * 16;
      f.d[kb] = *(const float4*)(du + kbase + fq * 4);
      f.ka[kb][0] = *(const bf16x8*)(ku + ((((w * NKB + kb) * 2 + 0) * 64 + lane) << 3));
      f.ka[kb][1] = *(const bf16x8*)(ku + ((((w * NKB + kb) * 2 + 1) * 64 + lane) << 3));
    }
  };
  FragsO fo;
  FragsS f0;
  load_o(0, fo);
  load_s(0, f0);
  for (int ci = 0; ci < nch; ++ci) {
    const int cn = ci + 1 < nch ? ci + 1 : ci;
    FragsO fo1;
    FragsS f1;
    load_o(cn, fo1);
    load_s(cn, f1);
    if (tid < 256) vreg = *(const u32x4_t*)(vrow + (size_t)cn * 64 * vld);
    __builtin_amdgcn_sched_barrier(0);
    const u16* STc = ST + cur * 32 * SST;
    u16* STn = ST + (cur ^ 1) * 32 * SST;
    const u16* VTc = VT + cur * 32 * VTS;
    u16* VTn = VT + (cur ^ 1) * 32 * VTS;
    bf16x8 vf[2][2];
#pragma unroll
    for (int vb = 0; vb < 2; ++vb)
#pragma unroll
      for (int ss = 0; ss < 2; ++ss) vf[vb][ss] = *(const bf16x8*)(VTc + (vb * 16 + fr) * VTS + ss * 32 + fq * 8);
    if (ci > 0 && tid < 256) {
      const uint4 ov = *(const uint4*)(LO + ((ci - 1) & 1) * 64 * LOS + v_s * LOS + v_p * 8);
      *(uint4*)(o + (size_t)(row0 + (ci - 1) * 64 + v_s) * D + ocol + vs * 32 + v_p * 8) = ov;
    }
    f32x4 ao = {0.f, 0.f, 0.f, 0.f};
#pragma unroll
    for (int ss = 0; ss < 2; ++ss) {
      if (ss == 0 || lb >= 2) {
        bf16x8 a = *(const bf16x8*)(VTc + (ovb * 16 + fr) * VTS + ss * 32 + fq * 8);
        ao = __builtin_amdgcn_mfma_f32_16x16x32_bf16(a, fo.op[ss], ao, 0, 0, 0);
      }
    }
#pragma unroll
    for (int kst = 0; kst < K / 32; ++kst) {
      bf16x8 a = *(const bf16x8*)(STc + (ovb * 16 + fr) * SST + kst * 32 + fq * 8);
      ao = __builtin_amdgcn_mfma_f32_16x16x32_bf16(a, fo.oq[kst], ao, 0, 0, 0);
    }
    *(uint2*)(LO + (ci & 1) * 64 * LOS + (lb * 16 + fr) * LOS + ovb * 16 + fq * 4) = make_uint2(pack2(ao[0], ao[1]), pack2(ao[2], ao[3]));
#pragma unroll
    for (int kb = 0; kb < NKB; ++kb) {
      const int kbase = (w * NKB + kb) * 16;
      const float4 d4 = f0.d[kb];
#pragma unroll
      for (int vb = 0; vb < 2; ++vb) {
        f32x4 sv = accS[kb][vb];
        sv[0] *= d4.x; sv[1] *= d4.y; sv[2] *= d4.z; sv[3] *= d4.w;
        sv = __builtin_amdgcn_mfma_f32_16x16x32_bf16(f0.ka[kb][0], vf[vb][0], sv, 0, 0, 0);
        sv = __builtin_amdgcn_mfma_f32_16x16x32_bf16(f0.ka[kb][1], vf[vb][1], sv, 0, 0, 0);
        accS[kb][vb] = sv;
        *(uint2*)(STn + (vb * 16 + fr) * SST + kbase + fq * 4) = make_uint2(pack2(sv[0], sv[1]), pack2(sv[2], sv[3]));
      }
    }
    if (tid < 256) {
#pragma unroll
      for (int j = 0; j < 4; ++j) {
        VTn[(v_p * 8 + 2 * j) * VTS + v_s] = (u16)(vreg[j] & 0xffffu);
        VTn[(v_p * 8 + 2 * j + 1) * VTS + v_s] = (u16)(vreg[j] >> 16);
      }
    }
    asm volatile("s_waitcnt lgkmcnt(0)" ::: "memory");
    __builtin_amdgcn_s_barrier();
    asm volatile("" ::: "memory");
    cur ^= 1;
    f0 = f1;
    fo = fo1;
  }
  if (tid < 256) {
    const uint4 ov = *(const uint4*)(LO + ((nch - 1) & 1) * 64 * LOS + v_s * LOS + v_p * 8);
    *(uint4*)(o + (size_t)(row0 + (nch - 1) * 64 + v_s) * D + ocol + vs * 32 + v_p * 8) = ov;
  }
#pragma unroll
  for (int kb = 0; kb < NKB; ++kb)
#pragma unroll
    for (int vb = 0; vb < 2; ++vb) {
      const int k = (w * NKB + kb) * 16 + fq * 4, vcol = vb * 16 + fr;
#pragma unroll
      for (int j = 0; j < 4; ++j) sout[(size_t)(k + j) * V + vs * 32 + vcol] = accS[kb][vb][j];
    }
}

__device__ __forceinline__ void seq_even_phase(int wv, const Params& p, unsigned char* shm) {
  unsigned char* R = p.ws + OFF_R;
  u16* o = (u16*)(p.ws + OFF_H);
  for (int u = blockIdx.x; u < 768; u += gridDim.x) {
    if (u < 256) {
      const int x = u & 7, y = u >> 3;
      if (y < 16) {
        const int g = x * 2 + (y >> 3), b = g >> 2, h = g & 3, vs = y & 7;
        seq_unit<128, 256>(wv, (u16*)(R + R_QA), (u16*)(R + R_KA), (u16*)(R + R_PA), (const u16*)(p.ws + OFF_BIG) + (size_t)(b * 2048) * NINE + 1024 + h * 256 + vs * 32, NINE, (float*)(R + R_DA), 4, b * 32, 32, h, vs,
                           nullptr, p.out + O_RETP + (size_t)(b * 4 + h) * 128 * 256, o, b * 2048, h * 256, shm);
      } else {
        const int yy = y - 16, g = x * 4 + (yy >> 2), b = g >> 3, h = g & 7, vs = yy & 3;
        seq_unit<128, 128>(wv, (u16*)(R + R_QB), (u16*)(R + R_KB), (u16*)(R + R_PB), (const u16*)(p.ws + OFF_BIG) + (size_t)(b * 2048) * NINE + 5120 + h * 128 + vs * 32, NINE, (float*)(R + R_DB), 8, b * 32, 32, h, vs,
                           nullptr, p.out + O_HGP + (size_t)(b * 8 + h) * 128 * 128, o, b * 2048, 1024 + h * 128, shm);
      }
    } else if (u < 512) {
      int x = u - 256, b = x >> 5, h = (x >> 3) & 3, vs = x & 7;
      seq_unit<128, 256>(wv, (u16*)(R + R_QA), (u16*)(R + R_KA), (u16*)(R + R_PA), (const u16*)(p.ws + OFF_BIG) + (size_t)(MP + b * 64) * NINE + 1024 + h * 256 + vs * 32, NINE, (float*)(R + R_DA), 4, 128 + b, 1, h, vs,
                         p.in[2] + (size_t)(b * 4 + h) * 128 * 256, p.out + O_RETS + (size_t)(b * 4 + h) * 128 * 256, o, MP + b * 64, h * 256, shm);
    } else {
      int x = u - 512, b = x >> 5, h = (x >> 2) & 7, vs = x & 3;
      seq_unit<128, 128>(wv, (u16*)(R + R_QB), (u16*)(R + R_KB), (u16*)(R + R_PB), (const u16*)(p.ws + OFF_BIG) + (size_t)(MP + b * 64) * NINE + 5120 + h * 128 + vs * 32, NINE, (float*)(R + R_DB), 8, 128 + b, 1, h, vs,
                         p.in[3] + (size_t)(b * 8 + h) * 128 * 128, p.out + O_HGS + (size_t)(b * 8 + h) * 128 * 128, o, MP + b * 64, 1024 + h * 128, shm);
    }
  }
}
__device__ __forceinline__ void seq_odd_phase(int wv, const Params& p, unsigned char* shm) {
  unsigned char* R = p.ws + OFF_R;
  u16* o = (u16*)(p.ws + OFF_H);
  for (int u = blockIdx.x; u < 768; u += gridDim.x) {
    if (u < 256) {
      const int x = u & 7, y = u >> 3, g = x * 2 + (y >> 4), b = g >> 2, h = g & 3, vs = y & 15;
      seq_unit<256, 512>(wv, (u16*)(R + R_QC), (u16*)(R + R_KC), (u16*)(R + R_PC), (const u16*)(p.ws + OFF_BIG) + (size_t)(b * 2048) * NINO_PAD + 2048 + h * 512 + vs * 32, NINO_PAD, (float*)(R + R_DC), 4, b * 32, 32, h, vs,
                         nullptr, p.out + O_GLP + (size_t)(b * 4 + h) * 256 * 512, o, b * 2048, h * 512, shm);
    } else {
      int x = u - 256, b = x >> 6, h = (x >> 4) & 3, vs = x & 15;
      seq_unit<256, 512>(wv, (u16*)(R + R_QC), (u16*)(R + R_KC), (u16*)(R + R_PC), (const u16*)(p.ws + OFF_BIG) + (size_t)(MP + b * 64) * NINO_PAD + 2048 + h * 512 + vs * 32, NINO_PAD, (float*)(R + R_DC), 4, 128 + b, 1, h, vs,
                         p.in[4] + (size_t)(b * 4 + h) * 256 * 512, p.out + O_GLS + (size_t)(b * 4 + h) * 256 * 512, o, MP + b * 64, h * 512, shm);
    }
  }
}

__device__ __forceinline__ void up8(u32x4_t v, float* f) {
  f[0] = __uint_as_float(v[0] << 16); f[1] = __uint_as_float(v[0] & 0xffff0000u);
  f[2] = __uint_as_float(v[1] << 16); f[3] = __uint_as_float(v[1] & 0xffff0000u);
  f[4] = __uint_as_float(v[2] << 16); f[5] = __uint_as_float(v[2] & 0xffff0000u);
  f[6] = __uint_as_float(v[3] << 16); f[7] = __uint_as_float(v[3] & 0xffff0000u);
}
template <int ODD>
__device__ __forceinline__ void post_phase(int wv, const Params& p) {
  const int tix = tidx(wv);
  const int lane = tix & 63, gw = blockIdx.x * 8 + (tix >> 6), nw = gridDim.x * 8;
  const u16* o = (const u16*)(p.ws + OFF_H);
  const u16* proj = (const u16*)(p.ws + OFF_BIG);
  u16* ao = (u16*)(p.ws + OFF_R);
#define POST_LOAD(xr_, gr_, row_) do { const int r_ = (row_); \
    _Pragma("unroll") for (int i = 0; i < 4; ++i) { const int col_ = i * 512 + lane * 8; \
      xr_[i] = *(const u32x4_t*)(o + (size_t)r_ * D + col_); \
      gr_[i] = *(const u32x4_t*)(proj + (size_t)r_ * (ODD ? NINO_PAD : NINE) + (ODD ? 4096 + col_ : (i < 2 ? 2048 + col_ : 6144 + (col_ - 1024)))); } } while (0)
  u32x4_t xr[4], gr[4];
  if (gw < MT) POST_LOAD(xr, gr, gw);
#pragma unroll 1
  for (int row = gw; row < MT; row += nw) {
    u32x4_t xn[4], gn4[4];
    if (row + nw < MT) POST_LOAD(xn, gn4, row + nw);
    else {
#pragma unroll
      for (int i = 0; i < 4; ++i) { xn[i] = xr[i]; gn4[i] = gr[i]; }
    }
    __builtin_amdgcn_sched_barrier(0);
#pragma unroll
    for (int i = 0; i < 4; ++i) {
      const int col = i * 512 + lane * 8;
      float x[8], g[8], y[8];
      up8(xr[i], x);
      up8(gr[i], g);
      if (ODD) {
        float ss = 0.f;
#pragma unroll
        for (int e = 0; e < 8; ++e) ss += x[e] * x[e];
#pragma unroll
        for (int off = 32; off > 0; off >>= 1) ss += __shfl_xor(ss, off, 64);
        const float rs = rsqrtf(ss * (1.f / 512.f) + EPS);
        const float* gn = p.in[16] + lane * 8;
#pragma unroll
        for (int e = 0; e < 8; ++e) y[e] = x[e] * rs * gn[e] * siluf_(g[e]);
      } else if (i < 2) {
        float s1 = 0.f;
#pragma unroll
        for (int e = 0; e < 8; ++e) s1 += x[e];
#pragma unroll
        for (int off = 16; off > 0; off >>= 1) s1 += __shfl_xor(s1, off, 64);
        const float mu = s1 * (1.f / 256.f);
        float s2 = 0.f;
#pragma unroll
        for (int e = 0; e < 8; ++e) { float dlt = x[e] - mu; s2 += dlt * dlt; }
#pragma unroll
        for (int off = 16; off > 0; off >>= 1) s2 += __shfl_xor(s2, off, 64);
        const float rs = rsqrtf(s2 * (1.f / 256.f) + EPS);
#pragma unroll
        for (int e = 0; e < 8; ++e) y[e] = (x[e] - mu) * rs * siluf_(g[e]);
      } else {
        float ss = 0.f;
#pragma unroll
        for (int e = 0; e < 8; ++e) ss += x[e] * x[e];
#pragma unroll
        for (int off = 8; off > 0; off >>= 1) ss += __shfl_xor(ss, off, 64);
        const float rs = rsqrtf(ss * (1.f / 128.f) + EPS);
        const float* gn = p.in[12] + (lane & 15) * 8;
#pragma unroll
        for (int e = 0; e < 8; ++e) y[e] = x[e] * rs * gn[e] * siluf_(g[e]);
      }
      st8(ao + (size_t)row * D + col, y);
    }
#pragma unroll
    for (int i = 0; i < 4; ++i) { xr[i] = xn[i]; gr[i] = gn4[i]; }
  }
#undef POST_LOAD
}


__device__ __forceinline__ void final_norm_phase(int wv, const Params& p) {
  const int tix = tidx(wv);
  const int lane = tix & 63, gw = blockIdx.x * 8 + (tix >> 6), nw = gridDim.x * 8;
  const u16* hb = (const u16*)(p.ws + OFF_HN);
  const float* w = p.in[8];
  u32x4_t v[4];
  if (gw < MT) {
#pragma unroll
    for (int i = 0; i < 4; ++i) v[i] = *(const u32x4_t*)(hb + (size_t)gw * D + i * 512 + lane * 8);
  }
#pragma unroll 1
  for (int row = gw; row < MT; row += nw) {
    u32x4_t nx[4];
    const int nrow = row + nw < MT ? row + nw : row;
#pragma unroll
    for (int i = 0; i < 4; ++i) nx[i] = *(const u32x4_t*)(hb + (size_t)nrow * D + i * 512 + lane * 8);
    __builtin_amdgcn_sched_barrier(0);
    float x[4][8];
    float ss = 0.f;
#pragma unroll
    for (int i = 0; i < 4; ++i) {
      up8(v[i], x[i]);
#pragma unroll
      for (int e = 0; e < 8; ++e) ss += x[i][e] * x[i][e];
    }
#pragma unroll
    for (int o = 32; o > 0; o >>= 1) ss += __shfl_xor(ss, o, 64);
    const float rs = rsqrtf(ss * (1.f / D) + EPS);
    float* dst = (row < MP) ? p.out + O_YP + (size_t)row * D : p.out + O_YS + (size_t)(row - MP) * D;
#pragma unroll
    for (int i = 0; i < 4; ++i) {
      const int col = i * 512 + lane * 8;
      const float4 w0 = *(const float4*)(w + col), w1 = *(const float4*)(w + col + 4);
      *(float4*)(dst + col) = make_float4(x[i][0] * rs * w0.x, x[i][1] * rs * w0.y, x[i][2] * rs * w0.z, x[i][3] * rs * w0.w);
      *(float4*)(dst + col + 4) = make_float4(x[i][4] * rs * w1.x, x[i][5] * rs * w1.y, x[i][6] * rs * w1.z, x[i][7] * rs * w1.w);
    }
#pragma unroll
    for (int i = 0; i < 4; ++i) v[i] = nx[i];
  }
}

__device__ __forceinline__ void gate_phase(int wv, const Params& p, int layer) {
  const int tix = tidx(wv);
  const u16* au = (const u16*)(p.ws + OFF_BIG);
  u16* gg = (u16*)(p.ws + OFF_R);
  const float* cw = p.in[19] + (size_t)layer * 3 * DFF;
  const float* cb = p.in[20] + (size_t)layer * DFF;
  const float* cache = p.in[5] + (size_t)layer * 8 * 2 * DFF;
  const int nitems = (MT / 16) * (DFF / 8);
  for (int it = blockIdx.x * 512 + tix; it < nitems; it += gridDim.x * 512) {
    const int cg8 = it % (DFF / 8), rb = it / (DFF / 8), c0 = cg8 * 8, r0 = rb * 16;
    float w0[8], w1[8], w2[8], bb[8], am2[8], am1[8];
#pragma unroll
    for (int e = 0; e < 8; ++e) { w0[e] = cw[c0 + e]; w1[e] = cw[DFF + c0 + e]; w2[e] = cw[2 * DFF + c0 + e]; bb[e] = cb[c0 + e]; }
    int t0, T, b; bool samp = r0 >= MP;
    if (!samp) { b = r0 >> 11; t0 = r0 & 2047; T = 2048; } else { b = (r0 - MP) >> 6; t0 = (r0 - MP) & 63; T = 64; }
    if (t0 == 0) {
      if (samp) {
#pragma unroll
        for (int e = 0; e < 8; ++e) { am2[e] = cache[(size_t)(b * 2 + 0) * DFF + c0 + e]; am1[e] = cache[(size_t)(b * 2 + 1) * DFF + c0 + e]; }
      } else {
#pragma unroll
        for (int e = 0; e < 8; ++e) { am2[e] = 0.f; am1[e] = 0.f; }
      }
    } else {
      ld8(au + (size_t)(r0 - 2) * NUP + c0, am2);
      ld8(au + (size_t)(r0 - 1) * NUP + c0, am1);
    }
#pragma unroll 4
    for (int i = 0; i < 16; ++i) {
      float a[8], uu[8], y[8];
      ld8(au + (size_t)(r0 + i) * NUP + c0, a);
      ld8(au + (size_t)(r0 + i) * NUP + DFF + c0, uu);
#pragma unroll
      for (int e = 0; e < 8; ++e) {
        float cv = bb[e] + w0[e] * am2[e] + w1[e] * am1[e] + w2[e] * a[e];
        y[e] = siluf_(cv) * uu[e];
        am2[e] = am1[e]; am1[e] = a[e];
      }
      st8(gg + (size_t)(r0 + i) * DFF + c0, y);
    }
    if (t0 + 16 == T) {
      float* dst = samp ? p.out + O_CVS + (size_t)(layer * 8 + b) * 2 * DFF : p.out + O_CVP + (size_t)(layer * 4 + b) * 2 * DFF;
#pragma unroll
      for (int e = 0; e < 8; ++e) { dst[c0 + e] = am2[e]; dst[DFF + c0 + e] = am1[e]; }
    }
  }
}


__device__ __forceinline__ void gate_fixup(int wv, const Params& p, int layer) {
  const int tix = tidx(wv);
  const u16* side = (const u16*)(p.ws + OFF_SIDE);
  u16* gg = (u16*)(p.ws + OFF_R);
  const float* cw = p.in[19] + (size_t)layer * 3 * DFF;
  const float* cb = p.in[20] + (size_t)layer * DFF;
  for (int vw = blockIdx.x; vw < (MP / BM) * (D / BM); vw += gridDim.x) {
    int pm, pn;
    tile_coords(vw, MP / BM, D / BM, pm, pn);
    if ((pm & 7) == 0) continue;
    for (int c8 = tix; c8 < DFF / 8; c8 += 512) {
      const int c = c8 * 8;
      float a0[8], a1[8], u0[8], u1[8], q2[8], q1[8], y0[8], y1[8];
      ld8(side + (size_t)(pm * 2 + 0) * DFF + c, a0);
      ld8(side + (size_t)(pm * 2 + 1) * DFF + c, a1);
      ld8(side + SZ_SIDE1 / 2 + (size_t)(pm * 2 + 0) * DFF + c, u0);
      ld8(side + SZ_SIDE1 / 2 + (size_t)(pm * 2 + 1) * DFF + c, u1);
      ld8(side + SZ_SIDE1 + (size_t)((pm - 1) * 2 + 0) * DFF + c, q2);
      ld8(side + SZ_SIDE1 + (size_t)((pm - 1) * 2 + 1) * DFF + c, q1);
#pragma unroll
      for (int e = 0; e < 8; ++e) {
        const float w0 = cw[c + e], w1 = cw[DFF + c + e], w2 = cw[2 * DFF + c + e], bb = cb[c + e];
        y0[e] = siluf_(bb + w0 * q2[e] + w1 * q1[e] + w2 * a0[e]) * u0[e];
        y1[e] = siluf_(bb + w0 * q1[e] + w1 * a0[e] + w2 * a1[e]) * u1[e];
      }
      st8(gg + (size_t)(pm * 256 + 0) * DFF + c, y0);
      st8(gg + (size_t)(pm * 256 + 1) * DFF + c, y1);
    }
  }
  asm volatile("s_waitcnt vmcnt(0)" ::: "memory");
  __syncthreads();
}

#define XB_TMO      128
#define XB_XCNT(j)  (256  + 64 * (j))
#define XB_XSUB(j)  (1280 + 64 * (j))
#define XB_XGEN(j)  (2304 + 64 * (j))
#define XB_TOP      3328
#define XB_TOPGEN   3392
#define XCD_BAR_WORDS 3456
#define XB_SPIN_CAP (1u << 22)
#define LAS __attribute__((address_space(3)))
__device__ __forceinline__ unsigned xb_ld(unsigned* p)              { return __hip_atomic_load(p, __ATOMIC_RELAXED, __HIP_MEMORY_SCOPE_AGENT); }
__device__ __forceinline__ unsigned xb_add(unsigned* p, unsigned v) { return __hip_atomic_fetch_add(p, v, __ATOMIC_RELAXED, __HIP_MEMORY_SCOPE_AGENT); }
__device__ __forceinline__ unsigned xb_xcc_id() { return (unsigned)__builtin_amdgcn_s_getreg((3 << 11) | 20) & 0xFu; }
#define XB_SPIN(cond, bar) do { unsigned _sp = 0; while (cond) { __builtin_amdgcn_s_sleep(1); \
    if ((++_sp & 255u) == 0u) { if (xb_ld(&(bar)[XB_TMO])) break; if (_sp > XB_SPIN_CAP) { atomicAdd(&(bar)[XB_TMO], 1u); break; } } } } while (0)
struct XcdBarrier { unsigned* bar; unsigned x; volatile LAS unsigned* st; };
__device__ __forceinline__ XcdBarrier xcd_barrier_post(int wv, unsigned* bar, volatile LAS unsigned* st) {
  XcdBarrier b; b.bar = bar; b.x = xb_xcc_id(); b.st = st;
  if (tidx(wv) == 0) (void)xb_add(&bar[XB_XCNT(b.x)], 1u);
  return b;
}
__device__ __forceinline__ void xcd_barrier_complete(unsigned* bar, unsigned x, unsigned& nloc, unsigned& nx) {
  const unsigned G = gridDim.x * gridDim.y * gridDim.z;
  unsigned sum, cnt, mine, sp = 0u;
  for (;;) {
    sum = 0u; cnt = 0u; mine = 0u;
#pragma unroll
    for (unsigned j = 0; j < 16; ++j) { const unsigned c = xb_ld(&bar[XB_XCNT(j)]); sum += c; cnt += (c > 0u) ? 1u : 0u; mine = (j == x) ? c : mine; }
    if (sum == G) break;
    __builtin_amdgcn_s_sleep(1);
    if ((++sp & 255u) == 0u) { if (xb_ld(&bar[XB_TMO])) break; if (sp > XB_SPIN_CAP) { atomicAdd(&bar[XB_TMO], 1u); break; } }
  }
  nloc = mine > 0u ? mine : 1u; nx = cnt > 0u ? cnt : 1u;
}
__device__ __forceinline__ void xcd_barrier(int wv, const XcdBarrier& b) {
  asm volatile("s_waitcnt vmcnt(0)" ::: "memory");
  __syncthreads();
  if (tidx(wv) == 0) {
    unsigned* bar = b.bar;
    __builtin_amdgcn_s_waitcnt(0);
    unsigned nloc = b.st[0], nx = b.st[1];
    if (nloc == 0u) { xcd_barrier_complete(bar, b.x, nloc, nx); b.st[0] = nloc; b.st[1] = nx; }
    const unsigned old = xb_add(&bar[XB_XSUB(b.x)], 1u);
    const unsigned gen = old / nloc;
    if (old + 1u == (gen + 1u) * nloc) {
      __builtin_amdgcn_fence(__ATOMIC_RELEASE, "agent");
      asm volatile("s_waitcnt vmcnt(0)" ::: "memory");
      const unsigned og = xb_add(&bar[XB_TOP], 1u);
      const unsigned tg = og / nx;
      if (og + 1u == (tg + 1u) * nx) xb_add(&bar[XB_TOPGEN], 1u);
      else XB_SPIN(xb_ld(&bar[XB_TOPGEN]) == tg, bar);
      __builtin_amdgcn_fence(__ATOMIC_ACQUIRE, "agent");
      xb_add(&bar[XB_XGEN(b.x)], 1u);
      asm volatile("s_waitcnt vmcnt(0)" ::: "memory");
    } else {
      XB_SPIN(xb_ld(&bar[XB_XGEN(b.x)]) == gen, bar);
      __builtin_amdgcn_fence(__ATOMIC_ACQUIRE, "agent");
      asm volatile("s_waitcnt vmcnt(0)" ::: "memory");
    }
  }
  __syncthreads();
}

constexpr int NPHASE = 21;
#ifndef PHMASK
#define PHMASK 0xFFFFFFFFu
#endif
#define PH_ON(k) (((PHMASK) >> (k)) & 1u)
constexpr int LDS_BYTES = 147456;

typedef const __attribute__((address_space(4))) Params* KParamsPtr;
#ifndef XSYNC
#define XSYNC 0
#endif
#ifndef DUPMASK
#define DUPMASK 0u
#endif
#define DUP_ON(k) (((DUPMASK) >> (k)) & 1u)
__device__ __forceinline__ bool ph_in(KParamsPtr& kp, int k) { asm volatile("" : "+s"(kp)); return kp->ph_lo <= k && k < kp->ph_hi; }
#define PH_IN(k) ph_in(kp, (k))
#define PHASE(k, ...) if (PH_IN(k)) { if (PH_ON(k)) { for (int rep = 0; rep < 1 + (int)DUP_ON(k); ++rep) { asm volatile("" : "+s"(kp)); Params p; __builtin_memcpy(&p, kp, sizeof(Params)); unsigned char* ws = p.ws; __VA_ARGS__ } } \
    asm volatile("" : "+s"(kp)); \
    if (kp->coop && (k) + 1 < kp->ph_hi) { XcdBarrier xb; xb.bar = (unsigned*)(kp->ws + OFF_BAR); xb.x = xb_xcc_id(); xb.st = (volatile LAS unsigned*)&xb_words; xcd_barrier(wv, xb); if (XSYNC) xcd_barrier(wv, xb); } }
#define PHASE_X(k, ...) if (PH_IN(k)) { asm volatile("" : "+s"(kp)); Params p; __builtin_memcpy(&p, kp, sizeof(Params)); unsigned char* ws = p.ws; __VA_ARGS__ }
#define GEMM_ACC(k, Aoff, Woff, KK, RSSP, FIXL, RINP, RINS) PHASE(k, { float* rssp = (RSSP); if ((FIXL) >= 0) gate_fixup(wv, p, FIXL); \
    gemm_phase<MP, D, KK, 0>(wv, (const u16*)(ws + Aoff), (const u16*)(ws + Woff), EpiAccum{(u16*)(ws + OFF_HN), rssp, (RINP)}, (u16*)shm); \
    gemm_tail_phase<KK>(wv, (const u16*)(ws + Aoff), (const u16*)(ws + Woff), (float*)shm, (u16*)(ws + OFF_HN), rssp, (RINS)); })

__global__ void __launch_bounds__(512) fwd_kernel(Params p_) {
  extern __shared__ __attribute__((aligned(16))) unsigned char shm[];
  cg::grid_group grid = cg::this_grid();
  KParamsPtr kp = (KParamsPtr)__builtin_amdgcn_kernarg_segment_ptr();
  const int wv = __builtin_amdgcn_readfirstlane((int)(threadIdx.x >> 6));
  __shared__ uint4 xb_words;
  if (tidx(wv) == 0) xb_words = make_uint4(0u, 0u, 0u, 0u);
  __syncthreads();
  if (kp->coop == 2) grid.sync();
  (void)xcd_barrier_post(wv, (unsigned*)(kp->ws + OFF_BAR), (volatile LAS unsigned*)&xb_words);
  PHASE(0,
        convert_w(wv, p.in[9], (u16*)(ws + OFF_WINE), D, NINE, NINE, (u16*)shm);
        convert_w(wv, p.in[10], (u16*)(ws + OFF_WOUTE), D, D, D, (u16*)shm);
        convert_w(wv, p.in[13], (u16*)(ws + OFF_WINO), D, NINO, NINO_PAD, (u16*)shm, p.in[6] + D);
        convert_w(wv, p.in[17], (u16*)(ws + OFF_WOUTO), D, D, D, (u16*)shm);
        convert_w(wv, p.in[18], (u16*)(ws + OFF_WUP0), D, NUP, NUP, (u16*)shm, p.in[7], 1);
        convert_w(wv, p.in[18] + (size_t)D * NUP, (u16*)(ws + OFF_WUP1), D, NUP, NUP, (u16*)shm, p.in[7] + D, 1);
        convert_w(wv, p.in[21], (u16*)(ws + OFF_WDN0), DFF, D, D, (u16*)shm);
        convert_w(wv, p.in[21] + (size_t)DFF * D, (u16*)(ws + OFF_WDN1), DFF, D, D, (u16*)shm);
        for (int i = blockIdx.x * 512 + tidx(wv); i < 3 * MT; i += gridDim.x * 512) ((float*)(ws + OFF_RSS))[i] = 0.f;
        rmsnorm_phase<0>(wv, p, p.in[6]);)
  PHASE(1, gemm_phase<MT, NINE, D, 0>(wv, (const u16*)(ws + OFF_HN), (const u16*)(ws + OFF_WINE), EpiStoreBf16{(u16*)(ws + OFF_BIG), NINE, nullptr}, (u16*)shm);)
  PHASE(2, { const int b_ = blockIdx.x, G_ = gridDim.x;
        prep_range<0>(wv, p, b_, NCH * 4, G_, shm);
        const int first1 = ((NCH * 4 - b_ + G_ - 1) / G_) * G_ + b_ - NCH * 4;
        prep_range<1>(wv, p, first1, NCH * 8, G_, shm); })
  PHASE(3, seq_even_phase(wv, p, shm);)
  PHASE(4, post_phase<0>(wv, p);)
  GEMM_ACC(5, OFF_R, OFF_WOUTE, D, (float*)(ws + OFF_RSS), -1, p.in[0], p.in[1])
  PHASE(7, gemm_phase<MT, NUP, D, 0>(wv, (const u16*)(ws + OFF_HN), (const u16*)(ws + OFF_WUP0), EpiGate{(const __attribute__((address_space(4))) void*)kp, 0, 0}, (u16*)shm);)
  GEMM_ACC(9, OFF_R, OFF_WDN0, DFF, (float*)(ws + OFF_RSS) + MT, 0, (const float*)nullptr, (const float*)nullptr)
  PHASE(11, gemm_phase<MT, NINO_PAD, D, 0>(wv, (const u16*)(ws + OFF_HN), (const u16*)(ws + OFF_WINO), EpiStoreBf16{(u16*)(ws + OFF_BIG), NINO_PAD, (const float*)(ws + OFF_RSS) + MT}, (u16*)shm);)
  PHASE(12, prep_range<2>(wv, p, blockIdx.x, NCH * 4, gridDim.x, shm);)
  PHASE(13, seq_odd_phase(wv, p, shm);)
  PHASE(14, post_phase<1>(wv, p);)
  GEMM_ACC(15, OFF_R, OFF_WOUTO, D, (float*)(ws + OFF_RSS) + 2 * MT, -1, (const float*)nullptr, (const float*)nullptr)
  PHASE(17, gemm_phase<MT, NUP, D, 0>(wv, (const u16*)(ws + OFF_HN), (const u16*)(ws + OFF_WUP1), EpiGate{(const __attribute__((address_space(4))) void*)kp, 1, 2 * MT}, (u16*)shm);)
  GEMM_ACC(19, OFF_R, OFF_WDN1, DFF, (float*)nullptr, 1, (const float*)nullptr, (const float*)nullptr)
  PHASE(20, final_norm_phase(wv, p);)
}

extern "C" void kernel_launch(void* const* d_in, const int* in_sizes, int n_in, void* d_out, int out_size, void* d_ws, size_t ws_size,
                              hipStream_t stream) {
  static int grid_blocks = 0;
  if (grid_blocks == 0) {
    int dev = 0, cus = 0, per_cu = 0;
    hipGetDevice(&dev);
    hipDeviceGetAttribute(&cus, hipDeviceAttributeMultiprocessorCount, dev);
    hipFuncSetAttribute((const void*)fwd_kernel, hipFuncAttributeMaxDynamicSharedMemorySize, LDS_BYTES);
    hipOccupancyMaxActiveBlocksPerMultiprocessor(&per_cu, (const void*)fwd_kernel, 512, LDS_BYTES);
    if (per_cu < 1) per_cu = 1;
    grid_blocks = cus * per_cu;
    (void)hipGetLastError();
  }
  if (n_in != 22 || ws_size < WS_NEED || (size_t)out_size != O_END) {
    fprintf(stderr, "kernel_launch: unexpected sizes n_in=%d ws=%zu need=%zu out=%d\n", n_in, ws_size, (size_t)WS_NEED, out_size);
    hipMemsetAsync(d_out, 0, (size_t)out_size * 4, stream);
    return;
  }
  Params p{};
  for (int i = 0; i < 22; ++i) p.in[i] = (const float*)d_in[i];
  p.out = (float*)d_out;
  p.ws = (unsigned char*)d_ws;
#if 0
  for (int ph = 0; ph < NPHASE; ++ph) {
    p.ph_lo = ph; p.ph_hi = ph + 1; p.coop = 0;
    hipLaunchKernelGGL(fwd_kernel, dim3(grid_blocks), dim3(512), LDS_BYTES, stream, p);
  }
#else
  p.ph_lo = 0; p.ph_hi = NPHASE; p.coop = 1;
  hipMemsetAsync((unsigned char*)d_ws + OFF_BAR, 0, XCD_BAR_WORDS * 4, stream);
  void* args[] = {&p};
  hipError_t e = hipLaunchCooperativeKernel((const void*)fwd_kernel, dim3(grid_blocks), dim3(512), args, LDS_BYTES, stream);
  if (e != hipSuccess) fprintf(stderr, "cooperative launch failed: %s (grid %d)\n", hipGetErrorString(e), grid_blocks);
#endif
}
```

```cpp
#include <hip/hip_runtime.h>
#include <hip/hip_bf16.h>
#include <hip/hip_cooperative_groups.h>
#include <cstdio>
namespace cg = cooperative_groups;

typedef unsigned short u16;
using bf16x8 = __attribute__((ext_vector_type(8))) short;
using f32x4 = __attribute__((ext_vector_type(4))) float;
typedef __attribute__((ext_vector_type(4))) unsigned u32x4_t;

constexpr int MP = 8192, MS = 512, MT = 8704, D = 2048;
constexpr int DFF = 5504, NUP = 11008;
constexpr int NINE = 7168, NINO = 6160, NINO_PAD = 6400;
constexpr int NCH = 136;
constexpr float EPS = 1e-6f;

constexpr size_t SZ_WINE = (size_t)NINE * D * 2, SZ_WOUT = (size_t)D * D * 2, SZ_WINO = (size_t)NINO_PAD * D * 2;
constexpr size_t SZ_WUP = (size_t)NUP * D * 2, SZ_WDN = (size_t)D * DFF * 2;
constexpr size_t OFF_WINE = 0;
constexpr size_t OFF_WOUTE = OFF_WINE + SZ_WINE;
constexpr size_t OFF_WINO = OFF_WOUTE + SZ_WOUT;
constexpr size_t OFF_WOUTO = OFF_WINO + SZ_WINO;
constexpr size_t OFF_WUP0 = OFF_WOUTO + SZ_WOUT;
constexpr size_t OFF_WUP1 = OFF_WUP0 + SZ_WUP;
constexpr size_t OFF_WDN0 = OFF_WUP1 + SZ_WUP;
constexpr size_t OFF_WDN1 = OFF_WDN0 + SZ_WDN;
constexpr size_t OFF_H = OFF_WDN1 + SZ_WDN;
constexpr size_t OFF_HN = OFF_H + (size_t)MT * D * 4;
constexpr size_t OFF_BIG = OFF_HN + (size_t)MT * D * 2;
constexpr size_t OFF_R = OFF_BIG + (size_t)MT * NUP * 2;
constexpr size_t SZ_R = 104ull * 1048576;
constexpr size_t OFF_RSS = OFF_R + SZ_R;
constexpr size_t OFF_SIDE = OFF_RSS + 3ull * MT * 4 + 256;
constexpr size_t SZ_SIDE1 = 34ull * 2 * DFF * 2;
constexpr size_t OFF_BAR = OFF_SIDE + 3 * SZ_SIDE1 + 256;
constexpr size_t WS_NEED = OFF_BAR + 16384;
constexpr size_t R_QA = 0;
constexpr size_t R_KA = R_QA + (size_t)NCH * 4 * 64 * 128 * 2;
constexpr size_t R_VA = R_KA + (size_t)NCH * 4 * 64 * 128 * 2;
constexpr size_t R_PA = R_VA + (size_t)NCH * 4 * 256 * 64 * 2;
constexpr size_t R_DA = R_PA + (size_t)NCH * 4 * 4096 * 2;
constexpr size_t R_QB = R_DA + (size_t)NCH * 4 * 128 * 4;
constexpr size_t R_KB = R_QB + (size_t)NCH * 8 * 64 * 128 * 2;
constexpr size_t R_VB = R_KB + (size_t)NCH * 8 * 64 * 128 * 2;
constexpr size_t R_PB = R_VB + (size_t)NCH * 8 * 128 * 64 * 2;
constexpr size_t R_DB = R_PB + (size_t)NCH * 8 * 4096 * 2;
constexpr size_t R_END_EVEN = R_DB + (size_t)NCH * 8 * 128 * 4;
constexpr size_t R_QC = 0;
constexpr size_t R_KC = R_QC + (size_t)NCH * 4 * 64 * 256 * 2;
constexpr size_t R_VC = R_KC + (size_t)NCH * 4 * 64 * 256 * 2;
constexpr size_t R_PC = R_VC + (size_t)NCH * 4 * 512 * 64 * 2;
constexpr size_t R_DC = R_PC + (size_t)NCH * 4 * 4096 * 2;
constexpr size_t R_END_ODD = R_DC + (size_t)NCH * 4 * 256 * 4;
static_assert(R_END_EVEN <= SZ_R && R_END_ODD <= SZ_R && (size_t)MT * DFF * 2 <= SZ_R, "R region too small");

constexpr size_t O_YP = 0;
constexpr size_t O_YS = O_YP + (size_t)MP * D;
constexpr size_t O_RETP = O_YS + (size_t)MS * D;
constexpr size_t O_RETS = O_RETP + 4ull * 4 * 128 * 256;
constexpr size_t O_HGP = O_RETS + 8ull * 4 * 128 * 256;
constexpr size_t O_HGS = O_HGP + 4ull * 8 * 128 * 128;
constexpr size_t O_GLP = O_HGS + 8ull * 8 * 128 * 128;
constexpr size_t O_GLS = O_GLP + 4ull * 4 * 256 * 512;
constexpr size_t O_CVP = O_GLS + 8ull * 4 * 256 * 512;
constexpr size_t O_CVS = O_CVP + 2ull * 4 * 2 * DFF;
constexpr size_t O_END = O_CVS + 2ull * 8 * 2 * DFF;

struct Params {
  const float* in[22];
  float* out;
  unsigned char* ws;
  int ph_lo, ph_hi, coop, pad;
};

__device__ __forceinline__ u16 f2bf(float f) {
  unsigned u = __float_as_uint(f);
  u += 0x7fffu + ((u >> 16) & 1u);
  return (u16)(u >> 16);
}
__device__ __forceinline__ float bf2f(u16 h) { return __uint_as_float(((unsigned)h) << 16); }
__device__ __forceinline__ unsigned pack2(float a, float b) { return (unsigned)f2bf(a) | ((unsigned)f2bf(b) << 16); }
__device__ __forceinline__ float sigmoidf_(float x) { return __builtin_amdgcn_rcpf(1.f + __expf(-x)); }
__device__ __forceinline__ float siluf_(float x) { return x * __builtin_amdgcn_rcpf(1.f + __expf(-x)); }

__device__ __forceinline__ int tidx(int wv) { int l; asm volatile("v_mbcnt_lo_u32_b32 %0, -1, 0\n\tv_mbcnt_hi_u32_b32 %0, -1, %0" : "=v"(l)); return wv * 64 + l; }

__device__ __forceinline__ void convert_w(int wv, const float* __restrict__ src, u16* __restrict__ dst, int K, int N, int Npad, u16* tile, const float* __restrict__ kscale = nullptr, int upperm = 0) {
  const int tix = tidx(wv);
  constexpr int TS = 262;
  const int tn = (Npad + 255) / 256, tk = K / 64, nt = tn * tk, tid = tix;
  for (int t = blockIdx.x; t < nt; t += gridDim.x) {
    const int n0 = (t % tn) * 256, k0 = (t / tn) * 64;
    float4 v[8];
#pragma unroll
    for (int i = 0; i < 8; ++i) {
      const int idx = tid + i * 512, kk = idx >> 6, n = n0 + (idx & 63) * 4;
      v[i] = make_float4(0.f, 0.f, 0.f, 0.f);
      if (n < N) { const f32x4 t_ = __builtin_nontemporal_load((const f32x4*)(src + (size_t)(k0 + kk) * N + n)); v[i] = make_float4(t_[0], t_[1], t_[2], t_[3]); }
      if (kscale) { const float sc = kscale[k0 + kk]; v[i].x *= sc; v[i].y *= sc; v[i].z *= sc; v[i].w *= sc; }
    }
    __syncthreads();
#pragma unroll
    for (int i = 0; i < 8; ++i) {
      const int idx = tid + i * 512, kk = idx >> 6, nl = (idx & 63) * 4;
      *(unsigned*)(tile + kk * TS + nl) = pack2(v[i].x, v[i].y);
      *(unsigned*)(tile + kk * TS + nl + 2) = pack2(v[i].z, v[i].w);
    }
    __syncthreads();
#pragma unroll
    for (int i = 0; i < 4; ++i) {
      const int item = tid + i * 512, ks = item & 7, n = item >> 3;
      if (n0 + n < Npad) {
        const u16* tp = tile + (ks * 8) * TS + n;
        uint4 o;
        o.x = (unsigned)tp[0] | ((unsigned)tp[TS] << 16);
        o.y = (unsigned)tp[2 * TS] | ((unsigned)tp[3 * TS] << 16);
        o.z = (unsigned)tp[4 * TS] | ((unsigned)tp[5 * TS] << 16);
        o.w = (unsigned)tp[6 * TS] | ((unsigned)tp[7 * TS] << 16);
        int nr = n0 + n;
        if (upperm) nr = (nr < DFF) ? ((nr >> 7) * 256 + (nr & 127)) : ((((nr - DFF) >> 7) * 256) + 128 + ((nr - DFF) & 127));
        *(uint4*)(dst + (size_t)nr * K + k0 + ks * 8) = o;
      }
    }
  }
}

template <int MODE>
__device__ __forceinline__ void rmsnorm_phase(int wv, const Params& p, const float* __restrict__ w) {
  const int tix = tidx(wv);
  const int lane = tix & 63, gw = blockIdx.x * 8 + (tix >> 6), nw = gridDim.x * 8;
  const float* h = (const float*)(p.ws + OFF_H);
  u16* hn = (u16*)(p.ws + OFF_HN);
#define RMS_LOAD(dst, row_) do { const int r_ = (row_); const float* src_; \
    if (MODE == 0) src_ = (r_ < MP) ? p.in[0] + (size_t)r_ * D : p.in[1] + (size_t)(r_ - MP) * D; \
    else src_ = h + (size_t)r_ * D; \
    _Pragma("unroll") for (int i = 0; i < 8; ++i) dst[i] = (MODE == 0) ? __builtin_nontemporal_load((const f32x4*)(src_ + (i * 64 + lane) * 4)) : *(const f32x4*)(src_ + (i * 64 + lane) * 4); } while (0)
  f32x4 v[8];
  if (gw < MT) RMS_LOAD(v, gw);
#pragma unroll 1
  for (int row = gw; row < MT; row += nw) {
    f32x4 nx[8];
    if (row + nw < MT) RMS_LOAD(nx, row + nw);
    else {
#pragma unroll
      for (int i = 0; i < 8; ++i) nx[i] = v[i];
    }
    __builtin_amdgcn_sched_barrier(0);
    float ss = 0.f;
#pragma unroll
    for (int i = 0; i < 8; ++i) ss += v[i][0] * v[i][0] + v[i][1] * v[i][1] + v[i][2] * v[i][2] + v[i][3] * v[i][3];
#pragma unroll
    for (int o = 32; o > 0; o >>= 1) ss += __shfl_xor(ss, o, 64);
    const float rs = rsqrtf(ss * (1.f / D) + EPS);
#pragma unroll
    for (int i = 0; i < 8; ++i) {
      const int col = (i * 64 + lane) * 4;
      const float4 wv4 = *(const float4*)(w + col);
      const float4 y = make_float4(v[i][0] * rs * wv4.x, v[i][1] * rs * wv4.y, v[i][2] * rs * wv4.z, v[i][3] * rs * wv4.w);
      if (MODE == 2) {
        float* dst = (row < MP) ? p.out + O_YP + (size_t)row * D : p.out + O_YS + (size_t)(row - MP) * D;
        *(float4*)(dst + col) = y;
      } else {
        *(uint2*)(hn + (size_t)row * D + col) = make_uint2(pack2(y.x, y.y), pack2(y.z, y.w));
      }
    }
#pragma unroll
    for (int i = 0; i < 8; ++i) v[i] = nx[i];
  }
#undef RMS_LOAD
}

__device__ __forceinline__ void ld8(const u16* p, float* f) {
  uint4 v = *(const uint4*)p;
  f[0] = __uint_as_float(v.x << 16); f[1] = __uint_as_float(v.x & 0xffff0000u);
  f[2] = __uint_as_float(v.y << 16); f[3] = __uint_as_float(v.y & 0xffff0000u);
  f[4] = __uint_as_float(v.z << 16); f[5] = __uint_as_float(v.z & 0xffff0000u);
  f[6] = __uint_as_float(v.w << 16); f[7] = __uint_as_float(v.w & 0xffff0000u);
}
__device__ __forceinline__ void st8(u16* p, const float* f) {
  *(uint4*)p = make_uint4(pack2(f[0], f[1]), pack2(f[2], f[3]), pack2(f[4], f[5]), pack2(f[6], f[7]));
}

constexpr int BM = 256, BK = 64, HALF = 128, NXCD = 8, WGM = 8, HT = HALF * BK;

__device__ __forceinline__ int lds_byte(int r, int c) {
  int st = (r >> 4) * 2 + (c >> 5), rr = r & 15, cc = c & 31, ob = rr * 64 + cc * 2;
  return st * 1024 + (ob ^ (((ob >> 9) & 1) << 5));
}
__device__ __forceinline__ void stage_rc(int b, int& R, int& C) {
  int st = b / 1024, sb = b % 1024, swz = sb ^ (((sb >> 9) & 1) << 5);
  R = (st >> 1) * 16 + swz / 64; C = (st & 1) * 32 + (swz % 64) / 2;
}

__device__ __forceinline__ void tile_coords(int wgid, int nM, int nN, int& pm, int& pn) {
  const int nwg = nM * nN;
  { int q = nwg / NXCD, r = nwg % NXCD, xcd = wgid % NXCD, off = wgid / NXCD;
    wgid = (xcd < r ? xcd * (q + 1) : r * (q + 1) + (xcd - r) * q) + off; }
  const int nig = WGM * nN, gid = wgid / nig, fm = gid * WGM, gsz = min(nM - fm, WGM);
  pm = fm + ((wgid % nig) % gsz); pn = (wgid % nig) / gsz;
}

struct EpiStoreBf16 {
  static constexpr bool GATE = false;
  static constexpr bool LDSST = true;
  u16* out; int ldo; const float* rss;
  __device__ __forceinline__ float row_scale(int row) const { return rss ? rsqrtf(rss[row] * (1.f / D) + EPS) : 1.f; }
  __device__ __forceinline__ float operator()(int row, int col, f32x4 v, float sc) const {
    uint2 pk = make_uint2(pack2(v[0] * sc, v[1] * sc), pack2(v[2] * sc, v[3] * sc));
    *(uint2*)(out + (size_t)row * ldo + col) = pk;
    return 0.f;
  }
  __device__ __forceinline__ void row_end(int, float, int) const {}
  __device__ __forceinline__ f32x4 finalize(int, int, f32x4 v, float sc, float&) const { return f32x4{v[0] * sc, v[1] * sc, v[2] * sc, v[3] * sc}; }
};
struct EpiAccum {
  static constexpr bool GATE = false;
  static constexpr bool LDSST = true;
  u16* out; float* rss; const float* rin32; static constexpr int ldo = D;
  __device__ __forceinline__ float row_scale(int) const { return 1.f; }
  __device__ __forceinline__ float operator()(int, int, f32x4, float) const { return 0.f; }
  __device__ __forceinline__ f32x4 finalize(int row, int col, f32x4 v, float, float& ss) const {
    float4 o;
    if (rin32) o = *(const float4*)(rin32 + (size_t)row * D + col);
    else { const uint2 r = *(const uint2*)(out + (size_t)row * D + col); o = make_float4(__uint_as_float(r.x << 16), __uint_as_float(r.x & 0xffff0000u), __uint_as_float(r.y << 16), __uint_as_float(r.y & 0xffff0000u)); }
    o.x += v[0]; o.y += v[1]; o.z += v[2]; o.w += v[3];
    if (rss) ss += o.x * o.x + o.y * o.y + o.z * o.z + o.w * o.w;
    return f32x4{o.x, o.y, o.z, o.w};
  }
  __device__ __forceinline__ void row_end(int row, float ss, int fq) const {
    if (rss) {
      ss += __shfl_xor(ss, 16, 64);
      ss += __shfl_xor(ss, 32, 64);
      if (fq == 0) unsafeAtomicAdd(rss + row, ss);
    }
  }
};

struct EpiGate {
  static constexpr bool GATE = true;
  static constexpr bool LDSST = false;
  const __attribute__((address_space(4))) void* kp; int layer; int rssoff;
  __device__ __forceinline__ float row_scale(int) const { return 1.f; }
  __device__ __forceinline__ float operator()(int, int, f32x4, float) const { return 0.f; }
  __device__ __forceinline__ void row_end(int, float, int) const {}
};

template <int M, int N, int K, int TAIL, class Epi>
__device__ __forceinline__ void gemm_phase(int wv, const u16* __restrict__ A, const u16* __restrict__ Bt, Epi epi, u16* shm) {
  const int tix = tidx(wv);
#define SA(b, h) (shm + ((b) * 2 + (h)) * HT)
#define SB(b, h) (shm + (4 + (b) * 2 + (h)) * HT)
#define STAGE(P, BASE, br, kt) do { const u16* _gb = BASE + ((long)(br) * K + (long)(kt0 + (kt)) * BK); \
    for (int _i = 0; _i < 2; ++_i) { int _b = tix * 16 + _i * 8192; \
      __builtin_amdgcn_global_load_lds((const unsigned*)(_gb + toff[_i]), \
        (__attribute__((address_space(3))) unsigned*)((char*)(P) + _b), 16, 0, 0); } } while (0)
#define LDA(dst, b, h) for (int m = 0; m < 4; ++m) for (int k = 0; k < 2; ++k) \
    dst[m][k] = *reinterpret_cast<const bf16x8*>((char*)SA(b, h) + lds_byte(wr * 64 + m * 16 + fr, k * 32 + fq * 8))
#define LDB(dst, b, h) for (int n = 0; n < 2; ++n) for (int k = 0; k < 2; ++k) \
    dst[n][k] = *reinterpret_cast<const bf16x8*>((char*)SB(b, h) + lds_byte(wc * 32 + n * 16 + fr, k * 32 + fq * 8))
#define MMA(ai, bj, At_, Bt_) do { __builtin_amdgcn_s_setprio(1); \
    for (int m = 0; m < 4; ++m) for (int n = 0; n < 2; ++n) for (int k = 0; k < 2; ++k) \
      acc[ai][bj][m][n] = __builtin_amdgcn_mfma_f32_16x16x32_bf16(Bt_[n][k], At_[m][k], acc[ai][bj][m][n], 0, 0, 0); \
    __builtin_amdgcn_s_setprio(0); } while (0)
#define WAIT_V(n) asm volatile("s_waitcnt vmcnt(" #n ")" ::: "memory")
#define WAIT_L(n) asm volatile("s_waitcnt lgkmcnt(" #n ")" ::: "memory")
#define BAR __builtin_amdgcn_s_barrier()
#define SCHED __builtin_amdgcn_sched_barrier(0)
  const int nM = M / BM, nN = N / BM, nwg = nM * nN, G = gridDim.x;
  const int nunits = nwg;
  const int wid = tix >> 6, lane = tix & 63, wr = wid >> 2, wc = wid & 3, fr = lane & 15, fq = lane >> 4;
  const int nt_total = K / BK;
  unsigned toff[2];
  for (int _i = 0; _i < 2; ++_i) { int _b = tix * 16 + _i * 8192; int _r, _c; stage_rc(_b, _r, _c); toff[_i] = (unsigned)(_r * K + _c); }
  for (int vw = blockIdx.x; vw < nunits; vw += G) {
    int pm, pn;
    tile_coords(vw, nM, nN, pm, pn);
    const int brow = pm * BM, bcol = pn * BM;
    constexpr int kt0 = 0, nt = nt_total;
    f32x4 acc[2][2][4][2];
    for (int a = 0; a < 2; ++a) for (int b = 0; b < 2; ++b) for (int m = 0; m < 4; ++m) for (int n = 0; n < 2; ++n) acc[a][b][m][n] = f32x4{0.f, 0.f, 0.f, 0.f};
    bf16x8 At[4][2], B0[2][2], B1[2][2];
    STAGE(SB(0, 0), Bt, bcol, 0); STAGE(SA(0, 0), A, brow, 0);
    STAGE(SB(0, 1), Bt, bcol + HALF, 0); STAGE(SA(0, 1), A, brow + HALF, 0);
    if (wr == 1) BAR;
    WAIT_V(4); BAR;
    STAGE(SB(1, 0), Bt, bcol, 1); STAGE(SA(1, 0), A, brow, 1); STAGE(SB(1, 1), Bt, bcol + HALF, 1);
    WAIT_V(6); BAR;
    for (int t = 0; t < nt - 2; t += 2) {
      LDB(B0, 0, 0); SCHED; LDA(At, 0, 0); STAGE(SA(1, 1), A, brow + HALF, t + 1);
      WAIT_L(8); BAR; WAIT_L(0); MMA(0, 0, At, B0); BAR; SCHED;
      LDB(B1, 0, 1); STAGE(SB(0, 0), Bt, bcol, t + 2);
      BAR; WAIT_L(0); MMA(0, 1, At, B1); BAR;
      LDA(At, 0, 1); STAGE(SA(0, 0), A, brow, t + 2);
      BAR; WAIT_L(0); MMA(1, 0, At, B0); BAR; SCHED;
      STAGE(SB(0, 1), Bt, bcol + HALF, t + 2);
      WAIT_V(6); BAR; MMA(1, 1, At, B1); BAR;
      LDB(B0, 1, 0); SCHED; LDA(At, 1, 0); STAGE(SA(0, 1), A, brow + HALF, t + 2);
      WAIT_L(8); BAR; WAIT_L(0); MMA(0, 0, At, B0); BAR; SCHED;
      LDB(B1, 1, 1); STAGE(SB(1, 0), Bt, bcol, t + 3);
      BAR; WAIT_L(0); MMA(0, 1, At, B1); BAR;
      LDA(At, 1, 1); STAGE(SA(1, 0), A, brow, t + 3);
      BAR; WAIT_L(0); MMA(1, 0, At, B0); BAR; SCHED;
      STAGE(SB(1, 1), Bt, bcol + HALF, t + 3);
      WAIT_V(6); BAR; MMA(1, 1, At, B1); BAR;
    }
    { LDB(B0, 0, 0); LDA(At, 0, 0); STAGE(SA(1, 1), A, brow + HALF, nt - 1);
      BAR; WAIT_L(0); MMA(0, 0, At, B0); BAR;
      LDB(B1, 0, 1); BAR; WAIT_L(0); MMA(0, 1, At, B1); BAR;
      LDA(At, 0, 1); WAIT_V(4); BAR; WAIT_L(0); MMA(1, 0, At, B0); MMA(1, 1, At, B1); BAR; }
    { LDB(B0, 1, 0); LDA(At, 1, 0); WAIT_V(2); BAR; WAIT_L(0); MMA(0, 0, At, B0); BAR;
      LDB(B1, 1, 1); WAIT_V(0); BAR; WAIT_L(0); MMA(0, 1, At, B1); BAR;
      LDA(At, 1, 1); BAR; WAIT_L(0); MMA(1, 0, At, B0); MMA(1, 1, At, B1); BAR; }
    if (wr == 0) BAR;
    if constexpr (Epi::GATE) {
      constexpr int LS = 136;
      u16* La = shm;
      u16* Lu = shm + 256 * LS;
      const __attribute__((address_space(4))) Params* gkp = (const __attribute__((address_space(4))) Params*)epi.kp;
      asm volatile("" : "+s"(gkp));
      int e_pm = pm, e_pn = pn, e_tix = tix;
      asm volatile("" : "+s"(e_pm), "+s"(e_pn));
      asm volatile("" : "+v"(e_tix));
      const int e_brow = e_pm * BM;
      {
        const int e_lane = e_tix & 63, e_wid = e_tix >> 6, e_wr = e_wid >> 2, e_wc = e_wid & 3, e_fr = e_lane & 15, e_fq = e_lane >> 4;
        const float* rss = (const float*)(gkp->ws + OFF_RSS) + epi.rssoff;
        _Pragma("unroll") for (int ai = 0; ai < 2; ++ai) _Pragma("unroll") for (int m = 0; m < 4; ++m) {
          const int rl = ai * HALF + e_wr * 64 + m * 16 + e_fr;
          const float sc = rsqrtf(rss[e_brow + rl] * (1.f / D) + EPS);
          _Pragma("unroll") for (int n = 0; n < 2; ++n) {
            const f32x4 a = acc[ai][0][m][n], uu = acc[ai][1][m][n];
            const int lo = rl * LS + e_wc * 32 + n * 16 + e_fq * 4;
            *(uint2*)(La + lo) = make_uint2(pack2(a[0] * sc, a[1] * sc), pack2(a[2] * sc, a[3] * sc));
            *(uint2*)(Lu + lo) = make_uint2(pack2(uu[0] * sc, uu[1] * sc), pack2(uu[2] * sc, uu[3] * sc));
          }
        }
      }
      WAIT_L(0); BAR; asm volatile("" ::: "memory");
      {
        const bool samp = e_brow >= MP;
        const int layer = epi.layer;
        u16* gg = (u16*)(gkp->ws + OFF_R);
        u16* side = (u16*)(gkp->ws + OFF_SIDE);
        const float* cw = gkp->in[19] + (size_t)layer * 3 * DFF;
        const float* cb = gkp->in[20] + (size_t)layer * DFF;
        const float* cache = gkp->in[5] + (size_t)layer * 8 * 2 * DFF;
        float* cvo = gkp->out + (samp ? O_CVS + (size_t)layer * 8 * 2 * DFF : O_CVP + (size_t)layer * 4 * 2 * DFF);
        const int cg = e_tix & 15, r0 = e_tix >> 4, c = e_pn * 128 + cg * 8;
        float w0[8], w1[8], w2[8], bb[8];
        _Pragma("unroll") for (int e = 0; e < 8; ++e) { w0[e] = cw[c + e]; w1[e] = cw[DFF + c + e]; w2[e] = cw[2 * DFF + c + e]; bb[e] = cb[c + e]; }
        _Pragma("unroll 1") for (int it = 0; it < 8; ++it) {
          const int rl = it * 32 + r0;
          const int t = samp ? (rl & 63) : ((e_pm & 7) * 256 + rl);
          const int sb = (e_pm - 32) * 4 + (rl >> 6);
          float a[8], uu[8], am1[8], am2[8], y[8];
          ld8(La + rl * LS + cg * 8, a);
          ld8(Lu + rl * LS + cg * 8, uu);
          _Pragma("unroll") for (int e = 0; e < 8; ++e) { am1[e] = 0.f; am2[e] = 0.f; }
          if (t >= 1 && rl >= 1) ld8(La + (rl - 1) * LS + cg * 8, am1);
          if (t >= 2 && rl >= 2) ld8(La + (rl - 2) * LS + cg * 8, am2);
          if (samp && t < 2) {
            const float* c1 = cache + (size_t)(sb * 2 + 1) * DFF + c;
            if (t == 0) {
              const float* c0 = cache + (size_t)(sb * 2 + 0) * DFF + c;
              _Pragma("unroll") for (int e = 0; e < 8; ++e) { am2[e] = c0[e]; am1[e] = c1[e]; }
            } else {
              _Pragma("unroll") for (int e = 0; e < 8; ++e) am2[e] = c1[e];
            }
          }
          if (!(t >= 2 && rl < 2)) {
            _Pragma("unroll") for (int e = 0; e < 8; ++e) { float cv = bb[e] + w0[e] * am2[e] + w1[e] * am1[e] + w2[e] * a[e]; y[e] = siluf_(cv) * uu[e]; }
            st8(gg + (size_t)(e_brow + rl) * DFF + c, y);
          } else {
            st8(side + (size_t)(e_pm * 2 + rl) * DFF + c, a);
            st8(side + SZ_SIDE1 / 2 + (size_t)(e_pm * 2 + rl) * DFF + c, uu);
          }
          if (rl >= 254) st8(side + SZ_SIDE1 + (size_t)(e_pm * 2 + rl - 254) * DFF + c, a);
          int crow = -1;
          if (!samp) { if ((e_pm & 7) == 7 && rl >= 254) crow = (e_pm >> 3) * 2 + rl - 254; }
          else { if ((rl & 63) >= 62) crow = sb * 2 + (rl & 63) - 62; }
          if (crow >= 0) {
            float* dst = cvo + (size_t)crow * DFF + c;
            *(float4*)dst = make_float4(a[0], a[1], a[2], a[3]);
            *(float4*)(dst + 4) = make_float4(a[4], a[5], a[6], a[7]);
          }
        }
      }
      WAIT_L(0); BAR; asm volatile("" ::: "memory");
    } else if constexpr (Epi::LDSST) {
      constexpr int LS = 136;
      u16* L0 = shm;
      u16* L1 = shm + 256 * LS;
      int e_brow = brow, e_bcol = bcol, e_tix = tix;
      asm volatile("" : "+s"(e_brow), "+s"(e_bcol));
      asm volatile("" : "+v"(e_tix));
      {
        const int e_lane = e_tix & 63, e_wid = e_tix >> 6, e_wr = e_wid >> 2, e_wc = e_wid & 3, e_fr = e_lane & 15, e_fq = e_lane >> 4;
        _Pragma("unroll") for (int ai = 0; ai < 2; ++ai) _Pragma("unroll") for (int m = 0; m < 4; ++m) {
          const int rl = ai * HALF + e_wr * 64 + m * 16 + e_fr;
          const float sc = epi.row_scale(e_brow + rl);
          float ss = 0.f;
          _Pragma("unroll") for (int n = 0; n < 2; ++n) {
            const int cl = e_wc * 32 + n * 16 + e_fq * 4;
            const f32x4 c0 = epi.finalize(e_brow + rl, e_bcol + cl, acc[ai][0][m][n], sc, ss);
            const f32x4 c1 = epi.finalize(e_brow + rl, e_bcol + 128 + cl, acc[ai][1][m][n], sc, ss);
            const int lo = rl * LS + cl;
            *(uint2*)(L0 + lo) = make_uint2(pack2(c0[0], c0[1]), pack2(c0[2], c0[3]));
            *(uint2*)(L1 + lo) = make_uint2(pack2(c1[0], c1[1]), pack2(c1[2], c1[3]));
          }
          epi.row_end(e_brow + rl, ss, e_fq);
          if (m & 1) asm volatile("" ::: "memory");
        }
      }
      WAIT_L(0); BAR; asm volatile("" ::: "memory");
      {
        const int cg = e_tix & 15, r0 = e_tix >> 4;
        _Pragma("unroll 1") for (int it = 0; it < 8; ++it) {
          const int rl = it * 32 + r0;
          const uint4 x0 = *(const uint4*)(L0 + rl * LS + cg * 8), x1 = *(const uint4*)(L1 + rl * LS + cg * 8);
          u16* dst = epi.out + (size_t)(e_brow + rl) * epi.ldo + e_bcol + cg * 8;
          *(uint4*)dst = x0;
          *(uint4*)(dst + 128) = x1;
        }
      }
      WAIT_L(0); BAR; asm volatile("" ::: "memory");
    } else {
    for (int ai = 0; ai < 2; ++ai) for (int m = 0; m < 4; ++m) {
      const int row = brow + ai * HALF + wr * 64 + m * 16 + fr;
      const float sc = epi.row_scale(row);
      float ss = 0.f;
      for (int bj = 0; bj < 2; ++bj) for (int n = 0; n < 2; ++n)
        ss += epi(row, bcol + bj * HALF + wc * 32 + n * 16 + fq * 4, acc[ai][bj][m][n], sc);
      epi.row_end(row, ss, fq);
      if (m & 1) asm volatile("" ::: "memory");
    }
    }
  }
#undef SA
#undef SB
#undef STAGE
#undef LDA
#undef LDB
#undef MMA
}


template <int K>
__device__ __forceinline__ void gemm_tail_phase(int wv, const u16* __restrict__ A, const u16* __restrict__ Bt, float* lds, u16* __restrict__ hb, float* __restrict__ rss, const float* __restrict__ rin32_tail) {
  const int tix = tidx(wv);
  const int tid = tix, w = tid >> 6, lane = tid & 63, fr = lane & 15, fq = lane >> 4;
  for (int u = blockIdx.x; u < 256; u += gridDim.x) {
    const int tm = u >> 5, tn = u & 31;
    const u16* Ab = A + (size_t)(MP + tm * 64 + fr) * K + fq * 8;
    const u16* Bb = Bt + (size_t)(tn * 64 + fr) * K + fq * 8;
    f32x4 acc[4][4];
#pragma unroll
    for (int i = 0; i < 4; ++i)
#pragma unroll
      for (int j = 0; j < 4; ++j) acc[i][j] = f32x4{0.f, 0.f, 0.f, 0.f};
    const u16* Ab2 = A + (size_t)(MP + tm * 64 + fr) * K + fq * 16;
    const u16* Bb2 = Bt + (size_t)(tn * 64 + fr) * K + fq * 16;
#pragma unroll 1
    for (int ks = w; ks < K / 64; ks += 8) {
      bf16x8 a[4][2], b[4][2];
#pragma unroll
      for (int i = 0; i < 4; ++i) {
        a[i][0] = *(const bf16x8*)(Ab2 + (size_t)i * 16 * K + ks * 64);
        a[i][1] = *(const bf16x8*)(Ab2 + (size_t)i * 16 * K + ks * 64 + 8);
        b[i][0] = *(const bf16x8*)(Bb2 + (size_t)i * 16 * K + ks * 64);
        b[i][1] = *(const bf16x8*)(Bb2 + (size_t)i * 16 * K + ks * 64 + 8);
      }
#pragma unroll
      for (int mb = 0; mb < 4; ++mb)
#pragma unroll
        for (int nb = 0; nb < 4; ++nb) {
          acc[mb][nb] = __builtin_amdgcn_mfma_f32_16x16x32_bf16(b[nb][0], a[mb][0], acc[mb][nb], 0, 0, 0);
          acc[mb][nb] = __builtin_amdgcn_mfma_f32_16x16x32_bf16(b[nb][1], a[mb][1], acc[mb][nb], 0, 0, 0);
        }
    }
    __syncthreads();
#pragma unroll
    for (int mb = 0; mb < 4; ++mb)
#pragma unroll
      for (int nb = 0; nb < 4; ++nb) *(f32x4*)(lds + w * 4096 + (mb * 16 + fr) * 64 + nb * 16 + fq * 4) = acc[mb][nb];
    __syncthreads();
    const int e = tid * 8, row = e >> 6, col = e & 63;
    float4 s0 = make_float4(0.f, 0.f, 0.f, 0.f), s1 = s0;
#pragma unroll
    for (int ww = 0; ww < 8; ++ww) {
      float4 x0 = *(const float4*)(lds + ww * 4096 + e), x1 = *(const float4*)(lds + ww * 4096 + e + 4);
      s0.x += x0.x; s0.y += x0.y; s0.z += x0.z; s0.w += x0.w;
      s1.x += x1.x; s1.y += x1.y; s1.z += x1.z; s1.w += x1.w;
    }
    const int grow = MP + tm * 64 + row;
    u16* q = hb + (size_t)grow * D + tn * 64 + col;
    float r8[8];
    if (rin32_tail) {
      const float* rq_ = rin32_tail + (size_t)(tm * 64 + row) * D + tn * 64 + col;
      const float4 a0 = *(const float4*)rq_, a1 = *(const float4*)(rq_ + 4);
      r8[0] = a0.x; r8[1] = a0.y; r8[2] = a0.z; r8[3] = a0.w; r8[4] = a1.x; r8[5] = a1.y; r8[6] = a1.z; r8[7] = a1.w;
    } else ld8(q, r8);
    r8[0] += s0.x; r8[1] += s0.y; r8[2] += s0.z; r8[3] += s0.w; r8[4] += s1.x; r8[5] += s1.y; r8[6] += s1.z; r8[7] += s1.w;
    st8(q, r8);
    if (rss) {
      float ss = 0.f;
#pragma unroll
      for (int e2 = 0; e2 < 8; ++e2) ss += r8[e2] * r8[e2];
      ss += __shfl_xor(ss, 1, 64); ss += __shfl_xor(ss, 2, 64); ss += __shfl_xor(ss, 4, 64);
      if ((tid & 7) == 0) unsafeAtomicAdd(rss + grow, ss);
    }
  }
}

template <int MODE>
__device__ __forceinline__ void prep_range(int wv, const Params& p, int u0, int u1, int ustride, unsigned char* shm) {
  const int tix = tidx(wv);
  constexpr int K = (MODE == 2) ? 256 : 128;
  constexpr int V = (MODE == 0) ? 256 : (MODE == 1 ? 128 : 512);
  constexpr int H = (MODE == 1) ? 8 : 4;
  constexpr int LD = (MODE == 2) ? NINO_PAD : NINE;
  constexpr int NSEG = 4, TL = 16, KS = K + 8, VS = V + 8, NPASS = K / 128;
  constexpr int NQ = K / 64, NV = V / 64;
  constexpr bool PFV = false;
  const int tid = tix, seg = tid >> 7;
  const u16* proj = (const u16*)(p.ws + OFF_BIG);
  unsigned char* R = p.ws + OFF_R;
  u16* qin = (u16*)(R + (MODE == 0 ? R_QA : MODE == 1 ? R_QB : R_QC));
  u16* koT = (u16*)(R + (MODE == 0 ? R_KA : MODE == 1 ? R_KB : R_KC));
  u16* vT = (u16*)(R + (MODE == 0 ? R_VA : MODE == 1 ? R_VB : R_VC));
  u16* Pm = (u16*)(R + (MODE == 0 ? R_PA : MODE == 1 ? R_PB : R_PC));
  float* dL = (float*)(R + (MODE == 0 ? R_DA : MODE == 1 ? R_DB : R_DC));
  u16* qs = (u16*)shm;
  u16* ksm = qs + 64 * KS;
  float* segtot = (float*)(ksm + 64 * KS);
  float* gl = segtot + NSEG * K;
  u16* rq = (u16*)(gl + 64 * 16);
  u16* rk = rq + 64 * KS;
  u16* rv = PFV ? rk + 64 * KS : rq;
  typedef __attribute__((ext_vector_type(4))) unsigned u32x4_t;
  u32x4_t rqr[NQ], rkr[NQ], rvr[PFV ? NV : 1];
#define PREP_ISSUE(uu_) do { \
    const int c_i = (uu_) / H, h_i = (uu_) % H; \
    const int row0_i = (c_i < 128) ? (c_i >> 5) * 2048 + (c_i & 31) * 64 : MP + (c_i - 128) * 64; \
    const u16* prow_i = proj + (size_t)row0_i * LD; \
    const int cq_i = (MODE == 0) ? h_i * 128 : (MODE == 1 ? 3072 + h_i * 128 : h_i * 256); \
    const int ck_i = (MODE == 0) ? 512 + h_i * 128 : (MODE == 1 ? 4096 + h_i * 128 : 1024 + h_i * 256); \
    const int vc_i = (MODE == 0) ? 1024 + h_i * 256 : (MODE == 1 ? 5120 + h_i * 128 : 2048 + h_i * 512); \
    _Pragma("unroll") for (int i = 0; i < NQ; ++i) { \
      const int idx = tid + i * 512, r = idx / (K / 8), cc = idx % (K / 8); \
      rqr[i] = *(const u32x4_t*)(prow_i + (size_t)r * LD + cq_i + cc * 8); \
      rkr[i] = *(const u32x4_t*)(prow_i + (size_t)r * LD + ck_i + cc * 8); \
    } \
    if constexpr (PFV) { \
      _Pragma("unroll") for (int i = 0; i < NV; ++i) { \
        const int idx = tid + i * 512, r = idx / (V / 8), cc = idx % (V / 8); \
        rvr[i] = *(const u32x4_t*)(prow_i + (size_t)r * LD + vc_i + cc * 8); \
      } \
    } } while (0)
  if (u0 < u1) PREP_ISSUE(u0);
#pragma unroll 1
  for (int uu = u0; uu < u1; uu += ustride) {
  const int c = uu / H, h = uu % H;
  int row0, pos0;
  if (c < 128) { row0 = (c >> 5) * 2048 + (c & 31) * 64; pos0 = (c & 31) * 64; }
  else { row0 = MP + (c - 128) * 64; pos0 = 1024; }
  const size_t u = (size_t)c * H + h;
  const u16* prow = proj + (size_t)row0 * LD;
  const int vc0 = (MODE == 0) ? 1024 + h * 256 : (MODE == 1 ? 5120 + h * 128 : 2048 + h * 512);
  __syncthreads();
#pragma unroll
  for (int i = 0; i < NQ; ++i) {
    const int idx = tid + i * 512, r = idx / (K / 8), cc = idx % (K / 8);
    *(u32x4_t*)(rq + r * KS + cc * 8) = rqr[i];
    *(u32x4_t*)(rk + r * KS + cc * 8) = rkr[i];
  }
  if constexpr (PFV) {
#pragma unroll
    for (int i = 0; i < NV; ++i) {
      const int idx = tid + i * 512, r = idx / (V / 8), cc = idx % (V / 8);
      *(u32x4_t*)(rv + r * VS + cc * 8) = rvr[i];
    }
  }
  if (MODE == 2) {
    for (int i = tid; i < 64 * 2; i += 512) {
      const int r = i >> 1, hh = i & 1;
      uint4 g4 = *(const uint4*)(prow + (size_t)r * LD + 6144 + hh * 8);
      float* d = gl + r * 16 + hh * 8;
      d[0] = __uint_as_float(g4.x << 16); d[1] = __uint_as_float(g4.x & 0xffff0000u);
      d[2] = __uint_as_float(g4.y << 16); d[3] = __uint_as_float(g4.y & 0xffff0000u);
      d[4] = __uint_as_float(g4.z << 16); d[5] = __uint_as_float(g4.z & 0xffff0000u);
      d[6] = __uint_as_float(g4.w << 16); d[7] = __uint_as_float(g4.w & 0xffff0000u);
    }
  }
  if (uu + ustride < u1) PREP_ISSUE(uu + ustride);
  __builtin_amdgcn_sched_barrier(0);
  __syncthreads();
#pragma unroll 1
  for (int pass = 0; pass < NPASS; ++pass) {
  const int kk = pass * 128 + (tid & 127);
  float qv[TL], kv[TL], bc[TL];
  if (MODE == 0) {
    const int j = kk & 63;
    const float invr = exp2f(-(float)j * (13.287712379549449f / 64.f)) * 0.15915494309189535f;
    const float lgam = log1pf(-exp2f(-5.f - (float)h));
#pragma unroll
    for (int i = 0; i < TL; ++i) {
      const int l = seg * TL + i;
      float rev = (float)(pos0 + l) * invr;
      rev -= floorf(rev);
      const float sn = __builtin_amdgcn_sinf(rev), cs = __builtin_amdgcn_cosf(rev);
      const float q1 = bf2f(rq[l * KS + j]), q2 = bf2f(rq[l * KS + j + 64]), k1 = bf2f(rk[l * KS + j]), k2 = bf2f(rk[l * KS + j + 64]);
      const float qr = (kk < 64) ? q1 * cs - q2 * sn : q1 * sn + q2 * cs;
      const float kr = (kk < 64) ? k1 * cs - k2 * sn : k1 * sn + k2 * cs;
      qv[i] = qr; kv[i] = kr * 0.08838834764831845f;
      bc[i] = lgam;
    }
  } else if (MODE == 1) {
    const int ch = h * 128 + kk;
    const float* lbp = p.in[11];
    float e0 = __expf(lbp[ch]), e1 = __expf(lbp[1024 + ch]), e2 = __expf(lbp[2048 + ch]);
    const float lb = e0 / (e0 + e1 + e2);
#pragma unroll
    for (int i = 0; i < TL; ++i) {
      const int l = seg * TL + i;
      const float qx = bf2f(rq[l * KS + kk]), fx = bf2f(rk[l * KS + kk]);
      qv[i] = siluf_(qx) * 0.08838834764831845f;
      const float sg = sigmoidf_(fx);
      const float f = lb + (1.f - lb) * sg;
      kv[i] = (1.f - lb) * (1.f - sg);
      bc[i] = __logf(f);
    }
  } else {
    const int ch = h * 256 + kk;
    const float* w2 = p.in[14];
    float wvv[16];
#pragma unroll
    for (int r = 0; r < 16; ++r) wvv[r] = w2[r * 1024 + ch];
    const float bias = p.in[15][ch];
#pragma unroll
    for (int i = 0; i < TL; ++i) {
      const int l = seg * TL + i;
      qv[i] = bf2f(rq[l * KS + kk]) * 0.0625f;
      kv[i] = bf2f(rk[l * KS + kk]);
      float x = bias;
#pragma unroll
      for (int r = 0; r < 16; ++r) x += gl[l * 16 + r] * wvv[r];
      const float ls = fminf(x, 0.f) - log1pf(__expf(-fabsf(x)));
      bc[i] = ls * (1.f / 16.f);
    }
  }
#pragma unroll
  for (int i = 1; i < TL; ++i) bc[i] += bc[i - 1];
  segtot[seg * K + kk] = bc[TL - 1];
  __syncthreads();
  float pre = 0.f, bL = 0.f;
#pragma unroll
  for (int sg = 0; sg < NSEG; ++sg) { float t = segtot[sg * K + kk]; bL += t; if (sg < seg) pre += t; }
  if (seg == 0) dL[u * K + kk] = __expf(bL);
  unsigned kop[TL / 2];
#pragma unroll
  for (int i = 0; i < TL; i += 2) {
    float ko2[2];
#pragma unroll
    for (int e = 0; e < 2; ++e) {
      const int l = seg * TL + i + e;
      const float b = bc[i + e] + pre;
      const float qi = qv[i + e] * __expf(b);
      const float ki = kv[i + e] * __expf(-b);
      ko2[e] = kv[i + e] * __expf(bL - b);
      const u16 qb = f2bf(qi);
      qs[l * KS + kk] = qb;
      ksm[l * KS + kk] = f2bf(ki);
    }
    kop[i / 2] = pack2(ko2[0], ko2[1]);
  }
  {
#pragma unroll
    for (int i = 0; i < TL / 8; ++i) {
      const int cc = seg * 2 + i;
      uint4* dst = (uint4*)(koT + u * K * 64 + ((((kk >> 4) * 2 + (cc >> 2)) * 64 + (cc & 3) * 16 + (kk & 15)) << 3));
      *dst = make_uint4(kop[i * 4 + 0], kop[i * 4 + 1], kop[i * 4 + 2], kop[i * 4 + 3]);
    }
  }
  }
  __syncthreads();
  for (int i = tid; i < 64 * (K / 8); i += 512) {
    const int r = i / (K / 8), cc = i % (K / 8);
    *(uint4*)(qin + u * 64 * K + ((((r >> 4) * (K / 32) + (cc >> 2)) * 64 + (cc & 3) * 16 + (r & 15)) << 3)) = *(const uint4*)(qs + r * KS + cc * 8);
  }
  {
    const int w = tid >> 6, lane = tid & 63, fr = lane & 15, fq = lane >> 4;
#pragma unroll 1
    for (int bi = 0; bi < 2; ++bi) {
      const int blk = w + bi * 8, lb = blk >> 2, sb = blk & 3;
      f32x4 acc = {0.f, 0.f, 0.f, 0.f};
      if (sb <= lb) {
#pragma unroll
        for (int kst = 0; kst < K / 32; ++kst) {
          bf16x8 a = *(const bf16x8*)(ksm + (sb * 16 + fr) * KS + kst * 32 + fq * 8);
          bf16x8 b = *(const bf16x8*)(qs + (lb * 16 + fr) * KS + kst * 32 + fq * 8);
          acc = __builtin_amdgcn_mfma_f32_16x16x32_bf16(a, b, acc, 0, 0, 0);
        }
      }
      const int l = lb * 16 + fr, s0 = sb * 16 + fq * 4;
      float v0 = (s0 + 0 <= l) ? acc[0] : 0.f, v1 = (s0 + 1 <= l) ? acc[1] : 0.f;
      float v2 = (s0 + 2 <= l) ? acc[2] : 0.f, v3 = (s0 + 3 <= l) ? acc[3] : 0.f;
      if (lb >= 2 || sb < 2) *(uint2*)(Pm + u * 4096 + ((((lb * 2 + (s0 >> 5)) * 64 + ((s0 & 31) >> 3) * 16 + fr) << 3) + (s0 & 7))) = make_uint2(pack2(v0, v1), pack2(v2, v3));
    }
  }
  }
}

template <int K, int V>
__device__ __forceinline__ void seq_unit(int wv, const u16* __restrict__ qin, const u16* __restrict__ koT, const u16* __restrict__ Pm, const u16* __restrict__ vsrc, int vld,
                         const float* __restrict__ dL, int H, int c0, int nch, int h, int vs,
                         const float* __restrict__ s0, float* __restrict__ sout, u16* __restrict__ o, int row0, int ocol, unsigned char* shm) {
  const int tix = tidx(wv);
  constexpr int NKB = K / 128, SST = K + 8;
  u16* ST = (u16*)shm;
  const int tid = tix, w = tid >> 6, lane = tid & 63, fr = lane & 15, fq = lane >> 4;
  f32x4 accS[NKB][2];
  __syncthreads();
#pragma unroll
  for (int kb = 0; kb < NKB; ++kb)
#pragma unroll
    for (int vb = 0; vb < 2; ++vb) {
      const int k = (w * NKB + kb) * 16 + fq * 4, vcol = vb * 16 + fr;
#pragma unroll
      for (int j = 0; j < 4; ++j) accS[kb][vb][j] = s0 ? s0[(size_t)(k + j) * V + vs * 32 + vcol] : 0.f;
      *(uint2*)(ST + vcol * SST + k) = make_uint2(pack2(accS[kb][vb][0], accS[kb][vb][1]), pack2(accS[kb][vb][2], accS[kb][vb][3]));
    }
  constexpr int VTS = 72, LOS = 40;
  u16* VT = ST + 2 * 32 * SST;
  u16* LO = VT + 2 * 32 * VTS;
  const int v_s = (tid >> 2) & 63, v_p = tid & 3;
  const u16* vrow = vsrc + (size_t)v_s * vld + v_p * 8;
  u32x4_t vreg = {0u, 0u, 0u, 0u};
  if (tid < 256) {
    vreg = *(const u32x4_t*)vrow;
#pragma unroll
    for (int j = 0; j < 4; ++j) {
      VT[(v_p * 8 + 2 * j) * VTS + v_s] = (u16)(vreg[j] & 0xffffu);
      VT[(v_p * 8 + 2 * j + 1) * VTS + v_s] = (u16)(vreg[j] >> 16);
    }
  }
  __syncthreads();
  int cur = 0;
  const int lb = w >> 1, ovb = w & 1;
  struct FragsO { bf16x8 op[2], oq[K / 32]; };
  struct FragsS { bf16x8 ka[NKB][2]; float4 d[NKB]; };
  auto load_o = [&](int ci, FragsO& f) {
    const size_t u = (size_t)(c0 + ci) * H + h;
    const u16* Pu = Pm + u * 4096;
    const u16* qu = qin + u * 64 * K;
#pragma unroll
    for (int ss = 0; ss < 2; ++ss) { if (ss == 0 || lb >= 2) f.op[ss] = *(const bf16x8*)(Pu + (((lb * 2 + ss) * 64 + lane) << 3)); else f.op[ss] = bf16x8{0, 0, 0, 0, 0, 0, 0, 0}; }
#pragma unroll
    for (int kst = 0; kst < K / 32; ++kst) f.oq[kst] = *(const bf16x8*)(qu + (((lb * (K / 32) + kst) * 64 + lane) << 3));
  };
  auto load_s = [&](int ci, FragsS& f) {
    const size_t u = (size_t)(c0 + ci) * H + h;
    const u16* ku = koT + u * K * 64;
    const float* du = dL + u * K;
#pragma unroll
    for (int kb = 0; kb < NKB; ++kb) {
      const int kbase = (w * NKB + kb) * 16;
      f.d[kb] = *(const float4*)(du + kbase + fq * 4);
      f.ka[kb][0] = *(const bf16x8*)(ku + ((((w * NKB + kb) * 2 + 0) * 64 + lane) << 3));
      f.ka[kb][1] = *(const bf16x8*)(ku + ((((w * NKB + kb) * 2 + 1) * 64 + lane) << 3));
    }
  };
  FragsO fo;
  FragsS f0;
  load_o(0, fo);
  load_s(0, f0);
  for (int ci = 0; ci < nch; ++ci) {
    const int cn = ci + 1 < nch ? ci + 1 : ci;
    FragsO fo1;
    FragsS f1;
    load_o(cn, fo1);
    load_s(cn, f1);
    if (tid < 256) vreg = *(const u32x4_t*)(vrow + (size_t)cn * 64 * vld);
    __builtin_amdgcn_sched_barrier(0);
    const u16* STc = ST + cur * 32 * SST;
    u16* STn = ST + (cur ^ 1) * 32 * SST;
    const u16* VTc = VT + cur * 32 * VTS;
    u16* VTn = VT + (cur ^ 1) * 32 * VTS;
    bf16x8 vf[2][2];
#pragma unroll
    for (int vb = 0; vb < 2; ++vb)
#pragma unroll
      for (int ss = 0; ss < 2; ++ss) vf[vb][ss] = *(const bf16x8*)(VTc + (vb * 16 + fr) * VTS + ss * 32 + fq * 8);
    if (ci > 0 && tid < 256) {
      const uint4 ov = *(const uint4*)(LO + ((ci - 1) & 1) * 64 * LOS + v_s * LOS + v_p * 8);
      *(uint4*)(o + (size_t)(row0 + (ci - 1) * 64 + v_s) * D + ocol + vs * 32 + v_p * 8) = ov;
    }
    f32x4 ao = {0.f, 0.f, 0.f, 0.f};
#pragma unroll
    for (int ss = 0; ss < 2; ++ss) {
      if (ss == 0 || lb >= 2) {
        bf16x8 a = *(const bf16x8*)(VTc + (ovb * 16 + fr) * VTS + ss * 32 + fq * 8);
        ao = __builtin_amdgcn_mfma_f32_16x16x32_bf16(a, fo.op[ss], ao, 0, 0, 0);
      }
    }
#pragma unroll
    for (int kst = 0; kst < K / 32; ++kst) {
      bf16x8 a = *(const bf16x8*)(STc + (ovb * 16 + fr) * SST + kst * 32 + fq * 8);
      ao = __builtin_amdgcn_mfma_f32_16x16x32_bf16(a, fo.oq[kst], ao, 0, 0, 0);
    }
    *(uint2*)(LO + (ci & 1) * 64 * LOS + (lb * 16 + fr) * LOS + ovb * 16 + fq * 4) = make_uint2(pack2(ao[0], ao[1]), pack2(ao[2], ao[3]));
#pragma unroll
    for (int kb = 0; kb < NKB; ++kb) {
      const int kbase = (w * NKB + kb) * 16;
      const float4 d4 = f0.d[kb];
#pragma unroll
      for (int vb = 0; vb < 2; ++vb) {
        f32x4 sv = accS[kb][vb];
        sv[0] *= d4.x; sv[1] *= d4.y; sv[2] *= d4.z; sv[3] *= d4.w;
        sv = __builtin_amdgcn_mfma_f32_16x16x32_bf16(f0.ka[kb][0], vf[vb][0], sv, 0, 0, 0);
        sv = __builtin_amdgcn_mfma_f32_16x16x32_bf16(f0.ka[kb][1], vf[vb][1], sv, 0, 0, 0);
        accS[kb][vb] = sv;
        *(uint2*)(STn + (vb * 16 + fr) * SST + kbase + fq * 4) = make_uint2(pack2(sv[0], sv[1]), pack2(sv[2], sv[3]));
      }
    }
    if (tid < 256) {
#pragma unroll
      for (int j = 0; j < 4; ++j) {
        VTn[(v_p * 8 + 2 * j) * VTS + v_s] = (u16)(vreg[j] & 0xffffu);
        VTn[(v_p * 8 + 2 * j + 1) * VTS + v_s] = (u16)(vreg[j] >> 16);
      }
    }
    asm volatile("s_waitcnt lgkmcnt(0)" ::: "memory");
    __builtin_amdgcn_s_barrier();
    asm volatile("" ::: "memory");
    cur ^= 1;
    f0 = f1;
    fo = fo1;
  }
  if (tid < 256) {
    const uint4 ov = *(const uint4*)(LO + ((nch - 1) & 1) * 64 * LOS + v_s * LOS + v_p * 8);
    *(uint4*)(o + (size_t)(row0 + (nch - 1) * 64 + v_s) * D + ocol + vs * 32 + v_p * 8) = ov;
  }
#pragma unroll
  for (int kb = 0; kb < NKB; ++kb)
#pragma unroll
    for (int vb = 0; vb < 2; ++vb) {
      const int k = (w * NKB + kb) * 16 + fq * 4, vcol = vb * 16 + fr;
#pragma unroll
      for (int j = 0; j < 4; ++j) sout[(size_t)(k + j) * V + vs * 32 + vcol] = accS[kb][vb][j];
    }
}

__device__ __forceinline__ void seq_even_phase(int wv, const Params& p, unsigned char* shm) {
  unsigned char* R = p.ws + OFF_R;
  u16* o = (u16*)(p.ws + OFF_H);
  for (int u = blockIdx.x; u < 768; u += gridDim.x) {
    if (u < 256) {
      const int x = u & 7, y = u >> 3;
      if (y < 16) {
        const int g = x * 2 + (y >> 3), b = g >> 2, h = g & 3, vs = y & 7;
        seq_unit<128, 256>(wv, (u16*)(R + R_QA), (u16*)(R + R_KA), (u16*)(R + R_PA), (const u16*)(p.ws + OFF_BIG) + (size_t)(b * 2048) * NINE + 1024 + h * 256 + vs * 32, NINE, (float*)(R + R_DA), 4, b * 32, 32, h, vs,
                           nullptr, p.out + O_RETP + (size_t)(b * 4 + h) * 128 * 256, o, b * 2048, h * 256, shm);
      } else {
        const int yy = y - 16, g = x * 4 + (yy >> 2), b = g >> 3, h = g & 7, vs = yy & 3;
        seq_unit<128, 128>(wv, (u16*)(R + R_QB), (u16*)(R + R_KB), (u16*)(R + R_PB), (const u16*)(p.ws + OFF_BIG) + (size_t)(b * 2048) * NINE + 5120 + h * 128 + vs * 32, NINE, (float*)(R + R_DB), 8, b * 32, 32, h, vs,
                           nullptr, p.out + O_HGP + (size_t)(b * 8 + h) * 128 * 128, o, b * 2048, 1024 + h * 128, shm);
      }
    } else if (u < 512) {
      int x = u - 256, b = x >> 5, h = (x >> 3) & 3, vs = x & 7;
      seq_unit<128, 256>(wv, (u16*)(R + R_QA), (u16*)(R + R_KA), (u16*)(R + R_PA), (const u16*)(p.ws + OFF_BIG) + (size_t)(MP + b * 64) * NINE + 1024 + h * 256 + vs * 32, NINE, (float*)(R + R_DA), 4, 128 + b, 1, h, vs,
                         p.in[2] + (size_t)(b * 4 + h) * 128 * 256, p.out + O_RETS + (size_t)(b * 4 + h) * 128 * 256, o, MP + b * 64, h * 256, shm);
    } else {
      int x = u - 512, b = x >> 5, h = (x >> 2) & 7, vs = x & 3;
      seq_unit<128, 128>(wv, (u16*)(R + R_QB), (u16*)(R + R_KB), (u16*)(R + R_PB), (const u16*)(p.ws + OFF_BIG) + (size_t)(MP + b * 64) * NINE + 5120 + h * 128 + vs * 32, NINE, (float*)(R + R_DB), 8, 128 + b, 1, h, vs,
                         p.in[3] + (size_t)(b * 8 + h) * 128 * 128, p.out + O_HGS + (size_t)(b * 8 + h) * 128 * 128, o, MP + b * 64, 1024 + h * 128, shm);
    }
  }
}
__device__ __forceinline__ void seq_odd_phase(int wv, const Params& p, unsigned char* shm) {
  unsigned char* R = p.ws + OFF_R;
  u16* o = (u16*)(p.ws + OFF_H);
  for (int u = blockIdx.x; u < 768; u += gridDim.x) {
    if (u < 256) {
      const int x = u & 7, y = u >> 3, g = x * 2 + (y >> 4), b = g >> 2, h = g & 3, vs = y & 15;
      seq_unit<256, 512>(wv, (u16*)(R + R_QC), (u16*)(R + R_KC), (u16*)(R + R_PC), (const u16*)(p.ws + OFF_BIG) + (size_t)(b * 2048) * NINO_PAD + 2048 + h * 512 + vs * 32, NINO_PAD, (float*)(R + R_DC), 4, b * 32, 32, h, vs,
                         nullptr, p.out + O_GLP + (size_t)(b * 4 + h) * 256 * 512, o, b * 2048, h * 512, shm);
    } else {
      int x = u - 256, b = x >> 6, h = (x >> 4) & 3, vs = x & 15;
      seq_unit<256, 512>(wv, (u16*)(R + R_QC), (u16*)(R + R_KC), (u16*)(R + R_PC), (const u16*)(p.ws + OFF_BIG) + (size_t)(MP + b * 64) * NINO_PAD + 2048 + h * 512 + vs * 32, NINO_PAD, (float*)(R + R_DC), 4, 128 + b, 1, h, vs,
                         p.in[4] + (size_t)(b * 4 + h) * 256 * 512, p.out + O_GLS + (size_t)(b * 4 + h) * 256 * 512, o, MP + b * 64, h * 512, shm);
    }
  }
}

__device__ __forceinline__ void up8(u32x4_t v, float* f) {
  f[0] = __uint_as_float(v[0] << 16); f[1] = __uint_as_float(v[0] & 0xffff0000u);
  f[2] = __uint_as_float(v[1] << 16); f[3] = __uint_as_float(v[1] & 0xffff0000u);
  f[4] = __uint_as_float(v[2] << 16); f[5] = __uint_as_float(v[2] & 0xffff0000u);
  f[6] = __uint_as_float(v[3] << 16); f[7] = __uint_as_float(v[3] & 0xffff0000u);
}
template <int ODD>
__device__ __forceinline__ void post_phase(int wv, const Params& p) {
  const int tix = tidx(wv);
  const int lane = tix & 63, gw = blockIdx.x * 8 + (tix >> 6), nw = gridDim.x * 8;
  const u16* o = (const u16*)(p.ws + OFF_H);
  const u16* proj = (const u16*)(p.ws + OFF_BIG);
  u16* ao = (u16*)(p.ws + OFF_R);
#define POST_LOAD(xr_, gr_, row_) do { const int r_ = (row_); \
    _Pragma("unroll") for (int i = 0; i < 4; ++i) { const int col_ = i * 512 + lane * 8; \
      xr_[i] = *(const u32x4_t*)(o + (size_t)r_ * D + col_); \
      gr_[i] = *(const u32x4_t*)(proj + (size_t)r_ * (ODD ? NINO_PAD : NINE) + (ODD ? 4096 + col_ : (i < 2 ? 2048 + col_ : 6144 + (col_ - 1024)))); } } while (0)
  u32x4_t xr[4], gr[4];
  if (gw < MT) POST_LOAD(xr, gr, gw);
#pragma unroll 1
  for (int row = gw; row < MT; row += nw) {
    u32x4_t xn[4], gn4[4];
    if (row + nw < MT) POST_LOAD(xn, gn4, row + nw);
    else {
#pragma unroll
      for (int i = 0; i < 4; ++i) { xn[i] = xr[i]; gn4[i] = gr[i]; }
    }
    __builtin_amdgcn_sched_barrier(0);
#pragma unroll
    for (int i = 0; i < 4; ++i) {
      const int col = i * 512 + lane * 8;
      float x[8], g[8], y[8];
      up8(xr[i], x);
      up8(gr[i], g);
      if (ODD) {
        float ss = 0.f;
#pragma unroll
        for (int e = 0; e < 8; ++e) ss += x[e] * x[e];
#pragma unroll
        for (int off = 32; off > 0; off >>= 1) ss += __shfl_xor(ss, off, 64);
        const float rs = rsqrtf(ss * (1.f / 512.f) + EPS);
        const float* gn = p.in[16] + lane * 8;
#pragma unroll
        for (int e = 0; e < 8; ++e) y[e] = x[e] * rs * gn[e] * siluf_(g[e]);
      } else if (i < 2) {
        float s1 = 0.f;
#pragma unroll
        for (int e = 0; e < 8; ++e) s1 += x[e];
#pragma unroll
        for (int off = 16; off > 0; off >>= 1) s1 += __shfl_xor(s1, off, 64);
        const float mu = s1 * (1.f / 256.f);
        float s2 = 0.f;
#pragma unroll
        for (int e = 0; e < 8; ++e) { float dlt = x[e] - mu; s2 += dlt * dlt; }
#pragma unroll
        for (int off = 16; off > 0; off >>= 1) s2 += __shfl_xor(s2, off, 64);
        const float rs = rsqrtf(s2 * (1.f / 256.f) + EPS);
#pragma unroll
        for (int e = 0; e < 8; ++e) y[e] = (x[e] - mu) * rs * siluf_(g[e]);
      } else {
        float ss = 0.f;
#pragma unroll
        for (int e = 0; e < 8; ++e) ss += x[e] * x[e];
#pragma unroll
        for (int off = 8; off > 0; off >>= 1) ss += __shfl_xor(ss, off, 64);
        const float rs = rsqrtf(ss * (1.f / 128.f) + EPS);
        const float* gn = p.in[12] + (lane & 15) * 8;
#pragma unroll
        for (int e = 0; e < 8; ++e) y[e] = x[e] * rs * gn[e] * siluf_(g[e]);
      }
      st8(ao + (size_t)row * D + col, y);
    }
#pragma unroll
    for (int i = 0; i < 4; ++i) { xr[i] = xn[i]; gr[i] = gn4[i]; }
  }
#undef POST_LOAD
}


__device__ __forceinline__ void final_norm_phase(int wv, const Params& p) {
  const int tix = tidx(wv);
  const int lane = tix & 63, gw = blockIdx.x * 8 + (tix >> 6), nw = gridDim.x * 8;
  const u16* hb = (const u16*)(p.ws + OFF_HN);
  const float* w = p.in[8];
  u32x4_t v[4];
  if (gw < MT) {
#pragma unroll
    for (int i = 0; i < 4; ++i) v[i] = *(const u32x4_t*)(hb + (size_t)gw * D + i * 512 + lane * 8);
  }
#pragma unroll 1
  for (int row = gw; row < MT; row += nw) {
    u32x4_t nx[4];
    const int nrow = row + nw < MT ? row + nw : row;
#pragma unroll
    for (int i = 0; i < 4; ++i) nx[i] = *(const u32x4_t*)(hb + (size_t)nrow * D + i * 512 + lane * 8);
    __builtin_amdgcn_sched_barrier(0);
    float x[4][8];
    float ss = 0.f;
#pragma unroll
    for (int i = 0; i < 4; ++i) {
      up8(v[i], x[i]);
#pragma unroll
      for (int e = 0; e < 8; ++e) ss += x[i][e] * x[i][e];
    }
#pragma unroll
    for (int o = 32; o > 0; o >>= 1) ss += __shfl_xor(ss, o, 64);
    const float rs = rsqrtf(ss * (1.f / D) + EPS);
    float* dst = (row < MP) ? p.out + O_YP + (size_t)row * D : p.out + O_YS + (size_t)(row - MP) * D;
#pragma unroll
    for (int i = 0; i < 4; ++i) {
      const int col = i * 512 + lane * 8;
      const float4 w0 = *(const float4*)(w + col), w1 = *(const float4*)(w + col + 4);
      *(float4*)(dst + col) = make_float4(x[i][0] * rs * w0.x, x[i][1] * rs * w0.y, x[i][2] * rs * w0.z, x[i][3] * rs * w0.w);
      *(float4*)(dst + col + 4) = make_float4(x[i][4] * rs * w1.x, x[i][5] * rs * w1.y, x[i][6] * rs * w1.z, x[i][7] * rs * w1.w);
    }
#pragma unroll
    for (int i = 0; i < 4; ++i) v[i] = nx[i];
  }
}

__device__ __forceinline__ void gate_phase(int wv, const Params& p, int layer) {
  const int tix = tidx(wv);
  const u16* au = (const u16*)(p.ws + OFF_BIG);
  u16* gg = (u16*)(p.ws + OFF_R);
  const float* cw = p.in[19] + (size_t)layer * 3 * DFF;
  const float* cb = p.in[20] + (size_t)layer * DFF;
  const float* cache = p.in[5] + (size_t)layer * 8 * 2 * DFF;
  const int nitems = (MT / 16) * (DFF / 8);
  for (int it = blockIdx.x * 512 + tix; it < nitems; it += gridDim.x * 512) {
    const int cg8 = it % (DFF / 8), rb = it / (DFF / 8), c0 = cg8 * 8, r0 = rb * 16;
    float w0[8], w1[8], w2[8], bb[8], am2[8], am1[8];
#pragma unroll
    for (int e = 0; e < 8; ++e) { w0[e] = cw[c0 + e]; w1[e] = cw[DFF + c0 + e]; w2[e] = cw[2 * DFF + c0 + e]; bb[e] = cb[c0 + e]; }
    int t0, T, b; bool samp = r0 >= MP;
    if (!samp) { b = r0 >> 11; t0 = r0 & 2047; T = 2048; } else { b = (r0 - MP) >> 6; t0 = (r0 - MP) & 63; T = 64; }
    if (t0 == 0) {
      if (samp) {
#pragma unroll
        for (int e = 0; e < 8; ++e) { am2[e] = cache[(size_t)(b * 2 + 0) * DFF + c0 + e]; am1[e] = cache[(size_t)(b * 2 + 1) * DFF + c0 + e]; }
      } else {
#pragma unroll
        for (int e = 0; e < 8; ++e) { am2[e] = 0.f; am1[e] = 0.f; }
      }
    } else {
      ld8(au + (size_t)(r0 - 2) * NUP + c0, am2);
      ld8(au + (size_t)(r0 - 1) * NUP + c0, am1);
    }
#pragma unroll 4
    for (int i = 0; i < 16; ++i) {
      float a[8], uu[8], y[8];
      ld8(au + (size_t)(r0 + i) * NUP + c0, a);
      ld8(au + (size_t)(r0 + i) * NUP + DFF + c0, uu);
#pragma unroll
      for (int e = 0; e < 8; ++e) {
        float cv = bb[e] + w0[e] * am2[e] + w1[e] * am1[e] + w2[e] * a[e];
        y[e] = siluf_(cv) * uu[e];
        am2[e] = am1[e]; am1[e] = a[e];
      }
      st8(gg + (size_t)(r0 + i) * DFF + c0, y);
    }
    if (t0 + 16 == T) {
      float* dst = samp ? p.out + O_CVS + (size_t)(layer * 8 + b) * 2 * DFF : p.out + O_CVP + (size_t)(layer * 4 + b) * 2 * DFF;
#pragma unroll
      for (int e = 0; e < 8; ++e) { dst[c0 + e] = am2[e]; dst[DFF + c0 + e] = am1[e]; }
    }
  }
}


__device__ __forceinline__ void gate_fixup(int wv, const Params& p, int layer) {
  const int tix = tidx(wv);
  const u16* side = (const u16*)(p.ws + OFF_SIDE);
  u16* gg = (u16*)(p.ws + OFF_R);
  const float* cw = p.in[19] + (size_t)layer * 3 * DFF;
  const float* cb = p.in[20] + (size_t)layer * DFF;
  for (int vw = blockIdx.x; vw < (MP / BM) * (D / BM); vw += gridDim.x) {
    int pm, pn;
    tile_coords(vw, MP / BM, D / BM, pm, pn);
    if ((pm & 7) == 0) continue;
    for (int c8 = tix; c8 < DFF / 8; c8 += 512) {
      const int c = c8 * 8;
      float a0[8], a1[8], u0[8], u1[8], q2[8], q1[8], y0[8], y1[8];
      ld8(side + (size_t)(pm * 2 + 0) * DFF + c, a0);
      ld8(side + (size_t)(pm * 2 + 1) * DFF + c, a1);
      ld8(side + SZ_SIDE1 / 2 + (size_t)(pm * 2 + 0) * DFF + c, u0);
      ld8(side + SZ_SIDE1 / 2 + (size_t)(pm * 2 + 1) * DFF + c, u1);
      ld8(side + SZ_SIDE1 + (size_t)((pm - 1) * 2 + 0) * DFF + c, q2);
      ld8(side + SZ_SIDE1 + (size_t)((pm - 1) * 2 + 1) * DFF + c, q1);
#pragma unroll
      for (int e = 0; e < 8; ++e) {
        const float w0 = cw[c + e], w1 = cw[DFF + c + e], w2 = cw[2 * DFF + c + e], bb = cb[c + e];
        y0[e] = siluf_(bb + w0 * q2[e] + w1 * q1[e] + w2 * a0[e]) * u0[e];
        y1[e] = siluf_(bb + w0 * q1[e] + w1 * a0[e] + w2 * a1[e]) * u1[e];
      }
      st8(gg + (size_t)(pm * 256 + 0) * DFF + c, y0);
      st8(gg + (size_t)(pm * 256 + 1) * DFF + c, y1);
    }
  }
  asm volatile("s_waitcnt vmcnt(0)" ::: "memory");
  __syncthreads();
}

#define XB_TMO      128
#define XB_XCNT(j)  (256  + 64 * (j))
#define XB_XSUB(j)  (1280 + 64 * (j))
#define XB_XGEN(j)  (2304 + 64 * (j))
#define XB_TOP      3328
#define XB_TOPGEN   3392
#define XCD_BAR_WORDS 3456
#define XB_SPIN_CAP (1u << 22)
#define LAS __attribute__((address_space(3)))
__device__ __forceinline__ unsigned xb_ld(unsigned* p)              { return __hip_atomic_load(p, __ATOMIC_RELAXED, __HIP_MEMORY_SCOPE_AGENT); }
__device__ __forceinline__ unsigned xb_add(unsigned* p, unsigned v) { return __hip_atomic_fetch_add(p, v, __ATOMIC_RELAXED, __HIP_MEMORY_SCOPE_AGENT); }
__device__ __forceinline__ unsigned xb_xcc_id() { return (unsigned)__builtin_amdgcn_s_getreg((3 << 11) | 20) & 0xFu; }
#define XB_SPIN(cond, bar) do { unsigned _sp = 0; while (cond) { __builtin_amdgcn_s_sleep(1); \
    if ((++_sp & 255u) == 0u) { if (xb_ld(&(bar)[XB_TMO])) break; if (_sp > XB_SPIN_CAP) { atomicAdd(&(bar)[XB_TMO], 1u); break; } } } } while (0)
struct XcdBarrier { unsigned* bar; unsigned x; volatile LAS unsigned* st; };
__device__ __forceinline__ XcdBarrier xcd_barrier_post(int wv, unsigned* bar, volatile LAS unsigned* st) {
  XcdBarrier b; b.bar = bar; b.x = xb_xcc_id(); b.st = st;
  if (tidx(wv) == 0) (void)xb_add(&bar[XB_XCNT(b.x)], 1u);
  return b;
}
__device__ __forceinline__ void xcd_barrier_complete(unsigned* bar, unsigned x, unsigned& nloc, unsigned& nx) {
  const unsigned G = gridDim.x * gridDim.y * gridDim.z;
  unsigned sum, cnt, mine, sp = 0u;
  for (;;) {
    sum = 0u; cnt = 0u; mine = 0u;
#pragma unroll
    for (unsigned j = 0; j < 16; ++j) { const unsigned c = xb_ld(&bar[XB_XCNT(j)]); sum += c; cnt += (c > 0u) ? 1u : 0u; mine = (j == x) ? c : mine; }
    if (sum == G) break;
    __builtin_amdgcn_s_sleep(1);
    if ((++sp & 255u) == 0u) { if (xb_ld(&bar[XB_TMO])) break; if (sp > XB_SPIN_CAP) { atomicAdd(&bar[XB_TMO], 1u); break; } }
  }
  nloc = mine > 0u ? mine : 1u; nx = cnt > 0u ? cnt : 1u;
}
__device__ __forceinline__ void xcd_barrier(int wv, const XcdBarrier& b) {
  asm volatile("s_waitcnt vmcnt(0)" ::: "memory");
  __syncthreads();
  if (tidx(wv) == 0) {
    unsigned* bar = b.bar;
    __builtin_amdgcn_s_waitcnt(0);
    unsigned nloc = b.st[0], nx = b.st[1];
    if (nloc == 0u) { xcd_barrier_complete(bar, b.x, nloc, nx); b.st[0] = nloc; b.st[1] = nx; }
    const unsigned old = xb_add(&bar[XB_XSUB(b.x)], 1u);
    const unsigned gen = old / nloc;
    if (old + 1u == (gen + 1u) * nloc) {
      __builtin_amdgcn_fence(__ATOMIC_RELEASE, "agent");
      asm volatile("s_waitcnt vmcnt(0)" ::: "memory");
      const unsigned og = xb_add(&bar[XB_TOP], 1u);
      const unsigned tg = og / nx;
      if (og + 1u == (tg + 1u) * nx) xb_add(&bar[XB_TOPGEN], 1u);
      else XB_SPIN(xb_ld(&bar[XB_TOPGEN]) == tg, bar);
      __builtin_amdgcn_fence(__ATOMIC_ACQUIRE, "agent");
      xb_add(&bar[XB_XGEN(b.x)], 1u);
      asm volatile("s_waitcnt vmcnt(0)" ::: "memory");
    } else {
      XB_SPIN(xb_ld(&bar[XB_XGEN(b.x)]) == gen, bar);
      __builtin_amdgcn_fence(__ATOMIC_ACQUIRE, "agent");
      asm volatile("s_waitcnt vmcnt(0)" ::: "memory");
    }
  }
  __syncthreads();
}

constexpr int NPHASE = 21;
#ifndef PHMASK
#define PHMASK 0xFFFFFFFFu
#endif
#define PH_ON(k) (((PHMASK) >> (k)) & 1u)
constexpr int LDS_BYTES = 147456;

typedef const __attribute__((address_space(4))) Params* KParamsPtr;
#ifndef XSYNC
#define XSYNC 0
#endif
#ifndef DUPMASK
#define DUPMASK 0u
#endif
#define DUP_ON(k) (((DUPMASK) >> (k)) & 1u)
__device__ __forceinline__ bool ph_in(KParamsPtr& kp, int k) { asm volatile("" : "+s"(kp)); return kp->ph_lo <= k && k < kp->ph_hi; }
#define PH_IN(k) ph_in(kp, (k))
#define PHASE(k, ...) if (PH_IN(k)) { if (PH_ON(k)) { for (int rep = 0; rep < 1 + (int)DUP_ON(k); ++rep) { asm volatile("" : "+s"(kp)); Params p; __builtin_memcpy(&p, kp, sizeof(Params)); unsigned char* ws = p.ws; __VA_ARGS__ } } \
    asm volatile("" : "+s"(kp)); \
    if (kp->coop && (k) + 1 < kp->ph_hi) { XcdBarrier xb; xb.bar = (unsigned*)(kp->ws + OFF_BAR); xb.x = xb_xcc_id(); xb.st = (volatile LAS unsigned*)&xb_words; xcd_barrier(wv, xb); if (XSYNC) xcd_barrier(wv, xb); } }
#define PHASE_X(k, ...) if (PH_IN(k)) { asm volatile("" : "+s"(kp)); Params p; __builtin_memcpy(&p, kp, sizeof(Params)); unsigned char* ws = p.ws; __VA_ARGS__ }
#define GEMM_ACC(k, Aoff, Woff, KK, RSSP, FIXL, RINP, RINS) PHASE(k, { float* rssp = (RSSP); if ((FIXL) >= 0) gate_fixup(wv, p, FIXL); \
    gemm_phase<MP, D, KK, 0>(wv, (const u16*)(ws + Aoff), (const u16*)(ws + Woff), EpiAccum{(u16*)(ws + OFF_HN), rssp, (RINP)}, (u16*)shm); \
    gemm_tail_phase<KK>(wv, (const u16*)(ws + Aoff), (const u16*)(ws + Woff), (float*)shm, (u16*)(ws + OFF_HN), rssp, (RINS)); })

__global__ void __launch_bounds__(512) fwd_kernel(Params p_) {
  extern __shared__ __attribute__((aligned(16))) unsigned char shm[];
  cg::grid_group grid = cg::this_grid();
  KParamsPtr kp = (KParamsPtr)__builtin_amdgcn_kernarg_segment_ptr();
  const int wv = __builtin_amdgcn_readfirstlane((int)(threadIdx.x >> 6));
  __shared__ uint4 xb_words;
  if (tidx(wv) == 0) xb_words = make_uint4(0u, 0u, 0u, 0u);
  __syncthreads();
  if (kp->coop == 2) grid.sync();
  (void)xcd_barrier_post(wv, (unsigned*)(kp->ws + OFF_BAR), (volatile LAS unsigned*)&xb_words);
  PHASE(0,
        convert_w(wv, p.in[9], (u16*)(ws + OFF_WINE), D, NINE, NINE, (u16*)shm);
        convert_w(wv, p.in[10], (u16*)(ws + OFF_WOUTE), D, D, D, (u16*)shm);
        convert_w(wv, p.in[13], (u16*)(ws + OFF_WINO), D, NINO, NINO_PAD, (u16*)shm, p.in[6] + D);
        convert_w(wv, p.in[17], (u16*)(ws + OFF_WOUTO), D, D, D, (u16*)shm);
        convert_w(wv, p.in[18], (u16*)(ws + OFF_WUP0), D, NUP, NUP, (u16*)shm, p.in[7], 1);
        convert_w(wv, p.in[18] + (size_t)D * NUP, (u16*)(ws + OFF_WUP1), D, NUP, NUP, (u16*)shm, p.in[7] + D, 1);
        convert_w(wv, p.in[21], (u16*)(ws + OFF_WDN0), DFF, D, D, (u16*)shm);
        convert_w(wv, p.in[21] + (size_t)DFF * D, (u16*)(ws + OFF_WDN1), DFF, D, D, (u16*)shm);
        for (int i = blockIdx.x * 512 + tidx(wv); i < 3 * MT; i += gridDim.x * 512) ((float*)(ws + OFF_RSS))[i] = 0.f;
        rmsnorm_phase<0>(wv, p, p.in[6]);)
  PHASE(1, gemm_phase<MT, NINE, D, 0>(wv, (const u16*)(ws + OFF_HN), (const u16*)(ws + OFF_WINE), EpiStoreBf16{(u16*)(ws + OFF_BIG), NINE, nullptr}, (u16*)shm);)
  PHASE(2, { const int b_ = blockIdx.x, G_ = gridDim.x;
        prep_range<0>(wv, p, b_, NCH * 4, G_, shm);
        const int first1 = ((NCH * 4 - b_ + G_ - 1) / G_) * G_ + b_ - NCH * 4;
        prep_range<1>(wv, p, first1, NCH * 8, G_, shm); })
  PHASE(3, seq_even_phase(wv, p, shm);)
  PHASE(4, post_phase<0>(wv, p);)
  GEMM_ACC(5, OFF_R, OFF_WOUTE, D, (float*)(ws + OFF_RSS), -1, p.in[0], p.in[1])
  PHASE(7, gemm_phase<MT, NUP, D, 0>(wv, (const u16*)(ws + OFF_HN), (const u16*)(ws + OFF_WUP0), EpiGate{(const __attribute__((address_space(4))) void*)kp, 0, 0}, (u16*)shm);)
  GEMM_ACC(9, OFF_R, OFF_WDN0, DFF, (float*)(ws + OFF_RSS) + MT, 0, (const float*)nullptr, (const float*)nullptr)
  PHASE(11, gemm_phase<MT, NINO_PAD, D, 0>(wv, (const u16*)(ws + OFF_HN), (const u16*)(ws + OFF_WINO), EpiStoreBf16{(u16*)(ws + OFF_BIG), NINO_PAD, (const float*)(ws + OFF_RSS) + MT}, (u16*)shm);)
  PHASE(12, prep_range<2>(wv, p, blockIdx.x, NCH * 4, gridDim.x, shm);)
  PHASE(13, seq_odd_phase(wv, p, shm);)
  PHASE(14, post_phase<1>(wv, p);)
  GEMM_ACC(15, OFF_R, OFF_WOUTO, D, (float*)(ws + OFF_RSS) + 2 * MT, -1, (const float*)nullptr, (const float*)nullptr)
  PHASE(17, gemm_phase<MT, NUP, D, 0>(wv, (const u16*)(ws + OFF_HN), (const u16*)(ws + OFF_WUP1), EpiGate{(const __attribute__((address_space(4))) void*)kp, 1, 2 * MT}, (u16*)shm);)
  GEMM_ACC(19, OFF_R, OFF_WDN1, DFF, (float*)nullptr, 1, (const float*)nullptr, (const float*)nullptr)
  PHASE(20, final_norm_phase(wv, p);)
}

extern "C" void kernel_launch(void* const* d_in, const int* in_sizes, int n_in, void* d_out, int out_size, void* d_ws, size_t ws_size,
                              hipStream_t stream) {
  static int grid_blocks = 0;
  if (grid_blocks == 0) {
    int dev = 0, cus = 0, per_cu = 0;
    hipGetDevice(&dev);
    hipDeviceGetAttribute(&cus, hipDeviceAttributeMultiprocessorCount, dev);
    hipFuncSetAttribute((const void*)fwd_kernel, hipFuncAttributeMaxDynamicSharedMemorySize, LDS_BYTES);
    hipOccupancyMaxActiveBlocksPerMultiprocessor(&per_cu, (const void*)fwd_kernel, 512, LDS_BYTES);
    if (per_cu < 1) per_cu = 1;
    grid_blocks = cus * per_cu;
    (void)hipGetLastError();
  }
  if (n_in != 22 || ws_size < WS_NEED || (size_t)out_size != O_END) {
    fprintf(stderr, "kernel_launch: unexpected sizes n_in=%d ws=%zu need=%zu out=%d\n", n_in, ws_size, (size_t)WS_NEED, out_size);
    hipMemsetAsync(d_out, 0, (size_t)out_size * 4, stream);
    return;
  }
  Params p{};
  for (int i = 0; i < 22; ++i) p.in[i] = (const float*)d_in[i];
  p.out = (float*)d_out;
  p.ws = (unsigned char*)d_ws;
#if 0
  for (int ph = 0; ph < NPHASE; ++ph) {
    p.ph_lo = ph; p.ph_hi = ph + 1; p.coop = 0;
    hipLaunchKernelGGL(fwd_kernel, dim3(grid_blocks), dim3(512), LDS_BYTES, stream, p);
  }
#else
  p.ph_lo = 0; p.ph_hi = NPHASE; p.coop = 1;
  hipMemsetAsync((unsigned char*)d_ws + OFF_BAR, 0, XCD_BAR_WORDS * 4, stream);
  void* args[] = {&p};
  hipError_t e = hipLaunchCooperativeKernel((const void*)fwd_kernel, dim3(grid_blocks), dim3(512), args, LDS_BYTES, stream);
  if (e != hipSuccess) fprintf(stderr, "cooperative launch failed: %s (grid %d)\n", hipGetErrorString(e), grid_blocks);
#endif
}
```

```cpp
#include <hip/hip_runtime.h>
#include <hip/hip_bf16.h>
#include <hip/hip_cooperative_groups.h>
#include <cstdio>
namespace cg = cooperative_groups;

typedef unsigned short u16;
using bf16x8 = __attribute__((ext_vector_type(8))) short;
using f32x4 = __attribute__((ext_vector_type(4))) float;
typedef __attribute__((ext_vector_type(4))) unsigned u32x4_t;

constexpr int MP = 8192, MS = 512, MT = 8704, D = 2048;
constexpr int DFF = 5504, NUP = 11008;
constexpr int NINE = 7168, NINO = 6160, NINO_PAD = 6400;
constexpr int NCH = 136;
constexpr float EPS = 1e-6f;

constexpr size_t SZ_WINE = (size_t)NINE * D * 2, SZ_WOUT = (size_t)D * D * 2, SZ_WINO = (size_t)NINO_PAD * D * 2;
constexpr size_t SZ_WUP = (size_t)NUP * D * 2, SZ_WDN = (size_t)D * DFF * 2;
constexpr size_t OFF_WINE = 0;
constexpr size_t OFF_WOUTE = OFF_WINE + SZ_WINE;
constexpr size_t OFF_WINO = OFF_WOUTE + SZ_WOUT;
constexpr size_t OFF_WOUTO = OFF_WINO + SZ_WINO;
constexpr size_t OFF_WUP0 = OFF_WOUTO + SZ_WOUT;
constexpr size_t OFF_WUP1 = OFF_WUP0 + SZ_WUP;
constexpr size_t OFF_WDN0 = OFF_WUP1 + SZ_WUP;
constexpr size_t OFF_WDN1 = OFF_WDN0 + SZ_WDN;
constexpr size_t OFF_H = OFF_WDN1 + SZ_WDN;
constexpr size_t OFF_HN = OFF_H + (size_t)MT * D * 4;
constexpr size_t OFF_BIG = OFF_HN + (size_t)MT * D * 2;
constexpr size_t OFF_R = OFF_BIG + (size_t)MT * NUP * 2;
constexpr size_t SZ_R = 104ull * 1048576;
constexpr size_t OFF_RSS = OFF_R + SZ_R;
constexpr size_t OFF_SIDE = OFF_RSS + 3ull * MT * 4 + 256;
constexpr size_t SZ_SIDE1 = 34ull * 2 * DFF * 2;
constexpr size_t OFF_BAR = OFF_SIDE + 3 * SZ_SIDE1 + 256;
constexpr size_t WS_NEED = OFF_BAR + 16384;
constexpr size_t R_QA = 0;
constexpr size_t R_KA = R_QA + (size_t)NCH * 4 * 64 * 128 * 2;
constexpr size_t R_VA = R_KA + (size_t)NCH * 4 * 64 * 128 * 2;
constexpr size_t R_PA = R_VA + (size_t)NCH * 4 * 256 * 64 * 2;
constexpr size_t R_DA = R_PA + (size_t)NCH * 4 * 4096 * 2;
constexpr size_t R_QB = R_DA + (size_t)NCH * 4 * 128 * 4;
constexpr size_t R_KB = R_QB + (size_t)NCH * 8 * 64 * 128 * 2;
constexpr size_t R_VB = R_KB + (size_t)NCH * 8 * 64 * 128 * 2;
constexpr size_t R_PB = R_VB + (size_t)NCH * 8 * 128 * 64 * 2;
constexpr size_t R_DB = R_PB + (size_t)NCH * 8 * 4096 * 2;
constexpr size_t R_END_EVEN = R_DB + (size_t)NCH * 8 * 128 * 4;
constexpr size_t R_QC = 0;
constexpr size_t R_KC = R_QC + (size_t)NCH * 4 * 64 * 256 * 2;
constexpr size_t R_VC = R_KC + (size_t)NCH * 4 * 64 * 256 * 2;
constexpr size_t R_PC = R_VC + (size_t)NCH * 4 * 512 * 64 * 2;
constexpr size_t R_DC = R_PC + (size_t)NCH * 4 * 4096 * 2;
constexpr size_t R_END_ODD = R_DC + (size_t)NCH * 4 * 256 * 4;
static_assert(R_END_EVEN <= SZ_R && R_END_ODD <= SZ_R && (size_t)MT * DFF * 2 <= SZ_R, "R region too small");

constexpr size_t O_YP = 0;
constexpr size_t O_YS = O_YP + (size_t)MP * D;
constexpr size_t O_RETP = O_YS + (size_t)MS * D;
constexpr size_t O_RETS = O_RETP + 4ull * 4 * 128 * 256;
constexpr size_t O_HGP = O_RETS + 8ull * 4 * 128 * 256;
constexpr size_t O_HGS = O_HGP + 4ull * 8 * 128 * 128;
constexpr size_t O_GLP = O_HGS + 8ull * 8 * 128 * 128;
constexpr size_t O_GLS = O_GLP + 4ull * 4 * 256 * 512;
constexpr size_t O_CVP = O_GLS + 8ull * 4 * 256 * 512;
constexpr size_t O_CVS = O_CVP + 2ull * 4 * 2 * DFF;
constexpr size_t O_END = O_CVS + 2ull * 8 * 2 * DFF;

struct Params {
  const float* in[22];
  float* out;
  unsigned char* ws;
  int ph_lo, ph_hi, coop, pad;
};

__device__ __forceinline__ u16 f2bf(float f) {
  unsigned u = __float_as_uint(f);
  u += 0x7fffu + ((u >> 16) & 1u);
  return (u16)(u >> 16);
}
__device__ __forceinline__ float bf2f(u16 h) { return __uint_as_float(((unsigned)h) << 16); }
__device__ __forceinline__ unsigned pack2_sw(float a, float b) { return (unsigned)f2bf(a) | ((unsigned)f2bf(b) << 16); }
typedef float f32x2_t __attribute__((ext_vector_type(2)));
typedef __bf16 bf16x2_t __attribute__((ext_vector_type(2)));
__device__ __forceinline__ unsigned pack2(float a, float b) { f32x2_t v = {a, b}; bf16x2_t r = __builtin_convertvector(v, bf16x2_t); return __builtin_bit_cast(unsigned, r); }
__device__ __forceinline__ float sigmoidf_(float x) { return __builtin_amdgcn_rcpf(1.f + __expf(-x)); }
__device__ __forceinline__ float siluf_(float x) { return x * __builtin_amdgcn_rcpf(1.f + __expf(-x)); }

__device__ __forceinline__ int tidx(int wv) { int l; asm volatile("v_mbcnt_lo_u32_b32 %0, -1, 0\n\tv_mbcnt_hi_u32_b32 %0, -1, %0" : "=v"(l)); return wv * 64 + l; }

__device__ __forceinline__ void convert_w(int wv, const float* __restrict__ src, u16* __restrict__ dst, int K, int N, int Npad, u16* tile, const float* __restrict__ kscale = nullptr, int upperm = 0) {
  const int tix = tidx(wv);
  constexpr int TS = 262;
  const int tn = (Npad + 255) / 256, tk = K / 64, nt = tn * tk, tid = tix;
  for (int t = blockIdx.x; t < nt; t += gridDim.x) {
    const int n0 = (t % tn) * 256, k0 = (t / tn) * 64;
    float4 v[8];
#pragma unroll
    for (int i = 0; i < 8; ++i) {
      const int idx = tid + i * 512, kk = idx >> 6, n = n0 + (idx & 63) * 4;
      v[i] = make_float4(0.f, 0.f, 0.f, 0.f);
      if (n < N) { const f32x4 t_ = __builtin_nontemporal_load((const f32x4*)(src + (size_t)(k0 + kk) * N + n)); v[i] = make_float4(t_[0], t_[1], t_[2], t_[3]); }
      if (kscale) { const float sc = kscale[k0 + kk]; v[i].x *= sc; v[i].y *= sc; v[i].z *= sc; v[i].w *= sc; }
    }
    __syncthreads();
#pragma unroll
    for (int i = 0; i < 8; ++i) {
      const int idx = tid + i * 512, kk = idx >> 6, nl = (idx & 63) * 4;
      *(unsigned*)(tile + kk * TS + nl) = pack2(v[i].x, v[i].y);
      *(unsigned*)(tile + kk * TS + nl + 2) = pack2(v[i].z, v[i].w);
    }
    __syncthreads();
#pragma unroll
    for (int i = 0; i < 4; ++i) {
      const int item = tid + i * 512, ks = item & 7, n = item >> 3;
      if (n0 + n < Npad) {
        const u16* tp = tile + (ks * 8) * TS + n;
        uint4 o;
        o.x = (unsigned)tp[0] | ((unsigned)tp[TS] << 16);
        o.y = (unsigned)tp[2 * TS] | ((unsigned)tp[3 * TS] << 16);
        o.z = (unsigned)tp[4 * TS] | ((unsigned)tp[5 * TS] << 16);
        o.w = (unsigned)tp[6 * TS] | ((unsigned)tp[7 * TS] << 16);
        int nr = n0 + n;
        if (upperm) nr = (nr < DFF) ? ((nr >> 7) * 256 + (nr & 127)) : ((((nr - DFF) >> 7) * 256) + 128 + ((nr - DFF) & 127));
        *(uint4*)(dst + (size_t)nr * K + k0 + ks * 8) = o;
      }
    }
  }
}

template <int MODE>
__device__ __forceinline__ void rmsnorm_phase(int wv, const Params& p, const float* __restrict__ w) {
  const int tix = tidx(wv);
  const int lane = tix & 63, gw = blockIdx.x * 8 + (tix >> 6), nw = gridDim.x * 8;
  const float* h = (const float*)(p.ws + OFF_H);
  u16* hn = (u16*)(p.ws + OFF_HN);
#define RMS_LOAD(dst, row_) do { const int r_ = (row_); const float* src_; \
    if (MODE == 0) src_ = (r_ < MP) ? p.in[0] + (size_t)r_ * D : p.in[1] + (size_t)(r_ - MP) * D; \
    else src_ = h + (size_t)r_ * D; \
    _Pragma("unroll") for (int i = 0; i < 8; ++i) dst[i] = (MODE == 0) ? __builtin_nontemporal_load((const f32x4*)(src_ + (i * 64 + lane) * 4)) : *(const f32x4*)(src_ + (i * 64 + lane) * 4); } while (0)
  f32x4 v[8];
  if (gw < MT) RMS_LOAD(v, gw);
#pragma unroll 1
  for (int row = gw; row < MT; row += nw) {
    f32x4 nx[8];
    if (row + nw < MT) RMS_LOAD(nx, row + nw);
    else {
#pragma unroll
      for (int i = 0; i < 8; ++i) nx[i] = v[i];
    }
    __builtin_amdgcn_sched_barrier(0);
    float ss = 0.f;
#pragma unroll
    for (int i = 0; i < 8; ++i) ss += v[i][0] * v[i][0] + v[i][1] * v[i][1] + v[i][2] * v[i][2] + v[i][3] * v[i][3];
#pragma unroll
    for (int o = 32; o > 0; o >>= 1) ss += __shfl_xor(ss, o, 64);
    const float rs = rsqrtf(ss * (1.f / D) + EPS);
#pragma unroll
    for (int i = 0; i < 8; ++i) {
      const int col = (i * 64 + lane) * 4;
      const float4 wv4 = *(const float4*)(w + col);
      const float4 y = make_float4(v[i][0] * rs * wv4.x, v[i][1] * rs * wv4.y, v[i][2] * rs * wv4.z, v[i][3] * rs * wv4.w);
      if (MODE == 2) {
        float* dst = (row < MP) ? p.out + O_YP + (size_t)row * D : p.out + O_YS + (size_t)(row - MP) * D;
        *(float4*)(dst + col) = y;
      } else {
        *(uint2*)(hn + (size_t)row * D + col) = make_uint2(pack2(y.x, y.y), pack2(y.z, y.w));
      }
    }
#pragma unroll
    for (int i = 0; i < 8; ++i) v[i] = nx[i];
  }
#undef RMS_LOAD
}

__device__ __forceinline__ void ld8(const u16* p, float* f) {
  uint4 v = *(const uint4*)p;
  f[0] = __uint_as_float(v.x << 16); f[1] = __uint_as_float(v.x & 0xffff0000u);
  f[2] = __uint_as_float(v.y << 16); f[3] = __uint_as_float(v.y & 0xffff0000u);
  f[4] = __uint_as_float(v.z << 16); f[5] = __uint_as_float(v.z & 0xffff0000u);
  f[6] = __uint_as_float(v.w << 16); f[7] = __uint_as_float(v.w & 0xffff0000u);
}
__device__ __forceinline__ void st8(u16* p, const float* f) {
  *(uint4*)p = make_uint4(pack2(f[0], f[1]), pack2(f[2], f[3]), pack2(f[4], f[5]), pack2(f[6], f[7]));
}
__device__ __forceinline__ void st8_sw(u16* p, const float* f) {
  *(uint4*)p = make_uint4(pack2_sw(f[0], f[1]), pack2_sw(f[2], f[3]), pack2_sw(f[4], f[5]), pack2_sw(f[6], f[7]));
}

constexpr int BM = 256, BK = 64, HALF = 128, NXCD = 8, WGM = 8, HT = HALF * BK;

__device__ __forceinline__ int lds_byte(int r, int c) {
  int st = (r >> 4) * 2 + (c >> 5), rr = r & 15, cc = c & 31, ob = rr * 64 + cc * 2;
  return st * 1024 + (ob ^ (((ob >> 9) & 1) << 5));
}
__device__ __forceinline__ void stage_rc(int b, int& R, int& C) {
  int st = b / 1024, sb = b % 1024, swz = sb ^ (((sb >> 9) & 1) << 5);
  R = (st >> 1) * 16 + swz / 64; C = (st & 1) * 32 + (swz % 64) / 2;
}

__device__ __forceinline__ void tile_coords(int wgid, int nM, int nN, int& pm, int& pn) {
  const int nwg = nM * nN;
  { int q = nwg / NXCD, r = nwg % NXCD, xcd = wgid % NXCD, off = wgid / NXCD;
    wgid = (xcd < r ? xcd * (q + 1) : r * (q + 1) + (xcd - r) * q) + off; }
  const int nig = WGM * nN, gid = wgid / nig, fm = gid * WGM, gsz = min(nM - fm, WGM);
  pm = fm + ((wgid % nig) % gsz); pn = (wgid % nig) / gsz;
}

struct EpiStoreBf16 {
  static constexpr bool GATE = false;
  static constexpr bool LDSST = true;
  u16* out; int ldo; const float* rss;
  __device__ __forceinline__ float row_scale(int row) const { return rss ? rsqrtf(rss[row] * (1.f / D) + EPS) : 1.f; }
  __device__ __forceinline__ float operator()(int row, int col, f32x4 v, float sc) const {
    uint2 pk = make_uint2(pack2(v[0] * sc, v[1] * sc), pack2(v[2] * sc, v[3] * sc));
    *(uint2*)(out + (size_t)row * ldo + col) = pk;
    return 0.f;
  }
  __device__ __forceinline__ void row_end(int, float, int) const {}
  __device__ __forceinline__ f32x4 finalize(int, int, f32x4 v, float sc, float&) const { return f32x4{v[0] * sc, v[1] * sc, v[2] * sc, v[3] * sc}; }
};
struct EpiAccum {
  static constexpr bool GATE = false;
  static constexpr bool LDSST = true;
  u16* out; float* rss; const float* rin32; static constexpr int ldo = D;
  __device__ __forceinline__ float row_scale(int) const { return 1.f; }
  __device__ __forceinline__ float operator()(int, int, f32x4, float) const { return 0.f; }
  __device__ __forceinline__ f32x4 finalize(int row, int col, f32x4 v, float, float& ss) const {
    float4 o;
    if (rin32) o = *(const float4*)(rin32 + (size_t)row * D + col);
    else { const uint2 r = *(const uint2*)(out + (size_t)row * D + col); o = make_float4(__uint_as_float(r.x << 16), __uint_as_float(r.x & 0xffff0000u), __uint_as_float(r.y << 16), __uint_as_float(r.y & 0xffff0000u)); }
    o.x += v[0]; o.y += v[1]; o.z += v[2]; o.w += v[3];
    if (rss) ss += o.x * o.x + o.y * o.y + o.z * o.z + o.w * o.w;
    return f32x4{o.x, o.y, o.z, o.w};
  }
  __device__ __forceinline__ void row_end(int row, float ss, int fq) const {
    if (rss) {
      ss += __shfl_xor(ss, 16, 64);
      ss += __shfl_xor(ss, 32, 64);
      if (fq == 0) unsafeAtomicAdd(rss + row, ss);
    }
  }
};

struct EpiGate {
  static constexpr bool GATE = true;
  static constexpr bool LDSST = false;
  const __attribute__((address_space(4))) void* kp; int layer; int rssoff;
  __device__ __forceinline__ float row_scale(int) const { return 1.f; }
  __device__ __forceinline__ float operator()(int, int, f32x4, float) const { return 0.f; }
  __device__ __forceinline__ void row_end(int, float, int) const {}
};

template <int M, int N, int K, int TAIL, class Epi>
__device__ __forceinline__ void gemm_phase(int wv, const u16* __restrict__ A, const u16* __restrict__ Bt, Epi epi, u16* shm) {
  const int tix = tidx(wv);
#define SA(b, h) (shm + ((b) * 2 + (h)) * HT)
#define SB(b, h) (shm + (4 + (b) * 2 + (h)) * HT)
#define STAGE(P, BASE, br, kt) do { const u16* _gb = BASE + ((long)(br) * K + (long)(kt0 + (kt)) * BK); \
    for (int _i = 0; _i < 2; ++_i) { int _b = tix * 16 + _i * 8192; \
      __builtin_amdgcn_global_load_lds((const unsigned*)(_gb + toff[_i]), \
        (__attribute__((address_space(3))) unsigned*)((char*)(P) + _b), 16, 0, 0); } } while (0)
#define LDA(dst, b, h) for (int m = 0; m < 4; ++m) for (int k = 0; k < 2; ++k) \
    dst[m][k] = *reinterpret_cast<const bf16x8*>((char*)SA(b, h) + lds_byte(wr * 64 + m * 16 + fr, k * 32 + fq * 8))
#define LDB(dst, b, h) for (int n = 0; n < 2; ++n) for (int k = 0; k < 2; ++k) \
    dst[n][k] = *reinterpret_cast<const bf16x8*>((char*)SB(b, h) + lds_byte(wc * 32 + n * 16 + fr, k * 32 + fq * 8))
#define MMA(ai, bj, At_, Bt_) do { __builtin_amdgcn_s_setprio(1); \
    for (int m = 0; m < 4; ++m) for (int n = 0; n < 2; ++n) for (int k = 0; k < 2; ++k) \
      acc[ai][bj][m][n] = __builtin_amdgcn_mfma_f32_16x16x32_bf16(Bt_[n][k], At_[m][k], acc[ai][bj][m][n], 0, 0, 0); \
    __builtin_amdgcn_s_setprio(0); } while (0)
#define WAIT_V(n) asm volatile("s_waitcnt vmcnt(" #n ")" ::: "memory")
#define WAIT_L(n) asm volatile("s_waitcnt lgkmcnt(" #n ")" ::: "memory")
#define BAR __builtin_amdgcn_s_barrier()
#define SCHED __builtin_amdgcn_sched_barrier(0)
  const int nM = M / BM, nN = N / BM, nwg = nM * nN, G = gridDim.x;
  const int nunits = nwg;
  const int wid = tix >> 6, lane = tix & 63, wr = wid >> 2, wc = wid & 3, fr = lane & 15, fq = lane >> 4;
  const int nt_total = K / BK;
  unsigned toff[2];
  for (int _i = 0; _i < 2; ++_i) { int _b = tix * 16 + _i * 8192; int _r, _c; stage_rc(_b, _r, _c); toff[_i] = (unsigned)(_r * K + _c); }
  for (int vw = blockIdx.x; vw < nunits; vw += G) {
    int pm, pn;
    tile_coords(vw, nM, nN, pm, pn);
    const int brow = pm * BM, bcol = pn * BM;
    constexpr int kt0 = 0, nt = nt_total;
    f32x4 acc[2][2][4][2];
    for (int a = 0; a < 2; ++a) for (int b = 0; b < 2; ++b) for (int m = 0; m < 4; ++m) for (int n = 0; n < 2; ++n) acc[a][b][m][n] = f32x4{0.f, 0.f, 0.f, 0.f};
    bf16x8 At[4][2], B0[2][2], B1[2][2];
    STAGE(SB(0, 0), Bt, bcol, 0); STAGE(SA(0, 0), A, brow, 0);
    STAGE(SB(0, 1), Bt, bcol + HALF, 0); STAGE(SA(0, 1), A, brow + HALF, 0);
    if (wr == 1) BAR;
    WAIT_V(4); BAR;
    STAGE(SB(1, 0), Bt, bcol, 1); STAGE(SA(1, 0), A, brow, 1); STAGE(SB(1, 1), Bt, bcol + HALF, 1);
    WAIT_V(6); BAR;
    for (int t = 0; t < nt - 2; t += 2) {
      LDB(B0, 0, 0); SCHED; LDA(At, 0, 0); STAGE(SA(1, 1), A, brow + HALF, t + 1);
      WAIT_L(8); BAR; WAIT_L(0); MMA(0, 0, At, B0); BAR; SCHED;
      LDB(B1, 0, 1); STAGE(SB(0, 0), Bt, bcol, t + 2);
      BAR; WAIT_L(0); MMA(0, 1, At, B1); BAR;
      LDA(At, 0, 1); STAGE(SA(0, 0), A, brow, t + 2);
      BAR; WAIT_L(0); MMA(1, 0, At, B0); BAR; SCHED;
      STAGE(SB(0, 1), Bt, bcol + HALF, t + 2);
      WAIT_V(6); BAR; MMA(1, 1, At, B1); BAR;
      LDB(B0, 1, 0); SCHED; LDA(At, 1, 0); STAGE(SA(0, 1), A, brow + HALF, t + 2);
      WAIT_L(8); BAR; WAIT_L(0); MMA(0, 0, At, B0); BAR; SCHED;
      LDB(B1, 1, 1); STAGE(SB(1, 0), Bt, bcol, t + 3);
      BAR; WAIT_L(0); MMA(0, 1, At, B1); BAR;
      LDA(At, 1, 1); STAGE(SA(1, 0), A, brow, t + 3);
      BAR; WAIT_L(0); MMA(1, 0, At, B0); BAR; SCHED;
      STAGE(SB(1, 1), Bt, bcol + HALF, t + 3);
      WAIT_V(6); BAR; MMA(1, 1, At, B1); BAR;
    }
    { LDB(B0, 0, 0); LDA(At, 0, 0); STAGE(SA(1, 1), A, brow + HALF, nt - 1);
      BAR; WAIT_L(0); MMA(0, 0, At, B0); BAR;
      LDB(B1, 0, 1); BAR; WAIT_L(0); MMA(0, 1, At, B1); BAR;
      LDA(At, 0, 1); WAIT_V(4); BAR; WAIT_L(0); MMA(1, 0, At, B0); MMA(1, 1, At, B1); BAR; }
    { LDB(B0, 1, 0); LDA(At, 1, 0); WAIT_V(2); BAR; WAIT_L(0); MMA(0, 0, At, B0); BAR;
      LDB(B1, 1, 1); WAIT_V(0); BAR; WAIT_L(0); MMA(0, 1, At, B1); BAR;
      LDA(At, 1, 1); BAR; WAIT_L(0); MMA(1, 0, At, B0); MMA(1, 1, At, B1); BAR; }
    if (wr == 0) BAR;
    if constexpr (Epi::GATE) {
      constexpr int LS = 136;
      u16* La = shm;
      u16* Lu = shm + 256 * LS;
      const __attribute__((address_space(4))) Params* gkp = (const __attribute__((address_space(4))) Params*)epi.kp;
      asm volatile("" : "+s"(gkp));
      int e_pm = pm, e_pn = pn, e_tix = tix;
      asm volatile("" : "+s"(e_pm), "+s"(e_pn));
      asm volatile("" : "+v"(e_tix));
      const int e_brow = e_pm * BM;
      {
        const int e_lane = e_tix & 63, e_wid = e_tix >> 6, e_wr = e_wid >> 2, e_wc = e_wid & 3, e_fr = e_lane & 15, e_fq = e_lane >> 4;
        const float* rss = (const float*)(gkp->ws + OFF_RSS) + epi.rssoff;
        _Pragma("unroll") for (int ai = 0; ai < 2; ++ai) _Pragma("unroll") for (int m = 0; m < 4; ++m) {
          const int rl = ai * HALF + e_wr * 64 + m * 16 + e_fr;
          const float sc = rsqrtf(rss[e_brow + rl] * (1.f / D) + EPS);
          _Pragma("unroll") for (int n = 0; n < 2; ++n) {
            const f32x4 a = acc[ai][0][m][n], uu = acc[ai][1][m][n];
            const int lo = rl * LS + e_wc * 32 + n * 16 + e_fq * 4;
            *(uint2*)(La + lo) = make_uint2(pack2_sw(a[0] * sc, a[1] * sc), pack2_sw(a[2] * sc, a[3] * sc));
            *(uint2*)(Lu + lo) = make_uint2(pack2_sw(uu[0] * sc, uu[1] * sc), pack2_sw(uu[2] * sc, uu[3] * sc));
          }
        }
      }
      WAIT_L(0); BAR; asm volatile("" ::: "memory");
      {
        const bool samp = e_brow >= MP;
        const int layer = epi.layer;
        u16* gg = (u16*)(gkp->ws + OFF_R);
        u16* side = (u16*)(gkp->ws + OFF_SIDE);
        const float* cw = gkp->in[19] + (size_t)layer * 3 * DFF;
        const float* cb = gkp->in[20] + (size_t)layer * DFF;
        const float* cache = gkp->in[5] + (size_t)layer * 8 * 2 * DFF;
        float* cvo = gkp->out + (samp ? O_CVS + (size_t)layer * 8 * 2 * DFF : O_CVP + (size_t)layer * 4 * 2 * DFF);
        const int cg = e_tix & 15, r0 = e_tix >> 4, c = e_pn * 128 + cg * 8;
        float w0[8], w1[8], w2[8], bb[8];
        _Pragma("unroll") for (int e = 0; e < 8; ++e) { w0[e] = cw[c + e]; w1[e] = cw[DFF + c + e]; w2[e] = cw[2 * DFF + c + e]; bb[e] = cb[c + e]; }
        _Pragma("unroll 1") for (int it = 0; it < 8; ++it) {
          const int rl = it * 32 + r0;
          const int t = samp ? (rl & 63) : ((e_pm & 7) * 256 + rl);
          const int sb = (e_pm - 32) * 4 + (rl >> 6);
          float a[8], uu[8], am1[8], am2[8], y[8];
          ld8(La + rl * LS + cg * 8, a);
          ld8(Lu + rl * LS + cg * 8, uu);
          _Pragma("unroll") for (int e = 0; e < 8; ++e) { am1[e] = 0.f; am2[e] = 0.f; }
          if (t >= 1 && rl >= 1) ld8(La + (rl - 1) * LS + cg * 8, am1);
          if (t >= 2 && rl >= 2) ld8(La + (rl - 2) * LS + cg * 8, am2);
          if (samp && t < 2) {
            const float* c1 = cache + (size_t)(sb * 2 + 1) * DFF + c;
            if (t == 0) {
              const float* c0 = cache + (size_t)(sb * 2 + 0) * DFF + c;
              _Pragma("unroll") for (int e = 0; e < 8; ++e) { am2[e] = c0[e]; am1[e] = c1[e]; }
            } else {
              _Pragma("unroll") for (int e = 0; e < 8; ++e) am2[e] = c1[e];
            }
          }
          if (!(t >= 2 && rl < 2)) {
            _Pragma("unroll") for (int e = 0; e < 8; ++e) { float cv = bb[e] + w0[e] * am2[e] + w1[e] * am1[e] + w2[e] * a[e]; y[e] = siluf_(cv) * uu[e]; }
            st8_sw(gg + (size_t)(e_brow + rl) * DFF + c, y);
          } else {
            st8_sw(side + (size_t)(e_pm * 2 + rl) * DFF + c, a);
            st8_sw(side + SZ_SIDE1 / 2 + (size_t)(e_pm * 2 + rl) * DFF + c, uu);
          }
          if (rl >= 254) st8_sw(side + SZ_SIDE1 + (size_t)(e_pm * 2 + rl - 254) * DFF + c, a);
          int crow = -1;
          if (!samp) { if ((e_pm & 7) == 7 && rl >= 254) crow = (e_pm >> 3) * 2 + rl - 254; }
          else { if ((rl & 63) >= 62) crow = sb * 2 + (rl & 63) - 62; }
          if (crow >= 0) {
            float* dst = cvo + (size_t)crow * DFF + c;
            *(float4*)dst = make_float4(a[0], a[1], a[2], a[3]);
            *(float4*)(dst + 4) = make_float4(a[4], a[5], a[6], a[7]);
          }
        }
      }
      WAIT_L(0); BAR; asm volatile("" ::: "memory");
    } else if constexpr (Epi::LDSST) {
      constexpr int LS = 136;
      u16* L0 = shm;
      u16* L1 = shm + 256 * LS;
      int e_brow = brow, e_bcol = bcol, e_tix = tix;
      asm volatile("" : "+s"(e_brow), "+s"(e_bcol));
      asm volatile("" : "+v"(e_tix));
      {
        const int e_lane = e_tix & 63, e_wid = e_tix >> 6, e_wr = e_wid >> 2, e_wc = e_wid & 3, e_fr = e_lane & 15, e_fq = e_lane >> 4;
        _Pragma("unroll") for (int ai = 0; ai < 2; ++ai) _Pragma("unroll") for (int m = 0; m < 4; ++m) {
          const int rl = ai * HALF + e_wr * 64 + m * 16 + e_fr;
          const float sc = epi.row_scale(e_brow + rl);
          float ss = 0.f;
          _Pragma("unroll") for (int n = 0; n < 2; ++n) {
            const int cl = e_wc * 32 + n * 16 + e_fq * 4;
            const f32x4 c0 = epi.finalize(e_brow + rl, e_bcol + cl, acc[ai][0][m][n], sc, ss);
            const f32x4 c1 = epi.finalize(e_brow + rl, e_bcol + 128 + cl, acc[ai][1][m][n], sc, ss);
            const int lo = rl * LS + cl;
            *(uint2*)(L0 + lo) = make_uint2(pack2(c0[0], c0[1]), pack2(c0[2], c0[3]));
            *(uint2*)(L1 + lo) = make_uint2(pack2(c1[0], c1[1]), pack2(c1[2], c1[3]));
          }
          epi.row_end(e_brow + rl, ss, e_fq);
          if (m & 1) asm volatile("" ::: "memory");
        }
      }
      WAIT_L(0); BAR; asm volatile("" ::: "memory");
      {
        const int cg = e_tix & 15, r0 = e_tix >> 4;
        _Pragma("unroll 1") for (int it = 0; it < 8; ++it) {
          const int rl = it * 32 + r0;
          const uint4 x0 = *(const uint4*)(L0 + rl * LS + cg * 8), x1 = *(const uint4*)(L1 + rl * LS + cg * 8);
          u16* dst = epi.out + (size_t)(e_brow + rl) * epi.ldo + e_bcol + cg * 8;
          *(uint4*)dst = x0;
          *(uint4*)(dst + 128) = x1;
        }
      }
      WAIT_L(0); BAR; asm volatile("" ::: "memory");
    } else {
    for (int ai = 0; ai < 2; ++ai) for (int m = 0; m < 4; ++m) {
      const int row = brow + ai * HALF + wr * 64 + m * 16 + fr;
      const float sc = epi.row_scale(row);
      float ss = 0.f;
      for (int bj = 0; bj < 2; ++bj) for (int n = 0; n < 2; ++n)
        ss += epi(row, bcol + bj * HALF + wc * 32 + n * 16 + fq * 4, acc[ai][bj][m][n], sc);
      epi.row_end(row, ss, fq);
      if (m & 1) asm volatile("" ::: "memory");
    }
    }
  }
#undef SA
#undef SB
#undef STAGE
#undef LDA
#undef LDB
#undef MMA
}


template <int K>
__device__ __forceinline__ void gemm_tail_phase(int wv, const u16* __restrict__ A, const u16* __restrict__ Bt, float* lds, u16* __restrict__ hb, float* __restrict__ rss, const float* __restrict__ rin32_tail) {
  const int tix = tidx(wv);
  const int tid = tix, w = tid >> 6, lane = tid & 63, fr = lane & 15, fq = lane >> 4;
  for (int u = blockIdx.x; u < 256; u += gridDim.x) {
    const int tm = u >> 5, tn = u & 31;
    const u16* Ab = A + (size_t)(MP + tm * 64 + fr) * K + fq * 8;
    const u16* Bb = Bt + (size_t)(tn * 64 + fr) * K + fq * 8;
    f32x4 acc[4][4];
#pragma unroll
    for (int i = 0; i < 4; ++i)
#pragma unroll
      for (int j = 0; j < 4; ++j) acc[i][j] = f32x4{0.f, 0.f, 0.f, 0.f};
    const u16* Ab2 = A + (size_t)(MP + tm * 64 + fr) * K + fq * 16;
    const u16* Bb2 = Bt + (size_t)(tn * 64 + fr) * K + fq * 16;
#pragma unroll 1
    for (int ks = w; ks < K / 64; ks += 8) {
      bf16x8 a[4][2], b[4][2];
#pragma unroll
      for (int i = 0; i < 4; ++i) {
        a[i][0] = *(const bf16x8*)(Ab2 + (size_t)i * 16 * K + ks * 64);
        a[i][1] = *(const bf16x8*)(Ab2 + (size_t)i * 16 * K + ks * 64 + 8);
        b[i][0] = *(const bf16x8*)(Bb2 + (size_t)i * 16 * K + ks * 64);
        b[i][1] = *(const bf16x8*)(Bb2 + (size_t)i * 16 * K + ks * 64 + 8);
      }
#pragma unroll
      for (int mb = 0; mb < 4; ++mb)
#pragma unroll
        for (int nb = 0; nb < 4; ++nb) {
          acc[mb][nb] = __builtin_amdgcn_mfma_f32_16x16x32_bf16(b[nb][0], a[mb][0], acc[mb][nb], 0, 0, 0);
          acc[mb][nb] = __builtin_amdgcn_mfma_f32_16x16x32_bf16(b[nb][1], a[mb][1], acc[mb][nb], 0, 0, 0);
        }
    }
    __syncthreads();
#pragma unroll
    for (int mb = 0; mb < 4; ++mb)
#pragma unroll
      for (int nb = 0; nb < 4; ++nb) *(f32x4*)(lds + w * 4096 + (mb * 16 + fr) * 64 + nb * 16 + fq * 4) = acc[mb][nb];
    __syncthreads();
    const int e = tid * 8, row = e >> 6, col = e & 63;
    float4 s0 = make_float4(0.f, 0.f, 0.f, 0.f), s1 = s0;
#pragma unroll
    for (int ww = 0; ww < 8; ++ww) {
      float4 x0 = *(const float4*)(lds + ww * 4096 + e), x1 = *(const float4*)(lds + ww * 4096 + e + 4);
      s0.x += x0.x; s0.y += x0.y; s0.z += x0.z; s0.w += x0.w;
      s1.x += x1.x; s1.y += x1.y; s1.z += x1.z; s1.w += x1.w;
    }
    const int grow = MP + tm * 64 + row;
    u16* q = hb + (size_t)grow * D + tn * 64 + col;
    float r8[8];
    if (rin32_tail) {
      const float* rq_ = rin32_tail + (size_t)(tm * 64 + row) * D + tn * 64 + col;
      const float4 a0 = *(const float4*)rq_, a1 = *(const float4*)(rq_ + 4);
      r8[0] = a0.x; r8[1] = a0.y; r8[2] = a0.z; r8[3] = a0.w; r8[4] = a1.x; r8[5] = a1.y; r8[6] = a1.z; r8[7] = a1.w;
    } else ld8(q, r8);
    r8[0] += s0.x; r8[1] += s0.y; r8[2] += s0.z; r8[3] += s0.w; r8[4] += s1.x; r8[5] += s1.y; r8[6] += s1.z; r8[7] += s1.w;
    st8(q, r8);
    if (rss) {
      float ss = 0.f;
#pragma unroll
      for (int e2 = 0; e2 < 8; ++e2) ss += r8[e2] * r8[e2];
      ss += __shfl_xor(ss, 1, 64); ss += __shfl_xor(ss, 2, 64); ss += __shfl_xor(ss, 4, 64);
      if ((tid & 7) == 0) unsafeAtomicAdd(rss + grow, ss);
    }
  }
}

template <int MODE>
__device__ __forceinline__ void prep_range(int wv, const Params& p, int u0, int u1, int ustride, unsigned char* shm) {
  const int tix = tidx(wv);
  constexpr int K = (MODE == 2) ? 256 : 128;
  constexpr int V = (MODE == 0) ? 256 : (MODE == 1 ? 128 : 512);
  constexpr int H = (MODE == 1) ? 8 : 4;
  constexpr int LD = (MODE == 2) ? NINO_PAD : NINE;
  constexpr int NSEG = 4, TL = 16, KS = K + 8, VS = V + 8, NPASS = K / 128;
  constexpr int NQ = K / 64, NV = V / 64;
  constexpr bool PFV = false;
  const int tid = tix, seg = tid >> 7;
  const u16* proj = (const u16*)(p.ws + OFF_BIG);
  unsigned char* R = p.ws + OFF_R;
  u16* qin = (u16*)(R + (MODE == 0 ? R_QA : MODE == 1 ? R_QB : R_QC));
  u16* koT = (u16*)(R + (MODE == 0 ? R_KA : MODE == 1 ? R_KB : R_KC));
  u16* vT = (u16*)(R + (MODE == 0 ? R_VA : MODE == 1 ? R_VB : R_VC));
  u16* Pm = (u16*)(R + (MODE == 0 ? R_PA : MODE == 1 ? R_PB : R_PC));
  float* dL = (float*)(R + (MODE == 0 ? R_DA : MODE == 1 ? R_DB : R_DC));
  u16* qs = (u16*)shm;
  u16* ksm = qs + 64 * KS;
  float* segtot = (float*)(ksm + 64 * KS);
  float* gl = segtot + NSEG * K;
  u16* rq = (u16*)(gl + 64 * 16);
  u16* rk = rq + 64 * KS;
  u16* rv = PFV ? rk + 64 * KS : rq;
  typedef __attribute__((ext_vector_type(4))) unsigned u32x4_t;
  u32x4_t rqr[NQ], rkr[NQ], rvr[PFV ? NV : 1];
#define PREP_ISSUE(uu_) do { \
    const int c_i = (uu_) / H, h_i = (uu_) % H; \
    const int row0_i = (c_i < 128) ? (c_i >> 5) * 2048 + (c_i & 31) * 64 : MP + (c_i - 128) * 64; \
    const u16* prow_i = proj + (size_t)row0_i * LD; \
    const int cq_i = (MODE == 0) ? h_i * 128 : (MODE == 1 ? 3072 + h_i * 128 : h_i * 256); \
    const int ck_i = (MODE == 0) ? 512 + h_i * 128 : (MODE == 1 ? 4096 + h_i * 128 : 1024 + h_i * 256); \
    const int vc_i = (MODE == 0) ? 1024 + h_i * 256 : (MODE == 1 ? 5120 + h_i * 128 : 2048 + h_i * 512); \
    _Pragma("unroll") for (int i = 0; i < NQ; ++i) { \
      const int idx = tid + i * 512, r = idx / (K / 8), cc = idx % (K / 8); \
      rqr[i] = *(const u32x4_t*)(prow_i + (size_t)r * LD + cq_i + cc * 8); \
      rkr[i] = *(const u32x4_t*)(prow_i + (size_t)r * LD + ck_i + cc * 8); \
    } \
    if constexpr (PFV) { \
      _Pragma("unroll") for (int i = 0; i < NV; ++i) { \
        const int idx = tid + i * 512, r = idx / (V / 8), cc = idx % (V / 8); \
        rvr[i] = *(const u32x4_t*)(prow_i + (size_t)r * LD + vc_i + cc * 8); \
      } \
    } } while (0)
  if (u0 < u1) PREP_ISSUE(u0);
#pragma unroll 1
  for (int uu = u0; uu < u1; uu += ustride) {
  const int c = uu / H, h = uu % H;
  int row0, pos0;
  if (c < 128) { row0 = (c >> 5) * 2048 + (c & 31) * 64; pos0 = (c & 31) * 64; }
  else { row0 = MP + (c - 128) * 64; pos0 = 1024; }
  const size_t u = (size_t)c * H + h;
  const u16* prow = proj + (size_t)row0 * LD;
  const int vc0 = (MODE == 0) ? 1024 + h * 256 : (MODE == 1 ? 5120 + h * 128 : 2048 + h * 512);
  __syncthreads();
#pragma unroll
  for (int i = 0; i < NQ; ++i) {
    const int idx = tid + i * 512, r = idx / (K / 8), cc = idx % (K / 8);
    *(u32x4_t*)(rq + r * KS + cc * 8) = rqr[i];
    *(u32x4_t*)(rk + r * KS + cc * 8) = rkr[i];
  }
  if constexpr (PFV) {
#pragma unroll
    for (int i = 0; i < NV; ++i) {
      const int idx = tid + i * 512, r = idx / (V / 8), cc = idx % (V / 8);
      *(u32x4_t*)(rv + r * VS + cc * 8) = rvr[i];
    }
  }
  if (MODE == 2) {
    for (int i = tid; i < 64 * 2; i += 512) {
      const int r = i >> 1, hh = i & 1;
      uint4 g4 = *(const uint4*)(prow + (size_t)r * LD + 6144 + hh * 8);
      float* d = gl + r * 16 + hh * 8;
      d[0] = __uint_as_float(g4.x << 16); d[1] = __uint_as_float(g4.x & 0xffff0000u);
      d[2] = __uint_as_float(g4.y << 16); d[3] = __uint_as_float(g4.y & 0xffff0000u);
      d[4] = __uint_as_float(g4.z << 16); d[5] = __uint_as_float(g4.z & 0xffff0000u);
      d[6] = __uint_as_float(g4.w << 16); d[7] = __uint_as_float(g4.w & 0xffff0000u);
    }
  }
  if (uu + ustride < u1) PREP_ISSUE(uu + ustride);
  __builtin_amdgcn_sched_barrier(0);
  __syncthreads();
#pragma unroll 1
  for (int pass = 0; pass < NPASS; ++pass) {
  const int kk = pass * 128 + (tid & 127);
  float qv[TL], kv[TL], bc[TL];
  if (MODE == 0) {
    const int j = kk & 63;
    const float invr = exp2f(-(float)j * (13.287712379549449f / 64.f)) * 0.15915494309189535f;
    const float lgam = log1pf(-exp2f(-5.f - (float)h));
#pragma unroll
    for (int i = 0; i < TL; ++i) {
      const int l = seg * TL + i;
      float rev = (float)(pos0 + l) * invr;
      rev -= floorf(rev);
      const float sn = __builtin_amdgcn_sinf(rev), cs = __builtin_amdgcn_cosf(rev);
      const float q1 = bf2f(rq[l * KS + j]), q2 = bf2f(rq[l * KS + j + 64]), k1 = bf2f(rk[l * KS + j]), k2 = bf2f(rk[l * KS + j + 64]);
      const float qr = (kk < 64) ? q1 * cs - q2 * sn : q1 * sn + q2 * cs;
      const float kr = (kk < 64) ? k1 * cs - k2 * sn : k1 * sn + k2 * cs;
      qv[i] = qr; kv[i] = kr * 0.08838834764831845f;
      bc[i] = lgam;
    }
  } else if (MODE == 1) {
    const int ch = h * 128 + kk;
    const float* lbp = p.in[11];
    float e0 = __expf(lbp[ch]), e1 = __expf(lbp[1024 + ch]), e2 = __expf(lbp[2048 + ch]);
    const float lb = e0 / (e0 + e1 + e2);
#pragma unroll
    for (int i = 0; i < TL; ++i) {
      const int l = seg * TL + i;
      const float qx = bf2f(rq[l * KS + kk]), fx = bf2f(rk[l * KS + kk]);
      qv[i] = siluf_(qx) * 0.08838834764831845f;
      const float sg = sigmoidf_(fx);
      const float f = lb + (1.f - lb) * sg;
      kv[i] = (1.f - lb) * (1.f - sg);
      bc[i] = __logf(f);
    }
  } else {
    const int ch = h * 256 + kk;
    const float* w2 = p.in[14];
    float wvv[16];
#pragma unroll
    for (int r = 0; r < 16; ++r) wvv[r] = w2[r * 1024 + ch];
    const float bias = p.in[15][ch];
#pragma unroll
    for (int i = 0; i < TL; ++i) {
      const int l = seg * TL + i;
      qv[i] = bf2f(rq[l * KS + kk]) * 0.0625f;
      kv[i] = bf2f(rk[l * KS + kk]);
      float x = bias;
#pragma unroll
      for (int r = 0; r < 16; ++r) x += gl[l * 16 + r] * wvv[r];
      const float ls = fminf(x, 0.f) - log1pf(__expf(-fabsf(x)));
      bc[i] = ls * (1.f / 16.f);
    }
  }
#pragma unroll
  for (int i = 1; i < TL; ++i) bc[i] += bc[i - 1];
  segtot[seg * K + kk] = bc[TL - 1];
  __syncthreads();
  float pre = 0.f, bL = 0.f;
#pragma unroll
  for (int sg = 0; sg < NSEG; ++sg) { float t = segtot[sg * K + kk]; bL += t; if (sg < seg) pre += t; }
  if (seg == 0) dL[u * K + kk] = __expf(bL);
  unsigned kop[TL / 2];
#pragma unroll
  for (int i = 0; i < TL; i += 2) {
    float ko2[2];
#pragma unroll
    for (int e = 0; e < 2; ++e) {
      const int l = seg * TL + i + e;
      const float b = bc[i + e] + pre;
      const float qi = qv[i + e] * __expf(b);
      const float ki = kv[i + e] * __expf(-b);
      ko2[e] = kv[i + e] * __expf(bL - b);
      const u16 qb = f2bf(qi);
      qs[l * KS + kk] = qb;
      ksm[l * KS + kk] = f2bf(ki);
    }
    kop[i / 2] = pack2(ko2[0], ko2[1]);
  }
  {
#pragma unroll
    for (int i = 0; i < TL / 8; ++i) {
      const int cc = seg * 2 + i;
      uint4* dst = (uint4*)(koT + u * K * 64 + ((((kk >> 4) * 2 + (cc >> 2)) * 64 + (cc & 3) * 16 + (kk & 15)) << 3));
      *dst = make_uint4(kop[i * 4 + 0], kop[i * 4 + 1], kop[i * 4 + 2], kop[i * 4 + 3]);
    }
  }
  }
  __syncthreads();
  for (int i = tid; i < 64 * (K / 8); i += 512) {
    const int r = i / (K / 8), cc = i % (K / 8);
    *(uint4*)(qin + u * 64 * K + ((((r >> 4) * (K / 32) + (cc >> 2)) * 64 + (cc & 3) * 16 + (r & 15)) << 3)) = *(const uint4*)(qs + r * KS + cc * 8);
  }
  {
    const int w = tid >> 6, lane = tid & 63, fr = lane & 15, fq = lane >> 4;
#pragma unroll 1
    for (int bi = 0; bi < 2; ++bi) {
      const int blk = w + bi * 8, lb = blk >> 2, sb = blk & 3;
      f32x4 acc = {0.f, 0.f, 0.f, 0.f};
      if (sb <= lb) {
#pragma unroll
        for (int kst = 0; kst < K / 32; ++kst) {
          bf16x8 a = *(const bf16x8*)(ksm + (sb * 16 + fr) * KS + kst * 32 + fq * 8);
          bf16x8 b = *(const bf16x8*)(qs + (lb * 16 + fr) * KS + kst * 32 + fq * 8);
          acc = __builtin_amdgcn_mfma_f32_16x16x32_bf16(a, b, acc, 0, 0, 0);
        }
      }
      const int l = lb * 16 + fr, s0 = sb * 16 + fq * 4;
      float v0 = (s0 + 0 <= l) ? acc[0] : 0.f, v1 = (s0 + 1 <= l) ? acc[1] : 0.f;
      float v2 = (s0 + 2 <= l) ? acc[2] : 0.f, v3 = (s0 + 3 <= l) ? acc[3] : 0.f;
      if (lb >= 2 || sb < 2) *(uint2*)(Pm + u * 4096 + ((((lb * 2 + (s0 >> 5)) * 64 + ((s0 & 31) >> 3) * 16 + fr) << 3) + (s0 & 7))) = make_uint2(pack2(v0, v1), pack2(v2, v3));
    }
  }
  }
}

template <int K, int V>
__device__ __forceinline__ void seq_unit(int wv, const u16* __restrict__ qin, const u16* __restrict__ koT, const u16* __restrict__ Pm, const u16* __restrict__ vsrc, int vld,
                         const float* __restrict__ dL, int H, int c0, int nch, int h, int vs,
                         const float* __restrict__ s0, float* __restrict__ sout, u16* __restrict__ o, int row0, int ocol, unsigned char* shm) {
  const int tix = tidx(wv);
  constexpr int NKB = K / 128, SST = K + 8;
  u16* ST = (u16*)shm;
  const int tid = tix, w = tid >> 6, lane = tid & 63, fr = lane & 15, fq = lane >> 4;
  f32x4 accS[NKB][2];
  __syncthreads();
#pragma unroll
  for (int kb = 0; kb < NKB; ++kb)
#pragma unroll
    for (int vb = 0; vb < 2; ++vb) {
      const int k = (w * NKB + kb) * 16 + fq * 4, vcol = vb * 16 + fr;
#pragma unroll
      for (int j = 0; j < 4; ++j) accS[kb][vb][j] = s0 ? s0[(size_t)(k + j) * V + vs * 32 + vcol] : 0.f;
      *(uint2*)(ST + vcol * SST + k) = make_uint2(pack2(accS[kb][vb][0], accS[kb][vb][1]), pack2(accS[kb][vb][2], accS[kb][vb][3]));
    }
  constexpr int VTS = 72, LOS = 40;
  u16* VT = ST + 2 * 32 * SST;
  u16* LO = VT + 2 * 32 * VTS;
  const int v_s = (tid >> 2) & 63, v_p = tid & 3;
  const u16* vrow = vsrc + (size_t)v_s * vld + v_p * 8;
  u32x4_t vreg = {0u, 0u, 0u, 0u};
  if (tid < 256) {
    vreg = *(const u32x4_t*)vrow;
#pragma unroll
    for (int j = 0; j < 4; ++j) {
      VT[(v_p * 8 + 2 * j) * VTS + v_s] = (u16)(vreg[j] & 0xffffu);
      VT[(v_p * 8 + 2 * j + 1) * VTS + v_s] = (u16)(vreg[j] >> 16);
    }
  }
  __syncthreads();
  int cur = 0;
  const int lb = w >> 1, ovb = w & 1;
  struct FragsO { bf16x8 op[2], oq[K / 32]; };
  struct FragsS { bf16x8 ka[NKB][2]; float4 d[NKB]; };
  auto load_o = [&](int ci, FragsO& f) {
    const size_t u = (size_t)(c0 + ci) * H + h;
    const u16* Pu = Pm + u * 4096;
    const u16* qu = qin + u * 64 * K;
#pragma unroll
    for (int ss = 0; ss < 2; ++ss) { if (ss == 0 || lb >= 2) f.op[ss] = *(const bf16x8*)(Pu + (((lb * 2 + ss) * 64 + lane) << 3)); else f.op[ss] = bf16x8{0, 0, 0, 0, 0, 0, 0, 0}; }
#pragma unroll
    for (int kst = 0; kst < K / 32; ++kst) f.oq[kst] = *(const bf16x8*)(qu + (((lb * (K / 32) + kst) * 64 + lane) << 3));
  };
  auto load_s = [&](int ci, FragsS& f) {
    const size_t u = (size_t)(c0 + ci) * H + h;
    const u16* ku = koT + u * K * 64;
    const float* du = dL + u * K;
#pragma unroll
    for (int kb = 0; kb < NKB; ++kb) {
      const int kbase = (w * NKB + kb) * 16;
      f.d[kb] = *(const float4*)(du + kbase + fq * 4);
      f.ka[kb][0] = *(const bf16x8*)(ku + ((((w * NKB + kb) * 2 + 0) * 64 + lane) << 3));
      f.ka[kb][1] = *(const bf16x8*)(ku + ((((w * NKB + kb) * 2 + 1) * 64 + lane) << 3));
    }
  };
  FragsO fo;
  FragsS f0;
  load_o(0, fo);
  load_s(0, f0);
  for (int ci = 0; ci < nch; ++ci) {
    const int cn = ci + 1 < nch ? ci + 1 : ci;
    FragsO fo1;
    FragsS f1;
    load_o(cn, fo1);
    load_s(cn, f1);
    if (tid < 256) vreg = *(const u32x4_t*)(vrow + (size_t)cn * 64 * vld);
    __builtin_amdgcn_sched_barrier(0);
    const u16* STc = ST + cur * 32 * SST;
    u16* STn = ST + (cur ^ 1) * 32 * SST;
    const u16* VTc = VT + cur * 32 * VTS;
    u16* VTn = VT + (cur ^ 1) * 32 * VTS;
    bf16x8 vf[2][2];
#pragma unroll
    for (int vb = 0; vb < 2; ++vb)
#pragma unroll
      for (int ss = 0; ss < 2; ++ss) vf[vb][ss] = *(const bf16x8*)(VTc + (vb * 16 + fr) * VTS + ss * 32 + fq * 8);
    if (ci > 0 && tid < 256) {
      const uint4 ov = *(const uint4*)(LO + ((ci - 1) & 1) * 64 * LOS + v_s * LOS + v_p * 8);
      *(uint4*)(o + (size_t)(row0 + (ci - 1) * 64 + v_s) * D + ocol + vs * 32 + v_p * 8) = ov;
    }
    f32x4 ao = {0.f, 0.f, 0.f, 0.f};
#pragma unroll
    for (int ss = 0; ss < 2; ++ss) {
      if (ss == 0 || lb >= 2) {
        bf16x8 a = *(const bf16x8*)(VTc + (ovb * 16 + fr) * VTS + ss * 32 + fq * 8);
        ao = __builtin_amdgcn_mfma_f32_16x16x32_bf16(a, fo.op[ss], ao, 0, 0, 0);
      }
    }
#pragma unroll
    for (int kst = 0; kst < K / 32; ++kst) {
      bf16x8 a = *(const bf16x8*)(STc + (ovb * 16 + fr) * SST + kst * 32 + fq * 8);
      ao = __builtin_amdgcn_mfma_f32_16x16x32_bf16(a, fo.oq[kst], ao, 0, 0, 0);
    }
    *(uint2*)(LO + (ci & 1) * 64 * LOS + (lb * 16 + fr) * LOS + ovb * 16 + fq * 4) = make_uint2(pack2(ao[0], ao[1]), pack2(ao[2], ao[3]));
#pragma unroll
    for (int kb = 0; kb < NKB; ++kb) {
      const int kbase = (w * NKB + kb) * 16;
      const float4 d4 = f0.d[kb];
#pragma unroll
      for (int vb = 0; vb < 2; ++vb) {
        f32x4 sv = accS[kb][vb];
        sv[0] *= d4.x; sv[1] *= d4.y; sv[2] *= d4.z; sv[3] *= d4.w;
        sv = __builtin_amdgcn_mfma_f32_16x16x32_bf16(f0.ka[kb][0], vf[vb][0], sv, 0, 0, 0);
        sv = __builtin_amdgcn_mfma_f32_16x16x32_bf16(f0.ka[kb][1], vf[vb][1], sv, 0, 0, 0);
        accS[kb][vb] = sv;
        *(uint2*)(STn + (vb * 16 + fr) * SST + kbase + fq * 4) = make_uint2(pack2(sv[0], sv[1]), pack2(sv[2], sv[3]));
      }
    }
    if (tid < 256) {
#pragma unroll
      for (int j = 0; j < 4; ++j) {
        VTn[(v_p * 8 + 2 * j) * VTS + v_s] = (u16)(vreg[j] & 0xffffu);
        VTn[(v_p * 8 + 2 * j + 1) * VTS + v_s] = (u16)(vreg[j] >> 16);
      }
    }
    asm volatile("s_waitcnt lgkmcnt(0)" ::: "memory");
    __builtin_amdgcn_s_barrier();
    asm volatile("" ::: "memory");
    cur ^= 1;
    f0 = f1;
    fo = fo1;
  }
  if (tid < 256) {
    const uint4 ov = *(const uint4*)(LO + ((nch - 1) & 1) * 64 * LOS + v_s * LOS + v_p * 8);
    *(uint4*)(o + (size_t)(row0 + (nch - 1) * 64 + v_s) * D + ocol + vs * 32 + v_p * 8) = ov;
  }
#pragma unroll
  for (int kb = 0; kb < NKB; ++kb)
#pragma unroll
    for (int vb = 0; vb < 2; ++vb) {
      const int k = (w * NKB + kb) * 16 + fq * 4, vcol = vb * 16 + fr;
#pragma unroll
      for (int j = 0; j < 4; ++j) sout[(size_t)(k + j) * V + vs * 32 + vcol] = accS[kb][vb][j];
    }
}

__device__ __forceinline__ void seq_even_phase(int wv, const Params& p, unsigned char* shm) {
  unsigned char* R = p.ws + OFF_R;
  u16* o = (u16*)(p.ws + OFF_H);
  for (int u = blockIdx.x; u < 768; u += gridDim.x) {
    if (u < 256) {
      const int x = u & 7, y = u >> 3;
      if (y < 16) {
        const int g = x * 2 + (y >> 3), b = g >> 2, h = g & 3, vs = y & 7;
        seq_unit<128, 256>(wv, (u16*)(R + R_QA), (u16*)(R + R_KA), (u16*)(R + R_PA), (const u16*)(p.ws + OFF_BIG) + (size_t)(b * 2048) * NINE + 1024 + h * 256 + vs * 32, NINE, (float*)(R + R_DA), 4, b * 32, 32, h, vs,
                           nullptr, p.out + O_RETP + (size_t)(b * 4 + h) * 128 * 256, o, b * 2048, h * 256, shm);
      } else {
        const int yy = y - 16, g = x * 4 + (yy >> 2), b = g >> 3, h = g & 7, vs = yy & 3;
        seq_unit<128, 128>(wv, (u16*)(R + R_QB), (u16*)(R + R_KB), (u16*)(R + R_PB), (const u16*)(p.ws + OFF_BIG) + (size_t)(b * 2048) * NINE + 5120 + h * 128 + vs * 32, NINE, (float*)(R + R_DB), 8, b * 32, 32, h, vs,
                           nullptr, p.out + O_HGP + (size_t)(b * 8 + h) * 128 * 128, o, b * 2048, 1024 + h * 128, shm);
      }
    } else if (u < 512) {
      int x = u - 256, b = x >> 5, h = (x >> 3) & 3, vs = x & 7;
      seq_unit<128, 256>(wv, (u16*)(R + R_QA), (u16*)(R + R_KA), (u16*)(R + R_PA), (const u16*)(p.ws + OFF_BIG) + (size_t)(MP + b * 64) * NINE + 1024 + h * 256 + vs * 32, NINE, (float*)(R + R_DA), 4, 128 + b, 1, h, vs,
                         p.in[2] + (size_t)(b * 4 + h) * 128 * 256, p.out + O_RETS + (size_t)(b * 4 + h) * 128 * 256, o, MP + b * 64, h * 256, shm);
    } else {
      int x = u - 512, b = x >> 5, h = (x >> 2) & 7, vs = x & 3;
      seq_unit<128, 128>(wv, (u16*)(R + R_QB), (u16*)(R + R_KB), (u16*)(R + R_PB), (const u16*)(p.ws + OFF_BIG) + (size_t)(MP + b * 64) * NINE + 5120 + h * 128 + vs * 32, NINE, (float*)(R + R_DB), 8, 128 + b, 1, h, vs,
                         p.in[3] + (size_t)(b * 8 + h) * 128 * 128, p.out + O_HGS + (size_t)(b * 8 + h) * 128 * 128, o, MP + b * 64, 1024 + h * 128, shm);
    }
  }
}
__device__ __forceinline__ void seq_odd_phase(int wv, const Params& p, unsigned char* shm) {
  unsigned char* R = p.ws + OFF_R;
  u16* o = (u16*)(p.ws + OFF_H);
  for (int u = blockIdx.x; u < 768; u += gridDim.x) {
    if (u < 256) {
      const int x = u & 7, y = u >> 3, g = x * 2 + (y >> 4), b = g >> 2, h = g & 3, vs = y & 15;
      seq_unit<256, 512>(wv, (u16*)(R + R_QC), (u16*)(R + R_KC), (u16*)(R + R_PC), (const u16*)(p.ws + OFF_BIG) + (size_t)(b * 2048) * NINO_PAD + 2048 + h * 512 + vs * 32, NINO_PAD, (float*)(R + R_DC), 4, b * 32, 32, h, vs,
                         nullptr, p.out + O_GLP + (size_t)(b * 4 + h) * 256 * 512, o, b * 2048, h * 512, shm);
    } else {
      int x = u - 256, b = x >> 6, h = (x >> 4) & 3, vs = x & 15;
      seq_unit<256, 512>(wv, (u16*)(R + R_QC), (u16*)(R + R_KC), (u16*)(R + R_PC), (const u16*)(p.ws + OFF_BIG) + (size_t)(MP + b * 64) * NINO_PAD + 2048 + h * 512 + vs * 32, NINO_PAD, (float*)(R + R_DC), 4, 128 + b, 1, h, vs,
                         p.in[4] + (size_t)(b * 4 + h) * 256 * 512, p.out + O_GLS + (size_t)(b * 4 + h) * 256 * 512, o, MP + b * 64, h * 512, shm);
    }
  }
}

__device__ __forceinline__ void up8(u32x4_t v, float* f) {
  f[0] = __uint_as_float(v[0] << 16); f[1] = __uint_as_float(v[0] & 0xffff0000u);
  f[2] = __uint_as_float(v[1] << 16); f[3] = __uint_as_float(v[1] & 0xffff0000u);
  f[4] = __uint_as_float(v[2] << 16); f[5] = __uint_as_float(v[2] & 0xffff0000u);
  f[6] = __uint_as_float(v[3] << 16); f[7] = __uint_as_float(v[3] & 0xffff0000u);
}
template <int ODD>
__device__ __forceinline__ void post_phase(int wv, const Params& p) {
  const int tix = tidx(wv);
  const int lane = tix & 63, gw = blockIdx.x * 8 + (tix >> 6), nw = gridDim.x * 8;
  const u16* o = (const u16*)(p.ws + OFF_H);
  const u16* proj = (const u16*)(p.ws + OFF_BIG);
  u16* ao = (u16*)(p.ws + OFF_R);
#define POST_LOAD(xr_, gr_, row_) do { const int r_ = (row_); \
    _Pragma("unroll") for (int i = 0; i < 4; ++i) { const int col_ = i * 512 + lane * 8; \
      xr_[i] = *(const u32x4_t*)(o + (size_t)r_ * D + col_); \
      gr_[i] = *(const u32x4_t*)(proj + (size_t)r_ * (ODD ? NINO_PAD : NINE) + (ODD ? 4096 + col_ : (i < 2 ? 2048 + col_ : 6144 + (col_ - 1024)))); } } while (0)
  u32x4_t xr[4], gr[4];
  if (gw < MT) POST_LOAD(xr, gr, gw);
#pragma unroll 1
  for (int row = gw; row < MT; row += nw) {
    u32x4_t xn[4], gn4[4];
    if (row + nw < MT) POST_LOAD(xn, gn4, row + nw);
    else {
#pragma unroll
      for (int i = 0; i < 4; ++i) { xn[i] = xr[i]; gn4[i] = gr[i]; }
    }
    __builtin_amdgcn_sched_barrier(0);
#pragma unroll
    for (int i = 0; i < 4; ++i) {
      const int col = i * 512 + lane * 8;
      float x[8], g[8], y[8];
      up8(xr[i], x);
      up8(gr[i], g);
      if (ODD) {
        float ss = 0.f;
#pragma unroll
        for (int e = 0; e < 8; ++e) ss += x[e] * x[e];
#pragma unroll
        for (int off = 32; off > 0; off >>= 1) ss += __shfl_xor(ss, off, 64);
        const float rs = rsqrtf(ss * (1.f / 512.f) + EPS);
        const float* gn = p.in[16] + lane * 8;
#pragma unroll
        for (int e = 0; e < 8; ++e) y[e] = x[e] * rs * gn[e] * siluf_(g[e]);
      } else if (i < 2) {
        float s1 = 0.f;
#pragma unroll
        for (int e = 0; e < 8; ++e) s1 += x[e];
#pragma unroll
        for (int off = 16; off > 0; off >>= 1) s1 += __shfl_xor(s1, off, 64);
        const float mu = s1 * (1.f / 256.f);
        float s2 = 0.f;
#pragma unroll
        for (int e = 0; e < 8; ++e) { float dlt = x[e] - mu; s2 += dlt * dlt; }
#pragma unroll
        for (int off = 16; off > 0; off >>= 1) s2 += __shfl_xor(s2, off, 64);
        const float rs = rsqrtf(s2 * (1.f / 256.f) + EPS);
#pragma unroll
        for (int e = 0; e < 8; ++e) y[e] = (x[e] - mu) * rs * siluf_(g[e]);
      } else {
        float ss = 0.f;
#pragma unroll
        for (int e = 0; e < 8; ++e) ss += x[e] * x[e];
#pragma unroll
        for (int off = 8; off > 0; off >>= 1) ss += __shfl_xor(ss, off, 64);
        const float rs = rsqrtf(ss * (1.f / 128.f) + EPS);
        const float* gn = p.in[12] + (lane & 15) * 8;
#pragma unroll
        for (int e = 0; e < 8; ++e) y[e] = x[e] * rs * gn[e] * siluf_(g[e]);
      }
      st8(ao + (size_t)row * D + col, y);
    }
#pragma unroll
    for (int i = 0; i < 4; ++i) { xr[i] = xn[i]; gr[i] = gn4[i]; }
  }
#undef POST_LOAD
}


__device__ __forceinline__ void final_norm_phase(int wv, const Params& p) {
  const int tix = tidx(wv);
  const int lane = tix & 63, gw = blockIdx.x * 8 + (tix >> 6), nw = gridDim.x * 8;
  const u16* hb = (const u16*)(p.ws + OFF_HN);
  const float* w = p.in[8];
  u32x4_t v[4];
  if (gw < MT) {
#pragma unroll
    for (int i = 0; i < 4; ++i) v[i] = *(const u32x4_t*)(hb + (size_t)gw * D + i * 512 + lane * 8);
  }
#pragma unroll 1
  for (int row = gw; row < MT; row += nw) {
    u32x4_t nx[4];
    const int nrow = row + nw < MT ? row + nw : row;
#pragma unroll
    for (int i = 0; i < 4; ++i) nx[i] = *(const u32x4_t*)(hb + (size_t)nrow * D + i * 512 + lane * 8);
    __builtin_amdgcn_sched_barrier(0);
    float x[4][8];
    float ss = 0.f;
#pragma unroll
    for (int i = 0; i < 4; ++i) {
      up8(v[i], x[i]);
#pragma unroll
      for (int e = 0; e < 8; ++e) ss += x[i][e] * x[i][e];
    }
#pragma unroll
    for (int o = 32; o > 0; o >>= 1) ss += __shfl_xor(ss, o, 64);
    const float rs = rsqrtf(ss * (1.f / D) + EPS);
    float* dst = (row < MP) ? p.out + O_YP + (size_t)row * D : p.out + O_YS + (size_t)(row - MP) * D;
#pragma unroll
    for (int i = 0; i < 4; ++i) {
      const int col = i * 512 + lane * 8;
      const float4 w0 = *(const float4*)(w + col), w1 = *(const float4*)(w + col + 4);
      *(float4*)(dst + col) = make_float4(x[i][0] * rs * w0.x, x[i][1] * rs * w0.y, x[i][2] * rs * w0.z, x[i][3] * rs * w0.w);
      *(float4*)(dst + col + 4) = make_float4(x[i][4] * rs * w1.x, x[i][5] * rs * w1.y, x[i][6] * rs * w1.z, x[i][7] * rs * w1.w);
    }
#pragma unroll
    for (int i = 0; i < 4; ++i) v[i] = nx[i];
  }
}

__device__ __forceinline__ void gate_phase(int wv, const Params& p, int layer) {
  const int tix = tidx(wv);
  const u16* au = (const u16*)(p.ws + OFF_BIG);
  u16* gg = (u16*)(p.ws + OFF_R);
  const float* cw = p.in[19] + (size_t)layer * 3 * DFF;
  const float* cb = p.in[20] + (size_t)layer * DFF;
  const float* cache = p.in[5] + (size_t)layer * 8 * 2 * DFF;
  const int nitems = (MT / 16) * (DFF / 8);
  for (int it = blockIdx.x * 512 + tix; it < nitems; it += gridDim.x * 512) {
    const int cg8 = it % (DFF / 8), rb = it / (DFF / 8), c0 = cg8 * 8, r0 = rb * 16;
    float w0[8], w1[8], w2[8], bb[8], am2[8], am1[8];
#pragma unroll
    for (int e = 0; e < 8; ++e) { w0[e] = cw[c0 + e]; w1[e] = cw[DFF + c0 + e]; w2[e] = cw[2 * DFF + c0 + e]; bb[e] = cb[c0 + e]; }
    int t0, T, b; bool samp = r0 >= MP;
    if (!samp) { b = r0 >> 11; t0 = r0 & 2047; T = 2048; } else { b = (r0 - MP) >> 6; t0 = (r0 - MP) & 63; T = 64; }
    if (t0 == 0) {
      if (samp) {
#pragma unroll
        for (int e = 0; e < 8; ++e) { am2[e] = cache[(size_t)(b * 2 + 0) * DFF + c0 + e]; am1[e] = cache[(size_t)(b * 2 + 1) * DFF + c0 + e]; }
      } else {
#pragma unroll
        for (int e = 0; e < 8; ++e) { am2[e] = 0.f; am1[e] = 0.f; }
      }
    } else {
      ld8(au + (size_t)(r0 - 2) * NUP + c0, am2);
      ld8(au + (size_t)(r0 - 1) * NUP + c0, am1);
    }
#pragma unroll 4
    for (int i = 0; i < 16; ++i) {
      float a[8], uu[8], y[8];
      ld8(au + (size_t)(r0 + i) * NUP + c0, a);
      ld8(au + (size_t)(r0 + i) * NUP + DFF + c0, uu);
#pragma unroll
      for (int e = 0; e < 8; ++e) {
        float cv = bb[e] + w0[e] * am2[e] + w1[e] * am1[e] + w2[e] * a[e];
        y[e] = siluf_(cv) * uu[e];
        am2[e] = am1[e]; am1[e] = a[e];
      }
      st8(gg + (size_t)(r0 + i) * DFF + c0, y);
    }
    if (t0 + 16 == T) {
      float* dst = samp ? p.out + O_CVS + (size_t)(layer * 8 + b) * 2 * DFF : p.out + O_CVP + (size_t)(layer * 4 + b) * 2 * DFF;
#pragma unroll
      for (int e = 0; e < 8; ++e) { dst[c0 + e] = am2[e]; dst[DFF + c0 + e] = am1[e]; }
    }
  }
}


__device__ __forceinline__ void gate_fixup(int wv, const Params& p, int layer) {
  const int tix = tidx(wv);
  const u16* side = (const u16*)(p.ws + OFF_SIDE);
  u16* gg = (u16*)(p.ws + OFF_R);
  const float* cw = p.in[19] + (size_t)layer * 3 * DFF;
  const float* cb = p.in[20] + (size_t)layer * DFF;
  for (int vw = blockIdx.x; vw < (MP / BM) * (D / BM); vw += gridDim.x) {
    int pm, pn;
    tile_coords(vw, MP / BM, D / BM, pm, pn);
    if ((pm & 7) == 0) continue;
    for (int c8 = tix; c8 < DFF / 8; c8 += 512) {
      const int c = c8 * 8;
      float a0[8], a1[8], u0[8], u1[8], q2[8], q1[8], y0[8], y1[8];
      ld8(side + (size_t)(pm * 2 + 0) * DFF + c, a0);
      ld8(side + (size_t)(pm * 2 + 1) * DFF + c, a1);
      ld8(side + SZ_SIDE1 / 2 + (size_t)(pm * 2 + 0) * DFF + c, u0);
      ld8(side + SZ_SIDE1 / 2 + (size_t)(pm * 2 + 1) * DFF + c, u1);
      ld8(side + SZ_SIDE1 + (size_t)((pm - 1) * 2 + 0) * DFF + c, q2);
      ld8(side + SZ_SIDE1 + (size_t)((pm - 1) * 2 + 1) * DFF + c, q1);
#pragma unroll
      for (int e = 0; e < 8; ++e) {
        const float w0 = cw[c + e], w1 = cw[DFF + c + e], w2 = cw[2 * DFF + c + e], bb = cb[c + e];
        y0[e] = siluf_(bb + w0 * q2[e] + w1 * q1[e] + w2 * a0[e]) * u0[e];
        y1[e] = siluf_(bb + w0 * q1[e] + w1 * a0[e] + w2 * a1[e]) * u1[e];
      }
      st8(gg + (size_t)(pm * 256 + 0) * DFF + c, y0);
      st8(gg + (size_t)(pm * 256 + 1) * DFF + c, y1);
    }
  }
  asm volatile("s_waitcnt vmcnt(0)" ::: "memory");
  __syncthreads();
}

#define XB_TMO      128
#define XB_XCNT(j)  (256  + 64 * (j))
#define XB_XSUB(j)  (1280 + 64 * (j))
#define XB_XGEN(j)  (2304 + 64 * (j))
#define XB_TOP      3328
#define XB_TOPGEN   3392
#define XCD_BAR_WORDS 3456
#define XB_SPIN_CAP (1u << 22)
#define LAS __attribute__((address_space(3)))
__device__ __forceinline__ unsigned xb_ld(unsigned* p)              { return __hip_atomic_load(p, __ATOMIC_RELAXED, __HIP_MEMORY_SCOPE_AGENT); }
__device__ __forceinline__ unsigned xb_add(unsigned* p, unsigned v) { return __hip_atomic_fetch_add(p, v, __ATOMIC_RELAXED, __HIP_MEMORY_SCOPE_AGENT); }
__device__ __forceinline__ unsigned xb_xcc_id() { return (unsigned)__builtin_amdgcn_s_getreg((3 << 11) | 20) & 0xFu; }
#define XB_SPIN(cond, bar) do { unsigned _sp = 0; while (cond) { __builtin_amdgcn_s_sleep(1); \
    if ((++_sp & 255u) == 0u) { if (xb_ld(&(bar)[XB_TMO])) break; if (_sp > XB_SPIN_CAP) { atomicAdd(&(bar)[XB_TMO], 1u); break; } } } } while (0)
struct XcdBarrier { unsigned* bar; unsigned x; volatile LAS unsigned* st; };
__device__ __forceinline__ XcdBarrier xcd_barrier_post(int wv, unsigned* bar, volatile LAS unsigned* st) {
  XcdBarrier b; b.bar = bar; b.x = xb_xcc_id(); b.st = st;
  if (tidx(wv) == 0) (void)xb_add(&bar[XB_XCNT(b.x)], 1u);
  return b;
}
__device__ __forceinline__ void xcd_barrier_complete(unsigned* bar, unsigned x, unsigned& nloc, unsigned& nx) {
  const unsigned G = gridDim.x * gridDim.y * gridDim.z;
  unsigned sum, cnt, mine, sp = 0u;
  for (;;) {
    sum = 0u; cnt = 0u; mine = 0u;
#pragma unroll
    for (unsigned j = 0; j < 16; ++j) { const unsigned c = xb_ld(&bar[XB_XCNT(j)]); sum += c; cnt += (c > 0u) ? 1u : 0u; mine = (j == x) ? c : mine; }
    if (sum == G) break;
    __builtin_amdgcn_s_sleep(1);
    if ((++sp & 255u) == 0u) { if (xb_ld(&bar[XB_TMO])) break; if (sp > XB_SPIN_CAP) { atomicAdd(&bar[XB_TMO], 1u); break; } }
  }
  nloc = mine > 0u ? mine : 1u; nx = cnt > 0u ? cnt : 1u;
}
__device__ __forceinline__ void xcd_barrier(int wv, const XcdBarrier& b) {
  asm volatile("s_waitcnt vmcnt(0)" ::: "memory");
  __syncthreads();
  if (tidx(wv) == 0) {
    unsigned* bar = b.bar;
    __builtin_amdgcn_s_waitcnt(0);
    unsigned nloc = b.st[0], nx = b.st[1];
    if (nloc == 0u) { xcd_barrier_complete(bar, b.x, nloc, nx); b.st[0] = nloc; b.st[1] = nx; }
    const unsigned old = xb_add(&bar[XB_XSUB(b.x)], 1u);
    const unsigned gen = old / nloc;
    if (old + 1u == (gen + 1u) * nloc) {
      __builtin_amdgcn_fence(__ATOMIC_RELEASE, "agent");
      asm volatile("s_waitcnt vmcnt(0)" ::: "memory");
      const unsigned og = xb_add(&bar[XB_TOP], 1u);
      const unsigned tg = og / nx;
      if (og + 1u == (tg + 1u) * nx) xb_add(&bar[XB_TOPGEN], 1u);
      else XB_SPIN(xb_ld(&bar[XB_TOPGEN]) == tg, bar);
      __builtin_amdgcn_fence(__ATOMIC_ACQUIRE, "agent");
      xb_add(&bar[XB_XGEN(b.x)], 1u);
      asm volatile("s_waitcnt vmcnt(0)" ::: "memory");
    } else {
      XB_SPIN(xb_ld(&bar[XB_XGEN(b.x)]) == gen, bar);
      __builtin_amdgcn_fence(__ATOMIC_ACQUIRE, "agent");
      asm volatile("s_waitcnt vmcnt(0)" ::: "memory");
    }
  }
  __syncthreads();
}

constexpr int NPHASE = 21;
#ifndef PHMASK
#define PHMASK 0xFFFFFFFFu
#endif
#define PH_ON(k) (((PHMASK) >> (k)) & 1u)
constexpr int LDS_BYTES = 147456;

typedef const __attribute__((address_space(4))) Params* KParamsPtr;
#ifndef XSYNC
#define XSYNC 0
#endif
#ifndef DUPMASK
#define DUPMASK 0u
#endif
#define DUP_ON(k) (((DUPMASK) >> (k)) & 1u)
__device__ __forceinline__ bool ph_in(KParamsPtr& kp, int k) { asm volatile("" : "+s"(kp)); return kp->ph_lo <= k && k < kp->ph_hi; }
#define PH_IN(k) ph_in(kp, (k))
#define PHASE(k, ...) if (PH_IN(k)) { if (PH_ON(k)) { for (int rep = 0; rep < 1 + (int)DUP_ON(k); ++rep) { asm volatile("" : "+s"(kp)); Params p; __builtin_memcpy(&p, kp, sizeof(Params)); unsigned char* ws = p.ws; __VA_ARGS__ } } \
    asm volatile("" : "+s"(kp)); \
    if (kp->coop && (k) + 1 < kp->ph_hi) { XcdBarrier xb; xb.bar = (unsigned*)(kp->ws + OFF_BAR); xb.x = xb_xcc_id(); xb.st = (volatile LAS unsigned*)&xb_words; xcd_barrier(wv, xb); if (XSYNC) xcd_barrier(wv, xb); } }
#define PHASE_X(k, ...) if (PH_IN(k)) { asm volatile("" : "+s"(kp)); Params p; __builtin_memcpy(&p, kp, sizeof(Params)); unsigned char* ws = p.ws; __VA_ARGS__ }
#define GEMM_ACC(k, Aoff, Woff, KK, RSSP, FIXL, RINP, RINS) PHASE(k, { float* rssp = (RSSP); if ((FIXL) >= 0) gate_fixup(wv, p, FIXL); \
    gemm_phase<MP, D, KK, 0>(wv, (const u16*)(ws + Aoff), (const u16*)(ws + Woff), EpiAccum{(u16*)(ws + OFF_HN), rssp, (RINP)}, (u16*)shm); \
    gemm_tail_phase<KK>(wv, (const u16*)(ws + Aoff), (const u16*)(ws + Woff), (float*)shm, (u16*)(ws + OFF_HN), rssp, (RINS)); })

__global__ void __launch_bounds__(512) fwd_kernel(Params p_) {
  extern __shared__ __attribute__((aligned(16))) unsigned char shm[];
  cg::grid_group grid = cg::this_grid();
  KParamsPtr kp = (KParamsPtr)__builtin_amdgcn_kernarg_segment_ptr();
  const int wv = __builtin_amdgcn_readfirstlane((int)(threadIdx.x >> 6));
  __shared__ uint4 xb_words;
  if (tidx(wv) == 0) xb_words = make_uint4(0u, 0u, 0u, 0u);
  __syncthreads();
  if (kp->coop == 2) grid.sync();
  (void)xcd_barrier_post(wv, (unsigned*)(kp->ws + OFF_BAR), (volatile LAS unsigned*)&xb_words);
  PHASE(0,
        convert_w(wv, p.in[9], (u16*)(ws + OFF_WINE), D, NINE, NINE, (u16*)shm);
        convert_w(wv, p.in[10], (u16*)(ws + OFF_WOUTE), D, D, D, (u16*)shm);
        convert_w(wv, p.in[13], (u16*)(ws + OFF_WINO), D, NINO, NINO_PAD, (u16*)shm, p.in[6] + D);
        convert_w(wv, p.in[17], (u16*)(ws + OFF_WOUTO), D, D, D, (u16*)shm);
        convert_w(wv, p.in[18], (u16*)(ws + OFF_WUP0), D, NUP, NUP, (u16*)shm, p.in[7], 1);
        convert_w(wv, p.in[18] + (size_t)D * NUP, (u16*)(ws + OFF_WUP1), D, NUP, NUP, (u16*)shm, p.in[7] + D, 1);
        convert_w(wv, p.in[21], (u16*)(ws + OFF_WDN0), DFF, D, D, (u16*)shm);
        convert_w(wv, p.in[21] + (size_t)DFF * D, (u16*)(ws + OFF_WDN1), DFF, D, D, (u16*)shm);
        for (int i = blockIdx.x * 512 + tidx(wv); i < 3 * MT; i += gridDim.x * 512) ((float*)(ws + OFF_RSS))[i] = 0.f;
        rmsnorm_phase<0>(wv, p, p.in[6]);)
  PHASE(1, gemm_phase<MT, NINE, D, 0>(wv, (const u16*)(ws + OFF_HN), (const u16*)(ws + OFF_WINE), EpiStoreBf16{(u16*)(ws + OFF_BIG), NINE, nullptr}, (u16*)shm);)
  PHASE(2, { const int b_ = blockIdx.x, G_ = gridDim.x;
        prep_range<0>(wv, p, b_, NCH * 4, G_, shm);
        const int first1 = ((NCH * 4 - b_ + G_ - 1) / G_) * G_ + b_ - NCH * 4;
        prep_range<1>(wv, p, first1, NCH * 8, G_, shm); })
  PHASE(3, seq_even_phase(wv, p, shm);)
  PHASE(4, post_phase<0>(wv, p);)
  GEMM_ACC(5, OFF_R, OFF_WOUTE, D, (float*)(ws + OFF_RSS), -1, p.in[0], p.in[1])
  PHASE(7, gemm_phase<MT, NUP, D, 0>(wv, (const u16*)(ws + OFF_HN), (const u16*)(ws + OFF_WUP0), EpiGate{(const __attribute__((address_space(4))) void*)kp, 0, 0}, (u16*)shm);)
  GEMM_ACC(9, OFF_R, OFF_WDN0, DFF, (float*)(ws + OFF_RSS) + MT, 0, (const float*)nullptr, (const float*)nullptr)
  PHASE(11, gemm_phase<MT, NINO_PAD, D, 0>(wv, (const u16*)(ws + OFF_HN), (const u16*)(ws + OFF_WINO), EpiStoreBf16{(u16*)(ws + OFF_BIG), NINO_PAD, (const float*)(ws + OFF_RSS) + MT}, (u16*)shm);)
  PHASE(12, prep_range<2>(wv, p, blockIdx.x, NCH * 4, gridDim.x, shm);)
  PHASE(13, seq_odd_phase(wv, p, shm);)
  PHASE(14, post_phase<1>(wv, p);)
  GEMM_ACC(15, OFF_R, OFF_WOUTO, D, (float*)(ws + OFF_RSS) + 2 * MT, -1, (const float*)nullptr, (const float*)nullptr)
  PHASE(17, gemm_phase<MT, NUP, D, 0>(wv, (const u16*)(ws + OFF_HN), (const u16*)(ws + OFF_WUP1), EpiGate{(const __attribute__((address_space(4))) void*)kp, 1, 2 * MT}, (u16*)shm);)
  GEMM_ACC(19, OFF_R, OFF_WDN1, DFF, (float*)nullptr, 1, (const float*)nullptr, (const float*)nullptr)
  PHASE(20, final_norm_phase(wv, p);)
}

extern "C" void kernel_launch(void* const* d_in, const int* in_sizes, int n_in, void* d_out, int out_size, void* d_ws, size_t ws_size,
                              hipStream_t stream) {
  static int grid_blocks = 0;
  if (grid_blocks == 0) {
    int dev = 0, cus = 0, per_cu = 0;
    hipGetDevice(&dev);
    hipDeviceGetAttribute(&cus, hipDeviceAttributeMultiprocessorCount, dev);
    hipFuncSetAttribute((const void*)fwd_kernel, hipFuncAttributeMaxDynamicSharedMemorySize, LDS_BYTES);
    hipOccupancyMaxActiveBlocksPerMultiprocessor(&per_cu, (const void*)fwd_kernel, 512, LDS_BYTES);
    if (per_cu < 1) per_cu = 1;
    grid_blocks = cus * per_cu;
    (void)hipGetLastError();
  }
  if (n_in != 22 || ws_size < WS_NEED || (size_t)out_size != O_END) {
    fprintf(stderr, "kernel_launch: unexpected sizes n_in=%d ws=%zu need=%zu out=%d\n", n_in, ws_size, (size_t)WS_NEED, out_size);
    hipMemsetAsync(d_out, 0, (size_t)out_size * 4, stream);
    return;
  }
  Params p{};
  for (int i = 0; i < 22; ++i) p.in[i] = (const float*)d_in[i];
  p.out = (float*)d_out;
  p.ws = (unsigned char*)d_ws;
#if 0
  for (int ph = 0; ph < NPHASE; ++ph) {
    p.ph_lo = ph; p.ph_hi = ph + 1; p.coop = 0;
    hipLaunchKernelGGL(fwd_kernel, dim3(grid_blocks), dim3(512), LDS_BYTES, stream, p);
  }
#else
  p.ph_lo = 0; p.ph_hi = NPHASE; p.coop = 1;
  hipMemsetAsync((unsigned char*)d_ws + OFF_BAR, 0, XCD_BAR_WORDS * 4, stream);
  void* args[] = {&p};
  hipError_t e = hipLaunchCooperativeKernel((const void*)fwd_kernel, dim3(grid_blocks), dim3(512), args, LDS_BYTES, stream);
  if (e != hipSuccess) fprintf(stderr, "cooperative launch failed: %s (grid %d)\n", hipGetErrorString(e), grid_blocks);
#endif
}
```

```cpp
#include <hip/hip_runtime.h>
#include <hip/hip_bf16.h>
#include <hip/hip_cooperative_groups.h>
#include <cstdio>
namespace cg = cooperative_groups;

typedef unsigned short u16;
using bf16x8 = __attribute__((ext_vector_type(8))) short;
using f32x4 = __attribute__((ext_vector_type(4))) float;
typedef __attribute__((ext_vector_type(4))) unsigned u32x4_t;

constexpr int MP = 8192, MS = 512, MT = 8704, D = 2048;
constexpr int DFF = 5504, NUP = 11008;
constexpr int NINE = 7168, NINO = 6160, NINO_PAD = 6400;
constexpr int NCH = 136;
constexpr float EPS = 1e-6f;

constexpr size_t SZ_WINE = (size_t)NINE * D * 2, SZ_WOUT = (size_t)D * D * 2, SZ_WINO = (size_t)NINO_PAD * D * 2;
constexpr size_t SZ_WUP = (size_t)NUP * D * 2, SZ_WDN = (size_t)D * DFF * 2;
constexpr size_t OFF_WINE = 0;
constexpr size_t OFF_WOUTE = OFF_WINE + SZ_WINE;
constexpr size_t OFF_WINO = OFF_WOUTE + SZ_WOUT;
constexpr size_t OFF_WOUTO = OFF_WINO + SZ_WINO;
constexpr size_t OFF_WUP0 = OFF_WOUTO + SZ_WOUT;
constexpr size_t OFF_WUP1 = OFF_WUP0 + SZ_WUP;
constexpr size_t OFF_WDN0 = OFF_WUP1 + SZ_WUP;
constexpr size_t OFF_WDN1 = OFF_WDN0 + SZ_WDN;
constexpr size_t OFF_H = OFF_WDN1 + SZ_WDN;
constexpr size_t OFF_HN = OFF_H + (size_t)MT * D * 4;
constexpr size_t OFF_BIG = OFF_HN + (size_t)MT * D * 2;
constexpr size_t OFF_R = OFF_BIG + (size_t)MT * NUP * 2;
constexpr size_t SZ_R = 104ull * 1048576;
constexpr size_t OFF_RSS = OFF_R + SZ_R;
constexpr size_t OFF_SIDE = OFF_RSS + 3ull * MT * 4 + 256;
constexpr size_t SZ_SIDE1 = 34ull * 2 * DFF * 2;
constexpr size_t OFF_BAR = OFF_SIDE + 3 * SZ_SIDE1 + 256;
constexpr size_t WS_NEED = OFF_BAR + 16384;
constexpr size_t R_QA = 0;
constexpr size_t R_KA = R_QA + (size_t)NCH * 4 * 64 * 128 * 2;
constexpr size_t R_VA = R_KA + (size_t)NCH * 4 * 64 * 128 * 2;
constexpr size_t R_PA = R_VA + (size_t)NCH * 4 * 256 * 64 * 2;
constexpr size_t R_DA = R_PA + (size_t)NCH * 4 * 4096 * 2;
constexpr size_t R_QB = R_DA + (size_t)NCH * 4 * 128 * 4;
constexpr size_t R_KB = R_QB + (size_t)NCH * 8 * 64 * 128 * 2;
constexpr size_t R_VB = R_KB + (size_t)NCH * 8 * 64 * 128 * 2;
constexpr size_t R_PB = R_VB + (size_t)NCH * 8 * 128 * 64 * 2;
constexpr size_t R_DB = R_PB + (size_t)NCH * 8 * 4096 * 2;
constexpr size_t R_END_EVEN = R_DB + (size_t)NCH * 8 * 128 * 4;
constexpr size_t R_QC = 0;
constexpr size_t R_KC = R_QC + (size_t)NCH * 4 * 64 * 256 * 2;
constexpr size_t R_VC = R_KC + (size_t)NCH * 4 * 64 * 256 * 2;
constexpr size_t R_PC = R_VC + (size_t)NCH * 4 * 512 * 64 * 2;
constexpr size_t R_DC = R_PC + (size_t)NCH * 4 * 4096 * 2;
constexpr size_t R_END_ODD = R_DC + (size_t)NCH * 4 * 256 * 4;
static_assert(R_END_EVEN <= SZ_R && R_END_ODD <= SZ_R && (size_t)MT * DFF * 2 <= SZ_R, "R region too small");

constexpr size_t O_YP = 0;
constexpr size_t O_YS = O_YP + (size_t)MP * D;
constexpr size_t O_RETP = O_YS + (size_t)MS * D;
constexpr size_t O_RETS = O_RETP + 4ull * 4 * 128 * 256;
constexpr size_t O_HGP = O_RETS + 8ull * 4 * 128 * 256;
constexpr size_t O_HGS = O_HGP + 4ull * 8 * 128 * 128;
constexpr size_t O_GLP = O_HGS + 8ull * 8 * 128 * 128;
constexpr size_t O_GLS = O_GLP + 4ull * 4 * 256 * 512;
constexpr size_t O_CVP = O_GLS + 8ull * 4 * 256 * 512;
constexpr size_t O_CVS = O_CVP + 2ull * 4 * 2 * DFF;
constexpr size_t O_END = O_CVS + 2ull * 8 * 2 * DFF;

struct Params {
  const float* in[22];
  float* out;
  unsigned char* ws;
  int ph_lo, ph_hi, coop, pad;
};

__device__ __forceinline__ u16 f2bf(float f) {
  unsigned u = __float_as_uint(f);
  u += 0x7fffu + ((u >> 16) & 1u);
  return (u16)(u >> 16);
}
__device__ __forceinline__ float bf2f(u16 h) { return __uint_as_float(((unsigned)h) << 16); }
__device__ __forceinline__ unsigned pack2_sw(float a, float b) { return (unsigned)f2bf(a) | ((unsigned)f2bf(b) << 16); }
typedef float f32x2_t __attribute__((ext_vector_type(2)));
typedef __bf16 bf16x2_t __attribute__((ext_vector_type(2)));
__device__ __forceinline__ unsigned pack2(float a, float b) { f32x2_t v = {a, b}; bf16x2_t r = __builtin_convertvector(v, bf16x2_t); return __builtin_bit_cast(unsigned, r); }
__device__ __forceinline__ float sigmoidf_(float x) { return __builtin_amdgcn_rcpf(1.f + __expf(-x)); }
__device__ __forceinline__ float siluf_(float x) { return x * __builtin_amdgcn_rcpf(1.f + __expf(-x)); }

__device__ __forceinline__ int tidx(int wv) { int l; asm volatile("v_mbcnt_lo_u32_b32 %0, -1, 0\n\tv_mbcnt_hi_u32_b32 %0, -1, %0" : "=v"(l)); return wv * 64 + l; }

__device__ __forceinline__ void convert_w(int wv, const float* __restrict__ src, u16* __restrict__ dst, int K, int N, int Npad, u16* tile, const float* __restrict__ kscale = nullptr, int upperm = 0) {
  const int tix = tidx(wv);
  constexpr int TS = 262;
  const int tn = (Npad + 255) / 256, tk = K / 64, nt = tn * tk, tid = tix;
  for (int t = blockIdx.x; t < nt; t += gridDim.x) {
    const int n0 = (t % tn) * 256, k0 = (t / tn) * 64;
    float4 v[8];
#pragma unroll
    for (int i = 0; i < 8; ++i) {
      const int idx = tid + i * 512, kk = idx >> 6, n = n0 + (idx & 63) * 4;
      v[i] = make_float4(0.f, 0.f, 0.f, 0.f);
      if (n < N) { const f32x4 t_ = __builtin_nontemporal_load((const f32x4*)(src + (size_t)(k0 + kk) * N + n)); v[i] = make_float4(t_[0], t_[1], t_[2], t_[3]); }
      if (kscale) { const float sc = kscale[k0 + kk]; v[i].x *= sc; v[i].y *= sc; v[i].z *= sc; v[i].w *= sc; }
    }
    __syncthreads();
#pragma unroll
    for (int i = 0; i < 8; ++i) {
      const int idx = tid + i * 512, kk = idx >> 6, nl = (idx & 63) * 4;
      *(unsigned*)(tile + kk * TS + nl) = pack2(v[i].x, v[i].y);
      *(unsigned*)(tile + kk * TS + nl + 2) = pack2(v[i].z, v[i].w);
    }
    __syncthreads();
#pragma unroll
    for (int i = 0; i < 4; ++i) {
      const int item = tid + i * 512, ks = item & 7, n = item >> 3;
      if (n0 + n < Npad) {
        const u16* tp = tile + (ks * 8) * TS + n;
        uint4 o;
        o.x = (unsigned)tp[0] | ((unsigned)tp[TS] << 16);
        o.y = (unsigned)tp[2 * TS] | ((unsigned)tp[3 * TS] << 16);
        o.z = (unsigned)tp[4 * TS] | ((unsigned)tp[5 * TS] << 16);
        o.w = (unsigned)tp[6 * TS] | ((unsigned)tp[7 * TS] << 16);
        int nr = n0 + n;
        if (upperm) nr = (nr < DFF) ? ((nr >> 7) * 256 + (nr & 127)) : ((((nr - DFF) >> 7) * 256) + 128 + ((nr - DFF) & 127));
        *(uint4*)(dst + (size_t)nr * K + k0 + ks * 8) = o;
      }
    }
  }
}

template <int MODE>
__device__ __forceinline__ void rmsnorm_phase(int wv, const Params& p, const float* __restrict__ w) {
  const int tix = tidx(wv);
  const int lane = tix & 63, gw = blockIdx.x * 8 + (tix >> 6), nw = gridDim.x * 8;
  const float* h = (const float*)(p.ws + OFF_H);
  u16* hn = (u16*)(p.ws + OFF_HN);
#define RMS_LOAD(dst, row_) do { const int r_ = (row_); const float* src_; \
    if (MODE == 0) src_ = (r_ < MP) ? p.in[0] + (size_t)r_ * D : p.in[1] + (size_t)(r_ - MP) * D; \
    else src_ = h + (size_t)r_ * D; \
    _Pragma("unroll") for (int i = 0; i < 8; ++i) dst[i] = (MODE == 0) ? __builtin_nontemporal_load((const f32x4*)(src_ + (i * 64 + lane) * 4)) : *(const f32x4*)(src_ + (i * 64 + lane) * 4); } while (0)
  f32x4 v[8];
  if (gw < MT) RMS_LOAD(v, gw);
#pragma unroll 1
  for (int row = gw; row < MT; row += nw) {
    f32x4 nx[8];
    if (row + nw < MT) RMS_LOAD(nx, row + nw);
    else {
#pragma unroll
      for (int i = 0; i < 8; ++i) nx[i] = v[i];
    }
    __builtin_amdgcn_sched_barrier(0);
    float ss = 0.f;
#pragma unroll
    for (int i = 0; i < 8; ++i) ss += v[i][0] * v[i][0] + v[i][1] * v[i][1] + v[i][2] * v[i][2] + v[i][3] * v[i][3];
#pragma unroll
    for (int o = 32; o > 0; o >>= 1) ss += __shfl_xor(ss, o, 64);
    const float rs = rsqrtf(ss * (1.f / D) + EPS);
#pragma unroll
    for (int i = 0; i < 8; ++i) {
      const int col = (i * 64 + lane) * 4;
      const float4 wv4 = *(const float4*)(w + col);
      const float4 y = make_float4(v[i][0] * rs * wv4.x, v[i][1] * rs * wv4.y, v[i][2] * rs * wv4.z, v[i][3] * rs * wv4.w);
      if (MODE == 2) {
        float* dst = (row < MP) ? p.out + O_YP + (size_t)row * D : p.out + O_YS + (size_t)(row - MP) * D;
        *(float4*)(dst + col) = y;
      } else {
        *(uint2*)(hn + (size_t)row * D + col) = make_uint2(pack2(y.x, y.y), pack2(y.z, y.w));
      }
    }
#pragma unroll
    for (int i = 0; i < 8; ++i) v[i] = nx[i];
  }
#undef RMS_LOAD
}

__device__ __forceinline__ void ld8(const u16* p, float* f) {
  uint4 v = *(const uint4*)p;
  f[0] = __uint_as_float(v.x << 16); f[1] = __uint_as_float(v.x & 0xffff0000u);
  f[2] = __uint_as_float(v.y << 16); f[3] = __uint_as_float(v.y & 0xffff0000u);
  f[4] = __uint_as_float(v.z << 16); f[5] = __uint_as_float(v.z & 0xffff0000u);
  f[6] = __uint_as_float(v.w << 16); f[7] = __uint_as_float(v.w & 0xffff0000u);
}
__device__ __forceinline__ void st8(u16* p, const float* f) {
  *(uint4*)p = make_uint4(pack2(f[0], f[1]), pack2(f[2], f[3]), pack2(f[4], f[5]), pack2(f[6], f[7]));
}
__device__ __forceinline__ void st8_sw(u16* p, const float* f) {
  *(uint4*)p = make_uint4(pack2_sw(f[0], f[1]), pack2_sw(f[2], f[3]), pack2_sw(f[4], f[5]), pack2_sw(f[6], f[7]));
}

constexpr int BM = 256, BK = 64, HALF = 128, NXCD = 8, WGM = 8, HT = HALF * BK;

__device__ __forceinline__ int lds_byte(int r, int c) {
  int st = (r >> 4) * 2 + (c >> 5), rr = r & 15, cc = c & 31, ob = rr * 64 + cc * 2;
  return st * 1024 + (ob ^ (((ob >> 9) & 1) << 5));
}
__device__ __forceinline__ void stage_rc(int b, int& R, int& C) {
  int st = b / 1024, sb = b % 1024, swz = sb ^ (((sb >> 9) & 1) << 5);
  R = (st >> 1) * 16 + swz / 64; C = (st & 1) * 32 + (swz % 64) / 2;
}

__device__ __forceinline__ void tile_coords(int wgid, int nM, int nN, int& pm, int& pn) {
  const int nwg = nM * nN;
  { int q = nwg / NXCD, r = nwg % NXCD, xcd = wgid % NXCD, off = wgid / NXCD;
    wgid = (xcd < r ? xcd * (q + 1) : r * (q + 1) + (xcd - r) * q) + off; }
  const int nig = WGM * nN, gid = wgid / nig, fm = gid * WGM, gsz = min(nM - fm, WGM);
  pm = fm + ((wgid % nig) % gsz); pn = (wgid % nig) / gsz;
}

struct EpiStoreBf16 {
  static constexpr bool GATE = false;
  static constexpr bool LDSST = true;
  u16* out; int ldo; const float* rss;
  __device__ __forceinline__ float row_scale(int row) const { return rss ? rsqrtf(rss[row] * (1.f / D) + EPS) : 1.f; }
  __device__ __forceinline__ float operator()(int row, int col, f32x4 v, float sc) const {
    uint2 pk = make_uint2(pack2(v[0] * sc, v[1] * sc), pack2(v[2] * sc, v[3] * sc));
    *(uint2*)(out + (size_t)row * ldo + col) = pk;
    return 0.f;
  }
  __device__ __forceinline__ void row_end(int, float, int) const {}
  __device__ __forceinline__ f32x4 finalize(int, int, f32x4 v, float sc, float&) const { return f32x4{v[0] * sc, v[1] * sc, v[2] * sc, v[3] * sc}; }
};
struct EpiAccum {
  static constexpr bool GATE = false;
  static constexpr bool LDSST = true;
  u16* out; float* rss; const float* rin32; static constexpr int ldo = D;
  __device__ __forceinline__ float row_scale(int) const { return 1.f; }
  __device__ __forceinline__ float operator()(int, int, f32x4, float) const { return 0.f; }
  __device__ __forceinline__ f32x4 finalize(int row, int col, f32x4 v, float, float& ss) const {
    float4 o;
    if (rin32) o = *(const float4*)(rin32 + (size_t)row * D + col);
    else { const uint2 r = *(const uint2*)(out + (size_t)row * D + col); o = make_float4(__uint_as_float(r.x << 16), __uint_as_float(r.x & 0xffff0000u), __uint_as_float(r.y << 16), __uint_as_float(r.y & 0xffff0000u)); }
    o.x += v[0]; o.y += v[1]; o.z += v[2]; o.w += v[3];
    if (rss) ss += o.x * o.x + o.y * o.y + o.z * o.z + o.w * o.w;
    return f32x4{o.x, o.y, o.z, o.w};
  }
  __device__ __forceinline__ void row_end(int row, float ss, int fq) const {
    if (rss) {
      ss += __shfl_xor(ss, 16, 64);
      ss += __shfl_xor(ss, 32, 64);
      if (fq == 0) unsafeAtomicAdd(rss + row, ss);
    }
  }
};

struct EpiGate {
  static constexpr bool GATE = true;
  static constexpr bool LDSST = false;
  const __attribute__((address_space(4))) void* kp; int layer; int rssoff;
  __device__ __forceinline__ float row_scale(int) const { return 1.f; }
  __device__ __forceinline__ float operator()(int, int, f32x4, float) const { return 0.f; }
  __device__ __forceinline__ void row_end(int, float, int) const {}
};

template <int M, int N, int K, int TAIL, class Epi>
__device__ __forceinline__ void gemm_phase(int wv, const u16* __restrict__ A, const u16* __restrict__ Bt, Epi epi, u16* shm) {
  const int tix = tidx(wv);
#define SA(b, h) (shm + ((b) * 2 + (h)) * HT)
#define SB(b, h) (shm + (4 + (b) * 2 + (h)) * HT)
#define STAGE(P, BASE, br, kt) do { const u16* _gb = BASE + ((long)(br) * K + (long)(kt0 + (kt)) * BK); \
    for (int _i = 0; _i < 2; ++_i) { int _b = tix * 16 + _i * 8192; \
      __builtin_amdgcn_global_load_lds((const unsigned*)(_gb + toff[_i]), \
        (__attribute__((address_space(3))) unsigned*)((char*)(P) + _b), 16, 0, 0); } } while (0)
#define LDA(dst, b, h) for (int m = 0; m < 4; ++m) for (int k = 0; k < 2; ++k) \
    dst[m][k] = *reinterpret_cast<const bf16x8*>((char*)SA(b, h) + lds_byte(wr * 64 + m * 16 + fr, k * 32 + fq * 8))
#define LDB(dst, b, h) for (int n = 0; n < 2; ++n) for (int k = 0; k < 2; ++k) \
    dst[n][k] = *reinterpret_cast<const bf16x8*>((char*)SB(b, h) + lds_byte(wc * 32 + n * 16 + fr, k * 32 + fq * 8))
#define MMA(ai, bj, At_, Bt_) do { __builtin_amdgcn_s_setprio(1); \
    for (int m = 0; m < 4; ++m) for (int n = 0; n < 2; ++n) for (int k = 0; k < 2; ++k) \
      acc[ai][bj][m][n] = __builtin_amdgcn_mfma_f32_16x16x32_bf16(Bt_[n][k], At_[m][k], acc[ai][bj][m][n], 0, 0, 0); \
    __builtin_amdgcn_s_setprio(0); } while (0)
#define WAIT_V(n) asm volatile("s_waitcnt vmcnt(" #n ")" ::: "memory")
#define WAIT_L(n) asm volatile("s_waitcnt lgkmcnt(" #n ")" ::: "memory")
#define BAR __builtin_amdgcn_s_barrier()
#define SCHED __builtin_amdgcn_sched_barrier(0)
  const int nM = M / BM, nN = N / BM, nwg = nM * nN, G = gridDim.x;
  const int nunits = nwg;
  const int wid = tix >> 6, lane = tix & 63, wr = wid >> 2, wc = wid & 3, fr = lane & 15, fq = lane >> 4;
  const int nt_total = K / BK;
  unsigned toff[2];
  for (int _i = 0; _i < 2; ++_i) { int _b = tix * 16 + _i * 8192; int _r, _c; stage_rc(_b, _r, _c); toff[_i] = (unsigned)(_r * K + _c); }
  for (int vw = blockIdx.x; vw < nunits; vw += G) {
    int pm, pn;
    tile_coords(vw, nM, nN, pm, pn);
    const int brow = pm * BM, bcol = pn * BM;
    constexpr int kt0 = 0, nt = nt_total;
    f32x4 acc[2][2][4][2];
    for (int a = 0; a < 2; ++a) for (int b = 0; b < 2; ++b) for (int m = 0; m < 4; ++m) for (int n = 0; n < 2; ++n) acc[a][b][m][n] = f32x4{0.f, 0.f, 0.f, 0.f};
    bf16x8 At[4][2], B0[2][2], B1[2][2];
    STAGE(SB(0, 0), Bt, bcol, 0); STAGE(SA(0, 0), A, brow, 0);
    STAGE(SB(0, 1), Bt, bcol + HALF, 0); STAGE(SA(0, 1), A, brow + HALF, 0);
    if (wr == 1) BAR;
    WAIT_V(4); BAR;
    STAGE(SB(1, 0), Bt, bcol, 1); STAGE(SA(1, 0), A, brow, 1); STAGE(SB(1, 1), Bt, bcol + HALF, 1);
    WAIT_V(6); BAR;
    for (int t = 0; t < nt - 2; t += 2) {
      LDB(B0, 0, 0); SCHED; LDA(At, 0, 0); STAGE(SA(1, 1), A, brow + HALF, t + 1);
      WAIT_L(8); BAR; WAIT_L(0); MMA(0, 0, At, B0); BAR; SCHED;
      LDB(B1, 0, 1); STAGE(SB(0, 0), Bt, bcol, t + 2);
      BAR; WAIT_L(0); MMA(0, 1, At, B1); BAR;
      LDA(At, 0, 1); STAGE(SA(0, 0), A, brow, t + 2);
      BAR; WAIT_L(0); MMA(1, 0, At, B0); BAR; SCHED;
      STAGE(SB(0, 1), Bt, bcol + HALF, t + 2);
      WAIT_V(6); BAR; MMA(1, 1, At, B1); BAR;
      LDB(B0, 1, 0); SCHED; LDA(At, 1, 0); STAGE(SA(0, 1), A, brow + HALF, t + 2);
      WAIT_L(8); BAR; WAIT_L(0); MMA(0, 0, At, B0); BAR; SCHED;
      LDB(B1, 1, 1); STAGE(SB(1, 0), Bt, bcol, t + 3);
      BAR; WAIT_L(0); MMA(0, 1, At, B1); BAR;
      LDA(At, 1, 1); STAGE(SA(1, 0), A, brow, t + 3);
      BAR; WAIT_L(0); MMA(1, 0, At, B0); BAR; SCHED;
      STAGE(SB(1, 1), Bt, bcol + HALF, t + 3);
      WAIT_V(6); BAR; MMA(1, 1, At, B1); BAR;
    }
    { LDB(B0, 0, 0); LDA(At, 0, 0); STAGE(SA(1, 1), A, brow + HALF, nt - 1);
      BAR; WAIT_L(0); MMA(0, 0, At, B0); BAR;
      LDB(B1, 0, 1); BAR; WAIT_L(0); MMA(0, 1, At, B1); BAR;
      LDA(At, 0, 1); WAIT_V(4); BAR; WAIT_L(0); MMA(1, 0, At, B0); MMA(1, 1, At, B1); BAR; }
    { LDB(B0, 1, 0); LDA(At, 1, 0); WAIT_V(2); BAR; WAIT_L(0); MMA(0, 0, At, B0); BAR;
      LDB(B1, 1, 1); WAIT_V(0); BAR; WAIT_L(0); MMA(0, 1, At, B1); BAR;
      LDA(At, 1, 1); BAR; WAIT_L(0); MMA(1, 0, At, B0); MMA(1, 1, At, B1); BAR; }
    if (wr == 0) BAR;
    if constexpr (Epi::GATE) {
      constexpr int LS = 136;
      u16* La = shm;
      u16* Lu = shm + 256 * LS;
      const __attribute__((address_space(4))) Params* gkp = (const __attribute__((address_space(4))) Params*)epi.kp;
      asm volatile("" : "+s"(gkp));
      int e_pm = pm, e_pn = pn, e_tix = tix;
      asm volatile("" : "+s"(e_pm), "+s"(e_pn));
      asm volatile("" : "+v"(e_tix));
      const int e_brow = e_pm * BM;
      {
        const int e_lane = e_tix & 63, e_wid = e_tix >> 6, e_wr = e_wid >> 2, e_wc = e_wid & 3, e_fr = e_lane & 15, e_fq = e_lane >> 4;
        const float* rss = (const float*)(gkp->ws + OFF_RSS) + epi.rssoff;
        _Pragma("unroll") for (int ai = 0; ai < 2; ++ai) _Pragma("unroll") for (int m = 0; m < 4; ++m) {
          const int rl = ai * HALF + e_wr * 64 + m * 16 + e_fr;
          const float sc = rsqrtf(rss[e_brow + rl] * (1.f / D) + EPS);
          _Pragma("unroll") for (int n = 0; n < 2; ++n) {
            const f32x4 a = acc[ai][0][m][n], uu = acc[ai][1][m][n];
            const int lo = rl * LS + e_wc * 32 + n * 16 + e_fq * 4;
            *(uint2*)(La + lo) = make_uint2(pack2_sw(a[0] * sc, a[1] * sc), pack2_sw(a[2] * sc, a[3] * sc));
            *(uint2*)(Lu + lo) = make_uint2(pack2_sw(uu[0] * sc, uu[1] * sc), pack2_sw(uu[2] * sc, uu[3] * sc));
          }
        }
      }
      WAIT_L(0); BAR; asm volatile("" ::: "memory");
      {
        const bool samp = e_brow >= MP;
        const int layer = epi.layer;
        u16* gg = (u16*)(gkp->ws + OFF_R);
        u16* side = (u16*)(gkp->ws + OFF_SIDE);
        const float* cw = gkp->in[19] + (size_t)layer * 3 * DFF;
        const float* cb = gkp->in[20] + (size_t)layer * DFF;
        const float* cache = gkp->in[5] + (size_t)layer * 8 * 2 * DFF;
        float* cvo = gkp->out + (samp ? O_CVS + (size_t)layer * 8 * 2 * DFF : O_CVP + (size_t)layer * 4 * 2 * DFF);
        const int cg = e_tix & 15, r0 = e_tix >> 4, c = e_pn * 128 + cg * 8;
        float w0[8], w1[8], w2[8], bb[8];
        _Pragma("unroll") for (int e = 0; e < 8; ++e) { w0[e] = cw[c + e]; w1[e] = cw[DFF + c + e]; w2[e] = cw[2 * DFF + c + e]; bb[e] = cb[c + e]; }
        _Pragma("unroll 1") for (int it = 0; it < 8; ++it) {
          const int rl = it * 32 + r0;
          const int t = samp ? (rl & 63) : ((e_pm & 7) * 256 + rl);
          const int sb = (e_pm - 32) * 4 + (rl >> 6);
          float a[8], uu[8], am1[8], am2[8], y[8];
          ld8(La + rl * LS + cg * 8, a);
          ld8(Lu + rl * LS + cg * 8, uu);
          _Pragma("unroll") for (int e = 0; e < 8; ++e) { am1[e] = 0.f; am2[e] = 0.f; }
          if (t >= 1 && rl >= 1) ld8(La + (rl - 1) * LS + cg * 8, am1);
          if (t >= 2 && rl >= 2) ld8(La + (rl - 2) * LS + cg * 8, am2);
          if (samp && t < 2) {
            const float* c1 = cache + (size_t)(sb * 2 + 1) * DFF + c;
            if (t == 0) {
              const float* c0 = cache + (size_t)(sb * 2 + 0) * DFF + c;
              _Pragma("unroll") for (int e = 0; e < 8; ++e) { am2[e] = c0[e]; am1[e] = c1[e]; }
            } else {
              _Pragma("unroll") for (int e = 0; e < 8; ++e) am2[e] = c1[e];
            }
          }
          if (!(t >= 2 && rl < 2)) {
            _Pragma("unroll") for (int e = 0; e < 8; ++e) { float cv = bb[e] + w0[e] * am2[e] + w1[e] * am1[e] + w2[e] * a[e]; y[e] = siluf_(cv) * uu[e]; }
            st8_sw(gg + (size_t)(e_brow + rl) * DFF + c, y);
          } else {
            st8_sw(side + (size_t)(e_pm * 2 + rl) * DFF + c, a);
            st8_sw(side + SZ_SIDE1 / 2 + (size_t)(e_pm * 2 + rl) * DFF + c, uu);
          }
          if (rl >= 254) st8_sw(side + SZ_SIDE1 + (size_t)(e_pm * 2 + rl - 254) * DFF + c, a);
          int crow = -1;
          if (!samp) { if ((e_pm & 7) == 7 && rl >= 254) crow = (e_pm >> 3) * 2 + rl - 254; }
          else { if ((rl & 63) >= 62) crow = sb * 2 + (rl & 63) - 62; }
          if (crow >= 0) {
            float* dst = cvo + (size_t)crow * DFF + c;
            *(float4*)dst = make_float4(a[0], a[1], a[2], a[3]);
            *(float4*)(dst + 4) = make_float4(a[4], a[5], a[6], a[7]);
          }
        }
      }
      WAIT_L(0); BAR; asm volatile("" ::: "memory");
    } else if constexpr (Epi::LDSST) {
      constexpr int LS = 136;
      u16* L0 = shm;
      u16* L1 = shm + 256 * LS;
      int e_brow = brow, e_bcol = bcol, e_tix = tix;
      asm volatile("" : "+s"(e_brow), "+s"(e_bcol));
      asm volatile("" : "+v"(e_tix));
      {
        const int e_lane = e_tix & 63, e_wid = e_tix >> 6, e_wr = e_wid >> 2, e_wc = e_wid & 3, e_fr = e_lane & 15, e_fq = e_lane >> 4;
        _Pragma("unroll") for (int ai = 0; ai < 2; ++ai) _Pragma("unroll") for (int m = 0; m < 4; ++m) {
          const int rl = ai * HALF + e_wr * 64 + m * 16 + e_fr;
          const float sc = epi.row_scale(e_brow + rl);
          float ss = 0.f;
          _Pragma("unroll") for (int n = 0; n < 2; ++n) {
            const int cl = e_wc * 32 + n * 16 + e_fq * 4;
            const f32x4 c0 = epi.finalize(e_brow + rl, e_bcol + cl, acc[ai][0][m][n], sc, ss);
            const f32x4 c1 = epi.finalize(e_brow + rl, e_bcol + 128 + cl, acc[ai][1][m][n], sc, ss);
            const int lo = rl * LS + cl;
            *(uint2*)(L0 + lo) = make_uint2(pack2(c0[0], c0[1]), pack2(c0[2], c0[3]));
            *(uint2*)(L1 + lo) = make_uint2(pack2(c1[0], c1[1]), pack2(c1[2], c1[3]));
          }
          epi.row_end(e_brow + rl, ss, e_fq);
          if (m & 1) asm volatile("" ::: "memory");
        }
      }
      WAIT_L(0); BAR; asm volatile("" ::: "memory");
      {
        const int cg = e_tix & 15, r0 = e_tix >> 4;
        _Pragma("unroll 1") for (int it = 0; it < 8; ++it) {
          const int rl = it * 32 + r0;
          const uint4 x0 = *(const uint4*)(L0 + rl * LS + cg * 8), x1 = *(const uint4*)(L1 + rl * LS + cg * 8);
          u16* dst = epi.out + (size_t)(e_brow + rl) * epi.ldo + e_bcol + cg * 8;
          *(uint4*)dst = x0;
          *(uint4*)(dst + 128) = x1;
        }
      }
      WAIT_L(0); BAR; asm volatile("" ::: "memory");
    } else {
    for (int ai = 0; ai < 2; ++ai) for (int m = 0; m < 4; ++m) {
      const int row = brow + ai * HALF + wr * 64 + m * 16 + fr;
      const float sc = epi.row_scale(row);
      float ss = 0.f;
      for (int bj = 0; bj < 2; ++bj) for (int n = 0; n < 2; ++n)
        ss += epi(row, bcol + bj * HALF + wc * 32 + n * 16 + fq * 4, acc[ai][bj][m][n], sc);
      epi.row_end(row, ss, fq);
      if (m & 1) asm volatile("" ::: "memory");
    }
    }
  }
#undef SA
#undef SB
#undef STAGE
#undef LDA
#undef LDB
#undef MMA
}


template <int K>
__device__ __forceinline__ void gemm_tail_phase(int wv, const u16* __restrict__ A, const u16* __restrict__ Bt, float* lds, u16* __restrict__ hb, float* __restrict__ rss, const float* __restrict__ rin32_tail) {
  const int tix = tidx(wv);
  const int tid = tix, w = tid >> 6, lane = tid & 63, fr = lane & 15, fq = lane >> 4;
  for (int u = blockIdx.x; u < 256; u += gridDim.x) {
    const int tm = u >> 5, tn = u & 31;
    const u16* Ab = A + (size_t)(MP + tm * 64 + fr) * K + fq * 8;
    const u16* Bb = Bt + (size_t)(tn * 64 + fr) * K + fq * 8;
    f32x4 acc[4][4];
#pragma unroll
    for (int i = 0; i < 4; ++i)
#pragma unroll
      for (int j = 0; j < 4; ++j) acc[i][j] = f32x4{0.f, 0.f, 0.f, 0.f};
    const u16* Ab2 = A + (size_t)(MP + tm * 64 + fr) * K + fq * 16;
    const u16* Bb2 = Bt + (size_t)(tn * 64 + fr) * K + fq * 16;
#pragma unroll 1
    for (int ks = w; ks < K / 64; ks += 8) {
      bf16x8 a[4][2], b[4][2];
#pragma unroll
      for (int i = 0; i < 4; ++i) {
        a[i][0] = *(const bf16x8*)(Ab2 + (size_t)i * 16 * K + ks * 64);
        a[i][1] = *(const bf16x8*)(Ab2 + (size_t)i * 16 * K + ks * 64 + 8);
        b[i][0] = *(const bf16x8*)(Bb2 + (size_t)i * 16 * K + ks * 64);
        b[i][1] = *(const bf16x8*)(Bb2 + (size_t)i * 16 * K + ks * 64 + 8);
      }
#pragma unroll
      for (int mb = 0; mb < 4; ++mb)
#pragma unroll
        for (int nb = 0; nb < 4; ++nb) {
          acc[mb][nb] = __builtin_amdgcn_mfma_f32_16x16x32_bf16(b[nb][0], a[mb][0], acc[mb][nb], 0, 0, 0);
          acc[mb][nb] = __builtin_amdgcn_mfma_f32_16x16x32_bf16(b[nb][1], a[mb][1], acc[mb][nb], 0, 0, 0);
        }
    }
    __syncthreads();
#pragma unroll
    for (int mb = 0; mb < 4; ++mb)
#pragma unroll
      for (int nb = 0; nb < 4; ++nb) *(f32x4*)(lds + w * 4096 + (mb * 16 + fr) * 64 + nb * 16 + fq * 4) = acc[mb][nb];
    __syncthreads();
    const int e = tid * 8, row = e >> 6, col = e & 63;
    float4 s0 = make_float4(0.f, 0.f, 0.f, 0.f), s1 = s0;
#pragma unroll
    for (int ww = 0; ww < 8; ++ww) {
      float4 x0 = *(const float4*)(lds + ww * 4096 + e), x1 = *(const float4*)(lds + ww * 4096 + e + 4);
      s0.x += x0.x; s0.y += x0.y; s0.z += x0.z; s0.w += x0.w;
      s1.x += x1.x; s1.y += x1.y; s1.z += x1.z; s1.w += x1.w;
    }
    const int grow = MP + tm * 64 + row;
    u16* q = hb + (size_t)grow * D + tn * 64 + col;
    float r8[8];
    if (rin32_tail) {
      const float* rq_ = rin32_tail + (size_t)(tm * 64 + row) * D + tn * 64 + col;
      const float4 a0 = *(const float4*)rq_, a1 = *(const float4*)(rq_ + 4);
      r8[0] = a0.x; r8[1] = a0.y; r8[2] = a0.z; r8[3] = a0.w; r8[4] = a1.x; r8[5] = a1.y; r8[6] = a1.z; r8[7] = a1.w;
    } else ld8(q, r8);
    r8[0] += s0.x; r8[1] += s0.y; r8[2] += s0.z; r8[3] += s0.w; r8[4] += s1.x; r8[5] += s1.y; r8[6] += s1.z; r8[7] += s1.w;
    st8(q, r8);
    if (rss) {
      float ss = 0.f;
#pragma unroll
      for (int e2 = 0; e2 < 8; ++e2) ss += r8[e2] * r8[e2];
      ss += __shfl_xor(ss, 1, 64); ss += __shfl_xor(ss, 2, 64); ss += __shfl_xor(ss, 4, 64);
      if ((tid & 7) == 0) unsafeAtomicAdd(rss + grow, ss);
    }
  }
}

template <int MODE>
__device__ __forceinline__ void prep_range(int wv, const Params& p, int u0, int u1, int ustride, unsigned char* shm) {
  const int tix = tidx(wv);
  constexpr int K = (MODE == 2) ? 256 : 128;
  constexpr int V = (MODE == 0) ? 256 : (MODE == 1 ? 128 : 512);
  constexpr int H = (MODE == 1) ? 8 : 4;
  constexpr int LD = (MODE == 2) ? NINO_PAD : NINE;
  constexpr int NSEG = 4, TL = 16, KS = K + 8, VS = V + 8, NPASS = K / 128;
  constexpr int NQ = K / 64, NV = V / 64;
  constexpr bool PFV = false;
  const int tid = tix, seg = tid >> 7;
  const u16* proj = (const u16*)(p.ws + OFF_BIG);
  unsigned char* R = p.ws + OFF_R;
  u16* qin = (u16*)(R + (MODE == 0 ? R_QA : MODE == 1 ? R_QB : R_QC));
  u16* koT = (u16*)(R + (MODE == 0 ? R_KA : MODE == 1 ? R_KB : R_KC));
  u16* vT = (u16*)(R + (MODE == 0 ? R_VA : MODE == 1 ? R_VB : R_VC));
  u16* Pm = (u16*)(R + (MODE == 0 ? R_PA : MODE == 1 ? R_PB : R_PC));
  float* dL = (float*)(R + (MODE == 0 ? R_DA : MODE == 1 ? R_DB : R_DC));
  u16* qs = (u16*)shm;
  u16* ksm = qs + 64 * KS;
  float* segtot = (float*)(ksm + 64 * KS);
  float* gl = segtot + NSEG * K;
  u16* rq = (u16*)(gl + 64 * 16);
  u16* rk = rq + 64 * KS;
  u16* rv = PFV ? rk + 64 * KS : rq;
  typedef __attribute__((ext_vector_type(4))) unsigned u32x4_t;
  u32x4_t rqr[NQ], rkr[NQ], rvr[PFV ? NV : 1];
#define PREP_ISSUE(uu_) do { \
    const int c_i = (uu_) / H, h_i = (uu_) % H; \
    const int row0_i = (c_i < 128) ? (c_i >> 5) * 2048 + (c_i & 31) * 64 : MP + (c_i - 128) * 64; \
    const u16* prow_i = proj + (size_t)row0_i * LD; \
    const int cq_i = (MODE == 0) ? h_i * 128 : (MODE == 1 ? 3072 + h_i * 128 : h_i * 256); \
    const int ck_i = (MODE == 0) ? 512 + h_i * 128 : (MODE == 1 ? 4096 + h_i * 128 : 1024 + h_i * 256); \
    const int vc_i = (MODE == 0) ? 1024 + h_i * 256 : (MODE == 1 ? 5120 + h_i * 128 : 2048 + h_i * 512); \
    _Pragma("unroll") for (int i = 0; i < NQ; ++i) { \
      const int idx = tid + i * 512, r = idx / (K / 8), cc = idx % (K / 8); \
      rqr[i] = *(const u32x4_t*)(prow_i + (size_t)r * LD + cq_i + cc * 8); \
      rkr[i] = *(const u32x4_t*)(prow_i + (size_t)r * LD + ck_i + cc * 8); \
    } \
    if constexpr (PFV) { \
      _Pragma("unroll") for (int i = 0; i < NV; ++i) { \
        const int idx = tid + i * 512, r = idx / (V / 8), cc = idx % (V / 8); \
        rvr[i] = *(const u32x4_t*)(prow_i + (size_t)r * LD + vc_i + cc * 8); \
      } \
    } } while (0)
  if (u0 < u1) PREP_ISSUE(u0);
#pragma unroll 1
  for (int uu = u0; uu < u1; uu += ustride) {
  const int c = uu / H, h = uu % H;
  int row0, pos0;
  if (c < 128) { row0 = (c >> 5) * 2048 + (c & 31) * 64; pos0 = (c & 31) * 64; }
  else { row0 = MP + (c - 128) * 64; pos0 = 1024; }
  const size_t u = (size_t)c * H + h;
  const u16* prow = proj + (size_t)row0 * LD;
  const int vc0 = (MODE == 0) ? 1024 + h * 256 : (MODE == 1 ? 5120 + h * 128 : 2048 + h * 512);
  __syncthreads();
#pragma unroll
  for (int i = 0; i < NQ; ++i) {
    const int idx = tid + i * 512, r = idx / (K / 8), cc = idx % (K / 8);
    *(u32x4_t*)(rq + r * KS + cc * 8) = rqr[i];
    *(u32x4_t*)(rk + r * KS + cc * 8) = rkr[i];
  }
  if constexpr (PFV) {
#pragma unroll
    for (int i = 0; i < NV; ++i) {
      const int idx = tid + i * 512, r = idx / (V / 8), cc = idx % (V / 8);
      *(u32x4_t*)(rv + r * VS + cc * 8) = rvr[i];
    }
  }
  if (MODE == 2) {
    for (int i = tid; i < 64 * 2; i += 512) {
      const int r = i >> 1, hh = i & 1;
      uint4 g4 = *(const uint4*)(prow + (size_t)r * LD + 6144 + hh * 8);
      float* d = gl + r * 16 + hh * 8;
      d[0] = __uint_as_float(g4.x << 16); d[1] = __uint_as_float(g4.x & 0xffff0000u);
      d[2] = __uint_as_float(g4.y << 16); d[3] = __uint_as_float(g4.y & 0xffff0000u);
      d[4] = __uint_as_float(g4.z << 16); d[5] = __uint_as_float(g4.z & 0xffff0000u);
      d[6] = __uint_as_float(g4.w << 16); d[7] = __uint_as_float(g4.w & 0xffff0000u);
    }
  }
  if (uu + ustride < u1) PREP_ISSUE(uu + ustride);
  __builtin_amdgcn_sched_barrier(0);
  __syncthreads();
#pragma unroll 1
  for (int pass = 0; pass < NPASS; ++pass) {
  const int kk = pass * 128 + (tid & 127);
  float qv[TL], kv[TL], bc[TL];
  if (MODE == 0) {
    const int j = kk & 63;
    const float invr = exp2f(-(float)j * (13.287712379549449f / 64.f)) * 0.15915494309189535f;
    const float lgam = log1pf(-exp2f(-5.f - (float)h));
#pragma unroll
    for (int i = 0; i < TL; ++i) {
      const int l = seg * TL + i;
      float rev = (float)(pos0 + l) * invr;
      rev -= floorf(rev);
      const float sn = __builtin_amdgcn_sinf(rev), cs = __builtin_amdgcn_cosf(rev);
      const float q1 = bf2f(rq[l * KS + j]), q2 = bf2f(rq[l * KS + j + 64]), k1 = bf2f(rk[l * KS + j]), k2 = bf2f(rk[l * KS + j + 64]);
      const float qr = (kk < 64) ? q1 * cs - q2 * sn : q1 * sn + q2 * cs;
      const float kr = (kk < 64) ? k1 * cs - k2 * sn : k1 * sn + k2 * cs;
      qv[i] = qr; kv[i] = kr * 0.08838834764831845f;
      bc[i] = lgam;
    }
  } else if (MODE == 1) {
    const int ch = h * 128 + kk;
    const float* lbp = p.in[11];
    float e0 = __expf(lbp[ch]), e1 = __expf(lbp[1024 + ch]), e2 = __expf(lbp[2048 + ch]);
    const float lb = e0 / (e0 + e1 + e2);
#pragma unroll
    for (int i = 0; i < TL; ++i) {
      const int l = seg * TL + i;
      const float qx = bf2f(rq[l * KS + kk]), fx = bf2f(rk[l * KS + kk]);
      qv[i] = siluf_(qx) * 0.08838834764831845f;
      const float sg = sigmoidf_(fx);
      const float f = lb + (1.f - lb) * sg;
      kv[i] = (1.f - lb) * (1.f - sg);
      bc[i] = __logf(f);
    }
  } else {
    const int ch = h * 256 + kk;
    const float* w2 = p.in[14];
    float wvv[16];
#pragma unroll
    for (int r = 0; r < 16; ++r) wvv[r] = w2[r * 1024 + ch];
    const float bias = p.in[15][ch];
#pragma unroll
    for (int i = 0; i < TL; ++i) {
      const int l = seg * TL + i;
      qv[i] = bf2f(rq[l * KS + kk]) * 0.0625f;
      kv[i] = bf2f(rk[l * KS + kk]);
      float x = bias;
#pragma unroll
      for (int r = 0; r < 16; ++r) x += gl[l * 16 + r] * wvv[r];
      const float ls = fminf(x, 0.f) - log1pf(__expf(-fabsf(x)));
      bc[i] = ls * (1.f / 16.f);
    }
  }
#pragma unroll
  for (int i = 1; i < TL; ++i) bc[i] += bc[i - 1];
  segtot[seg * K + kk] = bc[TL - 1];
  __syncthreads();
  float pre = 0.f, bL = 0.f;
#pragma unroll
  for (int sg = 0; sg < NSEG; ++sg) { float t = segtot[sg * K + kk]; bL += t; if (sg < seg) pre += t; }
  const float eL = __expf(bL);
  if (seg == 0) dL[u * K + kk] = eL;
  unsigned kop[TL / 2];
#pragma unroll
  for (int i = 0; i < TL; i += 2) {
    float ko2[2];
#pragma unroll
    for (int e = 0; e < 2; ++e) {
      const int l = seg * TL + i + e;
      const float b = bc[i + e] + pre;
      const float eb = __expf(b), rb = __builtin_amdgcn_rcpf(eb);
      const float qi = qv[i + e] * eb;
      const float ki = kv[i + e] * rb;
      ko2[e] = ki * eL;
      const u16 qb = f2bf(qi);
      qs[l * KS + kk] = qb;
      ksm[l * KS + kk] = f2bf(ki);
    }
    kop[i / 2] = pack2(ko2[0], ko2[1]);
  }
  {
#pragma unroll
    for (int i = 0; i < TL / 8; ++i) {
      const int cc = seg * 2 + i;
      uint4* dst = (uint4*)(koT + u * K * 64 + ((((kk >> 4) * 2 + (cc >> 2)) * 64 + (cc & 3) * 16 + (kk & 15)) << 3));
      *dst = make_uint4(kop[i * 4 + 0], kop[i * 4 + 1], kop[i * 4 + 2], kop[i * 4 + 3]);
    }
  }
  }
  __syncthreads();
  for (int i = tid; i < 64 * (K / 8); i += 512) {
    const int r = i / (K / 8), cc = i % (K / 8);
    *(uint4*)(qin + u * 64 * K + ((((r >> 4) * (K / 32) + (cc >> 2)) * 64 + (cc & 3) * 16 + (r & 15)) << 3)) = *(const uint4*)(qs + r * KS + cc * 8);
  }
  {
    const int w = tid >> 6, lane = tid & 63, fr = lane & 15, fq = lane >> 4;
#pragma unroll 1
    for (int bi = 0; bi < 2; ++bi) {
      const int blk = w + bi * 8, lb = blk >> 2, sb = blk & 3;
      f32x4 acc = {0.f, 0.f, 0.f, 0.f};
      if (sb <= lb) {
#pragma unroll
        for (int kst = 0; kst < K / 32; ++kst) {
          bf16x8 a = *(const bf16x8*)(ksm + (sb * 16 + fr) * KS + kst * 32 + fq * 8);
          bf16x8 b = *(const bf16x8*)(qs + (lb * 16 + fr) * KS + kst * 32 + fq * 8);
          acc = __builtin_amdgcn_mfma_f32_16x16x32_bf16(a, b, acc, 0, 0, 0);
        }
      }
      const int l = lb * 16 + fr, s0 = sb * 16 + fq * 4;
      float v0 = (s0 + 0 <= l) ? acc[0] : 0.f, v1 = (s0 + 1 <= l) ? acc[1] : 0.f;
      float v2 = (s0 + 2 <= l) ? acc[2] : 0.f, v3 = (s0 + 3 <= l) ? acc[3] : 0.f;
      if (lb >= 2 || sb < 2) *(uint2*)(Pm + u * 4096 + ((((lb * 2 + (s0 >> 5)) * 64 + ((s0 & 31) >> 3) * 16 + fr) << 3) + (s0 & 7))) = make_uint2(pack2(v0, v1), pack2(v2, v3));
    }
  }
  }
}

template <int K, int V>
__device__ __forceinline__ void seq_unit(int wv, const u16* __restrict__ qin, const u16* __restrict__ koT, const u16* __restrict__ Pm, const u16* __restrict__ vsrc, int vld,
                         const float* __restrict__ dL, int H, int c0, int nch, int h, int vs,
                         const float* __restrict__ s0, float* __restrict__ sout, u16* __restrict__ o, int row0, int ocol, unsigned char* shm) {
  const int tix = tidx(wv);
  constexpr int NKB = K / 128, SST = K + 8;
  u16* ST = (u16*)shm;
  const int tid = tix, w = tid >> 6, lane = tid & 63, fr = lane & 15, fq = lane >> 4;
  f32x4 accS[NKB][2];
  __syncthreads();
#pragma unroll
  for (int kb = 0; kb < NKB; ++kb)
#pragma unroll
    for (int vb = 0; vb < 2; ++vb) {
      const int k = (w * NKB + kb) * 16 + fq * 4, vcol = vb * 16 + fr;
#pragma unroll
      for (int j = 0; j < 4; ++j) accS[kb][vb][j] = s0 ? s0[(size_t)(k + j) * V + vs * 32 + vcol] : 0.f;
      *(uint2*)(ST + vcol * SST + k) = make_uint2(pack2(accS[kb][vb][0], accS[kb][vb][1]), pack2(accS[kb][vb][2], accS[kb][vb][3]));
    }
  constexpr int VTS = 72, LOS = 40;
  u16* VT = ST + 2 * 32 * SST;
  u16* LO = VT + 2 * 32 * VTS;
  const int v_s = (tid >> 2) & 63, v_p = tid & 3;
  const u16* vrow = vsrc + (size_t)v_s * vld + v_p * 8;
  u32x4_t vreg = {0u, 0u, 0u, 0u};
  if (tid < 256) {
    vreg = *(const u32x4_t*)vrow;
#pragma unroll
    for (int j = 0; j < 4; ++j) {
      VT[(v_p * 8 + 2 * j) * VTS + v_s] = (u16)(vreg[j] & 0xffffu);
      VT[(v_p * 8 + 2 * j + 1) * VTS + v_s] = (u16)(vreg[j] >> 16);
    }
  }
  __syncthreads();
  int cur = 0;
  const int lb = w >> 1, ovb = w & 1;
  struct FragsO { bf16x8 op[2], oq[K / 32]; };
  struct FragsS { bf16x8 ka[NKB][2]; float4 d[NKB]; };
  auto load_o = [&](int ci, FragsO& f) {
    const size_t u = (size_t)(c0 + ci) * H + h;
    const u16* Pu = Pm + u * 4096;
    const u16* qu = qin + u * 64 * K;
#pragma unroll
    for (int ss = 0; ss < 2; ++ss) { if (ss == 0 || lb >= 2) f.op[ss] = *(const bf16x8*)(Pu + (((lb * 2 + ss) * 64 + lane) << 3)); else f.op[ss] = bf16x8{0, 0, 0, 0, 0, 0, 0, 0}; }
#pragma unroll
    for (int kst = 0; kst < K / 32; ++kst) f.oq[kst] = *(const bf16x8*)(qu + (((lb * (K / 32) + kst) * 64 + lane) << 3));
  };
  auto load_s = [&](int ci, FragsS& f) {
    const size_t u = (size_t)(c0 + ci) * H + h;
    const u16* ku = koT + u * K * 64;
    const float* du = dL + u * K;
#pragma unroll
    for (int kb = 0; kb < NKB; ++kb) {
      const int kbase = (w * NKB + kb) * 16;
      f.d[kb] = *(const float4*)(du + kbase + fq * 4);
      f.ka[kb][0] = *(const bf16x8*)(ku + ((((w * NKB + kb) * 2 + 0) * 64 + lane) << 3));
      f.ka[kb][1] = *(const bf16x8*)(ku + ((((w * NKB + kb) * 2 + 1) * 64 + lane) << 3));
    }
  };
  FragsO fo;
  FragsS f0;
  load_o(0, fo);
  load_s(0, f0);
  for (int ci = 0; ci < nch; ++ci) {
    const int cn = ci + 1 < nch ? ci + 1 : ci;
    FragsO fo1;
    FragsS f1;
    load_o(cn, fo1);
    load_s(cn, f1);
    if (tid < 256) vreg = *(const u32x4_t*)(vrow + (size_t)cn * 64 * vld);
    __builtin_amdgcn_sched_barrier(0);
    const u16* STc = ST + cur * 32 * SST;
    u16* STn = ST + (cur ^ 1) * 32 * SST;
    const u16* VTc = VT + cur * 32 * VTS;
    u16* VTn = VT + (cur ^ 1) * 32 * VTS;
    bf16x8 vf[2][2];
#pragma unroll
    for (int vb = 0; vb < 2; ++vb)
#pragma unroll
      for (int ss = 0; ss < 2; ++ss) vf[vb][ss] = *(const bf16x8*)(VTc + (vb * 16 + fr) * VTS + ss * 32 + fq * 8);
    if (ci > 0 && tid < 256) {
      const uint4 ov = *(const uint4*)(LO + ((ci - 1) & 1) * 64 * LOS + v_s * LOS + v_p * 8);
      *(uint4*)(o + (size_t)(row0 + (ci - 1) * 64 + v_s) * D + ocol + vs * 32 + v_p * 8) = ov;
    }
    f32x4 ao = {0.f, 0.f, 0.f, 0.f};
#pragma unroll
    for (int ss = 0; ss < 2; ++ss) {
      if (ss == 0 || lb >= 2) {
        bf16x8 a = *(const bf16x8*)(VTc + (ovb * 16 + fr) * VTS + ss * 32 + fq * 8);
        ao = __builtin_amdgcn_mfma_f32_16x16x32_bf16(a, fo.op[ss], ao, 0, 0, 0);
      }
    }
#pragma unroll
    for (int kst = 0; kst < K / 32; ++kst) {
      bf16x8 a = *(const bf16x8*)(STc + (ovb * 16 + fr) * SST + kst * 32 + fq * 8);
      ao = __builtin_amdgcn_mfma_f32_16x16x32_bf16(a, fo.oq[kst], ao, 0, 0, 0);
    }
    *(uint2*)(LO + (ci & 1) * 64 * LOS + (lb * 16 + fr) * LOS + ovb * 16 + fq * 4) = make_uint2(pack2(ao[0], ao[1]), pack2(ao[2], ao[3]));
#pragma unroll
    for (int kb = 0; kb < NKB; ++kb) {
      const int kbase = (w * NKB + kb) * 16;
      const float4 d4 = f0.d[kb];
#pragma unroll
      for (int vb = 0; vb < 2; ++vb) {
        f32x4 sv = accS[kb][vb];
        sv[0] *= d4.x; sv[1] *= d4.y; sv[2] *= d4.z; sv[3] *= d4.w;
        sv = __builtin_amdgcn_mfma_f32_16x16x32_bf16(f0.ka[kb][0], vf[vb][0], sv, 0, 0, 0);
        sv = __builtin_amdgcn_mfma_f32_16x16x32_bf16(f0.ka[kb][1], vf[vb][1], sv, 0, 0, 0);
        accS[kb][vb] = sv;
        *(uint2*)(STn + (vb * 16 + fr) * SST + kbase + fq * 4) = make_uint2(pack2(sv[0], sv[1]), pack2(sv[2], sv[3]));
      }
    }
    if (tid < 256) {
#pragma unroll
      for (int j = 0; j < 4; ++j) {
        VTn[(v_p * 8 + 2 * j) * VTS + v_s] = (u16)(vreg[j] & 0xffffu);
        VTn[(v_p * 8 + 2 * j + 1) * VTS + v_s] = (u16)(vreg[j] >> 16);
      }
    }
    asm volatile("s_waitcnt lgkmcnt(0)" ::: "memory");
    __builtin_amdgcn_s_barrier();
    asm volatile("" ::: "memory");
    cur ^= 1;
    f0 = f1;
    fo = fo1;
  }
  if (tid < 256) {
    const uint4 ov = *(const uint4*)(LO + ((nch - 1) & 1) * 64 * LOS + v_s * LOS + v_p * 8);
    *(uint4*)(o + (size_t)(row0 + (nch - 1) * 64 + v_s) * D + ocol + vs * 32 + v_p * 8) = ov;
  }
#pragma unroll
  for (int kb = 0; kb < NKB; ++kb)
#pragma unroll
    for (int vb = 0; vb < 2; ++vb) {
      const int k = (w * NKB + kb) * 16 + fq * 4, vcol = vb * 16 + fr;
#pragma unroll
      for (int j = 0; j < 4; ++j) sout[(size_t)(k + j) * V + vs * 32 + vcol] = accS[kb][vb][j];
    }
}

__device__ __forceinline__ void seq_even_phase(int wv, const Params& p, unsigned char* shm) {
  unsigned char* R = p.ws + OFF_R;
  u16* o = (u16*)(p.ws + OFF_H);
  for (int u = blockIdx.x; u < 768; u += gridDim.x) {
    if (u < 256) {
      const int x = u & 7, y = u >> 3;
      if (y < 16) {
        const int g = x * 2 + (y >> 3), b = g >> 2, h = g & 3, vs = y & 7;
        seq_unit<128, 256>(wv, (u16*)(R + R_QA), (u16*)(R + R_KA), (u16*)(R + R_PA), (const u16*)(p.ws + OFF_BIG) + (size_t)(b * 2048) * NINE + 1024 + h * 256 + vs * 32, NINE, (float*)(R + R_DA), 4, b * 32, 32, h, vs,
                           nullptr, p.out + O_RETP + (size_t)(b * 4 + h) * 128 * 256, o, b * 2048, h * 256, shm);
      } else {
        const int yy = y - 16, g = x * 4 + (yy >> 2), b = g >> 3, h = g & 7, vs = yy & 3;
        seq_unit<128, 128>(wv, (u16*)(R + R_QB), (u16*)(R + R_KB), (u16*)(R + R_PB), (const u16*)(p.ws + OFF_BIG) + (size_t)(b * 2048) * NINE + 5120 + h * 128 + vs * 32, NINE, (float*)(R + R_DB), 8, b * 32, 32, h, vs,
                           nullptr, p.out + O_HGP + (size_t)(b * 8 + h) * 128 * 128, o, b * 2048, 1024 + h * 128, shm);
      }
    } else if (u < 512) {
      int x = u - 256, b = x >> 5, h = (x >> 3) & 3, vs = x & 7;
      seq_unit<128, 256>(wv, (u16*)(R + R_QA), (u16*)(R + R_KA), (u16*)(R + R_PA), (const u16*)(p.ws + OFF_BIG) + (size_t)(MP + b * 64) * NINE + 1024 + h * 256 + vs * 32, NINE, (float*)(R + R_DA), 4, 128 + b, 1, h, vs,
                         p.in[2] + (size_t)(b * 4 + h) * 128 * 256, p.out + O_RETS + (size_t)(b * 4 + h) * 128 * 256, o, MP + b * 64, h * 256, shm);
    } else {
      int x = u - 512, b = x >> 5, h = (x >> 2) & 7, vs = x & 3;
      seq_unit<128, 128>(wv, (u16*)(R + R_QB), (u16*)(R + R_KB), (u16*)(R + R_PB), (const u16*)(p.ws + OFF_BIG) + (size_t)(MP + b * 64) * NINE + 5120 + h * 128 + vs * 32, NINE, (float*)(R + R_DB), 8, 128 + b, 1, h, vs,
                         p.in[3] + (size_t)(b * 8 + h) * 128 * 128, p.out + O_HGS + (size_t)(b * 8 + h) * 128 * 128, o, MP + b * 64, 1024 + h * 128, shm);
    }
  }
}
__device__ __forceinline__ void seq_odd_phase(int wv, const Params& p, unsigned char* shm) {
  unsigned char* R = p.ws + OFF_R;
  u16* o = (u16*)(p.ws + OFF_H);
  for (int u = blockIdx.x; u < 768; u += gridDim.x) {
    if (u < 256) {
      const int x = u & 7, y = u >> 3, g = x * 2 + (y >> 4), b = g >> 2, h = g & 3, vs = y & 15;
      seq_unit<256, 512>(wv, (u16*)(R + R_QC), (u16*)(R + R_KC), (u16*)(R + R_PC), (const u16*)(p.ws + OFF_BIG) + (size_t)(b * 2048) * NINO_PAD + 2048 + h * 512 + vs * 32, NINO_PAD, (float*)(R + R_DC), 4, b * 32, 32, h, vs,
                         nullptr, p.out + O_GLP + (size_t)(b * 4 + h) * 256 * 512, o, b * 2048, h * 512, shm);
    } else {
      int x = u - 256, b = x >> 6, h = (x >> 4) & 3, vs = x & 15;
      seq_unit<256, 512>(wv, (u16*)(R + R_QC), (u16*)(R + R_KC), (u16*)(R + R_PC), (const u16*)(p.ws + OFF_BIG) + (size_t)(MP + b * 64) * NINO_PAD + 2048 + h * 512 + vs * 32, NINO_PAD, (float*)(R + R_DC), 4, 128 + b, 1, h, vs,
                         p.in[4] + (size_t)(b * 4 + h) * 256 * 512, p.out + O_GLS + (size_t)(b * 4 + h) * 256 * 512, o, MP + b * 64, h * 512, shm);
    }
  }
}

__device__ __forceinline__ void up8(u32x4_t v, float* f) {
  f[0] = __uint_as_float(v[0] << 16); f[1] = __uint_as_float(v[0] & 0xffff0000u);
  f[2] = __uint_as_float(v[1] << 16); f[3] = __uint_as_float(v[1] & 0xffff0000u);
  f[4] = __uint_as_float(v[2] << 16); f[5] = __uint_as_float(v[2] & 0xffff0000u);
  f[6] = __uint_as_float(v[3] << 16); f[7] = __uint_as_float(v[3] & 0xffff0000u);
}
template <int ODD>
__device__ __forceinline__ void post_phase(int wv, const Params& p) {
  const int tix = tidx(wv);
  const int lane = tix & 63, gw = blockIdx.x * 8 + (tix >> 6), nw = gridDim.x * 8;
  const u16* o = (const u16*)(p.ws + OFF_H);
  const u16* proj = (const u16*)(p.ws + OFF_BIG);
  u16* ao = (u16*)(p.ws + OFF_R);
#define POST_LOAD(xr_, gr_, row_) do { const int r_ = (row_); \
    _Pragma("unroll") for (int i = 0; i < 4; ++i) { const int col_ = i * 512 + lane * 8; \
      xr_[i] = *(const u32x4_t*)(o + (size_t)r_ * D + col_); \
      gr_[i] = *(const u32x4_t*)(proj + (size_t)r_ * (ODD ? NINO_PAD : NINE) + (ODD ? 4096 + col_ : (i < 2 ? 2048 + col_ : 6144 + (col_ - 1024)))); } } while (0)
  u32x4_t xr[4], gr[4];
  if (gw < MT) POST_LOAD(xr, gr, gw);
#pragma unroll 1
  for (int row = gw; row < MT; row += nw) {
    u32x4_t xn[4], gn4[4];
    if (row + nw < MT) POST_LOAD(xn, gn4, row + nw);
    else {
#pragma unroll
      for (int i = 0; i < 4; ++i) { xn[i] = xr[i]; gn4[i] = gr[i]; }
    }
    __builtin_amdgcn_sched_barrier(0);
#pragma unroll
    for (int i = 0; i < 4; ++i) {
      const int col = i * 512 + lane * 8;
      float x[8], g[8], y[8];
      up8(xr[i], x);
      up8(gr[i], g);
      if (ODD) {
        float ss = 0.f;
#pragma unroll
        for (int e = 0; e < 8; ++e) ss += x[e] * x[e];
#pragma unroll
        for (int off = 32; off > 0; off >>= 1) ss += __shfl_xor(ss, off, 64);
        const float rs = rsqrtf(ss * (1.f / 512.f) + EPS);
        const float* gn = p.in[16] + lane * 8;
#pragma unroll
        for (int e = 0; e < 8; ++e) y[e] = x[e] * rs * gn[e] * siluf_(g[e]);
      } else if (i < 2) {
        float s1 = 0.f;
#pragma unroll
        for (int e = 0; e < 8; ++e) s1 += x[e];
#pragma unroll
        for (int off = 16; off > 0; off >>= 1) s1 += __shfl_xor(s1, off, 64);
        const float mu = s1 * (1.f / 256.f);
        float s2 = 0.f;
#pragma unroll
        for (int e = 0; e < 8; ++e) { float dlt = x[e] - mu; s2 += dlt * dlt; }
#pragma unroll
        for (int off = 16; off > 0; off >>= 1) s2 += __shfl_xor(s2, off, 64);
        const float rs = rsqrtf(s2 * (1.f / 256.f) + EPS);
#pragma unroll
        for (int e = 0; e < 8; ++e) y[e] = (x[e] - mu) * rs * siluf_(g[e]);
      } else {
        float ss = 0.f;
#pragma unroll
        for (int e = 0; e < 8; ++e) ss += x[e] * x[e];
#pragma unroll
        for (int off = 8; off > 0; off >>= 1) ss += __shfl_xor(ss, off, 64);
        const float rs = rsqrtf(ss * (1.f / 128.f) + EPS);
        const float* gn = p.in[12] + (lane & 15) * 8;
#pragma unroll
        for (int e = 0; e < 8; ++e) y[e] = x[e] * rs * gn[e] * siluf_(g[e]);
      }
      st8(ao + (size_t)row * D + col, y);
    }
#pragma unroll
    for (int i = 0; i < 4; ++i) { xr[i] = xn[i]; gr[i] = gn4[i]; }
  }
#undef POST_LOAD
}


__device__ __forceinline__ void final_norm_phase(int wv, const Params& p) {
  const int tix = tidx(wv);
  const int lane = tix & 63, gw = blockIdx.x * 8 + (tix >> 6), nw = gridDim.x * 8;
  const u16* hb = (const u16*)(p.ws + OFF_HN);
  const float* w = p.in[8];
  u32x4_t v[4];
  if (gw < MT) {
#pragma unroll
    for (int i = 0; i < 4; ++i) v[i] = *(const u32x4_t*)(hb + (size_t)gw * D + i * 512 + lane * 8);
  }
#pragma unroll 1
  for (int row = gw; row < MT; row += nw) {
    u32x4_t nx[4];
    const int nrow = row + nw < MT ? row + nw : row;
#pragma unroll
    for (int i = 0; i < 4; ++i) nx[i] = *(const u32x4_t*)(hb + (size_t)nrow * D + i * 512 + lane * 8);
    __builtin_amdgcn_sched_barrier(0);
    float x[4][8];
    float ss = 0.f;
#pragma unroll
    for (int i = 0; i < 4; ++i) {
      up8(v[i], x[i]);
#pragma unroll
      for (int e = 0; e < 8; ++e) ss += x[i][e] * x[i][e];
    }
#pragma unroll
    for (int o = 32; o > 0; o >>= 1) ss += __shfl_xor(ss, o, 64);
    const float rs = rsqrtf(ss * (1.f / D) + EPS);
    float* dst = (row < MP) ? p.out + O_YP + (size_t)row * D : p.out + O_YS + (size_t)(row - MP) * D;
#pragma unroll
    for (int i = 0; i < 4; ++i) {
      const int col = i * 512 + lane * 8;
      const float4 w0 = *(const float4*)(w + col), w1 = *(const float4*)(w + col + 4);
      *(float4*)(dst + col) = make_float4(x[i][0] * rs * w0.x, x[i][1] * rs * w0.y, x[i][2] * rs * w0.z, x[i][3] * rs * w0.w);
      *(float4*)(dst + col + 4) = make_float4(x[i][4] * rs * w1.x, x[i][5] * rs * w1.y, x[i][6] * rs * w1.z, x[i][7] * rs * w1.w);
    }
#pragma unroll
    for (int i = 0; i < 4; ++i) v[i] = nx[i];
  }
}

__device__ __forceinline__ void gate_phase(int wv, const Params& p, int layer) {
  const int tix = tidx(wv);
  const u16* au = (const u16*)(p.ws + OFF_BIG);
  u16* gg = (u16*)(p.ws + OFF_R);
  const float* cw = p.in[19] + (size_t)layer * 3 * DFF;
  const float* cb = p.in[20] + (size_t)layer * DFF;
  const float* cache = p.in[5] + (size_t)layer * 8 * 2 * DFF;
  const int nitems = (MT / 16) * (DFF / 8);
  for (int it = blockIdx.x * 512 + tix; it < nitems; it += gridDim.x * 512) {
    const int cg8 = it % (DFF / 8), rb = it / (DFF / 8), c0 = cg8 * 8, r0 = rb * 16;
    float w0[8], w1[8], w2[8], bb[8], am2[8], am1[8];
#pragma unroll
    for (int e = 0; e < 8; ++e) { w0[e] = cw[c0 + e]; w1[e] = cw[DFF + c0 + e]; w2[e] = cw[2 * DFF + c0 + e]; bb[e] = cb[c0 + e]; }
    int t0, T, b; bool samp = r0 >= MP;
    if (!samp) { b = r0 >> 11; t0 = r0 & 2047; T = 2048; } else { b = (r0 - MP) >> 6; t0 = (r0 - MP) & 63; T = 64; }
    if (t0 == 0) {
      if (samp) {
#pragma unroll
        for (int e = 0; e < 8; ++e) { am2[e] = cache[(size_t)(b * 2 + 0) * DFF + c0 + e]; am1[e] = cache[(size_t)(b * 2 + 1) * DFF + c0 + e]; }
      } else {
#pragma unroll
        for (int e = 0; e < 8; ++e) { am2[e] = 0.f; am1[e] = 0.f; }
      }
    } else {
      ld8(au + (size_t)(r0 - 2) * NUP + c0, am2);
      ld8(au + (size_t)(r0 - 1) * NUP + c0, am1);
    }
#pragma unroll 4
    for (int i = 0; i < 16; ++i) {
      float a[8], uu[8], y[8];
      ld8(au + (size_t)(r0 + i) * NUP + c0, a);
      ld8(au + (size_t)(r0 + i) * NUP + DFF + c0, uu);
#pragma unroll
      for (int e = 0; e < 8; ++e) {
        float cv = bb[e] + w0[e] * am2[e] + w1[e] * am1[e] + w2[e] * a[e];
        y[e] = siluf_(cv) * uu[e];
        am2[e] = am1[e]; am1[e] = a[e];
      }
      st8(gg + (size_t)(r0 + i) * DFF + c0, y);
    }
    if (t0 + 16 == T) {
      float* dst = samp ? p.out + O_CVS + (size_t)(layer * 8 + b) * 2 * DFF : p.out + O_CVP + (size_t)(layer * 4 + b) * 2 * DFF;
#pragma unroll
      for (int e = 0; e < 8; ++e) { dst[c0 + e] = am2[e]; dst[DFF + c0 + e] = am1[e]; }
    }
  }
}


__device__ __forceinline__ void gate_fixup(int wv, const Params& p, int layer) {
  const int tix = tidx(wv);
  const u16* side = (const u16*)(p.ws + OFF_SIDE);
  u16* gg = (u16*)(p.ws + OFF_R);
  const float* cw = p.in[19] + (size_t)layer * 3 * DFF;
  const float* cb = p.in[20] + (size_t)layer * DFF;
  for (int vw = blockIdx.x; vw < (MP / BM) * (D / BM); vw += gridDim.x) {
    int pm, pn;
    tile_coords(vw, MP / BM, D / BM, pm, pn);
    if ((pm & 7) == 0) continue;
    for (int c8 = tix; c8 < DFF / 8; c8 += 512) {
      const int c = c8 * 8;
      float a0[8], a1[8], u0[8], u1[8], q2[8], q1[8], y0[8], y1[8];
      ld8(side + (size_t)(pm * 2 + 0) * DFF + c, a0);
      ld8(side + (size_t)(pm * 2 + 1) * DFF + c, a1);
      ld8(side + SZ_SIDE1 / 2 + (size_t)(pm * 2 + 0) * DFF + c, u0);
      ld8(side + SZ_SIDE1 / 2 + (size_t)(pm * 2 + 1) * DFF + c, u1);
      ld8(side + SZ_SIDE1 + (size_t)((pm - 1) * 2 + 0) * DFF + c, q2);
      ld8(side + SZ_SIDE1 + (size_t)((pm - 1) * 2 + 1) * DFF + c, q1);
#pragma unroll
      for (int e = 0; e < 8; ++e) {
        const float w0 = cw[c + e], w1 = cw[DFF + c + e], w2 = cw[2 * DFF + c + e], bb = cb[c + e];
        y0[e] = siluf_(bb + w0 * q2[e] + w1 * q1[e] + w2 * a0[e]) * u0[e];
        y1[e] = siluf_(bb + w0 * q1[e] + w1 * a0[e] + w2 * a1[e]) * u1[e];
      }
      st8(gg + (size_t)(pm * 256 + 0) * DFF + c, y0);
      st8(gg + (size_t)(pm * 256 + 1) * DFF + c, y1);
    }
  }
  asm volatile("s_waitcnt vmcnt(0)" ::: "memory");
  __syncthreads();
}

#define XB_TMO      128
#define XB_XCNT(j)  (256  + 64 * (j))
#define XB_XSUB(j)  (1280 + 64 * (j))
#define XB_XGEN(j)  (2304 + 64 * (j))
#define XB_TOP      3328
#define XB_TOPGEN   3392
#define XCD_BAR_WORDS 3456
#define XB_SPIN_CAP (1u << 22)
#define LAS __attribute__((address_space(3)))
__device__ __forceinline__ unsigned xb_ld(unsigned* p)              { return __hip_atomic_load(p, __ATOMIC_RELAXED, __HIP_MEMORY_SCOPE_AGENT); }
__device__ __forceinline__ unsigned xb_add(unsigned* p, unsigned v) { return __hip_atomic_fetch_add(p, v, __ATOMIC_RELAXED, __HIP_MEMORY_SCOPE_AGENT); }
__device__ __forceinline__ unsigned xb_xcc_id() { return (unsigned)__builtin_amdgcn_s_getreg((3 << 11) | 20) & 0xFu; }
#define XB_SPIN(cond, bar) do { unsigned _sp = 0; while (cond) { __builtin_amdgcn_s_sleep(1); \
    if ((++_sp & 255u) == 0u) { if (xb_ld(&(bar)[XB_TMO])) break; if (_sp > XB_SPIN_CAP) { atomicAdd(&(bar)[XB_TMO], 1u); break; } } } } while (0)
struct XcdBarrier { unsigned* bar; unsigned x; volatile LAS unsigned* st; };
__device__ __forceinline__ XcdBarrier xcd_barrier_post(int wv, unsigned* bar, volatile LAS unsigned* st) {
  XcdBarrier b; b.bar = bar; b.x = xb_xcc_id(); b.st = st;
  if (tidx(wv) == 0) (void)xb_add(&bar[XB_XCNT(b.x)], 1u);
  return b;
}
__device__ __forceinline__ void xcd_barrier_complete(unsigned* bar, unsigned x, unsigned& nloc, unsigned& nx) {
  const unsigned G = gridDim.x * gridDim.y * gridDim.z;
  unsigned sum, cnt, mine, sp = 0u;
  for (;;) {
    sum = 0u; cnt = 0u; mine = 0u;
#pragma unroll
    for (unsigned j = 0; j < 16; ++j) { const unsigned c = xb_ld(&bar[XB_XCNT(j)]); sum += c; cnt += (c > 0u) ? 1u : 0u; mine = (j == x) ? c : mine; }
    if (sum == G) break;
    __builtin_amdgcn_s_sleep(1);
    if ((++sp & 255u) == 0u) { if (xb_ld(&bar[XB_TMO])) break; if (sp > XB_SPIN_CAP) { atomicAdd(&bar[XB_TMO], 1u); break; } }
  }
  nloc = mine > 0u ? mine : 1u; nx = cnt > 0u ? cnt : 1u;
}
__device__ __forceinline__ void xcd_barrier(int wv, const XcdBarrier& b) {
  asm volatile("s_waitcnt vmcnt(0)" ::: "memory");
  __syncthreads();
  if (tidx(wv) == 0) {
    unsigned* bar = b.bar;
    __builtin_amdgcn_s_waitcnt(0);
    unsigned nloc = b.st[0], nx = b.st[1];
    if (nloc == 0u) { xcd_barrier_complete(bar, b.x, nloc, nx); b.st[0] = nloc; b.st[1] = nx; }
    const unsigned old = xb_add(&bar[XB_XSUB(b.x)], 1u);
    const unsigned gen = old / nloc;
    if (old + 1u == (gen + 1u) * nloc) {
      __builtin_amdgcn_fence(__ATOMIC_RELEASE, "agent");
      asm volatile("s_waitcnt vmcnt(0)" ::: "memory");
      const unsigned og = xb_add(&bar[XB_TOP], 1u);
      const unsigned tg = og / nx;
      if (og + 1u == (tg + 1u) * nx) xb_add(&bar[XB_TOPGEN], 1u);
      else XB_SPIN(xb_ld(&bar[XB_TOPGEN]) == tg, bar);
      __builtin_amdgcn_fence(__ATOMIC_ACQUIRE, "agent");
      xb_add(&bar[XB_XGEN(b.x)], 1u);
      asm volatile("s_waitcnt vmcnt(0)" ::: "memory");
    } else {
      XB_SPIN(xb_ld(&bar[XB_XGEN(b.x)]) == gen, bar);
      __builtin_amdgcn_fence(__ATOMIC_ACQUIRE, "agent");
      asm volatile("s_waitcnt vmcnt(0)" ::: "memory");
    }
  }
  __syncthreads();
}

constexpr int NPHASE = 21;
#ifndef PHMASK
#define PHMASK 0xFFFFFFFFu
#endif
#define PH_ON(k) (((PHMASK) >> (k)) & 1u)
constexpr int LDS_BYTES = 147456;

typedef const __attribute__((address_space(4))) Params* KParamsPtr;
#ifndef XSYNC
#define XSYNC 0
#endif
#ifndef DUPMASK
#define DUPMASK 0u
#endif
#define DUP_ON(k) (((DUPMASK) >> (k)) & 1u)
__device__ __forceinline__ bool ph_in(KParamsPtr& kp, int k) { asm volatile("" : "+s"(kp)); return kp->ph_lo <= k && k < kp->ph_hi; }
#define PH_IN(k) ph_in(kp, (k))
#define PHASE(k, ...) if (PH_IN(k)) { if (PH_ON(k)) { for (int rep = 0; rep < 1 + (int)DUP_ON(k); ++rep) { asm volatile("" : "+s"(kp)); Params p; __builtin_memcpy(&p, kp, sizeof(Params)); unsigned char* ws = p.ws; __VA_ARGS__ } } \
    asm volatile("" : "+s"(kp)); \
    if (kp->coop && (k) + 1 < kp->ph_hi) { XcdBarrier xb; xb.bar = (unsigned*)(kp->ws + OFF_BAR); xb.x = xb_xcc_id(); xb.st = (volatile LAS unsigned*)&xb_words; xcd_barrier(wv, xb); if (XSYNC) xcd_barrier(wv, xb); } }
#define PHASE_X(k, ...) if (PH_IN(k)) { asm volatile("" : "+s"(kp)); Params p; __builtin_memcpy(&p, kp, sizeof(Params)); unsigned char* ws = p.ws; __VA_ARGS__ }
#define GEMM_ACC(k, Aoff, Woff, KK, RSSP, FIXL, RINP, RINS) PHASE(k, { float* rssp = (RSSP); if ((FIXL) >= 0) gate_fixup(wv, p, FIXL); \
    gemm_phase<MP, D, KK, 0>(wv, (const u16*)(ws + Aoff), (const u16*)(ws + Woff), EpiAccum{(u16*)(ws + OFF_HN), rssp, (RINP)}, (u16*)shm); \
    gemm_tail_phase<KK>(wv, (const u16*)(ws + Aoff), (const u16*)(ws + Woff), (float*)shm, (u16*)(ws + OFF_HN), rssp, (RINS)); })

__global__ void __launch_bounds__(512) fwd_kernel(Params p_) {
  extern __shared__ __attribute__((aligned(16))) unsigned char shm[];
  cg::grid_group grid = cg::this_grid();
  KParamsPtr kp = (KParamsPtr)__builtin_amdgcn_kernarg_segment_ptr();
  const int wv = __builtin_amdgcn_readfirstlane((int)(threadIdx.x >> 6));
  __shared__ uint4 xb_words;
  if (tidx(wv) == 0) xb_words = make_uint4(0u, 0u, 0u, 0u);
  __syncthreads();
  if (kp->coop == 2) grid.sync();
  (void)xcd_barrier_post(wv, (unsigned*)(kp->ws + OFF_BAR), (volatile LAS unsigned*)&xb_words);
  PHASE(0,
        convert_w(wv, p.in[9], (u16*)(ws + OFF_WINE), D, NINE, NINE, (u16*)shm);
        convert_w(wv, p.in[10], (u16*)(ws + OFF_WOUTE), D, D, D, (u16*)shm);
        convert_w(wv, p.in[13], (u16*)(ws + OFF_WINO), D, NINO, NINO_PAD, (u16*)shm, p.in[6] + D);
        convert_w(wv, p.in[17], (u16*)(ws + OFF_WOUTO), D, D, D, (u16*)shm);
        convert_w(wv, p.in[18], (u16*)(ws + OFF_WUP0), D, NUP, NUP, (u16*)shm, p.in[7], 1);
        convert_w(wv, p.in[18] + (size_t)D * NUP, (u16*)(ws + OFF_WUP1), D, NUP, NUP, (u16*)shm, p.in[7] + D, 1);
        convert_w(wv, p.in[21], (u16*)(ws + OFF_WDN0), DFF, D, D, (u16*)shm);
        convert_w(wv, p.in[21] + (size_t)DFF * D, (u16*)(ws + OFF_WDN1), DFF, D, D, (u16*)shm);
        for (int i = blockIdx.x * 512 + tidx(wv); i < 3 * MT; i += gridDim.x * 512) ((float*)(ws + OFF_RSS))[i] = 0.f;
        rmsnorm_phase<0>(wv, p, p.in[6]);)
  PHASE(1, gemm_phase<MT, NINE, D, 0>(wv, (const u16*)(ws + OFF_HN), (const u16*)(ws + OFF_WINE), EpiStoreBf16{(u16*)(ws + OFF_BIG), NINE, nullptr}, (u16*)shm);)
  PHASE(2, { const int b_ = blockIdx.x, G_ = gridDim.x;
        prep_range<0>(wv, p, b_, NCH * 4, G_, shm);
        const int first1 = ((NCH * 4 - b_ + G_ - 1) / G_) * G_ + b_ - NCH * 4;
        prep_range<1>(wv, p, first1, NCH * 8, G_, shm); })
  PHASE(3, seq_even_phase(wv, p, shm);)
  PHASE(4, post_phase<0>(wv, p);)
  GEMM_ACC(5, OFF_R, OFF_WOUTE, D, (float*)(ws + OFF_RSS), -1, p.in[0], p.in[1])
  PHASE(7, gemm_phase<MT, NUP, D, 0>(wv, (const u16*)(ws + OFF_HN), (const u16*)(ws + OFF_WUP0), EpiGate{(const __attribute__((address_space(4))) void*)kp, 0, 0}, (u16*)shm);)
  GEMM_ACC(9, OFF_R, OFF_WDN0, DFF, (float*)(ws + OFF_RSS) + MT, 0, (const float*)nullptr, (const float*)nullptr)
  PHASE(11, gemm_phase<MT, NINO_PAD, D, 0>(wv, (const u16*)(ws + OFF_HN), (const u16*)(ws + OFF_WINO), EpiStoreBf16{(u16*)(ws + OFF_BIG), NINO_PAD, (const float*)(ws + OFF_RSS) + MT}, (u16*)shm);)
  PHASE(12, prep_range<2>(wv, p, blockIdx.x, NCH * 4, gridDim.x, shm);)
  PHASE(13, seq_odd_phase(wv, p, shm);)
  PHASE(14, post_phase<1>(wv, p);)
  GEMM_ACC(15, OFF_R, OFF_WOUTO, D, (float*)(ws + OFF_RSS) + 2 * MT, -1, (const float*)nullptr, (const float*)nullptr)
  PHASE(17, gemm_phase<MT, NUP, D, 0>(wv, (const u16*)(ws + OFF_HN), (const u16*)(ws + OFF_WUP1), EpiGate{(const __attribute__((address_space(4))) void*)kp, 1, 2 * MT}, (u16*)shm);)
  GEMM_ACC(19, OFF_R, OFF_WDN1, DFF, (float*)nullptr, 1, (const float*)nullptr, (const float*)nullptr)
  PHASE(20, final_norm_phase(wv, p);)
}

extern "C" void kernel_launch(void* const* d_in, const int* in_sizes, int n_in, void* d_out, int out_size, void* d_ws, size_t ws_size,
                              hipStream_t stream) {
  static int grid_blocks = 0;
  if (grid_blocks == 0) {
    int dev = 0, cus = 0, per_cu = 0;
    hipGetDevice(&dev);
    hipDeviceGetAttribute(&cus, hipDeviceAttributeMultiprocessorCount, dev);
    hipFuncSetAttribute((const void*)fwd_kernel, hipFuncAttributeMaxDynamicSharedMemorySize, LDS_BYTES);
    hipOccupancyMaxActiveBlocksPerMultiprocessor(&per_cu, (const void*)fwd_kernel, 512, LDS_BYTES);
    if (per_cu < 1) per_cu = 1;
    grid_blocks = cus * per_cu;
    (void)hipGetLastError();
  }
  if (n_in != 22 || ws_size < WS_NEED || (size_t)out_size != O_END) {
    fprintf(stderr, "kernel_launch: unexpected sizes n_in=%d ws=%zu need=%zu out=%d\n", n_in, ws_size, (size_t)WS_NEED, out_size);
    hipMemsetAsync(d_out, 0, (size_t)out_size * 4, stream);
    return;
  }
  Params p{};
  for (int i = 0; i < 22; ++i) p.in[i] = (const float*)d_in[i];
  p.out = (float*)d_out;
  p.ws = (unsigned char*)d_ws;
#if 0
  for (int ph = 0; ph < NPHASE; ++ph) {
    p.ph_lo = ph; p.ph_hi = ph + 1; p.coop = 0;
    hipLaunchKernelGGL(fwd_kernel, dim3(grid_blocks), dim3(512), LDS_BYTES, stream, p);
  }
#else
  p.ph_lo = 0; p.ph_hi = NPHASE; p.coop = 1;
  hipMemsetAsync((unsigned char*)d_ws + OFF_BAR, 0, XCD_BAR_WORDS * 4, stream);
  void* args[] = {&p};
  hipError_t e = hipLaunchCooperativeKernel((const void*)fwd_kernel, dim3(grid_blocks), dim3(512), args, LDS_BYTES, stream);
  if (e != hipSuccess) fprintf(stderr, "cooperative launch failed: %s (grid %d)\n", hipGetErrorString(e), grid_blocks);
#endif
}
```

```cpp
#include <hip/hip_runtime.h>
#include <hip/hip_bf16.h>
#include <hip/hip_cooperative_groups.h>
#include <cstdio>
namespace cg = cooperative_groups;

typedef unsigned short u16;
using bf16x8 = __attribute__((ext_vector_type(8))) short;
using f32x4 = __attribute__((ext_vector_type(4))) float;
typedef __attribute__((ext_vector_type(4))) unsigned u32x4_t;

constexpr int MP = 8192, MS = 512, MT = 8704, D = 2048;
constexpr int DFF = 5504, NUP = 11008;
constexpr int NINE = 7168, NINO = 6160, NINO_PAD = 6400;
constexpr int NCH = 136;
constexpr float EPS = 1e-6f;

constexpr size_t SZ_WINE = (size_t)NINE * D * 2, SZ_WOUT = (size_t)D * D * 2, SZ_WINO = (size_t)NINO_PAD * D * 2;
constexpr size_t SZ_WUP = (size_t)NUP * D * 2, SZ_WDN = (size_t)D * DFF * 2;
constexpr size_t OFF_WINE = 0;
constexpr size_t OFF_WOUTE = OFF_WINE + SZ_WINE;
constexpr size_t OFF_WINO = OFF_WOUTE + SZ_WOUT;
constexpr size_t OFF_WOUTO = OFF_WINO + SZ_WINO;
constexpr size_t OFF_WUP0 = OFF_WOUTO + SZ_WOUT;
constexpr size_t OFF_WUP1 = OFF_WUP0 + SZ_WUP;
constexpr size_t OFF_WDN0 = OFF_WUP1 + SZ_WUP;
constexpr size_t OFF_WDN1 = OFF_WDN0 + SZ_WDN;
constexpr size_t OFF_H = OFF_WDN1 + SZ_WDN;
constexpr size_t OFF_HN = OFF_H + (size_t)MT * D * 4;
constexpr size_t OFF_BIG = OFF_HN + (size_t)MT * D * 2;
constexpr size_t OFF_R = OFF_BIG + (size_t)MT * NUP * 2;
constexpr size_t SZ_R = 104ull * 1048576;
constexpr size_t OFF_RSS = OFF_R + SZ_R;
constexpr size_t OFF_SIDE = OFF_RSS + 3ull * MT * 4 + 256;
constexpr size_t SZ_SIDE1 = 34ull * 2 * DFF * 2;
constexpr size_t OFF_BAR = OFF_SIDE + 3 * SZ_SIDE1 + 256;
constexpr size_t WS_NEED = OFF_BAR + 16384;
constexpr size_t R_QA = 0;
constexpr size_t R_KA = R_QA + (size_t)NCH * 4 * 64 * 128 * 2;
constexpr size_t R_VA = R_KA + (size_t)NCH * 4 * 64 * 128 * 2;
constexpr size_t R_PA = R_VA + (size_t)NCH * 4 * 256 * 64 * 2;
constexpr size_t R_DA = R_PA + (size_t)NCH * 4 * 4096 * 2;
constexpr size_t R_QB = R_DA + (size_t)NCH * 4 * 128 * 4;
constexpr size_t R_KB = R_QB + (size_t)NCH * 8 * 64 * 128 * 2;
constexpr size_t R_VB = R_KB + (size_t)NCH * 8 * 64 * 128 * 2;
constexpr size_t R_PB = R_VB + (size_t)NCH * 8 * 128 * 64 * 2;
constexpr size_t R_DB = R_PB + (size_t)NCH * 8 * 4096 * 2;
constexpr size_t R_END_EVEN = R_DB + (size_t)NCH * 8 * 128 * 4;
constexpr size_t R_QC = 0;
constexpr size_t R_KC = R_QC + (size_t)NCH * 4 * 64 * 256 * 2;
constexpr size_t R_VC = R_KC + (size_t)NCH * 4 * 64 * 256 * 2;
constexpr size_t R_PC = R_VC + (size_t)NCH * 4 * 512 * 64 * 2;
constexpr size_t R_DC = R_PC + (size_t)NCH * 4 * 4096 * 2;
constexpr size_t R_END_ODD = R_DC + (size_t)NCH * 4 * 256 * 4;
static_assert(R_END_EVEN <= SZ_R && R_END_ODD <= SZ_R && (size_t)MT * DFF * 2 <= SZ_R, "R region too small");

constexpr size_t O_YP = 0;
constexpr size_t O_YS = O_YP + (size_t)MP * D;
constexpr size_t O_RETP = O_YS + (size_t)MS * D;
constexpr size_t O_RETS = O_RETP + 4ull * 4 * 128 * 256;
constexpr size_t O_HGP = O_RETS + 8ull * 4 * 128 * 256;
constexpr size_t O_HGS = O_HGP + 4ull * 8 * 128 * 128;
constexpr size_t O_GLP = O_HGS + 8ull * 8 * 128 * 128;
constexpr size_t O_GLS = O_GLP + 4ull * 4 * 256 * 512;
constexpr size_t O_CVP = O_GLS + 8ull * 4 * 256 * 512;
constexpr size_t O_CVS = O_CVP + 2ull * 4 * 2 * DFF;
constexpr size_t O_END = O_CVS + 2ull * 8 * 2 * DFF;

struct Params {
  const float* in[22];
  float* out;
  unsigned char* ws;
  int ph_lo, ph_hi, coop, pad;
};

__device__ __forceinline__ u16 f2bf(float f) {
  unsigned u = __float_as_uint(f);
  u += 0x7fffu + ((u >> 16) & 1u);
  return (u16)(u >> 16);
}
__device__ __forceinline__ float bf2f(u16 h) { return __uint_as_float(((unsigned)h) << 16); }
__device__ __forceinline__ unsigned pack2_sw(float a, float b) { return (unsigned)f2bf(a) | ((unsigned)f2bf(b) << 16); }
typedef float f32x2_t __attribute__((ext_vector_type(2)));
typedef __bf16 bf16x2_t __attribute__((ext_vector_type(2)));
__device__ __forceinline__ unsigned pack2(float a, float b) { f32x2_t v = {a, b}; bf16x2_t r = __builtin_convertvector(v, bf16x2_t); return __builtin_bit_cast(unsigned, r); }
__device__ __forceinline__ float sigmoidf_(float x) { return __builtin_amdgcn_rcpf(1.f + __expf(-x)); }
__device__ __forceinline__ float siluf_(float x) { return x * __builtin_amdgcn_rcpf(1.f + __expf(-x)); }

__device__ __forceinline__ int tidx(int wv) { int l; asm volatile("v_mbcnt_lo_u32_b32 %0, -1, 0\n\tv_mbcnt_hi_u32_b32 %0, -1, %0" : "=v"(l)); return wv * 64 + l; }

__device__ __forceinline__ void convert_w(int wv, const float* __restrict__ src, u16* __restrict__ dst, int K, int N, int Npad, u16* tile, const float* __restrict__ kscale = nullptr, int upperm = 0) {
  const int tix = tidx(wv);
  constexpr int TS = 262;
  const int tn = (Npad + 255) / 256, tk = K / 64, nt = tn * tk, tid = tix;
  for (int t = blockIdx.x; t < nt; t += gridDim.x) {
    const int n0 = (t % tn) * 256, k0 = (t / tn) * 64;
    float4 v[8];
#pragma unroll
    for (int i = 0; i < 8; ++i) {
      const int idx = tid + i * 512, kk = idx >> 6, n = n0 + (idx & 63) * 4;
      v[i] = make_float4(0.f, 0.f, 0.f, 0.f);
      if (n < N) { const f32x4 t_ = __builtin_nontemporal_load((const f32x4*)(src + (size_t)(k0 + kk) * N + n)); v[i] = make_float4(t_[0], t_[1], t_[2], t_[3]); }
      if (kscale) { const float sc = kscale[k0 + kk]; v[i].x *= sc; v[i].y *= sc; v[i].z *= sc; v[i].w *= sc; }
    }
    __syncthreads();
#pragma unroll
    for (int i = 0; i < 8; ++i) {
      const int idx = tid + i * 512, kk = idx >> 6, nl = (idx & 63) * 4;
      *(unsigned*)(tile + kk * TS + nl) = pack2(v[i].x, v[i].y);
      *(unsigned*)(tile + kk * TS + nl + 2) = pack2(v[i].z, v[i].w);
    }
    __syncthreads();
#pragma unroll
    for (int i = 0; i < 4; ++i) {
      const int item = tid + i * 512, ks = item & 7, n = item >> 3;
      if (n0 + n < Npad) {
        const u16* tp = tile + (ks * 8) * TS + n;
        uint4 o;
        o.x = (unsigned)tp[0] | ((unsigned)tp[TS] << 16);
        o.y = (unsigned)tp[2 * TS] | ((unsigned)tp[3 * TS] << 16);
        o.z = (unsigned)tp[4 * TS] | ((unsigned)tp[5 * TS] << 16);
        o.w = (unsigned)tp[6 * TS] | ((unsigned)tp[7 * TS] << 16);
        int nr = n0 + n;
        if (upperm) nr = (nr < DFF) ? ((nr >> 7) * 256 + (nr & 127)) : ((((nr - DFF) >> 7) * 256) + 128 + ((nr - DFF) & 127));
        *(uint4*)(dst + (size_t)nr * K + k0 + ks * 8) = o;
      }
    }
  }
}

template <int MODE>
__device__ __forceinline__ void rmsnorm_phase(int wv, const Params& p, const float* __restrict__ w) {
  const int tix = tidx(wv);
  const int lane = tix & 63, gw = blockIdx.x * 8 + (tix >> 6), nw = gridDim.x * 8;
  const float* h = (const float*)(p.ws + OFF_H);
  u16* hn = (u16*)(p.ws + OFF_HN);
#define RMS_LOAD(dst, row_) do { const int r_ = (row_); const float* src_; \
    if (MODE == 0) src_ = (r_ < MP) ? p.in[0] + (size_t)r_ * D : p.in[1] + (size_t)(r_ - MP) * D; \
    else src_ = h + (size_t)r_ * D; \
    _Pragma("unroll") for (int i = 0; i < 8; ++i) dst[i] = (MODE == 0) ? __builtin_nontemporal_load((const f32x4*)(src_ + (i * 64 + lane) * 4)) : *(const f32x4*)(src_ + (i * 64 + lane) * 4); } while (0)
  f32x4 v[8];
  if (gw < MT) RMS_LOAD(v, gw);
#pragma unroll 1
  for (int row = gw; row < MT; row += nw) {
    f32x4 nx[8];
    if (row + nw < MT) RMS_LOAD(nx, row + nw);
    else {
#pragma unroll
      for (int i = 0; i < 8; ++i) nx[i] = v[i];
    }
    __builtin_amdgcn_sched_barrier(0);
    float ss = 0.f;
#pragma unroll
    for (int i = 0; i < 8; ++i) ss += v[i][0] * v[i][0] + v[i][1] * v[i][1] + v[i][2] * v[i][2] + v[i][3] * v[i][3];
#pragma unroll
    for (int o = 32; o > 0; o >>= 1) ss += __shfl_xor(ss, o, 64);
    const float rs = rsqrtf(ss * (1.f / D) + EPS);
#pragma unroll
    for (int i = 0; i < 8; ++i) {
      const int col = (i * 64 + lane) * 4;
      const float4 wv4 = *(const float4*)(w + col);
      const float4 y = make_float4(v[i][0] * rs * wv4.x, v[i][1] * rs * wv4.y, v[i][2] * rs * wv4.z, v[i][3] * rs * wv4.w);
      if (MODE == 2) {
        float* dst = (row < MP) ? p.out + O_YP + (size_t)row * D : p.out + O_YS + (size_t)(row - MP) * D;
        *(float4*)(dst + col) = y;
      } else {
        *(uint2*)(hn + (size_t)row * D + col) = make_uint2(pack2(y.x, y.y), pack2(y.z, y.w));
      }
    }
#pragma unroll
    for (int i = 0; i < 8; ++i) v[i] = nx[i];
  }
#undef RMS_LOAD
}

__device__ __forceinline__ void ld8(const u16* p, float* f) {
  uint4 v = *(const uint4*)p;
  f[0] = __uint_as_float(v.x << 16); f[1] = __uint_as_float(v.x & 0xffff0000u);
  f[2] = __uint_as_float(v.y << 16); f[3] = __uint_as_float(v.y & 0xffff0000u);
  f[4] = __uint_as_float(v.z << 16); f[5] = __uint_as_float(v.z & 0xffff0000u);
  f[6] = __uint_as_float(v.w << 16); f[7] = __uint_as_float(v.w & 0xffff0000u);
}
__device__ __forceinline__ void st8(u16* p, const float* f) {
  *(uint4*)p = make_uint4(pack2(f[0], f[1]), pack2(f[2], f[3]), pack2(f[4], f[5]), pack2(f[6], f[7]));
}
__device__ __forceinline__ void st8_sw(u16* p, const float* f) {
  *(uint4*)p = make_uint4(pack2_sw(f[0], f[1]), pack2_sw(f[2], f[3]), pack2_sw(f[4], f[5]), pack2_sw(f[6], f[7]));
}

constexpr int BM = 256, BK = 64, HALF = 128, NXCD = 8, WGM = 8, HT = HALF * BK;

__device__ __forceinline__ int lds_byte(int r, int c) {
  int st = (r >> 4) * 2 + (c >> 5), rr = r & 15, cc = c & 31, ob = rr * 64 + cc * 2;
  return st * 1024 + (ob ^ (((ob >> 9) & 1) << 5));
}
__device__ __forceinline__ void stage_rc(int b, int& R, int& C) {
  int st = b / 1024, sb = b % 1024, swz = sb ^ (((sb >> 9) & 1) << 5);
  R = (st >> 1) * 16 + swz / 64; C = (st & 1) * 32 + (swz % 64) / 2;
}

__device__ __forceinline__ void tile_coords(int wgid, int nM, int nN, int& pm, int& pn) {
  const int nwg = nM * nN;
  { int q = nwg / NXCD, r = nwg % NXCD, xcd = wgid % NXCD, off = wgid / NXCD;
    wgid = (xcd < r ? xcd * (q + 1) : r * (q + 1) + (xcd - r) * q) + off; }
  const int nig = WGM * nN, gid = wgid / nig, fm = gid * WGM, gsz = min(nM - fm, WGM);
  pm = fm + ((wgid % nig) % gsz); pn = (wgid % nig) / gsz;
}

struct EpiStoreBf16 {
  static constexpr bool GATE = false;
  static constexpr bool LDSST = true;
  u16* out; int ldo; const float* rss;
  __device__ __forceinline__ float row_scale(int row) const { return rss ? rsqrtf(rss[row] * (1.f / D) + EPS) : 1.f; }
  __device__ __forceinline__ float operator()(int row, int col, f32x4 v, float sc) const {
    uint2 pk = make_uint2(pack2(v[0] * sc, v[1] * sc), pack2(v[2] * sc, v[3] * sc));
    *(uint2*)(out + (size_t)row * ldo + col) = pk;
    return 0.f;
  }
  __device__ __forceinline__ void row_end(int, float, int) const {}
  __device__ __forceinline__ f32x4 finalize(int, int, f32x4 v, float sc, float&) const { return f32x4{v[0] * sc, v[1] * sc, v[2] * sc, v[3] * sc}; }
};
struct EpiAccum {
  static constexpr bool GATE = false;
  static constexpr bool LDSST = true;
  u16* out; float* rss; const float* rin32; static constexpr int ldo = D;
  __device__ __forceinline__ float row_scale(int) const { return 1.f; }
  __device__ __forceinline__ float operator()(int, int, f32x4, float) const { return 0.f; }
  __device__ __forceinline__ f32x4 finalize(int row, int col, f32x4 v, float, float& ss) const {
    float4 o;
    if (rin32) o = *(const float4*)(rin32 + (size_t)row * D + col);
    else { const uint2 r = *(const uint2*)(out + (size_t)row * D + col); o = make_float4(__uint_as_float(r.x << 16), __uint_as_float(r.x & 0xffff0000u), __uint_as_float(r.y << 16), __uint_as_float(r.y & 0xffff0000u)); }
    o.x += v[0]; o.y += v[1]; o.z += v[2]; o.w += v[3];
    if (rss) ss += o.x * o.x + o.y * o.y + o.z * o.z + o.w * o.w;
    return f32x4{o.x, o.y, o.z, o.w};
  }
  __device__ __forceinline__ void row_end(int row, float ss, int fq) const {
    if (rss) {
      ss += __shfl_xor(ss, 16, 64);
      ss += __shfl_xor(ss, 32, 64);
      if (fq == 0) unsafeAtomicAdd(rss + row, ss);
    }
  }
};

struct EpiGate {
  static constexpr bool GATE = true;
  static constexpr bool LDSST = false;
  const __attribute__((address_space(4))) void* kp; int layer; int rssoff;
  __device__ __forceinline__ float row_scale(int) const { return 1.f; }
  __device__ __forceinline__ float operator()(int, int, f32x4, float) const { return 0.f; }
  __device__ __forceinline__ void row_end(int, float, int) const {}
};

template <int M, int N, int K, int TAIL, class Epi>
__device__ __forceinline__ void gemm_phase(int wv, const u16* __restrict__ A, const u16* __restrict__ Bt, Epi epi, u16* shm) {
  const int tix = tidx(wv);
#define SA(b, h) (shm + ((b) * 2 + (h)) * HT)
#define SB(b, h) (shm + (4 + (b) * 2 + (h)) * HT)
#define STAGE(P, BASE, br, kt) do { const u16* _gb = BASE + ((long)(br) * K + (long)(kt0 + (kt)) * BK); \
    for (int _i = 0; _i < 2; ++_i) { int _b = tix * 16 + _i * 8192; \
      __builtin_amdgcn_global_load_lds((const unsigned*)(_gb + toff[_i]), \
        (__attribute__((address_space(3))) unsigned*)((char*)(P) + _b), 16, 0, 0); } } while (0)
#define LDA(dst, b, h) for (int m = 0; m < 4; ++m) for (int k = 0; k < 2; ++k) \
    dst[m][k] = *reinterpret_cast<const bf16x8*>((char*)SA(b, h) + lds_byte(wr * 64 + m * 16 + fr, k * 32 + fq * 8))
#define LDB(dst, b, h) for (int n = 0; n < 2; ++n) for (int k = 0; k < 2; ++k) \
    dst[n][k] = *reinterpret_cast<const bf16x8*>((char*)SB(b, h) + lds_byte(wc * 32 + n * 16 + fr, k * 32 + fq * 8))
#define MMA(ai, bj, At_, Bt_) do { __builtin_amdgcn_s_setprio(1); \
    for (int m = 0; m < 4; ++m) for (int n = 0; n < 2; ++n) for (int k = 0; k < 2; ++k) \
      acc[ai][bj][m][n] = __builtin_amdgcn_mfma_f32_16x16x32_bf16(Bt_[n][k], At_[m][k], acc[ai][bj][m][n], 0, 0, 0); \
    __builtin_amdgcn_s_setprio(0); } while (0)
#define WAIT_V(n) asm volatile("s_waitcnt vmcnt(" #n ")" ::: "memory")
#define WAIT_L(n) asm volatile("s_waitcnt lgkmcnt(" #n ")" ::: "memory")
#define BAR __builtin_amdgcn_s_barrier()
#define SCHED __builtin_amdgcn_sched_barrier(0)
  const int nM = M / BM, nN = N / BM, nwg = nM * nN, G = gridDim.x;
  const int nunits = nwg;
  const int wid = tix >> 6, lane = tix & 63, wr = wid >> 2, wc = wid & 3, fr = lane & 15, fq = lane >> 4;
  const int nt_total = K / BK;
  unsigned toff[2];
  for (int _i = 0; _i < 2; ++_i) { int _b = tix * 16 + _i * 8192; int _r, _c; stage_rc(_b, _r, _c); toff[_i] = (unsigned)(_r * K + _c); }
  for (int vw = blockIdx.x; vw < nunits; vw += G) {
    int pm, pn;
    tile_coords(vw, nM, nN, pm, pn);
    const int brow = pm * BM, bcol = pn * BM;
    constexpr int kt0 = 0, nt = nt_total;
    f32x4 acc[2][2][4][2];
    for (int a = 0; a < 2; ++a) for (int b = 0; b < 2; ++b) for (int m = 0; m < 4; ++m) for (int n = 0; n < 2; ++n) acc[a][b][m][n] = f32x4{0.f, 0.f, 0.f, 0.f};
    bf16x8 At[4][2], B0[2][2], B1[2][2];
    STAGE(SB(0, 0), Bt, bcol, 0); STAGE(SA(0, 0), A, brow, 0);
    STAGE(SB(0, 1), Bt, bcol + HALF, 0); STAGE(SA(0, 1), A, brow + HALF, 0);
    if (wr == 1) BAR;
    WAIT_V(4); BAR;
    STAGE(SB(1, 0), Bt, bcol, 1); STAGE(SA(1, 0), A, brow, 1); STAGE(SB(1, 1), Bt, bcol + HALF, 1);
    WAIT_V(6); BAR;
    for (int t = 0; t < nt - 2; t += 2) {
      LDB(B0, 0, 0); SCHED; LDA(At, 0, 0); STAGE(SA(1, 1), A, brow + HALF, t + 1);
      WAIT_L(8); BAR; WAIT_L(0); MMA(0, 0, At, B0); BAR; SCHED;
      LDB(B1, 0, 1); STAGE(SB(0, 0), Bt, bcol, t + 2);
      BAR; WAIT_L(0); MMA(0, 1, At, B1); BAR;
      LDA(At, 0, 1); STAGE(SA(0, 0), A, brow, t + 2);
      BAR; WAIT_L(0); MMA(1, 0, At, B0); BAR; SCHED;
      STAGE(SB(0, 1), Bt, bcol + HALF, t + 2);
      WAIT_V(6); BAR; MMA(1, 1, At, B1); BAR;
      LDB(B0, 1, 0); SCHED; LDA(At, 1, 0); STAGE(SA(0, 1), A, brow + HALF, t + 2);
      WAIT_L(8); BAR; WAIT_L(0); MMA(0, 0, At, B0); BAR; SCHED;
      LDB(B1, 1, 1); STAGE(SB(1, 0), Bt, bcol, t + 3);
      BAR; WAIT_L(0); MMA(0, 1, At, B1); BAR;
      LDA(At, 1, 1); STAGE(SA(1, 0), A, brow, t + 3);
      BAR; WAIT_L(0); MMA(1, 0, At, B0); BAR; SCHED;
      STAGE(SB(1, 1), Bt, bcol + HALF, t + 3);
      WAIT_V(6); BAR; MMA(1, 1, At, B1); BAR;
    }
    { LDB(B0, 0, 0); LDA(At, 0, 0); STAGE(SA(1, 1), A, brow + HALF, nt - 1);
      BAR; WAIT_L(0); MMA(0, 0, At, B0); BAR;
      LDB(B1, 0, 1); BAR; WAIT_L(0); MMA(0, 1, At, B1); BAR;
      LDA(At, 0, 1); WAIT_V(4); BAR; WAIT_L(0); MMA(1, 0, At, B0); MMA(1, 1, At, B1); BAR; }
    { LDB(B0, 1, 0); LDA(At, 1, 0); WAIT_V(2); BAR; WAIT_L(0); MMA(0, 0, At, B0); BAR;
      LDB(B1, 1, 1); WAIT_V(0); BAR; WAIT_L(0); MMA(0, 1, At, B1); BAR;
      LDA(At, 1, 1); BAR; WAIT_L(0); MMA(1, 0, At, B0); MMA(1, 1, At, B1); BAR; }
    if (wr == 0) BAR;
    if constexpr (Epi::GATE) {
      constexpr int LS = 136;
      u16* La = shm;
      u16* Lu = shm + 256 * LS;
      const __attribute__((address_space(4))) Params* gkp = (const __attribute__((address_space(4))) Params*)epi.kp;
      asm volatile("" : "+s"(gkp));
      int e_pm = pm, e_pn = pn, e_tix = tix;
      asm volatile("" : "+s"(e_pm), "+s"(e_pn));
      asm volatile("" : "+v"(e_tix));
      const int e_brow = e_pm * BM;
      {
        const int e_lane = e_tix & 63, e_wid = e_tix >> 6, e_wr = e_wid >> 2, e_wc = e_wid & 3, e_fr = e_lane & 15, e_fq = e_lane >> 4;
        const float* rss = (const float*)(gkp->ws + OFF_RSS) + epi.rssoff;
        _Pragma("unroll") for (int ai = 0; ai < 2; ++ai) _Pragma("unroll") for (int m = 0; m < 4; ++m) {
          const int rl = ai * HALF + e_wr * 64 + m * 16 + e_fr;
          const float sc = rsqrtf(rss[e_brow + rl] * (1.f / D) + EPS);
          _Pragma("unroll") for (int n = 0; n < 2; ++n) {
            const f32x4 a = acc[ai][0][m][n], uu = acc[ai][1][m][n];
            const int lo = rl * LS + e_wc * 32 + n * 16 + e_fq * 4;
            *(uint2*)(La + lo) = make_uint2(pack2_sw(a[0] * sc, a[1] * sc), pack2_sw(a[2] * sc, a[3] * sc));
            *(uint2*)(Lu + lo) = make_uint2(pack2_sw(uu[0] * sc, uu[1] * sc), pack2_sw(uu[2] * sc, uu[3] * sc));
          }
        }
      }
      WAIT_L(0); BAR; asm volatile("" ::: "memory");
      {
        const bool samp = e_brow >= MP;
        const int layer = epi.layer;
        u16* gg = (u16*)(gkp->ws + OFF_R);
        u16* side = (u16*)(gkp->ws + OFF_SIDE);
        const float* cw = gkp->in[19] + (size_t)layer * 3 * DFF;
        const float* cb = gkp->in[20] + (size_t)layer * DFF;
        const float* cache = gkp->in[5] + (size_t)layer * 8 * 2 * DFF;
        float* cvo = gkp->out + (samp ? O_CVS + (size_t)layer * 8 * 2 * DFF : O_CVP + (size_t)layer * 4 * 2 * DFF);
        const int cg = e_tix & 15, r0 = e_tix >> 4, c = e_pn * 128 + cg * 8;
        float w0[8], w1[8], w2[8], bb[8];
        _Pragma("unroll") for (int e = 0; e < 8; ++e) { w0[e] = cw[c + e]; w1[e] = cw[DFF + c + e]; w2[e] = cw[2 * DFF + c + e]; bb[e] = cb[c + e]; }
        _Pragma("unroll 1") for (int it = 0; it < 8; ++it) {
          const int rl = it * 32 + r0;
          const int t = samp ? (rl & 63) : ((e_pm & 7) * 256 + rl);
          const int sb = (e_pm - 32) * 4 + (rl >> 6);
          float a[8], uu[8], am1[8], am2[8], y[8];
          ld8(La + rl * LS + cg * 8, a);
          ld8(Lu + rl * LS + cg * 8, uu);
          _Pragma("unroll") for (int e = 0; e < 8; ++e) { am1[e] = 0.f; am2[e] = 0.f; }
          if (t >= 1 && rl >= 1) ld8(La + (rl - 1) * LS + cg * 8, am1);
          if (t >= 2 && rl >= 2) ld8(La + (rl - 2) * LS + cg * 8, am2);
          if (samp && t < 2) {
            const float* c1 = cache + (size_t)(sb * 2 + 1) * DFF + c;
            if (t == 0) {
              const float* c0 = cache + (size_t)(sb * 2 + 0) * DFF + c;
              _Pragma("unroll") for (int e = 0; e < 8; ++e) { am2[e] = c0[e]; am1[e] = c1[e]; }
            } else {
              _Pragma("unroll") for (int e = 0; e < 8; ++e) am2[e] = c1[e];
            }
          }
          if (!(t >= 2 && rl < 2)) {
            _Pragma("unroll") for (int e = 0; e < 8; ++e) { float cv = bb[e] + w0[e] * am2[e] + w1[e] * am1[e] + w2[e] * a[e]; y[e] = siluf_(cv) * uu[e]; }
            st8_sw(gg + (size_t)(e_brow + rl) * DFF + c, y);
          } else {
            st8_sw(side + (size_t)(e_pm * 2 + rl) * DFF + c, a);
            st8_sw(side + SZ_SIDE1 / 2 + (size_t)(e_pm * 2 + rl) * DFF + c, uu);
          }
          if (rl >= 254) st8_sw(side + SZ_SIDE1 + (size_t)(e_pm * 2 + rl - 254) * DFF + c, a);
          int crow = -1;
          if (!samp) { if ((e_pm & 7) == 7 && rl >= 254) crow = (e_pm >> 3) * 2 + rl - 254; }
          else { if ((rl & 63) >= 62) crow = sb * 2 + (rl & 63) - 62; }
          if (crow >= 0) {
            float* dst = cvo + (size_t)crow * DFF + c;
            *(float4*)dst = make_float4(a[0], a[1], a[2], a[3]);
            *(float4*)(dst + 4) = make_float4(a[4], a[5], a[6], a[7]);
          }
        }
      }
      WAIT_L(0); BAR; asm volatile("" ::: "memory");
    } else if constexpr (Epi::LDSST) {
      constexpr int LS = 136;
      u16* L0 = shm;
      u16* L1 = shm + 256 * LS;
      int e_brow = brow, e_bcol = bcol, e_tix = tix;
      asm volatile("" : "+s"(e_brow), "+s"(e_bcol));
      asm volatile("" : "+v"(e_tix));
      {
        const int e_lane = e_tix & 63, e_wid = e_tix >> 6, e_wr = e_wid >> 2, e_wc = e_wid & 3, e_fr = e_lane & 15, e_fq = e_lane >> 4;
        _Pragma("unroll") for (int ai = 0; ai < 2; ++ai) _Pragma("unroll") for (int m = 0; m < 4; ++m) {
          const int rl = ai * HALF + e_wr * 64 + m * 16 + e_fr;
          const float sc = epi.row_scale(e_brow + rl);
          float ss = 0.f;
          _Pragma("unroll") for (int n = 0; n < 2; ++n) {
            const int cl = e_wc * 32 + n * 16 + e_fq * 4;
            const f32x4 c0 = epi.finalize(e_brow + rl, e_bcol + cl, acc[ai][0][m][n], sc, ss);
            const f32x4 c1 = epi.finalize(e_brow + rl, e_bcol + 128 + cl, acc[ai][1][m][n], sc, ss);
            const int lo = rl * LS + cl;
            *(uint2*)(L0 + lo) = make_uint2(pack2(c0[0], c0[1]), pack2(c0[2], c0[3]));
            *(uint2*)(L1 + lo) = make_uint2(pack2(c1[0], c1[1]), pack2(c1[2], c1[3]));
          }
          epi.row_end(e_brow + rl, ss, e_fq);
          if (m & 1) asm volatile("" ::: "memory");
        }
      }
      WAIT_L(0); BAR; asm volatile("" ::: "memory");
      {
        const int cg = e_tix & 15, r0 = e_tix >> 4;
        _Pragma("unroll 1") for (int it = 0; it < 8; ++it) {
          const int rl = it * 32 + r0;
          const uint4 x0 = *(const uint4*)(L0 + rl * LS + cg * 8), x1 = *(const uint4*)(L1 + rl * LS + cg * 8);
          u16* dst = epi.out + (size_t)(e_brow + rl) * epi.ldo + e_bcol + cg * 8;
          *(uint4*)dst = x0;
          *(uint4*)(dst + 128) = x1;
        }
      }
      WAIT_L(0); BAR; asm volatile("" ::: "memory");
    } else {
    for (int ai = 0; ai < 2; ++ai) for (int m = 0; m < 4; ++m) {
      const int row = brow + ai * HALF + wr * 64 + m * 16 + fr;
      const float sc = epi.row_scale(row);
      float ss = 0.f;
      for (int bj = 0; bj < 2; ++bj) for (int n = 0; n < 2; ++n)
        ss += epi(row, bcol + bj * HALF + wc * 32 + n * 16 + fq * 4, acc[ai][bj][m][n], sc);
      epi.row_end(row, ss, fq);
      if (m & 1) asm volatile("" ::: "memory");
    }
    }
  }
#undef SA
#undef SB
#undef STAGE
#undef LDA
#undef LDB
#undef MMA
}


template <int K>
__device__ __forceinline__ void gemm_tail_phase(int wv, const u16* __restrict__ A, const u16* __restrict__ Bt, float* lds, u16* __restrict__ hb, float* __restrict__ rss, const float* __restrict__ rin32_tail) {
  const int tix = tidx(wv);
  const int tid = tix, w = tid >> 6, lane = tid & 63, fr = lane & 15, fq = lane >> 4;
  for (int u = blockIdx.x; u < 256; u += gridDim.x) {
    const int tm = u >> 5, tn = u & 31;
    const u16* Ab = A + (size_t)(MP + tm * 64 + fr) * K + fq * 8;
    const u16* Bb = Bt + (size_t)(tn * 64 + fr) * K + fq * 8;
    f32x4 acc[4][4];
#pragma unroll
    for (int i = 0; i < 4; ++i)
#pragma unroll
      for (int j = 0; j < 4; ++j) acc[i][j] = f32x4{0.f, 0.f, 0.f, 0.f};
    const u16* Ab2 = A + (size_t)(MP + tm * 64 + fr) * K + fq * 16;
    const u16* Bb2 = Bt + (size_t)(tn * 64 + fr) * K + fq * 16;
#pragma unroll 1
    for (int ks = w; ks < K / 64; ks += 8) {
      bf16x8 a[4][2], b[4][2];
#pragma unroll
      for (int i = 0; i < 4; ++i) {
        a[i][0] = *(const bf16x8*)(Ab2 + (size_t)i * 16 * K + ks * 64);
        a[i][1] = *(const bf16x8*)(Ab2 + (size_t)i * 16 * K + ks * 64 + 8);
        b[i][0] = *(const bf16x8*)(Bb2 + (size_t)i * 16 * K + ks * 64);
        b[i][1] = *(const bf16x8*)(Bb2 + (size_t)i * 16 * K + ks * 64 + 8);
      }
#pragma unroll
      for (int mb = 0; mb < 4; ++mb)
#pragma unroll
        for (int nb = 0; nb < 4; ++nb) {
          acc[mb][nb] = __builtin_amdgcn_mfma_f32_16x16x32_bf16(b[nb][0], a[mb][0], acc[mb][nb], 0, 0, 0);
          acc[mb][nb] = __builtin_amdgcn_mfma_f32_16x16x32_bf16(b[nb][1], a[mb][1], acc[mb][nb], 0, 0, 0);
        }
    }
    __syncthreads();
#pragma unroll
    for (int mb = 0; mb < 4; ++mb)
#pragma unroll
      for (int nb = 0; nb < 4; ++nb) *(f32x4*)(lds + w * 4096 + (mb * 16 + fr) * 64 + nb * 16 + fq * 4) = acc[mb][nb];
    __syncthreads();
    const int e = tid * 8, row = e >> 6, col = e & 63;
    float4 s0 = make_float4(0.f, 0.f, 0.f, 0.f), s1 = s0;
#pragma unroll
    for (int ww = 0; ww < 8; ++ww) {
      float4 x0 = *(const float4*)(lds + ww * 4096 + e), x1 = *(const float4*)(lds + ww * 4096 + e + 4);
      s0.x += x0.x; s0.y += x0.y; s0.z += x0.z; s0.w += x0.w;
      s1.x += x1.x; s1.y += x1.y; s1.z += x1.z; s1.w += x1.w;
    }
    const int grow = MP + tm * 64 + row;
    u16* q = hb + (size_t)grow * D + tn * 64 + col;
    float r8[8];
    if (rin32_tail) {
      const float* rq_ = rin32_tail + (size_t)(tm * 64 + row) * D + tn * 64 + col;
      const float4 a0 = *(const float4*)rq_, a1 = *(const float4*)(rq_ + 4);
      r8[0] = a0.x; r8[1] = a0.y; r8[2] = a0.z; r8[3] = a0.w; r8[4] = a1.x; r8[5] = a1.y; r8[6] = a1.z; r8[7] = a1.w;
    } else ld8(q, r8);
    r8[0] += s0.x; r8[1] += s0.y; r8[2] += s0.z; r8[3] += s0.w; r8[4] += s1.x; r8[5] += s1.y; r8[6] += s1.z; r8[7] += s1.w;
    st8(q, r8);
    if (rss) {
      float ss = 0.f;
#pragma unroll
      for (int e2 = 0; e2 < 8; ++e2) ss += r8[e2] * r8[e2];
      ss += __shfl_xor(ss, 1, 64); ss += __shfl_xor(ss, 2, 64); ss += __shfl_xor(ss, 4, 64);
      if ((tid & 7) == 0) unsafeAtomicAdd(rss + grow, ss);
    }
  }
}

template <int MODE>
__device__ __forceinline__ void prep_range(int wv, const Params& p, int u0, int u1, int ustride, unsigned char* shm) {
  const int tix = tidx(wv);
  constexpr int K = (MODE == 2) ? 256 : 128;
  constexpr int V = (MODE == 0) ? 256 : (MODE == 1 ? 128 : 512);
  constexpr int H = (MODE == 1) ? 8 : 4;
  constexpr int LD = (MODE == 2) ? NINO_PAD : NINE;
  constexpr int NSEG = 4, TL = 16, KS = K + 8, VS = V + 8, NPASS = K / 128;
  constexpr int NQ = K / 64, NV = V / 64;
  constexpr bool PFV = false;
  const int tid = tix, seg = tid >> 7;
  const u16* proj = (const u16*)(p.ws + OFF_BIG);
  unsigned char* R = p.ws + OFF_R;
  u16* qin = (u16*)(R + (MODE == 0 ? R_QA : MODE == 1 ? R_QB : R_QC));
  u16* koT = (u16*)(R + (MODE == 0 ? R_KA : MODE == 1 ? R_KB : R_KC));
  u16* vT = (u16*)(R + (MODE == 0 ? R_VA : MODE == 1 ? R_VB : R_VC));
  u16* Pm = (u16*)(R + (MODE == 0 ? R_PA : MODE == 1 ? R_PB : R_PC));
  float* dL = (float*)(R + (MODE == 0 ? R_DA : MODE == 1 ? R_DB : R_DC));
  u16* qs = (u16*)shm;
  u16* ksm = qs + 64 * KS;
  float* segtot = (float*)(ksm + 64 * KS);
  float* gl = segtot + NSEG * K;
  u16* rq = (u16*)(gl + 64 * 16);
  u16* rk = rq + 64 * KS;
  u16* rv = PFV ? rk + 64 * KS : rq;
  typedef __attribute__((ext_vector_type(4))) unsigned u32x4_t;
  u32x4_t rqr[NQ], rkr[NQ], rvr[PFV ? NV : 1];
#define PREP_ISSUE(uu_) do { \
    const int c_i = (uu_) / H, h_i = (uu_) % H; \
    const int row0_i = (c_i < 128) ? (c_i >> 5) * 2048 + (c_i & 31) * 64 : MP + (c_i - 128) * 64; \
    const u16* prow_i = proj + (size_t)row0_i * LD; \
    const int cq_i = (MODE == 0) ? h_i * 128 : (MODE == 1 ? 3072 + h_i * 128 : h_i * 256); \
    const int ck_i = (MODE == 0) ? 512 + h_i * 128 : (MODE == 1 ? 4096 + h_i * 128 : 1024 + h_i * 256); \
    const int vc_i = (MODE == 0) ? 1024 + h_i * 256 : (MODE == 1 ? 5120 + h_i * 128 : 2048 + h_i * 512); \
    _Pragma("unroll") for (int i = 0; i < NQ; ++i) { \
      const int idx = tid + i * 512, r = idx / (K / 8), cc = idx % (K / 8); \
      rqr[i] = *(const u32x4_t*)(prow_i + (size_t)r * LD + cq_i + cc * 8); \
      rkr[i] = *(const u32x4_t*)(prow_i + (size_t)r * LD + ck_i + cc * 8); \
    } \
    if constexpr (PFV) { \
      _Pragma("unroll") for (int i = 0; i < NV; ++i) { \
        const int idx = tid + i * 512, r = idx / (V / 8), cc = idx % (V / 8); \
        rvr[i] = *(const u32x4_t*)(prow_i + (size_t)r * LD + vc_i + cc * 8); \
      } \
    } } while (0)
  if (u0 < u1) PREP_ISSUE(u0);
#pragma unroll 1
  for (int uu = u0; uu < u1; uu += ustride) {
  const int c = uu / H, h = uu % H;
  int row0, pos0;
  if (c < 128) { row0 = (c >> 5) * 2048 + (c & 31) * 64; pos0 = (c & 31) * 64; }
  else { row0 = MP + (c - 128) * 64; pos0 = 1024; }
  const size_t u = (size_t)c * H + h;
  const u16* prow = proj + (size_t)row0 * LD;
  const int vc0 = (MODE == 0) ? 1024 + h * 256 : (MODE == 1 ? 5120 + h * 128 : 2048 + h * 512);
  __syncthreads();
#pragma unroll
  for (int i = 0; i < NQ; ++i) {
    const int idx = tid + i * 512, r = idx / (K / 8), cc = idx % (K / 8);
    *(u32x4_t*)(rq + r * KS + cc * 8) = rqr[i];
    *(u32x4_t*)(rk + r * KS + cc * 8) = rkr[i];
  }
  if constexpr (PFV) {
#pragma unroll
    for (int i = 0; i < NV; ++i) {
      const int idx = tid + i * 512, r = idx / (V / 8), cc = idx % (V / 8);
      *(u32x4_t*)(rv + r * VS + cc * 8) = rvr[i];
    }
  }
  if (MODE == 2) {
    for (int i = tid; i < 64 * 2; i += 512) {
      const int r = i >> 1, hh = i & 1;
      uint4 g4 = *(const uint4*)(prow + (size_t)r * LD + 6144 + hh * 8);
      float* d = gl + r * 16 + hh * 8;
      d[0] = __uint_as_float(g4.x << 16); d[1] = __uint_as_float(g4.x & 0xffff0000u);
      d[2] = __uint_as_float(g4.y << 16); d[3] = __uint_as_float(g4.y & 0xffff0000u);
      d[4] = __uint_as_float(g4.z << 16); d[5] = __uint_as_float(g4.z & 0xffff0000u);
      d[6] = __uint_as_float(g4.w << 16); d[7] = __uint_as_float(g4.w & 0xffff0000u);
    }
  }
  if (uu + ustride < u1) PREP_ISSUE(uu + ustride);
  __builtin_amdgcn_sched_barrier(0);
  __syncthreads();
#pragma unroll 1
  for (int pass = 0; pass < NPASS; ++pass) {
  const int kk = pass * 128 + (tid & 127);
  float qv[TL], kv[TL], bc[TL];
  if (MODE == 0) {
    const int j = kk & 63;
    const float invr = exp2f(-(float)j * (13.287712379549449f / 64.f)) * 0.15915494309189535f;
    const float lgam = log1pf(-exp2f(-5.f - (float)h));
#pragma unroll
    for (int i = 0; i < TL; ++i) {
      const int l = seg * TL + i;
      float rev = (float)(pos0 + l) * invr;
      rev -= floorf(rev);
      const float sn = __builtin_amdgcn_sinf(rev), cs = __builtin_amdgcn_cosf(rev);
      const float q1 = bf2f(rq[l * KS + j]), q2 = bf2f(rq[l * KS + j + 64]), k1 = bf2f(rk[l * KS + j]), k2 = bf2f(rk[l * KS + j + 64]);
      const float qr = (kk < 64) ? q1 * cs - q2 * sn : q1 * sn + q2 * cs;
      const float kr = (kk < 64) ? k1 * cs - k2 * sn : k1 * sn + k2 * cs;
      qv[i] = qr; kv[i] = kr * 0.08838834764831845f;
      bc[i] = lgam;
    }
  } else if (MODE == 1) {
    const int ch = h * 128 + kk;
    const float* lbp = p.in[11];
    float e0 = __expf(lbp[ch]), e1 = __expf(lbp[1024 + ch]), e2 = __expf(lbp[2048 + ch]);
    const float lb = e0 / (e0 + e1 + e2);
#pragma unroll
    for (int i = 0; i < TL; ++i) {
      const int l = seg * TL + i;
      const float qx = bf2f(rq[l * KS + kk]), fx = bf2f(rk[l * KS + kk]);
      qv[i] = siluf_(qx) * 0.08838834764831845f;
      const float sg = sigmoidf_(fx);
      const float f = lb + (1.f - lb) * sg;
      kv[i] = (1.f - lb) * (1.f - sg);
      bc[i] = __logf(f);
    }
  } else {
    const int ch = h * 256 + kk;
    const float* w2 = p.in[14];
    float wvv[16];
#pragma unroll
    for (int r = 0; r < 16; ++r) wvv[r] = w2[r * 1024 + ch];
    const float bias = p.in[15][ch];
#pragma unroll
    for (int i = 0; i < TL; ++i) {
      const int l = seg * TL + i;
      qv[i] = bf2f(rq[l * KS + kk]) * 0.0625f;
      kv[i] = bf2f(rk[l * KS + kk]);
      float x = bias;
#pragma unroll
      for (int r = 0; r < 16; ++r) x += gl[l * 16 + r] * wvv[r];
      const float ls = fminf(x, 0.f) - __logf(1.f + __expf(-fabsf(x)));
      bc[i] = ls * (1.f / 16.f);
    }
  }
#pragma unroll
  for (int i = 1; i < TL; ++i) bc[i] += bc[i - 1];
  segtot[seg * K + kk] = bc[TL - 1];
  __syncthreads();
  float pre = 0.f, bL = 0.f;
#pragma unroll
  for (int sg = 0; sg < NSEG; ++sg) { float t = segtot[sg * K + kk]; bL += t; if (sg < seg) pre += t; }
  const float eL = __expf(bL);
  if (seg == 0) dL[u * K + kk] = eL;
  unsigned kop[TL / 2];
#pragma unroll
  for (int i = 0; i < TL; i += 2) {
    float ko2[2];
#pragma unroll
    for (int e = 0; e < 2; ++e) {
      const int l = seg * TL + i + e;
      const float b = bc[i + e] + pre;
      const float eb = __expf(b), rb = __builtin_amdgcn_rcpf(eb);
      const float qi = qv[i + e] * eb;
      const float ki = kv[i + e] * rb;
      ko2[e] = ki * eL;
      const u16 qb = f2bf(qi);
      qs[l * KS + kk] = qb;
      ksm[l * KS + kk] = f2bf(ki);
    }
    kop[i / 2] = pack2(ko2[0], ko2[1]);
  }
  {
#pragma unroll
    for (int i = 0; i < TL / 8; ++i) {
      const int cc = seg * 2 + i;
      uint4* dst = (uint4*)(koT + u * K * 64 + ((((kk >> 4) * 2 + (cc >> 2)) * 64 + (cc & 3) * 16 + (kk & 15)) << 3));
      *dst = make_uint4(kop[i * 4 + 0], kop[i * 4 + 1], kop[i * 4 + 2], kop[i * 4 + 3]);
    }
  }
  }
  __syncthreads();
  for (int i = tid; i < 64 * (K / 8); i += 512) {
    const int r = i / (K / 8), cc = i % (K / 8);
    *(uint4*)(qin + u * 64 * K + ((((r >> 4) * (K / 32) + (cc >> 2)) * 64 + (cc & 3) * 16 + (r & 15)) << 3)) = *(const uint4*)(qs + r * KS + cc * 8);
  }
  {
    const int w = tid >> 6, lane = tid & 63, fr = lane & 15, fq = lane >> 4;
#pragma unroll 1
    for (int bi = 0; bi < 2; ++bi) {
      const int blk = w + bi * 8, lb = blk >> 2, sb = blk & 3;
      f32x4 acc = {0.f, 0.f, 0.f, 0.f};
      if (sb <= lb) {
#pragma unroll
        for (int kst = 0; kst < K / 32; ++kst) {
          bf16x8 a = *(const bf16x8*)(ksm + (sb * 16 + fr) * KS + kst * 32 + fq * 8);
          bf16x8 b = *(const bf16x8*)(qs + (lb * 16 + fr) * KS + kst * 32 + fq * 8);
          acc = __builtin_amdgcn_mfma_f32_16x16x32_bf16(a, b, acc, 0, 0, 0);
        }
      }
      const int l = lb * 16 + fr, s0 = sb * 16 + fq * 4;
      float v0 = (s0 + 0 <= l) ? acc[0] : 0.f, v1 = (s0 + 1 <= l) ? acc[1] : 0.f;
      float v2 = (s0 + 2 <= l) ? acc[2] : 0.f, v3 = (s0 + 3 <= l) ? acc[3] : 0.f;
      if (lb >= 2 || sb < 2) *(uint2*)(Pm + u * 4096 + ((((lb * 2 + (s0 >> 5)) * 64 + ((s0 & 31) >> 3) * 16 + fr) << 3) + (s0 & 7))) = make_uint2(pack2(v0, v1), pack2(v2, v3));
    }
  }
  }
}

template <int K, int V>
__device__ __forceinline__ void seq_unit(int wv, const u16* __restrict__ qin, const u16* __restrict__ koT, const u16* __restrict__ Pm, const u16* __restrict__ vsrc, int vld,
                         const float* __restrict__ dL, int H, int c0, int nch, int h, int vs,
                         const float* __restrict__ s0, float* __restrict__ sout, u16* __restrict__ o, int row0, int ocol, unsigned char* shm) {
  const int tix = tidx(wv);
  constexpr int NKB = K / 128, SST = K + 8;
  u16* ST = (u16*)shm;
  const int tid = tix, w = tid >> 6, lane = tid & 63, fr = lane & 15, fq = lane >> 4;
  f32x4 accS[NKB][2];
  __syncthreads();
#pragma unroll
  for (int kb = 0; kb < NKB; ++kb)
#pragma unroll
    for (int vb = 0; vb < 2; ++vb) {
      const int k = (w * NKB + kb) * 16 + fq * 4, vcol = vb * 16 + fr;
#pragma unroll
      for (int j = 0; j < 4; ++j) accS[kb][vb][j] = s0 ? s0[(size_t)(k + j) * V + vs * 32 + vcol] : 0.f;
      *(uint2*)(ST + vcol * SST + k) = make_uint2(pack2(accS[kb][vb][0], accS[kb][vb][1]), pack2(accS[kb][vb][2], accS[kb][vb][3]));
    }
  constexpr int VTS = 72, LOS = 40;
  u16* VT = ST + 2 * 32 * SST;
  u16* LO = VT + 2 * 32 * VTS;
  const int v_s = (tid >> 2) & 63, v_p = tid & 3;
  const u16* vrow = vsrc + (size_t)v_s * vld + v_p * 8;
  u32x4_t vreg = {0u, 0u, 0u, 0u};
  if (tid < 256) {
    vreg = *(const u32x4_t*)vrow;
#pragma unroll
    for (int j = 0; j < 4; ++j) {
      VT[(v_p * 8 + 2 * j) * VTS + v_s] = (u16)(vreg[j] & 0xffffu);
      VT[(v_p * 8 + 2 * j + 1) * VTS + v_s] = (u16)(vreg[j] >> 16);
    }
  }
  __syncthreads();
  int cur = 0;
  const int lb = w >> 1, ovb = w & 1;
  struct FragsO { bf16x8 op[2], oq[K / 32]; };
  struct FragsS { bf16x8 ka[NKB][2]; float4 d[NKB]; };
  auto load_o = [&](int ci, FragsO& f) {
    const size_t u = (size_t)(c0 + ci) * H + h;
    const u16* Pu = Pm + u * 4096;
    const u16* qu = qin + u * 64 * K;
#pragma unroll
    for (int ss = 0; ss < 2; ++ss) { if (ss == 0 || lb >= 2) f.op[ss] = *(const bf16x8*)(Pu + (((lb * 2 + ss) * 64 + lane) << 3)); else f.op[ss] = bf16x8{0, 0, 0, 0, 0, 0, 0, 0}; }
#pragma unroll
    for (int kst = 0; kst < K / 32; ++kst) f.oq[kst] = *(const bf16x8*)(qu + (((lb * (K / 32) + kst) * 64 + lane) << 3));
  };
  auto load_s = [&](int ci, FragsS& f) {
    const size_t u = (size_t)(c0 + ci) * H + h;
    const u16* ku = koT + u * K * 64;
    const float* du = dL + u * K;
#pragma unroll
    for (int kb = 0; kb < NKB; ++kb) {
      const int kbase = (w * NKB + kb) * 16;
      f.d[kb] = *(const float4*)(du + kbase + fq * 4);
      f.ka[kb][0] = *(const bf16x8*)(ku + ((((w * NKB + kb) * 2 + 0) * 64 + lane) << 3));
      f.ka[kb][1] = *(const bf16x8*)(ku + ((((w * NKB + kb) * 2 + 1) * 64 + lane) << 3));
    }
  };
  FragsO fo;
  FragsS f0;
  load_o(0, fo);
  load_s(0, f0);
  for (int ci = 0; ci < nch; ++ci) {
    const int cn = ci + 1 < nch ? ci + 1 : ci;
    FragsO fo1;
    FragsS f1;
    load_o(cn, fo1);
    load_s(cn, f1);
    if (tid < 256) vreg = *(const u32x4_t*)(vrow + (size_t)cn * 64 * vld);
    __builtin_amdgcn_sched_barrier(0);
    const u16* STc = ST + cur * 32 * SST;
    u16* STn = ST + (cur ^ 1) * 32 * SST;
    const u16* VTc = VT + cur * 32 * VTS;
    u16* VTn = VT + (cur ^ 1) * 32 * VTS;
    bf16x8 vf[2][2];
#pragma unroll
    for (int vb = 0; vb < 2; ++vb)
#pragma unroll
      for (int ss = 0; ss < 2; ++ss) vf[vb][ss] = *(const bf16x8*)(VTc + (vb * 16 + fr) * VTS + ss * 32 + fq * 8);
    if (ci > 0 && tid < 256) {
      const uint4 ov = *(const uint4*)(LO + ((ci - 1) & 1) * 64 * LOS + v_s * LOS + v_p * 8);
      *(uint4*)(o + (size_t)(row0 + (ci - 1) * 64 + v_s) * D + ocol + vs * 32 + v_p * 8) = ov;
    }
    f32x4 ao = {0.f, 0.f, 0.f, 0.f};
#pragma unroll
    for (int ss = 0; ss < 2; ++ss) {
      if (ss == 0 || lb >= 2) {
        bf16x8 a = *(const bf16x8*)(VTc + (ovb * 16 + fr) * VTS + ss * 32 + fq * 8);
        ao = __builtin_amdgcn_mfma_f32_16x16x32_bf16(a, fo.op[ss], ao, 0, 0, 0);
      }
    }
#pragma unroll
    for (int kst = 0; kst < K / 32; ++kst) {
      bf16x8 a = *(const bf16x8*)(STc + (ovb * 16 + fr) * SST + kst * 32 + fq * 8);
      ao = __builtin_amdgcn_mfma_f32_16x16x32_bf16(a, fo.oq[kst], ao, 0, 0, 0);
    }
    *(uint2*)(LO + (ci & 1) * 64 * LOS + (lb * 16 + fr) * LOS + ovb * 16 + fq * 4) = make_uint2(pack2(ao[0], ao[1]), pack2(ao[2], ao[3]));
#pragma unroll
    for (int kb = 0; kb < NKB; ++kb) {
      const int kbase = (w * NKB + kb) * 16;
      const float4 d4 = f0.d[kb];
#pragma unroll
      for (int vb = 0; vb < 2; ++vb) {
        f32x4 sv = accS[kb][vb];
        sv[0] *= d4.x; sv[1] *= d4.y; sv[2] *= d4.z; sv[3] *= d4.w;
        sv = __builtin_amdgcn_mfma_f32_16x16x32_bf16(f0.ka[kb][0], vf[vb][0], sv, 0, 0, 0);
        sv = __builtin_amdgcn_mfma_f32_16x16x32_bf16(f0.ka[kb][1], vf[vb][1], sv, 0, 0, 0);
        accS[kb][vb] = sv;
        *(uint2*)(STn + (vb * 16 + fr) * SST + kbase + fq * 4) = make_uint2(pack2(sv[0], sv[1]), pack2(sv[2], sv[3]));
      }
    }
    if (tid < 256) {
#pragma unroll
      for (int j = 0; j < 4; ++j) {
        VTn[(v_p * 8 + 2 * j) * VTS + v_s] = (u16)(vreg[j] & 0xffffu);
        VTn[(v_p * 8 + 2 * j + 1) * VTS + v_s] = (u16)(vreg[j] >> 16);
      }
    }
    asm volatile("s_waitcnt lgkmcnt(0)" ::: "memory");
    __builtin_amdgcn_s_barrier();
    asm volatile("" ::: "memory");
    cur ^= 1;
    f0 = f1;
    fo = fo1;
  }
  if (tid < 256) {
    const uint4 ov = *(const uint4*)(LO + ((nch - 1) & 1) * 64 * LOS + v_s * LOS + v_p * 8);
    *(uint4*)(o + (size_t)(row0 + (nch - 1) * 64 + v_s) * D + ocol + vs * 32 + v_p * 8) = ov;
  }
#pragma unroll
  for (int kb = 0; kb < NKB; ++kb)
#pragma unroll
    for (int vb = 0; vb < 2; ++vb) {
      const int k = (w * NKB + kb) * 16 + fq * 4, vcol = vb * 16 + fr;
#pragma unroll
      for (int j = 0; j < 4; ++j) sout[(size_t)(k + j) * V + vs * 32 + vcol] = accS[kb][vb][j];
    }
}

__device__ __forceinline__ void seq_even_phase(int wv, const Params& p, unsigned char* shm) {
  unsigned char* R = p.ws + OFF_R;
  u16* o = (u16*)(p.ws + OFF_H);
  for (int u = blockIdx.x; u < 768; u += gridDim.x) {
    if (u < 256) {
      const int x = u & 7, y = u >> 3;
      if (y < 16) {
        const int g = x * 2 + (y >> 3), b = g >> 2, h = g & 3, vs = y & 7;
        seq_unit<128, 256>(wv, (u16*)(R + R_QA), (u16*)(R + R_KA), (u16*)(R + R_PA), (const u16*)(p.ws + OFF_BIG) + (size_t)(b * 2048) * NINE + 1024 + h * 256 + vs * 32, NINE, (float*)(R + R_DA), 4, b * 32, 32, h, vs,
                           nullptr, p.out + O_RETP + (size_t)(b * 4 + h) * 128 * 256, o, b * 2048, h * 256, shm);
      } else {
        const int yy = y - 16, g = x * 4 + (yy >> 2), b = g >> 3, h = g & 7, vs = yy & 3;
        seq_unit<128, 128>(wv, (u16*)(R + R_QB), (u16*)(R + R_KB), (u16*)(R + R_PB), (const u16*)(p.ws + OFF_BIG) + (size_t)(b * 2048) * NINE + 5120 + h * 128 + vs * 32, NINE, (float*)(R + R_DB), 8, b * 32, 32, h, vs,
                           nullptr, p.out + O_HGP + (size_t)(b * 8 + h) * 128 * 128, o, b * 2048, 1024 + h * 128, shm);
      }
    } else if (u < 512) {
      int x = u - 256, b = x >> 5, h = (x >> 3) & 3, vs = x & 7;
      seq_unit<128, 256>(wv, (u16*)(R + R_QA), (u16*)(R + R_KA), (u16*)(R + R_PA), (const u16*)(p.ws + OFF_BIG) + (size_t)(MP + b * 64) * NINE + 1024 + h * 256 + vs * 32, NINE, (float*)(R + R_DA), 4, 128 + b, 1, h, vs,
                         p.in[2] + (size_t)(b * 4 + h) * 128 * 256, p.out + O_RETS + (size_t)(b * 4 + h) * 128 * 256, o, MP + b * 64, h * 256, shm);
    } else {
      int x = u - 512, b = x >> 5, h = (x >> 2) & 7, vs = x & 3;
      seq_unit<128, 128>(wv, (u16*)(R + R_QB), (u16*)(R + R_KB), (u16*)(R + R_PB), (const u16*)(p.ws + OFF_BIG) + (size_t)(MP + b * 64) * NINE + 5120 + h * 128 + vs * 32, NINE, (float*)(R + R_DB), 8, 128 + b, 1, h, vs,
                         p.in[3] + (size_t)(b * 8 + h) * 128 * 128, p.out + O_HGS + (size_t)(b * 8 + h) * 128 * 128, o, MP + b * 64, 1024 + h * 128, shm);
    }
  }
}
__device__ __forceinline__ void seq_odd_phase(int wv, const Params& p, unsigned char* shm) {
  unsigned char* R = p.ws + OFF_R;
  u16* o = (u16*)(p.ws + OFF_H);
  for (int u = blockIdx.x; u < 768; u += gridDim.x) {
    if (u < 256) {
      const int x = u & 7, y = u >> 3, g = x * 2 + (y >> 4), b = g >> 2, h = g & 3, vs = y & 15;
      seq_unit<256, 512>(wv, (u16*)(R + R_QC), (u16*)(R + R_KC), (u16*)(R + R_PC), (const u16*)(p.ws + OFF_BIG) + (size_t)(b * 2048) * NINO_PAD + 2048 + h * 512 + vs * 32, NINO_PAD, (float*)(R + R_DC), 4, b * 32, 32, h, vs,
                         nullptr, p.out + O_GLP + (size_t)(b * 4 + h) * 256 * 512, o, b * 2048, h * 512, shm);
    } else {
      int x = u - 256, b = x >> 6, h = (x >> 4) & 3, vs = x & 15;
      seq_unit<256, 512>(wv, (u16*)(R + R_QC), (u16*)(R + R_KC), (u16*)(R + R_PC), (const u16*)(p.ws + OFF_BIG) + (size_t)(MP + b * 64) * NINO_PAD + 2048 + h * 512 + vs * 32, NINO_PAD, (float*)(R + R_DC), 4, 128 + b, 1, h, vs,
                         p.in[4] + (size_t)(b * 4 + h) * 256 * 512, p.out + O_GLS + (size_t)(b * 4 + h) * 256 * 512, o, MP + b * 64, h * 512, shm);
    }
  }
}

__device__ __forceinline__ void up8(u32x4_t v, float* f) {
  f[0] = __uint_as_float(v[0] << 16); f[1] = __uint_as_float(v[0] & 0xffff0000u);
  f[2] = __uint_as_float(v[1] << 16); f[3] = __uint_as_float(v[1] & 0xffff0000u);
  f[4] = __uint_as_float(v[2] << 16); f[5] = __uint_as_float(v[2] & 0xffff0000u);
  f[6] = __uint_as_float(v[3] << 16); f[7] = __uint_as_float(v[3] & 0xffff0000u);
}
template <int ODD>
__device__ __forceinline__ void post_phase(int wv, const Params& p) {
  const int tix = tidx(wv);
  const int lane = tix & 63, gw = blockIdx.x * 8 + (tix >> 6), nw = gridDim.x * 8;
  const u16* o = (const u16*)(p.ws + OFF_H);
  const u16* proj = (const u16*)(p.ws + OFF_BIG);
  u16* ao = (u16*)(p.ws + OFF_R);
#define POST_LOAD(xr_, gr_, row_) do { const int r_ = (row_); \
    _Pragma("unroll") for (int i = 0; i < 4; ++i) { const int col_ = i * 512 + lane * 8; \
      xr_[i] = *(const u32x4_t*)(o + (size_t)r_ * D + col_); \
      gr_[i] = *(const u32x4_t*)(proj + (size_t)r_ * (ODD ? NINO_PAD : NINE) + (ODD ? 4096 + col_ : (i < 2 ? 2048 + col_ : 6144 + (col_ - 1024)))); } } while (0)
  u32x4_t xr[4], gr[4];
  if (gw < MT) POST_LOAD(xr, gr, gw);
#pragma unroll 1
  for (int row = gw; row < MT; row += nw) {
    u32x4_t xn[4], gn4[4];
    if (row + nw < MT) POST_LOAD(xn, gn4, row + nw);
    else {
#pragma unroll
      for (int i = 0; i < 4; ++i) { xn[i] = xr[i]; gn4[i] = gr[i]; }
    }
    __builtin_amdgcn_sched_barrier(0);
#pragma unroll
    for (int i = 0; i < 4; ++i) {
      const int col = i * 512 + lane * 8;
      float x[8], g[8], y[8];
      up8(xr[i], x);
      up8(gr[i], g);
      if (ODD) {
        float ss = 0.f;
#pragma unroll
        for (int e = 0; e < 8; ++e) ss += x[e] * x[e];
#pragma unroll
        for (int off = 32; off > 0; off >>= 1) ss += __shfl_xor(ss, off, 64);
        const float rs = rsqrtf(ss * (1.f / 512.f) + EPS);
        const float* gn = p.in[16] + lane * 8;
#pragma unroll
        for (int e = 0; e < 8; ++e) y[e] = x[e] * rs * gn[e] * siluf_(g[e]);
      } else if (i < 2) {
        float s1 = 0.f;
#pragma unroll
        for (int e = 0; e < 8; ++e) s1 += x[e];
#pragma unroll
        for (int off = 16; off > 0; off >>= 1) s1 += __shfl_xor(s1, off, 64);
        const float mu = s1 * (1.f / 256.f);
        float s2 = 0.f;
#pragma unroll
        for (int e = 0; e < 8; ++e) { float dlt = x[e] - mu; s2 += dlt * dlt; }
#pragma unroll
        for (int off = 16; off > 0; off >>= 1) s2 += __shfl_xor(s2, off, 64);
        const float rs = rsqrtf(s2 * (1.f / 256.f) + EPS);
#pragma unroll
        for (int e = 0; e < 8; ++e) y[e] = (x[e] - mu) * rs * siluf_(g[e]);
      } else {
        float ss = 0.f;
#pragma unroll
        for (int e = 0; e < 8; ++e) ss += x[e] * x[e];
#pragma unroll
        for (int off = 8; off > 0; off >>= 1) ss += __shfl_xor(ss, off, 64);
        const float rs = rsqrtf(ss * (1.f / 128.f) + EPS);
        const float* gn = p.in[12] + (lane & 15) * 8;
#pragma unroll
        for (int e = 0; e < 8; ++e) y[e] = x[e] * rs * gn[e] * siluf_(g[e]);
      }
      st8(ao + (size_t)row * D + col, y);
    }
#pragma unroll
    for (int i = 0; i < 4; ++i) { xr[i] = xn[i]; gr[i] = gn4[i]; }
  }
#undef POST_LOAD
}


__device__ __forceinline__ void final_norm_phase(int wv, const Params& p) {
  const int tix = tidx(wv);
  const int lane = tix & 63, gw = blockIdx.x * 8 + (tix >> 6), nw = gridDim.x * 8;
  const u16* hb = (const u16*)(p.ws + OFF_HN);
  const float* w = p.in[8];
  u32x4_t v[4];
  if (gw < MT) {
#pragma unroll
    for (int i = 0; i < 4; ++i) v[i] = *(const u32x4_t*)(hb + (size_t)gw * D + i * 512 + lane * 8);
  }
#pragma unroll 1
  for (int row = gw; row < MT; row += nw) {
    u32x4_t nx[4];
    const int nrow = row + nw < MT ? row + nw : row;
#pragma unroll
    for (int i = 0; i < 4; ++i) nx[i] = *(const u32x4_t*)(hb + (size_t)nrow * D + i * 512 + lane * 8);
    __builtin_amdgcn_sched_barrier(0);
    float x[4][8];
    float ss = 0.f;
#pragma unroll
    for (int i = 0; i < 4; ++i) {
      up8(v[i], x[i]);
#pragma unroll
      for (int e = 0; e < 8; ++e) ss += x[i][e] * x[i][e];
    }
#pragma unroll
    for (int o = 32; o > 0; o >>= 1) ss += __shfl_xor(ss, o, 64);
    const float rs = rsqrtf(ss * (1.f / D) + EPS);
    float* dst = (row < MP) ? p.out + O_YP + (size_t)row * D : p.out + O_YS + (size_t)(row - MP) * D;
#pragma unroll
    for (int i = 0; i < 4; ++i) {
      const int col = i * 512 + lane * 8;
      const float4 w0 = *(const float4*)(w + col), w1 = *(const float4*)(w + col + 4);
      *(float4*)(dst + col) = make_float4(x[i][0] * rs * w0.x, x[i][1] * rs * w0.y, x[i][2] * rs * w0.z, x[i][3] * rs * w0.w);
      *(float4*)(dst + col + 4) = make_float4(x[i][4] * rs * w1.x, x[i][5] * rs * w1.y, x[i][6] * rs * w1.z, x[i][7] * rs * w1.w);
    }
#pragma unroll
    for (int i = 0; i < 4; ++i) v[i] = nx[i];
  }
}

__device__ __forceinline__ void gate_phase(int wv, const Params& p, int layer) {
  const int tix = tidx(wv);
  const u16* au = (const u16*)(p.ws + OFF_BIG);
  u16* gg = (u16*)(p.ws + OFF_R);
  const float* cw = p.in[19] + (size_t)layer * 3 * DFF;
  const float* cb = p.in[20] + (size_t)layer * DFF;
  const float* cache = p.in[5] + (size_t)layer * 8 * 2 * DFF;
  const int nitems = (MT / 16) * (DFF / 8);
  for (int it = blockIdx.x * 512 + tix; it < nitems; it += gridDim.x * 512) {
    const int cg8 = it % (DFF / 8), rb = it / (DFF / 8), c0 = cg8 * 8, r0 = rb * 16;
    float w0[8], w1[8], w2[8], bb[8], am2[8], am1[8];
#pragma unroll
    for (int e = 0; e < 8; ++e) { w0[e] = cw[c0 + e]; w1[e] = cw[DFF + c0 + e]; w2[e] = cw[2 * DFF + c0 + e]; bb[e] = cb[c0 + e]; }
    int t0, T, b; bool samp = r0 >= MP;
    if (!samp) { b = r0 >> 11; t0 = r0 & 2047; T = 2048; } else { b = (r0 - MP) >> 6; t0 = (r0 - MP) & 63; T = 64; }
    if (t0 == 0) {
      if (samp) {
#pragma unroll
        for (int e = 0; e < 8; ++e) { am2[e] = cache[(size_t)(b * 2 + 0) * DFF + c0 + e]; am1[e] = cache[(size_t)(b * 2 + 1) * DFF + c0 + e]; }
      } else {
#pragma unroll
        for (int e = 0; e < 8; ++e) { am2[e] = 0.f; am1[e] = 0.f; }
      }
    } else {
      ld8(au + (size_t)(r0 - 2) * NUP + c0, am2);
      ld8(au + (size_t)(r0 - 1) * NUP + c0, am1);
    }
#pragma unroll 4
    for (int i = 0; i < 16; ++i) {
      float a[8], uu[8], y[8];
      ld8(au + (size_t)(r0 + i) * NUP + c0, a);
      ld8(au + (size_t)(r0 + i) * NUP + DFF + c0, uu);
#pragma unroll
      for (int e = 0; e < 8; ++e) {
        float cv = bb[e] + w0[e] * am2[e] + w1[e] * am1[e] + w2[e] * a[e];
        y[e] = siluf_(cv) * uu[e];
        am2[e] = am1[e]; am1[e] = a[e];
      }
      st8(gg + (size_t)(r0 + i) * DFF + c0, y);
    }
    if (t0 + 16 == T) {
      float* dst = samp ? p.out + O_CVS + (size_t)(layer * 8 + b) * 2 * DFF : p.out + O_CVP + (size_t)(layer * 4 + b) * 2 * DFF;
#pragma unroll
      for (int e = 0; e < 8; ++e) { dst[c0 + e] = am2[e]; dst[DFF + c0 + e] = am1[e]; }
    }
  }
}


__device__ __forceinline__ void gate_fixup(int wv, const Params& p, int layer) {
  const int tix = tidx(wv);
  const u16* side = (const u16*)(p.ws + OFF_SIDE);
  u16* gg = (u16*)(p.ws + OFF_R);
  const float* cw = p.in[19] + (size_t)layer * 3 * DFF;
  const float* cb = p.in[20] + (size_t)layer * DFF;
  for (int vw = blockIdx.x; vw < (MP / BM) * (D / BM); vw += gridDim.x) {
    int pm, pn;
    tile_coords(vw, MP / BM, D / BM, pm, pn);
    if ((pm & 7) == 0) continue;
    for (int c8 = tix; c8 < DFF / 8; c8 += 512) {
      const int c = c8 * 8;
      float a0[8], a1[8], u0[8], u1[8], q2[8], q1[8], y0[8], y1[8];
      ld8(side + (size_t)(pm * 2 + 0) * DFF + c, a0);
      ld8(side + (size_t)(pm * 2 + 1) * DFF + c, a1);
      ld8(side + SZ_SIDE1 / 2 + (size_t)(pm * 2 + 0) * DFF + c, u0);
      ld8(side + SZ_SIDE1 / 2 + (size_t)(pm * 2 + 1) * DFF + c, u1);
      ld8(side + SZ_SIDE1 + (size_t)((pm - 1) * 2 + 0) * DFF + c, q2);
      ld8(side + SZ_SIDE1 + (size_t)((pm - 1) * 2 + 1) * DFF + c, q1);
#pragma unroll
      for (int e = 0; e < 8; ++e) {
        const float w0 = cw[c + e], w1 = cw[DFF + c + e], w2 = cw[2 * DFF + c + e], bb = cb[c + e];
        y0[e] = siluf_(bb + w0 * q2[e] + w1 * q1[e] + w2 * a0[e]) * u0[e];
        y1[e] = siluf_(bb + w0 * q1[e] + w1 * a0[e] + w2 * a1[e]) * u1[e];
      }
      st8(gg + (size_t)(pm * 256 + 0) * DFF + c, y0);
      st8(gg + (size_t)(pm * 256 + 1) * DFF + c, y1);
    }
  }
  asm volatile("s_waitcnt vmcnt(0)" ::: "memory");
  __syncthreads();
}

#define XB_TMO      128
#define XB_XCNT(j)  (256  + 64 * (j))
#define XB_XSUB(j)  (1280 + 64 * (j))
#define XB_XGEN(j)  (2304 + 64 * (j))
#define XB_TOP      3328
#define XB_TOPGEN   3392
#define XCD_BAR_WORDS 3456
#define XB_SPIN_CAP (1u << 22)
#define LAS __attribute__((address_space(3)))
__device__ __forceinline__ unsigned xb_ld(unsigned* p)              { return __hip_atomic_load(p, __ATOMIC_RELAXED, __HIP_MEMORY_SCOPE_AGENT); }
__device__ __forceinline__ unsigned xb_add(unsigned* p, unsigned v) { return __hip_atomic_fetch_add(p, v, __ATOMIC_RELAXED, __HIP_MEMORY_SCOPE_AGENT); }
__device__ __forceinline__ unsigned xb_xcc_id() { return (unsigned)__builtin_amdgcn_s_getreg((3 << 11) | 20) & 0xFu; }
#define XB_SPIN(cond, bar) do { unsigned _sp = 0; while (cond) { __builtin_amdgcn_s_sleep(1); \
    if ((++_sp & 255u) == 0u) { if (xb_ld(&(bar)[XB_TMO])) break; if (_sp > XB_SPIN_CAP) { atomicAdd(&(bar)[XB_TMO], 1u); break; } } } } while (0)
struct XcdBarrier { unsigned* bar; unsigned x; volatile LAS unsigned* st; };
__device__ __forceinline__ XcdBarrier xcd_barrier_post(int wv, unsigned* bar, volatile LAS unsigned* st) {
  XcdBarrier b; b.bar = bar; b.x = xb_xcc_id(); b.st = st;
  if (tidx(wv) == 0) (void)xb_add(&bar[XB_XCNT(b.x)], 1u);
  return b;
}
__device__ __forceinline__ void xcd_barrier_complete(unsigned* bar, unsigned x, unsigned& nloc, unsigned& nx) {
  const unsigned G = gridDim.x * gridDim.y * gridDim.z;
  unsigned sum, cnt, mine, sp = 0u;
  for (;;) {
    sum = 0u; cnt = 0u; mine = 0u;
#pragma unroll
    for (unsigned j = 0; j < 16; ++j) { const unsigned c = xb_ld(&bar[XB_XCNT(j)]); sum += c; cnt += (c > 0u) ? 1u : 0u; mine = (j == x) ? c : mine; }
    if (sum == G) break;
    __builtin_amdgcn_s_sleep(1);
    if ((++sp & 255u) == 0u) { if (xb_ld(&bar[XB_TMO])) break; if (sp > XB_SPIN_CAP) { atomicAdd(&bar[XB_TMO], 1u); break; } }
  }
  nloc = mine > 0u ? mine : 1u; nx = cnt > 0u ? cnt : 1u;
}
__device__ __forceinline__ void xcd_barrier(int wv, const XcdBarrier& b) {
  asm volatile("s_waitcnt vmcnt(0)" ::: "memory");
  __syncthreads();
  if (tidx(wv) == 0) {
    unsigned* bar = b.bar;
    __builtin_amdgcn_s_waitcnt(0);
    unsigned nloc = b.st[0], nx = b.st[1];
    if (nloc == 0u) { xcd_barrier_complete(bar, b.x, nloc, nx); b.st[0] = nloc; b.st[1] = nx; }
    const unsigned old = xb_add(&bar[XB_XSUB(b.x)], 1u);
    const unsigned gen = old / nloc;
    if (old + 1u == (gen + 1u) * nloc) {
      __builtin_amdgcn_fence(__ATOMIC_RELEASE, "agent");
      asm volatile("s_waitcnt vmcnt(0)" ::: "memory");
      const unsigned og = xb_add(&bar[XB_TOP], 1u);
      const unsigned tg = og / nx;
      if (og + 1u == (tg + 1u) * nx) xb_add(&bar[XB_TOPGEN], 1u);
      else XB_SPIN(xb_ld(&bar[XB_TOPGEN]) == tg, bar);
      __builtin_amdgcn_fence(__ATOMIC_ACQUIRE, "agent");
      xb_add(&bar[XB_XGEN(b.x)], 1u);
      asm volatile("s_waitcnt vmcnt(0)" ::: "memory");
    } else {
      XB_SPIN(xb_ld(&bar[XB_XGEN(b.x)]) == gen, bar);
      __builtin_amdgcn_fence(__ATOMIC_ACQUIRE, "agent");
      asm volatile("s_waitcnt vmcnt(0)" ::: "memory");
    }
  }
  __syncthreads();
}

constexpr int NPHASE = 21;
#ifndef PHMASK
#define PHMASK 0xFFFFFFFFu
#endif
#define PH_ON(k) (((PHMASK) >> (k)) & 1u)
constexpr int LDS_BYTES = 147456;

typedef const __attribute__((address_space(4))) Params* KParamsPtr;
#ifndef XSYNC
#define XSYNC 0
#endif
#ifndef DUPMASK
#define DUPMASK 0u
#endif
#define DUP_ON(k) (((DUPMASK) >> (k)) & 1u)
__device__ __forceinline__ bool ph_in(KParamsPtr& kp, int k) { asm volatile("" : "+s"(kp)); return kp->ph_lo <= k && k < kp->ph_hi; }
#define PH_IN(k) ph_in(kp, (k))
#define PHASE(k, ...) if (PH_IN(k)) { if (PH_ON(k)) { for (int rep = 0; rep < 1 + (int)DUP_ON(k); ++rep) { asm volatile("" : "+s"(kp)); Params p; __builtin_memcpy(&p, kp, sizeof(Params)); unsigned char* ws = p.ws; __VA_ARGS__ } } \
    asm volatile("" : "+s"(kp)); \
    if (kp->coop && (k) + 1 < kp->ph_hi) { XcdBarrier xb; xb.bar = (unsigned*)(kp->ws + OFF_BAR); xb.x = xb_xcc_id(); xb.st = (volatile LAS unsigned*)&xb_words; xcd_barrier(wv, xb); if (XSYNC) xcd_barrier(wv, xb); } }
#define PHASE_X(k, ...) if (PH_IN(k)) { asm volatile("" : "+s"(kp)); Params p; __builtin_memcpy(&p, kp, sizeof(Params)); unsigned char* ws = p.ws; __VA_ARGS__ }
#define GEMM_ACC(k, Aoff, Woff, KK, RSSP, FIXL, RINP, RINS) PHASE(k, { float* rssp = (RSSP); if ((FIXL) >= 0) gate_fixup(wv, p, FIXL); \
    gemm_phase<MP, D, KK, 0>(wv, (const u16*)(ws + Aoff), (const u16*)(ws + Woff), EpiAccum{(u16*)(ws + OFF_HN), rssp, (RINP)}, (u16*)shm); \
    gemm_tail_phase<KK>(wv, (const u16*)(ws + Aoff), (const u16*)(ws + Woff), (float*)shm, (u16*)(ws + OFF_HN), rssp, (RINS)); })

__global__ void __launch_bounds__(512) fwd_kernel(Params p_) {
  extern __shared__ __attribute__((aligned(16))) unsigned char shm[];
  cg::grid_group grid = cg::this_grid();
  KParamsPtr kp = (KParamsPtr)__builtin_amdgcn_kernarg_segment_ptr();
  const int wv = __builtin_amdgcn_readfirstlane((int)(threadIdx.x >> 6));
  __shared__ uint4 xb_words;
  if (tidx(wv) == 0) xb_words = make_uint4(0u, 0u, 0u, 0u);
  __syncthreads();
  if (kp->coop == 2) grid.sync();
  (void)xcd_barrier_post(wv, (unsigned*)(kp->ws + OFF_BAR), (volatile LAS unsigned*)&xb_words);
  PHASE(0,
        convert_w(wv, p.in[9], (u16*)(ws + OFF_WINE), D, NINE, NINE, (u16*)shm);
        convert_w(wv, p.in[10], (u16*)(ws + OFF_WOUTE), D, D, D, (u16*)shm);
        convert_w(wv, p.in[13], (u16*)(ws + OFF_WINO), D, NINO, NINO_PAD, (u16*)shm, p.in[6] + D);
        convert_w(wv, p.in[17], (u16*)(ws + OFF_WOUTO), D, D, D, (u16*)shm);
        convert_w(wv, p.in[18], (u16*)(ws + OFF_WUP0), D, NUP, NUP, (u16*)shm, p.in[7], 1);
        convert_w(wv, p.in[18] + (size_t)D * NUP, (u16*)(ws + OFF_WUP1), D, NUP, NUP, (u16*)shm, p.in[7] + D, 1);
        convert_w(wv, p.in[21], (u16*)(ws + OFF_WDN0), DFF, D, D, (u16*)shm);
        convert_w(wv, p.in[21] + (size_t)DFF * D, (u16*)(ws + OFF_WDN1), DFF, D, D, (u16*)shm);
        for (int i = blockIdx.x * 512 + tidx(wv); i < 3 * MT; i += gridDim.x * 512) ((float*)(ws + OFF_RSS))[i] = 0.f;
        rmsnorm_phase<0>(wv, p, p.in[6]);)
  PHASE(1, gemm_phase<MT, NINE, D, 0>(wv, (const u16*)(ws + OFF_HN), (const u16*)(ws + OFF_WINE), EpiStoreBf16{(u16*)(ws + OFF_BIG), NINE, nullptr}, (u16*)shm);)
  PHASE(2, { const int b_ = blockIdx.x, G_ = gridDim.x;
        prep_range<0>(wv, p, b_, NCH * 4, G_, shm);
        const int first1 = ((NCH * 4 - b_ + G_ - 1) / G_) * G_ + b_ - NCH * 4;
        prep_range<1>(wv, p, first1, NCH * 8, G_, shm); })
  PHASE(3, seq_even_phase(wv, p, shm);)
  PHASE(4, post_phase<0>(wv, p);)
  GEMM_ACC(5, OFF_R, OFF_WOUTE, D, (float*)(ws + OFF_RSS), -1, p.in[0], p.in[1])
  PHASE(7, gemm_phase<MT, NUP, D, 0>(wv, (const u16*)(ws + OFF_HN), (const u16*)(ws + OFF_WUP0), EpiGate{(const __attribute__((address_space(4))) void*)kp, 0, 0}, (u16*)shm);)
  GEMM_ACC(9, OFF_R, OFF_WDN0, DFF, (float*)(ws + OFF_RSS) + MT, 0, (const float*)nullptr, (const float*)nullptr)
  PHASE(11, gemm_phase<MT, NINO_PAD, D, 0>(wv, (const u16*)(ws + OFF_HN), (const u16*)(ws + OFF_WINO), EpiStoreBf16{(u16*)(ws + OFF_BIG), NINO_PAD, (const float*)(ws + OFF_RSS) + MT}, (u16*)shm);)
  PHASE(12, prep_range<2>(wv, p, blockIdx.x, NCH * 4, gridDim.x, shm);)
  PHASE(13, seq_odd_phase(wv, p, shm);)
  PHASE(14, post_phase<1>(wv, p);)
  GEMM_ACC(15, OFF_R, OFF_WOUTO, D, (float*)(ws + OFF_RSS) + 2 * MT, -1, (const float*)nullptr, (const float*)nullptr)
  PHASE(17, gemm_phase<MT, NUP, D, 0>(wv, (const u16*)(ws + OFF_HN), (const u16*)(ws + OFF_WUP1), EpiGate{(const __attribute__((address_space(4))) void*)kp, 1, 2 * MT}, (u16*)shm);)
  GEMM_ACC(19, OFF_R, OFF_WDN1, DFF, (float*)nullptr, 1, (const float*)nullptr, (const float*)nullptr)
  PHASE(20, final_norm_phase(wv, p);)
}

extern "C" void kernel_launch(void* const* d_in, const int* in_sizes, int n_in, void* d_out, int out_size, void* d_ws, size_t ws_size,
                              hipStream_t stream) {
  static int grid_blocks = 0;
  if (grid_blocks == 0) {
    int dev = 0, cus = 0, per_cu = 0;
    hipGetDevice(&dev);
    hipDeviceGetAttribute(&cus, hipDeviceAttributeMultiprocessorCount, dev);
    hipFuncSetAttribute((const void*)fwd_kernel, hipFuncAttributeMaxDynamicSharedMemorySize, LDS_BYTES);
    hipOccupancyMaxActiveBlocksPerMultiprocessor(&per_cu, (const void*)fwd_kernel, 512, LDS_BYTES);
    if (per_cu < 1) per_cu = 1;
    grid_blocks = cus * per_cu;
    (void)hipGetLastError();
  }
  if (n_in != 22 || ws_size < WS_NEED || (size_t)out_size != O_END) {
    fprintf(stderr, "kernel_launch: unexpected sizes n_in=%d ws=%zu need=%zu out=%d\n", n_in, ws_size, (size_t)WS_NEED, out_size);
    hipMemsetAsync(d_out, 0, (size_t)out_size * 4, stream);
    return;
  }
  Params p{};
  for (int i = 0; i < 22; ++i) p.in[i] = (const float*)d_in[i];
  p.out = (float*)d_out;
  p.ws = (unsigned char*)d_ws;
#if 0
  for (int ph = 0; ph < NPHASE; ++ph) {
    p.ph_lo = ph; p.ph_hi = ph + 1; p.coop = 0;
    hipLaunchKernelGGL(fwd_kernel, dim3(grid_blocks), dim3(512), LDS_BYTES, stream, p);
  }
#else
  p.ph_lo = 0; p.ph_hi = NPHASE; p.coop = 1;
  hipMemsetAsync((unsigned char*)d_ws + OFF_BAR, 0, XCD_BAR_WORDS * 4, stream);
  void* args[] = {&p};
  hipError_t e = hipLaunchCooperativeKernel((const void*)fwd_kernel, dim3(grid_blocks), dim3(512), args, LDS_BYTES, stream);
  if (e != hipSuccess) fprintf(stderr, "cooperative launch failed: %s (grid %d)\n", hipGetErrorString(e), grid_blocks);
#endif
}
```
